# Optimizing an MI355X kernel written in HIP

```python
import jax, jax.numpy as jnp
from jax import lax
import numpy as np

D_MODEL = 1024
BATCH = 8
SEQ = 4096
DEPTH = 2
DEC_BATCH = 4
DEC_SEQ = 8192
PAST_LEN = 128

HEAD_DIM = 64
N_ATTN_HEADS = 8
ATTN_WIDTH = N_ATTN_HEADS * HEAD_DIM
DILATED_PATTERNS = ((128, 1), (512, 4), (2048, 16))
ROT_DIM = HEAD_DIM // 4
ROPE_THETA = 500000.0
N_DN_HEADS = 4
DN_HEAD_DIM = 128
DN_WIDTH = N_DN_HEADS * DN_HEAD_DIM
CHUNK = 64
CONV_K = 5
D_FF = 2816
IN_WIDTH = 3 * ATTN_WIDTH + 4 * DN_WIDTH + 4 * N_DN_HEADS
MIX_WIDTH = ATTN_WIDTH + DN_WIDTH
N_MOD = 9
EPS = 1e-6

kernel_name = "hybrid_dilated_attn_gated_deltanet_encoder"


def _rmsnorm(x, w):
    xf = x.astype(jnp.float32)
    y = xf * lax.rsqrt(jnp.mean(xf * xf, axis=-1, keepdims=True) + EPS)
    return (y * w.astype(jnp.float32)).astype(x.dtype)


def _l2norm(x):
    return x * lax.rsqrt(jnp.sum(x * x, axis=-1, keepdims=True) + EPS)


def _partial_rope(x):
    S = x.shape[1]
    half = ROT_DIM // 2
    inv = ROPE_THETA ** (-jnp.arange(half, dtype=jnp.float32) / half)
    ang = jnp.arange(S, dtype=jnp.float32)[:, None] * inv[None, :]
    cos = jnp.cos(ang)[None, :, None, :]
    sin = jnp.sin(ang)[None, :, None, :]
    xr = x[..., :ROT_DIM].astype(jnp.float32)
    x1, x2 = xr[..., :half], xr[..., half:]
    rot = jnp.concatenate([x1 * cos - x2 * sin, x2 * cos + x1 * sin], axis=-1).astype(x.dtype)
    return jnp.concatenate([rot, x[..., ROT_DIM:]], axis=-1)


def _dilated_window_attn(q, k, v, dilation, radius):
    B, S, H, Dh = q.shape
    L = S // dilation
    G = B * dilation

    def to_sub(t):
        return t.reshape(B, L, dilation, H, Dh).transpose(0, 2, 1, 3, 4).reshape(G, L, H, Dh)

    qs, ks, vs = to_sub(q), to_sub(k), to_sub(v)
    nb = -(-L // radius)
    Lp = nb * radius
    qb = jnp.pad(qs, ((0, 0), (0, Lp - L), (0, 0), (0, 0))).reshape(G, nb, radius, H, Dh)

    def kblocks(t):
        tp = jnp.pad(t, ((0, 0), (radius, Lp - L + radius), (0, 0), (0, 0))).reshape(G, nb + 2, radius, H, Dh)
        return jnp.concatenate([tp[:, :-2], tp[:, 1:-1], tp[:, 2:]], axis=2)

    kb, vb = kblocks(ks), kblocks(vs)
    qpos = np.arange(nb)[:, None] * radius + np.arange(radius)[None, :]
    kpos = np.arange(nb)[:, None] * radius - radius + np.arange(3 * radius)[None, :]
    valid = ((kpos[:, None, :] >= 0) & (kpos[:, None, :] < L)
             & (np.abs(qpos[:, :, None] - kpos[:, None, :]) <= radius))

    scores = jnp.einsum('gnqhd,gnkhd->gnhqk', qb, kb).astype(jnp.float32) * (Dh ** -0.5)
    scores = jnp.where(valid[None, :, None], scores, -1e30)
    m = jnp.max(scores, axis=-1, keepdims=True)
    p = jnp.exp(scores - m)
    denom = jnp.sum(p, axis=-1, keepdims=True)
    o = jnp.einsum('gnhqk,gnkhd->gnhqd', p, vb.astype(jnp.float32)) / denom
    lse = (m + jnp.log(denom))[..., 0]

    o = o.transpose(0, 1, 3, 2, 4).reshape(G, Lp, H, Dh)[:, :L]
    o = o.reshape(B, dilation, L, H, Dh).transpose(0, 2, 1, 3, 4).reshape(B, S, H, Dh)
    lse = lse.transpose(0, 1, 3, 2).reshape(G, Lp, H)[:, :L]
    lse = lse.reshape(B, dilation, L, H).transpose(0, 2, 1, 3).reshape(B, S, H)
    return o, lse


def _short_conv(x, w):
    S = x.shape[1]
    pad = CONV_K // 2
    xp = jnp.pad(x, ((0, 0), (pad, pad), (0, 0)))
    y = xp[:, 0:S] * w[0]
    for j in range(1, CONV_K):
        y = y + xp[:, j:j + S] * w[j]
    return jax.nn.silu(y)


def _gated_delta_chunked(q, k, v, g, beta):
    B, S, H, Dk = q.shape
    Dv = v.shape[-1]
    N = S // CHUNK

    def chunks(t):
        return t.reshape(B, N, CHUNK, H, t.shape[-1]).transpose(1, 0, 3, 2, 4)

    qc, kc, vc = chunks(q), chunks(k), chunks(v)
    gc = jnp.cumsum(g.reshape(B, N, CHUNK, H).transpose(1, 0, 3, 2), axis=-1)
    bc = beta.reshape(B, N, CHUNK, H).transpose(1, 0, 3, 2)
    lower = np.tril(np.ones((CHUNK, CHUNK), dtype=bool))
    strict = np.tril(np.ones((CHUNK, CHUNK), dtype=bool), -1)
    decay = jnp.exp(jnp.where(lower, gc[..., :, None] - gc[..., None, :], -jnp.inf))
    kbeta = kc * bc[..., None]
    A = jnp.where(strict, jnp.einsum('nbhid,nbhjd->nbhij', kbeta, kc) * decay, 0.0)
    eye = jnp.eye(CHUNK, dtype=jnp.float32)
    T = lax.linalg.triangular_solve(eye + A, jnp.broadcast_to(eye, A.shape), left_side=True, lower=True)
    u = T @ (vc * bc[..., None])
    w = T @ (kbeta * jnp.exp(gc)[..., None])
    qk = jnp.einsum('nbhid,nbhjd->nbhij', qc, kc) * decay

    def step(state, xs):
        q_i, k_i, u_i, w_i, qk_i, g_i = xs
        v_new = u_i - w_i @ state
        o = (q_i * jnp.exp(g_i)[..., None]) @ state + qk_i @ v_new
        g_last = g_i[..., -1]
        k_dec = k_i * jnp.exp(g_last[..., None] - g_i)[..., None]
        state = state * jnp.exp(g_last)[..., None, None] + jnp.einsum('bhcd,bhce->bhde', k_dec, v_new)
        return state, o

    state0 = jnp.zeros((B, H, Dk, Dv), jnp.float32)
    _, o = lax.scan(step, state0, (qc, kc, u, w, qk, gc))
    return o.transpose(1, 0, 3, 2, 4).reshape(B, S, H, Dv)


def _mixer(h, w_in, conv_w, a_log, dt_bias, dn_norm, w_out):
    B, S, _ = h.shape
    proj = h @ w_in
    aq, ak, av, dn_qkv, z, a, b = jnp.split(
        proj, [ATTN_WIDTH, 2 * ATTN_WIDTH, 3 * ATTN_WIDTH, 3 * ATTN_WIDTH + 3 * DN_WIDTH,
               3 * ATTN_WIDTH + 4 * DN_WIDTH, 3 * ATTN_WIDTH + 4 * DN_WIDTH + 2 * N_DN_HEADS], axis=-1)

    aq = _partial_rope(aq.reshape(B, S, N_ATTN_HEADS, HEAD_DIM))
    ak = _partial_rope(ak.reshape(B, S, N_ATTN_HEADS, HEAD_DIM))
    av = av.reshape(B, S, N_ATTN_HEADS, HEAD_DIM)
    outs, lses = [], []
    for window, dil in DILATED_PATTERNS:
        o_g, lse_g = _dilated_window_attn(aq, ak, av, dil, window // (2 * dil))
        outs.append(o_g)
        lses.append(lse_g)
    wts = jax.nn.softmax(jnp.stack(lses, axis=0), axis=0)
    attn = jnp.sum(wts[..., None] * jnp.stack(outs, axis=0), axis=0)
    attn = attn.reshape(B, S, ATTN_WIDTH).astype(h.dtype)

    qkv = _short_conv(dn_qkv, conv_w).astype(jnp.float32)
    dq, dk, dv = jnp.split(qkv, 3, axis=-1)
    dq = _l2norm(dq.reshape(B, S, N_DN_HEADS, DN_HEAD_DIM)) * (DN_HEAD_DIM ** -0.5)
    dk = _l2norm(dk.reshape(B, S, N_DN_HEADS, DN_HEAD_DIM))
    dv = dv.reshape(B, S, N_DN_HEADS, DN_HEAD_DIM)
    a = a.astype(jnp.float32).reshape(B, S, 2, N_DN_HEADS)
    g = -jnp.exp(a_log.astype(jnp.float32)) * jax.nn.softplus(a + dt_bias.astype(jnp.float32))
    beta = jax.nn.sigmoid(b.astype(jnp.float32).reshape(B, S, 2, N_DN_HEADS))
    o_f = _gated_delta_chunked(dq, dk, dv, g[:, :, 0], beta[:, :, 0])
    flip = lambda t: jnp.flip(t, axis=1)
    o_b = flip(_gated_delta_chunked(flip(dq), flip(dk), flip(dv), flip(g[:, :, 1]), flip(beta[:, :, 1])))
    o = o_f + o_b
    zf = z.astype(jnp.float32).reshape(B, S, N_DN_HEADS, DN_HEAD_DIM)
    o = o * lax.rsqrt(jnp.mean(o * o, axis=-1, keepdims=True) + EPS) * dn_norm.astype(jnp.float32) * jax.nn.silu(zf)
    dn = o.reshape(B, S, DN_WIDTH).astype(h.dtype)

    return jnp.concatenate([attn, dn], axis=-1) @ w_out


def _swiglu(h, w_gate, w_up, w_down):
    return (jax.nn.silu(h @ w_gate) * (h @ w_up)) @ w_down


def _trunk(x, c, ada_w, ada_b, norm_ffn1, ffn1_w_gate, ffn1_w_up, ffn1_w_down, norm_mix, w_in, conv_w,
           a_log, dt_bias, dn_norm, w_out, norm_ffn2, ffn2_w_gate, ffn2_w_up, ffn2_w_down, norm_final):
    sc = jax.nn.silu(c)
    for l in range(DEPTH):
        mod = (sc @ ada_w[l] + ada_b[l])[:, None, :]
        sh1, sc1, gt1, sh2, sc2, gt2, sh3, sc3, gt3 = jnp.split(mod, N_MOD, axis=-1)
        h = _rmsnorm(x, norm_ffn1[l]) * (1 + sc1) + sh1
        x = x + 0.5 * gt1 * _swiglu(h, ffn1_w_gate[l], ffn1_w_up[l], ffn1_w_down[l])
        h = _rmsnorm(x, norm_mix[l]) * (1 + sc2) + sh2
        x = x + gt2 * _mixer(h, w_in[l], conv_w[l], a_log[l], dt_bias[l], dn_norm[l], w_out[l])
        h = _rmsnorm(x, norm_ffn2[l]) * (1 + sc3) + sh3
        x = x + 0.5 * gt3 * _swiglu(h, ffn2_w_gate[l], ffn2_w_up[l], ffn2_w_down[l])
    return _rmsnorm(x, norm_final)


def setup_inputs(seed: int = 0) -> dict:
    key = jax.random.key(seed)
    ks = jax.random.split(key, 24)
    f32 = jnp.float32
    D, F = D_MODEL, D_FF
    nrm = lambda k, shape, scale: jax.random.normal(k, shape, f32) * scale
    gain = lambda k, shape: 1.0 + 0.02 * jax.random.normal(k, shape, f32)
    dt = jnp.exp(jax.random.uniform(ks[13], (DEPTH, 2, N_DN_HEADS), f32, np.log(1e-3), np.log(1e-1)))
    return {
        "x_prompt": nrm(ks[0], (BATCH, SEQ, D), 1.0),
        "x_sample": nrm(ks[1], (DEC_BATCH, DEC_SEQ, D), 1.0),
        "c_prompt": nrm(ks[2], (BATCH, D), 1.0),
        "c_sample": nrm(ks[3], (DEC_BATCH, D), 1.0),
        "ada_w": nrm(ks[4], (DEPTH, D, N_MOD * D), D ** -0.5),
        "ada_b": nrm(ks[5], (DEPTH, N_MOD * D), 0.02),
        "norm_ffn1": gain(ks[6], (DEPTH, D)),
        "ffn1_w_gate": nrm(ks[7], (DEPTH, D, F), D ** -0.5),
        "ffn1_w_up": nrm(ks[8], (DEPTH, D, F), D ** -0.5),
        "ffn1_w_down": nrm(ks[9], (DEPTH, F, D), F ** -0.5),
        "norm_mix": gain(ks[10], (DEPTH, D)),
        "w_in": nrm(ks[11], (DEPTH, D, IN_WIDTH), D ** -0.5),
        "conv_w": nrm(ks[12], (DEPTH, CONV_K, 3 * DN_WIDTH), CONV_K ** -0.5),
        "a_log": jnp.log(jax.random.uniform(ks[14], (DEPTH, 2, N_DN_HEADS), f32, 1.0, 16.0)),
        "dt_bias": dt + jnp.log(-jnp.expm1(-dt)),
        "dn_norm": gain(ks[15], (DEPTH, DN_HEAD_DIM)),
        "w_out": nrm(ks[16], (DEPTH, MIX_WIDTH, D), MIX_WIDTH ** -0.5),
        "norm_ffn2": gain(ks[17], (DEPTH, D)),
        "ffn2_w_gate": nrm(ks[18], (DEPTH, D, F), D ** -0.5),
        "ffn2_w_up": nrm(ks[19], (DEPTH, D, F), D ** -0.5),
        "ffn2_w_down": nrm(ks[20], (DEPTH, F, D), F ** -0.5),
        "norm_final": gain(ks[21], (D,)),
    }


def reference(x_prompt, x_sample, c_prompt, c_sample, ada_w, ada_b, norm_ffn1, ffn1_w_gate, ffn1_w_up,
              ffn1_w_down, norm_mix, w_in, conv_w, a_log, dt_bias, dn_norm, w_out, norm_ffn2, ffn2_w_gate,
              ffn2_w_up, ffn2_w_down, norm_final):
    y_prompt = _trunk(x_prompt, c_prompt, ada_w, ada_b, norm_ffn1, ffn1_w_gate, ffn1_w_up, ffn1_w_down,
                      norm_mix, w_in, conv_w, a_log, dt_bias, dn_norm, w_out, norm_ffn2, ffn2_w_gate,
                      ffn2_w_up, ffn2_w_down, norm_final)
    y_sample = _trunk(x_sample, c_sample, ada_w, ada_b, norm_ffn1, ffn1_w_gate, ffn1_w_up, ffn1_w_down,
                      norm_mix, w_in, conv_w, a_log, dt_bias, dn_norm, w_out, norm_ffn2, ffn2_w_gate,
                      ffn2_w_up, ffn2_w_down, norm_final)
    return (y_prompt, y_sample)
```

```cpp
#include <hip/hip_runtime.h>
#include <hip/hip_cooperative_groups.h>
#include <cstdio>
#include <cstdint>
namespace cg = cooperative_groups;
namespace pg8 {
#define PG8_LAS __attribute__((address_space(3)))
typedef unsigned short bf16_t;
typedef short bf16x8 __attribute__((ext_vector_type(8)));
typedef float f32x4 __attribute__((ext_vector_type(4)));
typedef unsigned u32x4 __attribute__((ext_vector_type(4)));
constexpr int BM = 256, BK = 64, HALF = 128, HTB = HALF * BK * 2  , STAGE_BYTES = 8 * HTB, NXCD = 8, WGM = 8;

__host__ __device__ __forceinline__ int lds_byte(int r, int c) { const int st = (r >> 4) * 2 + (c >> 5), rr = r & 15, cc = c & 31, ob = rr * 64 + cc * 2; return st * 1024 + (ob ^ (((ob >> 9) & 1) << 5)); }
__host__ __device__ __forceinline__ void stage_rc(int b, int& R, int& C) { const int st = b / 1024, sb = b % 1024, swz = sb ^ (((sb >> 9) & 1) << 5); R = (st >> 1) * 16 + swz / 64; C = (st & 1) * 32 + (swz % 64) / 2; }
__host__ __device__ __forceinline__ int perm32(int rho) { const int n = rho >> 4, i = rho & 15; return 8 * (i >> 2) + 4 * n + (i & 3); }

struct Unit { int pm, pn; };
struct Gemm { const bf16_t* A; const bf16_t* Bt; int M, N, K; };

struct StaticOrder {
    int nM, nN, nwg, G, c;
    __host__ __device__ void init(int M, int N, int G_, int c_) { nM = M / BM; nN = N / BM; nwg = nM * nN; G = G_; c = c_; }
    __host__ __device__ bool next(int i, Unit& u) const {
        const long L = (long)i * G + c; if (L >= nwg) return false;
        int wgid = (int)L; { const int q = nwg / NXCD, r = nwg % NXCD, xcd = wgid % NXCD, off = wgid / NXCD; wgid = (xcd < r ? xcd * (q + 1) : r * (q + 1) + (xcd - r) * q) + off; }
        const int nig = WGM * nN, gid = wgid / nig, fm = gid * WGM, gsz = (nM - fm) < WGM ? (nM - fm) : WGM;
        u.pm = fm + ((wgid % nig) % gsz); u.pn = (wgid % nig) / gsz; return true;
    }
    __device__ __forceinline__ void a_ready(const Unit&) const {}
    __device__ __forceinline__ void done(const Unit&) const {}
};
typedef __bf16 bf16x2_t __attribute__((ext_vector_type(2)));
typedef float f32x2_t __attribute__((ext_vector_type(2)));
__device__ __forceinline__ unsigned cvt_pk_bf16(float lo, float hi) { unsigned r; asm volatile("v_cvt_pk_bf16_f32 %0, %1, %2" : "=v"(r) : "v"(lo), "v"(hi)); return r; }
__device__ __forceinline__ unsigned cvt_pk_bf16_cv(float lo, float hi) { const f32x2_t v = {lo, hi}; const bf16x2_t b = __builtin_convertvector(v, bf16x2_t); return __builtin_bit_cast(unsigned, b); }
__device__ __forceinline__ int otid() { int t = threadIdx.x; asm volatile("" : "+v"(t)); return t; }
__device__ __forceinline__ float silu_f(float v) { return v * __builtin_amdgcn_rcpf(1.0f + __expf(-v)); }

#define EPI_PIN(p) asm volatile("" : "+v"(p))
struct EpiSwiGLU {
    static constexpr bool PERM = true, AFTER_DRAIN = false;
    bf16_t* O; int ldc;
    __device__ __forceinline__ void operator()(const f32x4 (&acc)[2][2][4][2], const Unit& u, int wr, int wc, int fr, int fq) const {
        const int row0 = u.pm * BM + wr * 64 + fr, col0 = u.pn * 128 + wc * 32 + 8 * fq;
        bf16_t* rowp = O + (size_t)row0 * ldc + col0;
#pragma unroll
        for (int ai = 0; ai < 2; ++ai) {
#pragma unroll
            for (int m = 0; m < 4; ++m) {
                const f32x4 g0 = acc[ai][0][m][0], g1 = acc[ai][0][m][1], u0 = acc[ai][1][m][0], u1 = acc[ai][1][m][1];
                u32x4 w;
                w.x = cvt_pk_bf16(silu_f(g0[0]) * u0[0], silu_f(g0[1]) * u0[1]); w.y = cvt_pk_bf16(silu_f(g0[2]) * u0[2], silu_f(g0[3]) * u0[3]);
                w.z = cvt_pk_bf16(silu_f(g1[0]) * u1[0], silu_f(g1[1]) * u1[1]); w.w = cvt_pk_bf16(silu_f(g1[2]) * u1[2], silu_f(g1[3]) * u1[3]);
                *(u32x4*)rowp = w;
                rowp += (size_t)16 * ldc; EPI_PIN(rowp);
            }
            rowp += (size_t)64 * ldc; EPI_PIN(rowp);
        }
    }
};
struct EpiResid {
    static constexpr bool PERM = false, AFTER_DRAIN = false;
    const float* xin; float* xout; const float* gate; float scale; int half;
    __device__ __forceinline__ void operator()(const f32x4 (&acc)[2][2][4][2], const Unit& u, int wr, int wc, int fr, int fq) const {
        const int row0 = u.pm * BM + wr * 64 + fr, col0 = u.pn * BM + wc * 32 + 4 * fq;
        const int batch = half ? 8 + (u.pm >> 5) : (u.pm >> 4);
        const float* gp = gate + (size_t)batch * 9216 + col0;
        f32x4 gv[2][2];
#pragma unroll
        for (int bj = 0; bj < 2; ++bj)
#pragma unroll
            for (int n = 0; n < 2; ++n) gv[bj][n] = *(const f32x4*)(gp + bj * HALF + n * 16) * scale;
        const float* xp = xin + (size_t)row0 * 1024 + col0; float* op = xout + (size_t)row0 * 1024 + col0;
#pragma unroll
        for (int ai = 0; ai < 2; ++ai) {
#pragma unroll
            for (int m = 0; m < 4; ++m) {
#pragma unroll
                for (int bj = 0; bj < 2; ++bj)
#pragma unroll
                    for (int n = 0; n < 2; ++n) { const f32x4 xi = *(const f32x4*)(xp + bj * HALF + n * 16); *(f32x4*)(op + bj * HALF + n * 16) = xi + gv[bj][n] * acc[ai][bj][m][n]; }
                xp += 16 * 1024; op += 16 * 1024; EPI_PIN(xp); EPI_PIN(op);
                asm volatile("" ::: "memory"); }
            xp += 64 * 1024; op += 64 * 1024; EPI_PIN(xp); EPI_PIN(op);
        }
    }
};
struct EpiProj {
    static constexpr bool PERM = true, AFTER_DRAIN = false;
    static constexpr size_t OFF_PA = (size_t)144 << 20, OFF_PD = (size_t)272 << 20, OFF_Z = (size_t)240 << 20;
    unsigned char* wsb; float* AB; const float* rope; int smask;
    __device__ __forceinline__ void operator()(const f32x4 (&acc)[2][2][4][2], const Unit& u, int wr, int wc, int fr, int fq) const {
        const int row0 = u.pm * BM + wr * 64 + fr, pn = u.pn;
        if (pn < 14) {
            const size_t poff = pn < 6 ? OFF_PA : (pn < 12 ? OFF_PD : OFF_Z); bf16_t* P = (bf16_t*)(wsb + poff); const int ldp = pn < 12 ? 1536 : 512;
            const int col0 = (pn < 6 ? pn : (pn < 12 ? pn - 6 : pn - 12)) * 256 + wc * 32 + 8 * fq;
            const bool rot = (pn < 4) && ((wc & 1) == 0) && (fq < 2);
            const float sgn = (fq & 1) ? 1.f : -1.f;
            bf16_t* rowp = P + (size_t)row0 * ldp + col0; int row = row0;
#pragma unroll
            for (int ai = 0; ai < 2; ++ai) {
#pragma unroll
                for (int m = 0; m < 4; ++m) {
                    f32x4 c0 = {0.f, 0.f, 0.f, 0.f}, c1 = c0, s0 = c0, s1 = c0;
                    if (pn < 4) { const float* rp = rope + (size_t)(row & smask) * 16; c0 = *(const f32x4*)rp; c1 = *(const f32x4*)(rp + 4); s0 = *(const f32x4*)(rp + 8); s1 = *(const f32x4*)(rp + 12); }
#pragma unroll
                    for (int bj = 0; bj < 2; ++bj) { f32x4 v0 = acc[ai][bj][m][0], v1 = acc[ai][bj][m][1];
                        if (pn < 4) { f32x4 p0, p1;
#pragma unroll
                            for (int j = 0; j < 4; ++j) { p0[j] = __shfl_xor(v0[j], 16); p1[j] = __shfl_xor(v1[j], 16); }
                            const f32x4 r0 = v0 * c0 + sgn * (p0 * s0), r1 = v1 * c1 + sgn * (p1 * s1);
                            if (rot) { v0 = r0; v1 = r1; } }
                        u32x4 w; w.x = cvt_pk_bf16(v0[0], v0[1]); w.y = cvt_pk_bf16(v0[2], v0[3]); w.z = cvt_pk_bf16(v1[0], v1[1]); w.w = cvt_pk_bf16(v1[2], v1[3]);
                        *(u32x4*)(rowp + bj * HALF) = w; }
                    rowp += (size_t)16 * ldp; row += 16; EPI_PIN(rowp); EPI_PIN(row);
                    asm volatile("" ::: "memory"); }
                rowp += (size_t)64 * ldp; row += 64; EPI_PIN(rowp); EPI_PIN(row);
            }
        } else {
            if (wc == 0 && fq < 2) {
                float* ap = AB + (size_t)row0 * 16 + 8 * fq;
#pragma unroll
                for (int ai = 0; ai < 2; ++ai) {
#pragma unroll
                    for (int m = 0; m < 4; ++m) { *(f32x4*)ap = acc[ai][0][m][0]; *(f32x4*)(ap + 4) = acc[ai][0][m][1]; ap += 16 * 16; EPI_PIN(ap); }
                    ap += 64 * 16; EPI_PIN(ap); }
            }
        }
    }
};

template <class Epi, class Sched, bool ALIGN_EPI = false, bool SP2 = false>
__device__ __forceinline__ void gemm_phase(PG8_LAS unsigned char* lds, const Gemm g, const Sched& S, const Epi& E) {
    const int tid = otid(), wid = __builtin_amdgcn_readfirstlane(tid >> 6), lane = tid & 63, wr = wid >> 2, wc = wid & 3, fr = lane & 15, fq = lane >> 4;
    const int K = g.K, nt = K / BK;
    unsigned voffA[2], voffB[2];
#pragma unroll
    for (int i = 0; i < 2; ++i) { int R, C; stage_rc(tid * 16 + i * 8192, R, C); const int Rb = Epi::PERM ? ((R & ~31) + perm32(R & 31)) : R;
        voffA[i] = (unsigned)(R * K + C) * 2u; voffB[i] = (unsigned)(Rb * K + C) * 2u; }
    const size_t kstep = (size_t)(BK * 2);
    const size_t hstep = (size_t)HALF * K * 2;
    const size_t tstep = 2 * hstep;
    const unsigned ldsw = (unsigned)wid * 1024u;
    const int aoff = lds_byte(wr * 64 + fr, fq * 8), boff = lds_byte(wc * 32 + fr, fq * 8);
#define PG8_SA(b, h) (((b) * 2 + (h)) * HTB)
#define PG8_SB(b, h) ((4 + (b) * 2 + (h)) * HTB)
#define PG8_STAGE(bufoff, gbase, voff) do { _Pragma("unroll") for (int _i = 0; _i < 2; ++_i) \
        __builtin_amdgcn_global_load_lds((const unsigned*)((const char*)(gbase) + (voff)[_i]), (PG8_LAS unsigned*)(lds + (bufoff) + ldsw + _i * 8192), 16, 0, 0); } while (0)
#define PG8_LDA(dst, b, h) do { _Pragma("unroll") for (int m = 0; m < 4; ++m) _Pragma("unroll") for (int k = 0; k < 2; ++k) dst[m][k] = *(const PG8_LAS bf16x8*)(lds + PG8_SA(b, h) + aoff + m * 2048 + k * 1024); } while (0)
#define PG8_LDB(dst, b, h) do { _Pragma("unroll") for (int n = 0; n < 2; ++n) _Pragma("unroll") for (int k = 0; k < 2; ++k) dst[n][k] = *(const PG8_LAS bf16x8*)(lds + PG8_SB(b, h) + boff + n * 2048 + k * 1024); } while (0)
#define PG8_MMA(ai, bj, At, Bt) do { __builtin_amdgcn_s_setprio(1); _Pragma("unroll") for (int m = 0; m < 4; ++m) _Pragma("unroll") for (int n = 0; n < 2; ++n) _Pragma("unroll") for (int k = 0; k < 2; ++k) \
        acc[ai][bj][m][n] = __builtin_amdgcn_mfma_f32_16x16x32_bf16(Bt[n][k], At[m][k], acc[ai][bj][m][n], 0, 0, 0); __builtin_amdgcn_s_setprio(0); } while (0)
#define PG8_WAIT_V(n) asm volatile("s_waitcnt vmcnt(" #n ")" ::: "memory")
#define PG8_WAIT_L(n) asm volatile("s_waitcnt lgkmcnt(" #n ")" ::: "memory")
#define PG8_BAR __builtin_amdgcn_s_barrier()
#define PG8_SCHED __builtin_amdgcn_sched_barrier(0)
    Unit cur, nxt; int ui = 0;
    if (!S.next(0, cur)) return;
    f32x4 acc[2][2][4][2];
#pragma unroll
    for (int a = 0; a < 2; ++a)
#pragma unroll
        for (int b = 0; b < 2; ++b)
#pragma unroll
            for (int m = 0; m < 4; ++m)
#pragma unroll
                for (int n = 0; n < 2; ++n) acc[a][b][m][n] = (f32x4){0.f, 0.f, 0.f, 0.f};
    bf16x8 At[4][2], B0[2][2], B1[2][2];
    const char* cA = (const char*)g.A + (size_t)cur.pm * tstep; const char* cB = (const char*)g.Bt + (size_t)cur.pn * tstep;
    S.a_ready(cur);
    if constexpr (SP2) {
        PG8_STAGE(PG8_SB(0, 0), cB, voffB); PG8_STAGE(PG8_SB(0, 1), cB + hstep, voffB); PG8_STAGE(PG8_SA(0, 0), cA, voffA); PG8_STAGE(PG8_SA(0, 1), cA + hstep, voffA);
        if (wr == 1) PG8_BAR;
        PG8_WAIT_V(2); PG8_BAR;
        PG8_STAGE(PG8_SB(1, 0), cB + kstep, voffB); PG8_STAGE(PG8_SA(1, 0), cA + kstep, voffA); PG8_STAGE(PG8_SB(1, 1), cB + hstep + kstep, voffB);
        PG8_WAIT_V(6); PG8_BAR;
    } else {
        PG8_STAGE(PG8_SB(0, 0), cB, voffB); PG8_STAGE(PG8_SA(0, 0), cA, voffA); PG8_STAGE(PG8_SB(0, 1), cB + hstep, voffB); PG8_STAGE(PG8_SA(0, 1), cA + hstep, voffA);
        if (wr == 1) PG8_BAR;
        PG8_WAIT_V(4); PG8_BAR;
        PG8_STAGE(PG8_SB(1, 0), cB + kstep, voffB); PG8_STAGE(PG8_SA(1, 0), cA + kstep, voffA); PG8_STAGE(PG8_SB(1, 1), cB + hstep + kstep, voffB);
        PG8_WAIT_V(6); PG8_BAR;
    }
    for (;;) {
        const bool has_next = S.next(ui + 1, nxt);
        const char* nA = has_next ? (const char*)g.A + (size_t)nxt.pm * tstep : cA; const char* nB = has_next ? (const char*)g.Bt + (size_t)nxt.pn * tstep : cB;
        for (int t = 0; t < nt; t += 2) {
            const bool last = (t == nt - 2);
            const char* a1 = cA + (size_t)(t + 1) * kstep;
            const char* a2 = last ? nA : cA + (size_t)(t + 2) * kstep; const char* b2 = last ? nB : cB + (size_t)(t + 2) * kstep;
            const char* a3 = a2 + kstep; const char* b3 = b2 + kstep;
            if (last && has_next) S.a_ready(nxt);
            if constexpr (SP2) {
            PG8_LDB(B0, 0, 0); PG8_LDB(B1, 0, 1); PG8_SCHED; PG8_LDA(At, 0, 0); PG8_STAGE(PG8_SA(1, 1), a1 + hstep, voffA);
            PG8_WAIT_V(8); PG8_WAIT_L(0); PG8_BAR; PG8_MMA(0, 0, At, B0); PG8_MMA(0, 1, At, B1); PG8_BAR; PG8_SCHED;
            PG8_LDA(At, 0, 1); PG8_STAGE(PG8_SB(0, 0), b2, voffB); PG8_STAGE(PG8_SB(0, 1), b2 + hstep, voffB); PG8_STAGE(PG8_SA(0, 0), a2, voffA);
            PG8_WAIT_V(8); PG8_WAIT_L(0); PG8_BAR; PG8_MMA(1, 0, At, B0); PG8_MMA(1, 1, At, B1); PG8_BAR; PG8_SCHED;
            PG8_LDB(B0, 1, 0); PG8_LDB(B1, 1, 1); PG8_SCHED; PG8_LDA(At, 1, 0); PG8_STAGE(PG8_SA(0, 1), a2 + hstep, voffA);
            PG8_WAIT_V(8); PG8_WAIT_L(0); PG8_BAR; PG8_MMA(0, 0, At, B0); PG8_MMA(0, 1, At, B1); PG8_BAR; PG8_SCHED;
            PG8_LDA(At, 1, 1); PG8_STAGE(PG8_SB(1, 0), b3, voffB); PG8_STAGE(PG8_SB(1, 1), b3 + hstep, voffB); PG8_STAGE(PG8_SA(1, 0), a3, voffA);
            PG8_WAIT_V(8); PG8_WAIT_L(0); PG8_BAR; PG8_MMA(1, 0, At, B0); PG8_MMA(1, 1, At, B1); PG8_BAR; PG8_SCHED;
            } else {
            PG8_LDB(B0, 0, 0); PG8_SCHED; PG8_LDA(At, 0, 0); PG8_STAGE(PG8_SA(1, 1), a1 + hstep, voffA);
            PG8_WAIT_L(8); PG8_BAR; PG8_WAIT_L(0); PG8_MMA(0, 0, At, B0); PG8_BAR; PG8_SCHED;
            PG8_LDB(B1, 0, 1); PG8_STAGE(PG8_SB(0, 0), b2, voffB);
            PG8_BAR; PG8_WAIT_L(0); PG8_MMA(0, 1, At, B1); PG8_BAR;
            PG8_LDA(At, 0, 1); PG8_STAGE(PG8_SA(0, 0), a2, voffA);
            PG8_BAR; PG8_WAIT_L(0); PG8_MMA(1, 0, At, B0); PG8_BAR; PG8_SCHED;
            PG8_STAGE(PG8_SB(0, 1), b2 + hstep, voffB);
            PG8_WAIT_V(6); PG8_BAR; PG8_MMA(1, 1, At, B1); PG8_BAR;
            PG8_LDB(B0, 1, 0); PG8_SCHED; PG8_LDA(At, 1, 0); PG8_STAGE(PG8_SA(0, 1), a2 + hstep, voffA);
            PG8_WAIT_L(8); PG8_BAR; PG8_WAIT_L(0); PG8_MMA(0, 0, At, B0); PG8_BAR; PG8_SCHED;
            PG8_LDB(B1, 1, 1); PG8_STAGE(PG8_SB(1, 0), b3, voffB);
            PG8_BAR; PG8_WAIT_L(0); PG8_MMA(0, 1, At, B1); PG8_BAR;
            PG8_LDA(At, 1, 1); PG8_STAGE(PG8_SA(1, 0), a3, voffA);
            PG8_BAR; PG8_WAIT_L(0); PG8_MMA(1, 0, At, B0); PG8_BAR; PG8_SCHED;
            PG8_STAGE(PG8_SB(1, 1), b3 + hstep, voffB);
            PG8_WAIT_V(6); PG8_BAR; PG8_MMA(1, 1, At, B1); PG8_BAR;
            }
        }
        if constexpr (ALIGN_EPI) { if (wr == 0) PG8_BAR; }
        if constexpr (!Epi::AFTER_DRAIN) { E(acc, cur, wr, wc, fr, fq); S.done(cur); }
        if (!has_next) break;
#pragma unroll
        for (int a = 0; a < 2; ++a)
#pragma unroll
            for (int b = 0; b < 2; ++b)
#pragma unroll
                for (int m = 0; m < 4; ++m)
#pragma unroll
                    for (int n = 0; n < 2; ++n) acc[a][b][m][n] = (f32x4){0.f, 0.f, 0.f, 0.f};
        cur = nxt; cA = nA; cB = nB; ++ui;
        if constexpr (ALIGN_EPI) { if (wr == 1) PG8_BAR; }
    }
    PG8_WAIT_V(0);
    if constexpr (!ALIGN_EPI) { if (wr == 0) PG8_BAR; }
    PG8_BAR;
    if constexpr (Epi::AFTER_DRAIN) { E.fused(acc, cur, wr, wc, fr, fq, lds, wid, lane); S.done(cur); }
#undef PG8_SA
#undef PG8_SB
#undef PG8_STAGE
#undef PG8_LDA
#undef PG8_LDB
#undef PG8_MMA
#undef PG8_WAIT_V
#undef PG8_WAIT_L
#undef PG8_BAR
#undef PG8_SCHED
}
}

#define LAS __attribute__((address_space(3)))
typedef unsigned short bf16;
typedef short bf16x8 __attribute__((ext_vector_type(8)));
typedef short s16x4 __attribute__((ext_vector_type(4)));
typedef float f32x4 __attribute__((ext_vector_type(4)));
typedef unsigned v4u __attribute__((ext_vector_type(4)));
typedef unsigned v2u __attribute__((ext_vector_type(2)));
#define MFMA16(a, b, c) __builtin_amdgcn_mfma_f32_16x16x32_bf16((a), (b), (c), 0, 0, 0)
#define CAT8(lo, hi) __builtin_shufflevector((lo), (hi), 0, 1, 2, 3, 4, 5, 6, 7)
#define LDS_WAIT() asm volatile("s_waitcnt lgkmcnt(0)" ::: "memory")

constexpr int D = 1024, FF = 2816, MH = 32768, NPROJ = 3840, INW = 3600;
constexpr float EPS = 1e-6f;
constexpr size_t MiB = 1u << 20;
constexpr size_t WS_MOD = 1 * MiB, WS_ROPE = 2 * MiB;
constexpr size_t WS_WGU1 = 4 * MiB, WS_WD1 = 15 * MiB, WS_WIN = 15 * MiB + 5632 * 1024, WS_WOUT = 28 * MiB, WS_WGU2 = 30 * MiB, WS_WD2 = 41 * MiB;
constexpr size_t WS_H = 48 * MiB, WS_DQ = 48 * MiB, WS_DK = 80 * MiB, WS_DV = 112 * MiB, WS_OF = 80 * MiB, WS_OB = 112 * MiB;
constexpr size_t WS_ACT = 112 * MiB, WS_PA = 144 * MiB, WS_Z = 240 * MiB, WS_CH = 272 * MiB, WS_PD = 272 * MiB, WS_OG = 272 * MiB, WS_LSE = 368 * MiB, WS_MIX = 374 * MiB;
constexpr size_t WS_AB = 496 * MiB, WS_GB = 498 * MiB, WS_GC = 500 * MiB, WS_END = 501 * MiB;
constexpr int LDS_BYTES = 151552;
constexpr int CHJOB = 57344;

__device__ __forceinline__ float bf2f(unsigned short v) { return __uint_as_float(((unsigned)v) << 16); }
__device__ __forceinline__ float bflo(unsigned w) { return __uint_as_float(w << 16); }
__device__ __forceinline__ float bfhi(unsigned w) { return __uint_as_float(w & 0xffff0000u); }
__device__ __forceinline__ unsigned pk2(float lo, float hi) { return pg8::cvt_pk_bf16(lo, hi); }
__device__ __forceinline__ float opaque_one() { float o = 1.0f; asm volatile("" : "+v"(o)); return o; }
__device__ __forceinline__ float silu(float v) { return v * __builtin_amdgcn_rcpf(1.0f + __expf(-v)); }
__device__ __forceinline__ float wave_sum(float v) {
#pragma unroll
    for (int o = 1; o < 64; o <<= 1) v += __shfl_xor(v, o);
    return v;
}
__device__ __forceinline__ bf16x8 pack8(const f32x4 a, const f32x4 b) {
    v4u w; w.x = pk2(a[0], a[1]); w.y = pk2(a[2], a[3]); w.z = pk2(b[0], b[1]); w.w = pk2(b[2], b[3]);
    return __builtin_bit_cast(bf16x8, w);
}
__device__ __forceinline__ f32x4 ld_bf4(const bf16* p) { const v2u w = *(const v2u*)p; return (f32x4){bflo(w.x), bfhi(w.x), bflo(w.y), bfhi(w.y)}; }

__device__ __forceinline__ void ph_mod(const float* c_prompt, const float* c_sample, const float* ada_w, const float* ada_b, float* MOD, LAS unsigned char* lds) {
    const int tid = pg8::otid(), lane = tid & 63, wave = tid >> 6;
    LAS float* sc = (LAS float*)lds;
    LAS float* red = (LAS float*)(lds + 49152);
    for (int i = tid; i < 12 * 1024; i += 512) { const int b = i >> 10, k = i & 1023; const float v = b < 8 ? c_prompt[b * 1024 + k] : c_sample[(b - 8) * 1024 + k]; sc[i] = silu(v); }
    __syncthreads();
    const int cl = tid & 7, kg = tid >> 3;
    for (int item = blockIdx.x; item < 576; item += gridDim.x) {
        const int layer = item / 288, cg32 = item % 288, col = cg32 * 32 + cl * 4;
        float acc[12][4];
#pragma unroll
        for (int b = 0; b < 12; ++b)
#pragma unroll
            for (int j = 0; j < 4; ++j) acc[b][j] = 0.f;
        const float* wp = ada_w + (size_t)layer * 1024 * 9216 + col;
#pragma unroll 4
        for (int kk = 0; kk < 16; ++kk) { const int k = kg * 16 + kk; const f32x4 w = *(const f32x4*)(wp + (size_t)k * 9216);
#pragma unroll
            for (int b = 0; b < 12; ++b) { const float s = sc[b * 1024 + k];
#pragma unroll
                for (int j = 0; j < 4; ++j) acc[b][j] += s * w[j]; } }
#pragma unroll
        for (int b = 0; b < 12; ++b)
#pragma unroll
            for (int j = 0; j < 4; ++j) { float v = acc[b][j]; v += __shfl_xor(v, 8); v += __shfl_xor(v, 16); v += __shfl_xor(v, 32); if ((lane >> 3) == 0) red[(wave * 8 + cl) * 48 + b * 4 + j] = v; }
        __syncthreads();
        if (tid < 384) { const int b = tid >> 5, c = tid & 31; float s = 0.f;
#pragma unroll
            for (int w = 0; w < 8; ++w) s += red[(w * 8 + (c >> 2)) * 48 + b * 4 + (c & 3)];
            MOD[(size_t)(layer * 12 + b) * 9216 + cg32 * 32 + c] = s + ada_b[layer * 9216 + cg32 * 32 + c]; }
        __syncthreads();
    }
}
__device__ __forceinline__ void ph_rope(float* ROPE) {
    for (int idx = blockIdx.x * 512 + pg8::otid(); idx < 8192 * 8; idx += gridDim.x * 512) {
        const int s = idx >> 3, i = idx & 7;
        const float inv = exp2f(-(float)i * 0.125f * 18.931568569324174f);
        const float ang = (float)s * inv;
        double rev = (double)ang * 0.15915494309189535; rev -= __builtin_rint(rev);
        const float fr = (float)rev;
        ROPE[s * 16 + i] = __builtin_amdgcn_cosf(fr); ROPE[s * 16 + 8 + i] = __builtin_amdgcn_sinf(fr);
    }
}
__device__ __forceinline__ void tr_item(const float* W, int K, int N, bf16* WT, int k0, int n0, int dst_row0, LAS float* scr, int lane) {
#pragma unroll 8
    for (int i = 0; i < 32; ++i) { const int kk = 2 * i + (lane >> 5), n = n0 + (lane & 31); scr[kk * 33 + (lane & 31)] = (n < N) ? W[(size_t)(k0 + kk) * N + n] : 0.f; }
    LDS_WAIT();
    const int c = lane & 7;
#pragma unroll
    for (int j = 0; j < 4; ++j) { const int n = (lane >> 3) + 8 * j; const LAS float* s = scr + (8 * c) * 33 + n;
        v4u o; o.x = pk2(s[0 * 33], s[1 * 33]); o.y = pk2(s[2 * 33], s[3 * 33]); o.z = pk2(s[4 * 33], s[5 * 33]); o.w = pk2(s[6 * 33], s[7 * 33]);
        *(v4u*)(WT + (size_t)(dst_row0 + n) * K + k0 + 8 * c) = o; }
    LDS_WAIT();
}
__device__ __forceinline__ void ph_wconv(const float* wg1, const float* wu1, const float* wd1, const float* wg2, const float* wu2, const float* wd2, const float* win, const float* wout,
                                         int layer, unsigned char* ws, LAS unsigned char* lds) {
    const int tid_ = pg8::otid(), lane = tid_ & 63, wave = tid_ >> 6;
    LAS float* scr = (LAS float*)(lds + wave * 16384);
    const int gw = blockIdx.x * 8 + wave, NGW = gridDim.x * 8;
    constexpr int I_GU = 16 * 88, I_DN = 44 * 32, I_IN = 16 * 120, I_OUT = 16 * 32;
    constexpr int NIT = 6 * I_GU + I_IN + I_OUT;
    static_assert(I_DN == I_GU, "item counts");
    for (int it = gw; it < NIT; it += NGW) {
        int r = it;
        if (r < 6 * I_GU) {
            const int which = r / I_GU; r -= which * I_GU;
            const int f = which / 3, t = which % 3;
            if (t < 2) { const float* W = (f ? (t ? wu2 : wg2) : (t ? wu1 : wg1)) + (size_t)layer * D * FF; bf16* WT = (bf16*)(ws + (f ? WS_WGU2 : WS_WGU1));
                const int kb = r / 88, nb = r % 88, n0 = nb * 32; tr_item(W, D, FF, WT, kb * 64, n0, (n0 >> 7) * 256 + t * 128 + (n0 & 127), scr, lane); }
            else { const float* W = (f ? wd2 : wd1) + (size_t)layer * D * FF; bf16* WT = (bf16*)(ws + (f ? WS_WD2 : WS_WD1));
                const int kb = r / 32, nb = r % 32; tr_item(W, FF, D, WT, kb * 64, nb * 32, nb * 32, scr, lane); }
            continue;
        }
        r -= 6 * I_GU;
        if (r < I_IN) { const int kb = r / 120, nb = r % 120; tr_item(win + (size_t)layer * D * INW, D, INW, (bf16*)(ws + WS_WIN), kb * 64, nb * 32, nb * 32, scr, lane); continue; }
        r -= I_IN;
        { const int kb = r / 32, nb = r % 32; tr_item(wout + (size_t)layer * D * D, D, D, (bf16*)(ws + WS_WOUT), kb * 64, nb * 32, nb * 32, scr, lane); }
    }
}
__device__ __forceinline__ void ph_norm(const float* x, const float* nw, const float* modl, int sb, int half, bf16* H) {
    const int tid_ = pg8::otid(), lane = tid_ & 63, wave = tid_ >> 6;
    const int gw = blockIdx.x * 8 + wave, NGW = gridDim.x * 8;
    for (int r0 = gw * 16; r0 < MH; r0 += NGW * 16) {
        const int batch = half ? 8 + (r0 >> 13) : (r0 >> 12);
        const float* mp = modl + (size_t)batch * 9216 + sb * 3072;
        f32x4 A[4], B[4];
#pragma unroll
        for (int j = 0; j < 4; ++j) { const int c = 4 * lane + 256 * j; const f32x4 w = *(const f32x4*)(nw + c), sh = *(const f32x4*)(mp + c), scl = *(const f32x4*)(mp + 1024 + c); A[j] = w * (1.0f + scl); B[j] = sh; }
        for (int r = r0; r < r0 + 16; ++r) {
            const f32x4* xr = (const f32x4*)(x + (size_t)r * D) + lane;
            f32x4 v[4]; float s = 0.f;
#pragma unroll
            for (int j = 0; j < 4; ++j) { v[j] = xr[64 * j]; s += (v[j].x * v[j].x + v[j].y * v[j].y) + (v[j].z * v[j].z + v[j].w * v[j].w); }
            const float rstd = __builtin_amdgcn_rsqf(wave_sum(s) * (1.f / D) + EPS);
            v2u* o8 = (v2u*)(H + (size_t)r * D) + lane;
#pragma unroll
            for (int j = 0; j < 4; ++j) { const f32x4 h = v[j] * rstd * A[j] + B[j]; v2u w; w.x = pk2(h.x, h.y); w.y = pk2(h.z, h.w); o8[64 * j] = w; }
        }
    }
}
__device__ __forceinline__ void ph_final(float* x, const float* nw) {
    const int tid_ = pg8::otid(), lane = tid_ & 63, wave = tid_ >> 6;
    const int gw = blockIdx.x * 8 + wave, NGW = gridDim.x * 8;
    f32x4 A[4];
#pragma unroll
    for (int j = 0; j < 4; ++j) A[j] = *(const f32x4*)(nw + 4 * lane + 256 * j);
    for (int r = gw; r < 2 * MH; r += NGW) {
        f32x4* xr = (f32x4*)(x + (size_t)r * D) + lane;
        f32x4 v[4]; float s = 0.f;
#pragma unroll
        for (int j = 0; j < 4; ++j) { v[j] = xr[64 * j]; s += (v[j].x * v[j].x + v[j].y * v[j].y) + (v[j].z * v[j].z + v[j].w * v[j].w); }
        const float rstd = __builtin_amdgcn_rsqf(wave_sum(s) * (1.f / D) + EPS);
#pragma unroll
        for (int j = 0; j < 4; ++j) xr[64 * j] = v[j] * rstd * A[j];
    }
}
__device__ __forceinline__ void ph_dnpre(const bf16* PD, const float* AB, const float* conv_w, const float* a_log, const float* dt_bias,
                                         bf16* DQ, bf16* DK, bf16* DV, float* GB, int S) {
    const int tid_ = pg8::otid(), lane = tid_ & 63, wave = tid_ >> 6;
    const int gw = blockIdx.x * 8 + wave, NGW = gridDim.x * 8;
    for (int t0 = gw * 16; t0 < MH; t0 += NGW * 16) {
        const int s0 = t0 & (S - 1);
        for (int part = 0; part < 3; ++part) {
            const bf16* src = PD + part * 512 + lane * 8;
            bf16* dst = (part == 0 ? DQ : (part == 1 ? DK : DV)) + lane * 8;
            f32x4 w[5][2];
#pragma unroll
            for (int j = 0; j < 5; ++j) { const float* wp = conv_w + j * 1536 + part * 512 + lane * 8; w[j][0] = *(const f32x4*)wp; w[j][1] = *(const f32x4*)(wp + 4); }
            v4u r0, r1, r2, r3, r4;
            const v4u zero = {0u, 0u, 0u, 0u};
#define ROWLD(off) (((unsigned)(s0 + (off)) < (unsigned)S) ? *(const v4u*)(src + (size_t)(t0 + (off)) * 1536) : zero)
            r0 = ROWLD(-2); r1 = ROWLD(-1); r2 = ROWLD(0); r3 = ROWLD(1);
            for (int i = 0; i < 16; ++i) {
                r4 = ROWLD(i + 2);
                f32x4 y0, y1;
#define TAP(rr, j, first) { const f32x4 a = {bflo(rr.x), bfhi(rr.x), bflo(rr.y), bfhi(rr.y)}, b = {bflo(rr.z), bfhi(rr.z), bflo(rr.w), bfhi(rr.w)}; \
                    if (first) { y0 = a * w[j][0]; y1 = b * w[j][1]; } else { y0 += a * w[j][0]; y1 += b * w[j][1]; } }
                TAP(r0, 0, true) TAP(r1, 1, false) TAP(r2, 2, false) TAP(r3, 3, false) TAP(r4, 4, false)
#undef TAP
#pragma unroll
                for (int e = 0; e < 4; ++e) { y0[e] = silu(y0[e]); y1[e] = silu(y1[e]); }
                if (part < 2) {
                    float ss = (y0.x * y0.x + y0.y * y0.y) + (y0.z * y0.z + y0.w * y0.w) + (y1.x * y1.x + y1.y * y1.y) + (y1.z * y1.z + y1.w * y1.w);
                    ss += __shfl_xor(ss, 1); ss += __shfl_xor(ss, 2); ss += __shfl_xor(ss, 4); ss += __shfl_xor(ss, 8);
                    const float scl = __builtin_amdgcn_rsqf(ss + EPS) * (part == 0 ? 0.08838834764831845f : 1.0f);
                    y0 *= scl; y1 *= scl;
                }
                v4u o; o.x = pk2(y0.x, y0.y); o.y = pk2(y0.z, y0.w); o.z = pk2(y1.x, y1.y); o.w = pk2(y1.z, y1.w);
                *(v4u*)(dst + (size_t)(t0 + i) * 512) = o;
                r0 = r1; r1 = r2; r2 = r3; r3 = r4;
            }
#undef ROWLD
        }
#pragma unroll
        for (int jj = 0; jj < 4; ++jj) { const int idx = lane + 64 * jj, tok = t0 + (idx >> 4), c = idx & 15; const float v = AB[(size_t)tok * 16 + c];
            float res;
            if (c < 8) { const float xx = v + dt_bias[c]; const float sp = fmaxf(xx, 0.f) + __logf(1.0f + __expf(-fabsf(xx))); res = -__expf(a_log[c]) * sp; }
            else res = __builtin_amdgcn_rcpf(1.0f + __expf(-v));
            GB[(size_t)tok * 16 + c] = res; }
    }
}
__device__ __forceinline__ void ph_attn(const bf16* P, bf16* OG, float* LSE, int S, int lgS, LAS unsigned char* lds) {
    const int tid = pg8::otid(), lane = tid & 63, wave = tid >> 6, l15 = lane & 15, g = lane >> 4;
    const float one = opaque_one();
    LAS unsigned char* KL = lds; LAS unsigned char* VT = lds + 41472;
    for (int u = blockIdx.x; u < 3 * 8 * 256; u += gridDim.x) {
        const int tb = u & 255, h = (u >> 8) & 7, p = u >> 11;
        const int lgd = 2 * p, L = S >> lgd, nb = L >> 7, bps = S >> 7;
        const int seq = tb >> (lgS - 7), lb = tb & (bps - 1);
        const int r = lb / nb, ib = lb - r * nb, i0 = ib << 7;
        const int seqbase = seq << lgS;
        __syncthreads();
        for (int idx = tid; idx < 288 * 8; idx += 512) {
            const int kl = idx >> 3, pc = idx & 7, ik = i0 - 64 + kl;
            v4u kv = {0u, 0u, 0u, 0u}, vv = kv;
            if (ik >= 0 && ik < L) { const bf16* src = P + (size_t)(seqbase + (ik << lgd) + r) * 1536 + h * 64 + pc * 8; kv = *(const v4u*)(src + 512); vv = *(const v4u*)(src + 1024); }
            *(LAS v4u*)(KL + kl * 144 + pc * 16) = kv;
#pragma unroll
            for (int e = 0; e < 8; ++e) { const unsigned wv = vv[e >> 1]; *(LAS unsigned short*)(VT + (pc * 8 + e) * 592 + kl * 2) = (unsigned short)((e & 1) ? (wv >> 16) : (wv & 0xffffu)); }
        }
        __syncthreads();
        const int iq = i0 + 16 * wave + l15, tokq = seqbase + (iq << lgd) + r;
        bf16x8 qf[2];
#pragma unroll
        for (int ks = 0; ks < 2; ++ks) qf[ks] = *(const bf16x8*)(P + (size_t)tokq * 1536 + h * 64 + 32 * ks + 8 * g);
        f32x4 acc[4];
#pragma unroll
        for (int dt = 0; dt < 4; ++dt) acc[dt] = (f32x4){0.f, 0.f, 0.f, 0.f};
        float m = -1e30f, lsum = 0.f;
        for (int s = 0; s < 5; ++s) {
            const int kl0 = 16 * wave + 32 * s;
            f32x4 c[2];
#pragma unroll
            for (int t = 0; t < 2; ++t) { c[t] = (f32x4){0.f, 0.f, 0.f, 0.f};
#pragma unroll
                for (int ks = 0; ks < 2; ++ks) { const bf16x8 a = *(const LAS bf16x8*)(KL + (kl0 + 16 * t + l15) * 144 + (32 * ks + 8 * g) * 2); c[t] = MFMA16(a, qf[ks], c[t]); } }
            float sc[8]; float mx = -1e30f;
#pragma unroll
            for (int t = 0; t < 2; ++t)
#pragma unroll
                for (int rg = 0; rg < 4; ++rg) { const int ik = i0 - 64 + kl0 + 16 * t + 4 * g + rg, dl = ik - iq;
                    const bool valid = (ik >= 0) && (ik < L) && (dl <= 64) && (dl >= -64);
                    const float sv = valid ? c[t][rg] * 0.18033688011112042f : -1e30f; sc[t * 4 + rg] = sv; mx = fmaxf(mx, sv); }
            mx = fmaxf(mx, __shfl_xor(mx, 16)); mx = fmaxf(mx, __shfl_xor(mx, 32));
            const float mn = fmaxf(m, mx), alpha = __builtin_amdgcn_exp2f(m - mn); m = mn;
            float ps = 0.f; f32x4 p0, p1;
#pragma unroll
            for (int e = 0; e < 4; ++e) { p0[e] = __builtin_amdgcn_exp2f(sc[e] - mn); p1[e] = __builtin_amdgcn_exp2f(sc[4 + e] - mn); ps += p0[e] + p1[e]; }
            lsum = lsum * alpha + ps;
            const bf16x8 pf = pack8(p0 * one, p1 * one);
#pragma unroll
            for (int dt = 0; dt < 4; ++dt) { acc[dt] *= alpha;
                const s16x4 lo = *(const LAS s16x4*)(VT + (16 * dt + l15) * 592 + (kl0 + 4 * g) * 2), hi = *(const LAS s16x4*)(VT + (16 * dt + l15) * 592 + (kl0 + 16 + 4 * g) * 2);
                acc[dt] = MFMA16(CAT8(lo, hi), pf, acc[dt]); }
        }
        lsum += __shfl_xor(lsum, 16); lsum += __shfl_xor(lsum, 32);
        const float inv = 1.0f / lsum;
        bf16* og = OG + ((size_t)p * MH + tokq) * 512 + h * 64 + 4 * g;
#pragma unroll
        for (int dt = 0; dt < 4; ++dt) { v2u w; w.x = pk2(acc[dt][0] * inv, acc[dt][1] * inv); w.y = pk2(acc[dt][2] * inv, acc[dt][3] * inv); *(v2u*)(og + 16 * dt) = w; }
        if (g == 0) LSE[((size_t)p * MH + tokq) * 8 + h] = (m + __log2f(lsum)) * 0.6931471805599453f;
    }
}
__device__ __forceinline__ void ph_chunk(const bf16* DQ, const bf16* DK, const bf16* DV, const float* GB, unsigned char* CH, float* GC, int S, int lgS, LAS unsigned char* lds) {
    const int tid_ = pg8::otid(), lane = tid_ & 63, wave = tid_ >> 6, l15 = lane & 15, g = lane >> 4;
    const float one = opaque_one();
    LAS unsigned char* wl = lds + wave * 18432;
    LAS float* Al = (LAS float*)wl; LAS float* gcs = (LAS float*)(wl + 17408); LAS float* bts = gcs + 64;
    LAS bf16* TP = (LAS bf16*)wl; LAS bf16* TPP = (LAS bf16*)(wl + 8192);
    for (int job = blockIdx.x * 8 + wave; job < 4096; job += gridDim.x * 8) {
        const int dir = job & 1, h = (job >> 1) & 3, cgi = job >> 3, cps = S >> 6;
        const int seq = cgi >> (lgS - 6), n = cgi & (cps - 1), seqbase = seq << lgS;
#define TOK(c) (seqbase + (dir ? (S - 1 - (64 * n + (c))) : (64 * n + (c))))
        {   const int tokc = TOK(lane);
            const float gv = GB[(size_t)tokc * 16 + dir * 4 + h], bv = GB[(size_t)tokc * 16 + 8 + dir * 4 + h];
            float cs = gv;
#pragma unroll
            for (int o = 1; o < 64; o <<= 1) { const float t = __shfl_up(cs, o); if (lane >= o) cs += t; }
            gcs[lane] = cs; bts[lane] = bv; GC[(size_t)job * 64 + lane] = cs; }
        LDS_WAIT();
        bf16x8 kf[4][4];
#pragma unroll
        for (int t = 0; t < 4; ++t)
#pragma unroll
            for (int ks = 0; ks < 4; ++ks) kf[t][ks] = *(const bf16x8*)(DK + (size_t)TOK(16 * t + l15) * 512 + h * 128 + 32 * ks + 8 * g);
#pragma unroll
        for (int it = 0; it < 4; ++it) { const int i = 16 * it + l15; const float gi = gcs[i], bi = bts[i];
#pragma unroll
            for (int jt = 0; jt <= it; ++jt) { f32x4 c = {0.f, 0.f, 0.f, 0.f};
#pragma unroll
                for (int ks = 0; ks < 4; ++ks) c = MFMA16(kf[jt][ks], kf[it][ks], c);
                const f32x4 gj = *(const LAS f32x4*)(gcs + 16 * jt + 4 * g); f32x4 o;
#pragma unroll
                for (int rg = 0; rg < 4; ++rg) { const int j = 16 * jt + 4 * g + rg; o[rg] = (j < i) ? bi * c[rg] * __expf(gi - gj[rg]) : 0.f; }
                *(LAS f32x4*)(Al + i * 68 + 16 * jt + 4 * g) = o; } }
        unsigned char* chb = CH + (size_t)job * CHJOB;
        bf16* UT = (bf16*)chb; bf16* Wm = (bf16*)(chb + 16384); bf16* KT = (bf16*)(chb + 32768); bf16* QK = (bf16*)(chb + 49152);
#pragma unroll
        for (int it = 0; it < 4; ++it) { const int i = 16 * it + l15; const float gi = gcs[i];
            bf16x8 qfr[4];
#pragma unroll
            for (int ks = 0; ks < 4; ++ks) qfr[ks] = *(const bf16x8*)(DQ + (size_t)TOK(i) * 512 + h * 128 + 32 * ks + 8 * g);
#pragma unroll
            for (int jt = 0; jt < 4; ++jt) { v2u out = {0u, 0u};
                if (jt <= it) { f32x4 c = {0.f, 0.f, 0.f, 0.f};
#pragma unroll
                    for (int ks = 0; ks < 4; ++ks) c = MFMA16(kf[jt][ks], qfr[ks], c);
                    const f32x4 gj = *(const LAS f32x4*)(gcs + 16 * jt + 4 * g); f32x4 o;
#pragma unroll
                    for (int rg = 0; rg < 4; ++rg) { const int j = 16 * jt + 4 * g + rg; o[rg] = (j <= i) ? c[rg] * __expf(gi - gj[rg]) : 0.f; }
                    out.x = pk2(o[0], o[1]); out.y = pk2(o[2], o[3]); }
                *(v2u*)(QK + i * 64 + 16 * jt + 4 * g) = out; } }
        LDS_WAIT();
        float t[64];
#pragma unroll
        for (int i = 0; i < 64; ++i) { float a0 = 0.f, a1 = 0.f, a2 = 0.f, a3 = 0.f;
#pragma unroll
            for (int j4 = 0; j4 * 4 < i; ++j4) { const f32x4 a = *(const LAS f32x4*)(Al + i * 68 + 4 * j4);
                if (4 * j4 + 0 < i) a0 += a[0] * t[4 * j4 + 0];
                if (4 * j4 + 1 < i) a1 += a[1] * t[4 * j4 + 1];
                if (4 * j4 + 2 < i) a2 += a[2] * t[4 * j4 + 2];
                if (4 * j4 + 3 < i) a3 += a[3] * t[4 * j4 + 3]; }
            t[i] = ((lane == i) ? 1.f : 0.f) - ((a0 + a1) + (a2 + a3)); }
        const float bc = bts[lane], ec = bc * __expf(gcs[lane]);
        LDS_WAIT();
#pragma unroll
        for (int i = 0; i < 64; ++i) { const unsigned w = pk2(t[i] * bc, t[i] * ec); TP[i * 64 + lane] = (bf16)(w & 0xffffu); TPP[i * 64 + lane] = (bf16)(w >> 16); }
        LDS_WAIT();
        bf16x8 tf[4][2];
#pragma unroll
        for (int mt = 0; mt < 4; ++mt)
#pragma unroll
            for (int ks = 0; ks < 2; ++ks) tf[mt][ks] = *(const LAS bf16x8*)(TP + (16 * mt + l15) * 64 + 32 * ks + 8 * g);
        for (int nt = 0; nt < 8; ++nt) {
            bf16x8 vf[2];
#pragma unroll
            for (int ks = 0; ks < 2; ++ks)
#pragma unroll
                for (int e = 0; e < 8; ++e) vf[ks][e] = (short)DV[(size_t)TOK(32 * ks + 8 * g + e) * 512 + h * 128 + 16 * nt + l15];
#pragma unroll
            for (int mt = 0; mt < 4; ++mt) { f32x4 c = {0.f, 0.f, 0.f, 0.f};
#pragma unroll
                for (int ks = 0; ks < 2; ++ks) c = MFMA16(tf[mt][ks], vf[ks], c);
                c *= one;
                v2u w; w.x = pk2(c[0], c[1]); w.y = pk2(c[2], c[3]); *(v2u*)(UT + (16 * nt + l15) * 64 + 16 * mt + 4 * g) = w; }
        }
#pragma unroll
        for (int mt = 0; mt < 4; ++mt)
#pragma unroll
            for (int ks = 0; ks < 2; ++ks) tf[mt][ks] = *(const LAS bf16x8*)(TPP + (16 * mt + l15) * 64 + 32 * ks + 8 * g);
        for (int dt = 0; dt < 8; ++dt) {
            bf16x8 kt[2];
#pragma unroll
            for (int ks = 0; ks < 2; ++ks) {
#pragma unroll
                for (int e = 0; e < 8; ++e) kt[ks][e] = (short)DK[(size_t)TOK(32 * ks + 8 * g + e) * 512 + h * 128 + 16 * dt + l15];
                *(bf16x8*)(KT + (16 * dt + l15) * 64 + 32 * ks + 8 * g) = kt[ks]; }
#pragma unroll
            for (int mt = 0; mt < 4; ++mt) { f32x4 c = {0.f, 0.f, 0.f, 0.f};
#pragma unroll
                for (int ks = 0; ks < 2; ++ks) c = MFMA16(kt[ks], tf[mt][ks], c);
                c *= one;
                v2u w; w.x = pk2(c[0], c[1]); w.y = pk2(c[2], c[3]); *(v2u*)(Wm + (16 * mt + l15) * 128 + 16 * dt + 4 * g) = w; }
        }
        LDS_WAIT();
    }
}
__device__ __forceinline__ void ph_scan(const bf16* DQ, const unsigned char* CH, const float* GC, bf16* OF, bf16* OB, int S, int lgS, int half) {
    const int tid_ = pg8::otid(), lane = tid_ & 63, wave = tid_ >> 6, l15 = lane & 15, g = lane >> 4;
    const float one = opaque_one();
    const int nchain = half ? 32 : 64, njobs = nchain * 8, cps = S >> 6;
    const int G = gridDim.x;
    for (int wj = wave * G + blockIdx.x; wj < njobs; wj += 8 * G) {
        int chain, slice;
        if (G == 256) { const int xcd = wj & 7, lj = wj >> 3; slice = lj & 7; chain = xcd * (nchain >> 3) + (lj >> 3); }
        else { chain = wj >> 3; slice = wj & 7; }
        const int dir = chain & 1, h = (chain >> 1) & 3, seq = chain >> 3, seqbase = seq << lgS, dv0 = slice * 16;
        bf16* OX = dir ? OB : OF;
        f32x4 St[8];
#pragma unroll
        for (int t = 0; t < 8; ++t) St[t] = (f32x4){0.f, 0.f, 0.f, 0.f};
        for (int n = 0; n < cps; ++n) {
            const int job = ((seq * cps + n) << 3) | (h << 1) | dir;
            const unsigned char* chb = CH + (size_t)job * CHJOB;
            const bf16* UT = (const bf16*)chb; const bf16* Wm = (const bf16*)(chb + 16384); const bf16* KT = (const bf16*)(chb + 32768); const bf16* QK = (const bf16*)(chb + 49152);
            const float* gcp = GC + (size_t)job * 64;
            f32x4 gcv[4];
#pragma unroll
            for (int mt = 0; mt < 4; ++mt) gcv[mt] = *(const f32x4*)(gcp + 16 * mt + 4 * g);
            const float glast = gcp[63];
            bf16x8 sb[4];
#pragma unroll
            for (int ks = 0; ks < 4; ++ks) sb[ks] = pack8(St[2 * ks] * one, St[2 * ks + 1] * one);
            f32x4 vnew[4], o[4];
#pragma unroll
            for (int mt = 0; mt < 4; ++mt) { const int i = 16 * mt + l15;
                const bf16* wrow = Wm + i * 128 + 4 * g; const bf16* qrow = DQ + (size_t)TOK(i) * 512 + h * 128 + 4 * g;
                f32x4 ws = {0.f, 0.f, 0.f, 0.f}, o1 = ws;
#pragma unroll
                for (int ks = 0; ks < 4; ++ks) {
                    const s16x4 wlo = *(const s16x4*)(wrow + 32 * ks), whi = *(const s16x4*)(wrow + 32 * ks + 16);
                    ws = MFMA16(CAT8(wlo, whi), sb[ks], ws);
                    const s16x4 qlo = *(const s16x4*)(qrow + 32 * ks), qhi = *(const s16x4*)(qrow + 32 * ks + 16);
                    o1 = MFMA16(CAT8(qlo, qhi), sb[ks], o1); }
                const f32x4 u4 = ld_bf4(UT + (dv0 + l15) * 64 + 16 * mt + 4 * g);
                vnew[mt] = u4 - ws;
#pragma unroll
                for (int rg = 0; rg < 4; ++rg) o1[rg] *= __expf(gcv[mt][rg]);
                o[mt] = o1; }
            bf16x8 vb[2];
#pragma unroll
            for (int k2 = 0; k2 < 2; ++k2) vb[k2] = pack8(vnew[2 * k2], vnew[2 * k2 + 1]);
#pragma unroll
            for (int mt = 0; mt < 4; ++mt) { const bf16* qkrow = QK + (16 * mt + l15) * 64 + 4 * g;
#pragma unroll
                for (int k2 = 0; k2 < 2; ++k2) { const s16x4 lo = *(const s16x4*)(qkrow + 32 * k2), hi = *(const s16x4*)(qkrow + 32 * k2 + 16); o[mt] = MFMA16(CAT8(lo, hi), vb[k2], o[mt]); } }
#pragma unroll
            for (int mt = 0; mt < 4; ++mt)
#pragma unroll
                for (int rg = 0; rg < 4; ++rg) { const int tk = TOK(16 * mt + 4 * g + rg); OX[(size_t)tk * 512 + h * 128 + dv0 + l15] = (bf16)(pk2(o[mt][rg] * one, 0.f) & 0xffffu); }
            const float eg = __expf(glast);
#pragma unroll
            for (int mt = 0; mt < 4; ++mt)
#pragma unroll
                for (int rg = 0; rg < 4; ++rg) vnew[mt][rg] *= __expf(glast - gcv[mt][rg]);
#pragma unroll
            for (int k2 = 0; k2 < 2; ++k2) vb[k2] = pack8(vnew[2 * k2], vnew[2 * k2 + 1]);
#pragma unroll
            for (int t = 0; t < 8; ++t) { St[t] *= eg; const bf16* ktrow = KT + (16 * t + l15) * 64 + 4 * g;
#pragma unroll
                for (int k2 = 0; k2 < 2; ++k2) { const s16x4 lo = *(const s16x4*)(ktrow + 32 * k2), hi = *(const s16x4*)(ktrow + 32 * k2 + 16); St[t] = MFMA16(CAT8(lo, hi), vb[k2], St[t]); } }
        }
    }
#undef TOK
}
__device__ __forceinline__ void ph_post(const bf16* OG, const float* LSE, const bf16* OF, const bf16* OB, const bf16* Z, const float* dn_norm, bf16* MIX) {
    const int tid_ = pg8::otid(), lane = tid_ & 63, wave = tid_ >> 6;
    const int gw = blockIdx.x * 8 + wave, NGW = gridDim.x * 8;
    f32x4 nw0 = *(const f32x4*)(dn_norm + (lane & 15) * 8), nw1 = *(const f32x4*)(dn_norm + (lane & 15) * 8 + 4);
    for (int t = gw; t < MH; t += NGW) {
        {   const int hd = lane >> 3;
            const float l0 = LSE[((size_t)0 * MH + t) * 8 + hd], l1 = LSE[((size_t)1 * MH + t) * 8 + hd], l2 = LSE[((size_t)2 * MH + t) * 8 + hd];
            const float mx = fmaxf(l0, fmaxf(l1, l2));
            float w0 = __expf(l0 - mx), w1 = __expf(l1 - mx), w2 = __expf(l2 - mx); const float inv = 1.0f / (w0 + w1 + w2); w0 *= inv; w1 *= inv; w2 *= inv;
            const v4u a = *(const v4u*)(OG + ((size_t)0 * MH + t) * 512 + lane * 8), b = *(const v4u*)(OG + ((size_t)1 * MH + t) * 512 + lane * 8), c = *(const v4u*)(OG + ((size_t)2 * MH + t) * 512 + lane * 8);
            v4u o;
#pragma unroll
            for (int e = 0; e < 4; ++e) o[e] = pk2(w0 * bflo(a[e]) + w1 * bflo(b[e]) + w2 * bflo(c[e]), w0 * bfhi(a[e]) + w1 * bfhi(b[e]) + w2 * bfhi(c[e]));
            *(v4u*)(MIX + (size_t)t * 1024 + lane * 8) = o; }
        {   const v4u a = *(const v4u*)(OF + (size_t)t * 512 + lane * 8), b = *(const v4u*)(OB + (size_t)t * 512 + lane * 8), z = *(const v4u*)(Z + (size_t)t * 512 + lane * 8);
            float ov[8]; float ss = 0.f;
#pragma unroll
            for (int e = 0; e < 4; ++e) { ov[2 * e] = bflo(a[e]) + bflo(b[e]); ov[2 * e + 1] = bfhi(a[e]) + bfhi(b[e]); ss += ov[2 * e] * ov[2 * e] + ov[2 * e + 1] * ov[2 * e + 1]; }
            ss += __shfl_xor(ss, 1); ss += __shfl_xor(ss, 2); ss += __shfl_xor(ss, 4); ss += __shfl_xor(ss, 8);
            const float rs = __builtin_amdgcn_rsqf(ss * (1.0f / 128.0f) + EPS);
            v4u o;
#pragma unroll
            for (int e = 0; e < 4; ++e) { const float n0 = (e < 2) ? nw0[2 * e] : nw1[2 * e - 4], n1 = (e < 2) ? nw0[2 * e + 1] : nw1[2 * e - 3];
                o[e] = pk2(ov[2 * e] * rs * n0 * silu(bflo(z[e])), ov[2 * e + 1] * rs * n1 * silu(bfhi(z[e]))); }
            *(v4u*)(MIX + (size_t)t * 1024 + 512 + lane * 8) = o; }
    }
}
#ifndef DBG_SKIP_MIXER
#define DBG_SKIP_MIXER 0
#endif
#ifndef MK_MULTI
#define MK_MULTI 0
#endif
constexpr int NPH = 1 + 2 * (2 * 14) + 1 + 1;
static_assert(pg8::EpiProj::OFF_PA == WS_PA && pg8::EpiProj::OFF_PD == WS_PD && pg8::EpiProj::OFF_Z == WS_Z, "EpiProj offsets");
struct Args { const float* in[22]; float* out; unsigned char* ws; int lo, hi; };

__global__ void __launch_bounds__(512, 2) fwd(Args a) {
    extern __shared__ __attribute__((aligned(16))) unsigned char lds_raw[];
    LAS unsigned char* lds = (LAS unsigned char*)lds_raw;
    cg::grid_group grid = cg::this_grid();
    unsigned char* ws = a.ws;
    const int lo = a.lo, hi = a.hi; int pc = 0;
    const float* x_prompt = a.in[0]; const float* x_sample = a.in[1];
    float* MOD = (float*)(ws + WS_MOD); float* ROPE = (float*)(ws + WS_ROPE);
    bf16* H = (bf16*)(ws + WS_H); bf16* ACT = (bf16*)(ws + WS_ACT); bf16* PA = (bf16*)(ws + WS_PA); bf16* PD = (bf16*)(ws + WS_PD); bf16* Zb = (bf16*)(ws + WS_Z);
    bf16* DQ = (bf16*)(ws + WS_DQ); bf16* DK = (bf16*)(ws + WS_DK); bf16* DV = (bf16*)(ws + WS_DV); bf16* OF = (bf16*)(ws + WS_OF); bf16* OB = (bf16*)(ws + WS_OB);
    unsigned char* CH = ws + WS_CH; bf16* OG = (bf16*)(ws + WS_OG); float* LSE = (float*)(ws + WS_LSE); bf16* MIX = (bf16*)(ws + WS_MIX);
    float* AB = (float*)(ws + WS_AB); float* GB = (float*)(ws + WS_GB); float* GC = (float*)(ws + WS_GC);
#define PH_BEGIN if (pc >= lo && pc < hi) {
#define PH_END } ++pc; if (pc > lo && pc < hi) grid.sync();

    PH_BEGIN
        ph_mod(a.in[2], a.in[3], a.in[4], a.in[5], MOD, lds);
        ph_rope(ROPE);
        ph_wconv(a.in[7], a.in[8], a.in[9], a.in[18], a.in[19], a.in[20], a.in[11], a.in[16], 0, ws, lds);
    PH_END
    for (int layer = 0; layer < 2; ++layer) {
        if (layer == 1) {
            PH_BEGIN ph_wconv(a.in[7], a.in[8], a.in[9], a.in[18], a.in[19], a.in[20], a.in[11], a.in[16], 1, ws, lds); PH_END
        }
        const float* modl = MOD + (size_t)layer * 12 * 9216;
        for (int half = 0; half < 2; ++half) {
            const int S = half ? 8192 : 4096, lgS = half ? 13 : 12;
            float* X = a.out + (size_t)half * MH * D;
            const float* xin0 = half ? x_sample : x_prompt;
            for (int sb = 0; sb < 3; ++sb) {
                if (DBG_SKIP_MIXER && sb == 1) continue;
                const bool first = (layer == 0 && sb == 0);
                const float* xsrc = first ? xin0 : X;
                const float* nw = (sb == 0 ? a.in[6] : (sb == 1 ? a.in[10] : a.in[17])) + layer * D;
                PH_BEGIN ph_norm(xsrc, nw, modl, sb, half, H); PH_END
                if (sb != 1) {
                    PH_BEGIN
                        pg8::Gemm g{H, (const bf16*)(ws + (sb ? WS_WGU2 : WS_WGU1)), MH, 2 * FF, D}; pg8::StaticOrder So; So.init(MH, 2 * FF, gridDim.x, (int)blockIdx.x);
                        pg8::EpiSwiGLU E{ACT, FF};
                        pg8::gemm_phase<pg8::EpiSwiGLU, pg8::StaticOrder, true, true>(lds, g, So, E);
                    PH_END
                    PH_BEGIN
                        pg8::Gemm g{ACT, (const bf16*)(ws + (sb ? WS_WD2 : WS_WD1)), MH, D, FF}; pg8::StaticOrder So; So.init(MH, D, gridDim.x, (int)blockIdx.x);
                        pg8::EpiResid E{xsrc, X, modl + (3 * sb + 2) * 1024, 0.5f, half};
                        pg8::gemm_phase<pg8::EpiResid, pg8::StaticOrder, true, true>(lds, g, So, E);
                    PH_END
                } else {
                    PH_BEGIN
                        pg8::Gemm g{H, (const bf16*)(ws + WS_WIN), MH, NPROJ, D}; pg8::StaticOrder So; So.init(MH, NPROJ, gridDim.x, (int)blockIdx.x);
                        pg8::EpiProj E{ws, AB, ROPE, S - 1};
                        pg8::gemm_phase<pg8::EpiProj, pg8::StaticOrder, true, true>(lds, g, So, E);
                    PH_END
                    PH_BEGIN ph_dnpre(PD, AB, a.in[12] + (size_t)layer * 5 * 1536, a.in[13] + layer * 8, a.in[14] + layer * 8, DQ, DK, DV, GB, S); PH_END
                    PH_BEGIN ph_chunk(DQ, DK, DV, GB, CH, GC, S, lgS, lds); PH_END
                    PH_BEGIN ph_scan(DQ, CH, GC, OF, OB, S, lgS, half); PH_END
                    PH_BEGIN ph_attn(PA, OG, LSE, S, lgS, lds); PH_END
                    PH_BEGIN ph_post(OG, LSE, OF, OB, Zb, a.in[15] + layer * 128, MIX); PH_END
                    PH_BEGIN
                        pg8::Gemm g{MIX, (const bf16*)(ws + WS_WOUT), MH, D, D}; pg8::StaticOrder So; So.init(MH, D, gridDim.x, (int)blockIdx.x);
                        pg8::EpiResid E{X, X, modl + 5 * 1024, 1.0f, half};
                        pg8::gemm_phase<pg8::EpiResid, pg8::StaticOrder, true, true>(lds, g, So, E);
                    PH_END
                }
            }
        }
    }
    PH_BEGIN ph_final(a.out, a.in[21]); PH_END
}

extern "C" void kernel_launch(void* const* d_in, const int* in_sizes, int n_in, void* d_out, int out_size, void* d_ws, size_t ws_size, hipStream_t stream) {
    static int grid = 0;
    if (grid == 0) {
        if (n_in != 22 || ws_size < WS_END) { fprintf(stderr, "kernel_launch: unexpected n_in %d / ws_size %zu\n", n_in, ws_size); grid = -1; return; }
        int dev = 0, cus = 0, per_cu = 0;
        hipGetDevice(&dev); hipDeviceGetAttribute(&cus, hipDeviceAttributeMultiprocessorCount, dev);
        if (hipFuncSetAttribute((const void*)fwd, hipFuncAttributeMaxDynamicSharedMemorySize, LDS_BYTES) != hipSuccess) { fprintf(stderr, "kernel_launch: hipFuncSetAttribute failed\n"); grid = -1; return; }
        if (hipOccupancyMaxActiveBlocksPerMultiprocessor(&per_cu, (const void*)fwd, 512, LDS_BYTES) != hipSuccess || per_cu < 1) { per_cu = 1; (void)hipGetLastError(); }
        grid = cus * per_cu;
        fprintf(stderr, "kernel_launch: grid %d (cus %d x %d), ws %zu MiB\n", grid, cus, per_cu, ws_size >> 20);
    }
    if (grid < 0) return;
    Args a{};
    for (int i = 0; i < 22; ++i) a.in[i] = (const float*)d_in[i];
    a.out = (float*)d_out; a.ws = (unsigned char*)d_ws;
#if MK_MULTI
    for (int p = 0; p < NPH; ++p) { a.lo = p; a.hi = p + 1; hipLaunchKernelGGL(fwd, dim3(grid), dim3(512), LDS_BYTES, stream, a); }
#else
    a.lo = 0; a.hi = NPH;
    void* args[] = {&a};
    hipError_t e = hipLaunchCooperativeKernel((const void*)fwd, dim3(grid), dim3(512), args, LDS_BYTES, stream);
    if (e != hipSuccess) fprintf(stderr, "cooperative launch failed: %s (grid %d)\n", hipGetErrorString(e), grid);
#endif
}
```

```cpp
#include <hip/hip_runtime.h>
#include <hip/hip_cooperative_groups.h>
#include <cstdio>
#include <cstdint>
namespace cg = cooperative_groups;
namespace pg8 {
#define PG8_LAS __attribute__((address_space(3)))
typedef unsigned short bf16_t;
typedef short bf16x8 __attribute__((ext_vector_type(8)));
typedef float f32x4 __attribute__((ext_vector_type(4)));
typedef unsigned u32x4 __attribute__((ext_vector_type(4)));
constexpr int BM = 256, BK = 64, HALF = 128, HTB = HALF * BK * 2  , STAGE_BYTES = 8 * HTB, NXCD = 8, WGM = 8;

__host__ __device__ __forceinline__ int lds_byte(int r, int c) { const int st = (r >> 4) * 2 + (c >> 5), rr = r & 15, cc = c & 31, ob = rr * 64 + cc * 2; return st * 1024 + (ob ^ (((ob >> 9) & 1) << 5)); }
__host__ __device__ __forceinline__ void stage_rc(int b, int& R, int& C) { const int st = b / 1024, sb = b % 1024, swz = sb ^ (((sb >> 9) & 1) << 5); R = (st >> 1) * 16 + swz / 64; C = (st & 1) * 32 + (swz % 64) / 2; }
__host__ __device__ __forceinline__ int perm32(int rho) { const int n = rho >> 4, i = rho & 15; return 8 * (i >> 2) + 4 * n + (i & 3); }

struct Unit { int pm, pn; };
struct Gemm { const bf16_t* A; const bf16_t* Bt; int M, N, K; };

struct StaticOrder {
    int nM, nN, nwg, G, c;
    __host__ __device__ void init(int M, int N, int G_, int c_) { nM = M / BM; nN = N / BM; nwg = nM * nN; G = G_; c = c_; }
    __host__ __device__ bool next(int i, Unit& u) const {
        const long L = (long)i * G + c; if (L >= nwg) return false;
        int wgid = (int)L; { const int q = nwg / NXCD, r = nwg % NXCD, xcd = wgid % NXCD, off = wgid / NXCD; wgid = (xcd < r ? xcd * (q + 1) : r * (q + 1) + (xcd - r) * q) + off; }
        const int nig = WGM * nN, gid = wgid / nig, fm = gid * WGM, gsz = (nM - fm) < WGM ? (nM - fm) : WGM;
        u.pm = fm + ((wgid % nig) % gsz); u.pn = (wgid % nig) / gsz; return true;
    }
    __device__ __forceinline__ void a_ready(const Unit&) const {}
    __device__ __forceinline__ void done(const Unit&) const {}
};
typedef __bf16 bf16x2_t __attribute__((ext_vector_type(2)));
typedef float f32x2_t __attribute__((ext_vector_type(2)));
__device__ __forceinline__ unsigned cvt_pk_bf16(float lo, float hi) { unsigned r; asm volatile("v_cvt_pk_bf16_f32 %0, %1, %2" : "=v"(r) : "v"(lo), "v"(hi)); return r; }
__device__ __forceinline__ unsigned cvt_pk_bf16_cv(float lo, float hi) { const f32x2_t v = {lo, hi}; const bf16x2_t b = __builtin_convertvector(v, bf16x2_t); return __builtin_bit_cast(unsigned, b); }
__device__ __forceinline__ int otid() { int t = threadIdx.x; asm volatile("" : "+v"(t)); return t; }
__device__ __forceinline__ float silu_f(float v) { return v * __builtin_amdgcn_rcpf(1.0f + __expf(-v)); }

#define EPI_PIN(p) asm volatile("" : "+v"(p))
struct EpiSwiGLU {
    static constexpr bool PERM = true, AFTER_DRAIN = false;
    bf16_t* O; int ldc;
    __device__ __forceinline__ void operator()(const f32x4 (&acc)[2][2][4][2], const Unit& u, int wr, int wc, int fr, int fq) const {
        const int row0 = u.pm * BM + wr * 64 + fr, col0 = u.pn * 128 + wc * 32 + 8 * fq;
        bf16_t* rowp = O + (size_t)row0 * ldc + col0;
#pragma unroll
        for (int ai = 0; ai < 2; ++ai) {
#pragma unroll
            for (int m = 0; m < 4; ++m) {
                const f32x4 g0 = acc[ai][0][m][0], g1 = acc[ai][0][m][1], u0 = acc[ai][1][m][0], u1 = acc[ai][1][m][1];
                u32x4 w;
                w.x = cvt_pk_bf16(silu_f(g0[0]) * u0[0], silu_f(g0[1]) * u0[1]); w.y = cvt_pk_bf16(silu_f(g0[2]) * u0[2], silu_f(g0[3]) * u0[3]);
                w.z = cvt_pk_bf16(silu_f(g1[0]) * u1[0], silu_f(g1[1]) * u1[1]); w.w = cvt_pk_bf16(silu_f(g1[2]) * u1[2], silu_f(g1[3]) * u1[3]);
                *(u32x4*)rowp = w;
                rowp += (size_t)16 * ldc; EPI_PIN(rowp);
            }
            rowp += (size_t)64 * ldc; EPI_PIN(rowp);
        }
    }
};
struct EpiResid {
    static constexpr bool PERM = false, AFTER_DRAIN = false;
    const float* xin; float* xout; const float* gate; float scale; int half;
    __device__ __forceinline__ void operator()(const f32x4 (&acc)[2][2][4][2], const Unit& u, int wr, int wc, int fr, int fq) const {
        const int row0 = u.pm * BM + wr * 64 + fr, col0 = u.pn * BM + wc * 32 + 4 * fq;
        const int batch = half ? 8 + (u.pm >> 5) : (u.pm >> 4);
        const float* gp = gate + (size_t)batch * 9216 + col0;
        f32x4 gv[2][2];
#pragma unroll
        for (int bj = 0; bj < 2; ++bj)
#pragma unroll
            for (int n = 0; n < 2; ++n) gv[bj][n] = *(const f32x4*)(gp + bj * HALF + n * 16) * scale;
        const float* xp = xin + (size_t)row0 * 1024 + col0; float* op = xout + (size_t)row0 * 1024 + col0;
#pragma unroll
        for (int ai = 0; ai < 2; ++ai) {
#pragma unroll
            for (int m = 0; m < 4; ++m) {
#pragma unroll
                for (int bj = 0; bj < 2; ++bj)
#pragma unroll
                    for (int n = 0; n < 2; ++n) { const f32x4 xi = *(const f32x4*)(xp + bj * HALF + n * 16); *(f32x4*)(op + bj * HALF + n * 16) = xi + gv[bj][n] * acc[ai][bj][m][n]; }
                xp += 16 * 1024; op += 16 * 1024; EPI_PIN(xp); EPI_PIN(op);
                asm volatile("" ::: "memory"); }
            xp += 64 * 1024; op += 64 * 1024; EPI_PIN(xp); EPI_PIN(op);
        }
    }
};
struct EpiProj {
    static constexpr bool PERM = true, AFTER_DRAIN = false;
    static constexpr size_t OFF_PA = (size_t)144 << 20, OFF_PD = (size_t)272 << 20, OFF_Z = (size_t)240 << 20;
    unsigned char* wsb; float* AB; const float* rope; int smask;
    __device__ __forceinline__ void operator()(const f32x4 (&acc)[2][2][4][2], const Unit& u, int wr, int wc, int fr, int fq) const {
        const int row0 = u.pm * BM + wr * 64 + fr, pn = u.pn;
        if (pn < 14) {
            const size_t poff = pn < 6 ? OFF_PA : (pn < 12 ? OFF_PD : OFF_Z); bf16_t* P = (bf16_t*)(wsb + poff); const int ldp = pn < 12 ? 1536 : 512;
            const int col0 = (pn < 6 ? pn : (pn < 12 ? pn - 6 : pn - 12)) * 256 + wc * 32 + 8 * fq;
            const bool rot = (pn < 4) && ((wc & 1) == 0) && (fq < 2);
            const float sgn = (fq & 1) ? 1.f : -1.f;
            bf16_t* rowp = P + (size_t)row0 * ldp + col0; int row = row0;
#pragma unroll
            for (int ai = 0; ai < 2; ++ai) {
#pragma unroll
                for (int m = 0; m < 4; ++m) {
                    f32x4 c0 = {0.f, 0.f, 0.f, 0.f}, c1 = c0, s0 = c0, s1 = c0;
                    if (pn < 4) { const float* rp = rope + (size_t)(row & smask) * 16; c0 = *(const f32x4*)rp; c1 = *(const f32x4*)(rp + 4); s0 = *(const f32x4*)(rp + 8); s1 = *(const f32x4*)(rp + 12); }
#pragma unroll
                    for (int bj = 0; bj < 2; ++bj) { f32x4 v0 = acc[ai][bj][m][0], v1 = acc[ai][bj][m][1];
                        if (pn < 4) { f32x4 p0, p1;
#pragma unroll
                            for (int j = 0; j < 4; ++j) { p0[j] = __shfl_xor(v0[j], 16); p1[j] = __shfl_xor(v1[j], 16); }
                            const f32x4 r0 = v0 * c0 + sgn * (p0 * s0), r1 = v1 * c1 + sgn * (p1 * s1);
                            if (rot) { v0 = r0; v1 = r1; } }
                        u32x4 w; w.x = cvt_pk_bf16(v0[0], v0[1]); w.y = cvt_pk_bf16(v0[2], v0[3]); w.z = cvt_pk_bf16(v1[0], v1[1]); w.w = cvt_pk_bf16(v1[2], v1[3]);
                        *(u32x4*)(rowp + bj * HALF) = w; }
                    rowp += (size_t)16 * ldp; row += 16; EPI_PIN(rowp); EPI_PIN(row);
                    asm volatile("" ::: "memory"); }
                rowp += (size_t)64 * ldp; row += 64; EPI_PIN(rowp); EPI_PIN(row);
            }
        } else {
            if (wc == 0 && fq < 2) {
                float* ap = AB + (size_t)row0 * 16 + 8 * fq;
#pragma unroll
                for (int ai = 0; ai < 2; ++ai) {
#pragma unroll
                    for (int m = 0; m < 4; ++m) { *(f32x4*)ap = acc[ai][0][m][0]; *(f32x4*)(ap + 4) = acc[ai][0][m][1]; ap += 16 * 16; EPI_PIN(ap); }
                    ap += 64 * 16; EPI_PIN(ap); }
            }
        }
    }
};

template <class Epi, class Sched, bool ALIGN_EPI = false, bool SP2 = false>
__device__ __forceinline__ void gemm_phase(PG8_LAS unsigned char* lds, const Gemm g, const Sched& S, const Epi& E) {
    const int tid = otid(), wid = __builtin_amdgcn_readfirstlane(tid >> 6), lane = tid & 63, wr = wid >> 2, wc = wid & 3, fr = lane & 15, fq = lane >> 4;
    const int K = g.K, nt = K / BK;
    unsigned voffA[2], voffB[2];
#pragma unroll
    for (int i = 0; i < 2; ++i) { int R, C; stage_rc(tid * 16 + i * 8192, R, C); const int Rb = Epi::PERM ? ((R & ~31) + perm32(R & 31)) : R;
        voffA[i] = (unsigned)(R * K + C) * 2u; voffB[i] = (unsigned)(Rb * K + C) * 2u; }
    const size_t kstep = (size_t)(BK * 2);
    const size_t hstep = (size_t)HALF * K * 2;
    const size_t tstep = 2 * hstep;
    const unsigned ldsw = (unsigned)wid * 1024u;
    const int aoff = lds_byte(wr * 64 + fr, fq * 8), boff = lds_byte(wc * 32 + fr, fq * 8);
#define PG8_SA(b, h) (((b) * 2 + (h)) * HTB)
#define PG8_SB(b, h) ((4 + (b) * 2 + (h)) * HTB)
#define PG8_STAGE(bufoff, gbase, voff) do { _Pragma("unroll") for (int _i = 0; _i < 2; ++_i) \
        __builtin_amdgcn_global_load_lds((const unsigned*)((const char*)(gbase) + (voff)[_i]), (PG8_LAS unsigned*)(lds + (bufoff) + ldsw + _i * 8192), 16, 0, 0); } while (0)
#define PG8_LDA(dst, b, h) do { _Pragma("unroll") for (int m = 0; m < 4; ++m) _Pragma("unroll") for (int k = 0; k < 2; ++k) dst[m][k] = *(const PG8_LAS bf16x8*)(lds + PG8_SA(b, h) + aoff + m * 2048 + k * 1024); } while (0)
#define PG8_LDB(dst, b, h) do { _Pragma("unroll") for (int n = 0; n < 2; ++n) _Pragma("unroll") for (int k = 0; k < 2; ++k) dst[n][k] = *(const PG8_LAS bf16x8*)(lds + PG8_SB(b, h) + boff + n * 2048 + k * 1024); } while (0)
#define PG8_MMA(ai, bj, At, Bt) do { __builtin_amdgcn_s_setprio(1); _Pragma("unroll") for (int m = 0; m < 4; ++m) _Pragma("unroll") for (int n = 0; n < 2; ++n) _Pragma("unroll") for (int k = 0; k < 2; ++k) \
        acc[ai][bj][m][n] = __builtin_amdgcn_mfma_f32_16x16x32_bf16(Bt[n][k], At[m][k], acc[ai][bj][m][n], 0, 0, 0); __builtin_amdgcn_s_setprio(0); } while (0)
#define PG8_WAIT_V(n) asm volatile("s_waitcnt vmcnt(" #n ")" ::: "memory")
#define PG8_WAIT_L(n) asm volatile("s_waitcnt lgkmcnt(" #n ")" ::: "memory")
#define PG8_BAR __builtin_amdgcn_s_barrier()
#define PG8_SCHED __builtin_amdgcn_sched_barrier(0)
    Unit cur, nxt; int ui = 0;
    if (!S.next(0, cur)) return;
    f32x4 acc[2][2][4][2];
#pragma unroll
    for (int a = 0; a < 2; ++a)
#pragma unroll
        for (int b = 0; b < 2; ++b)
#pragma unroll
            for (int m = 0; m < 4; ++m)
#pragma unroll
                for (int n = 0; n < 2; ++n) acc[a][b][m][n] = (f32x4){0.f, 0.f, 0.f, 0.f};
    bf16x8 At[4][2], B0[2][2], B1[2][2];
    const char* cA = (const char*)g.A + (size_t)cur.pm * tstep; const char* cB = (const char*)g.Bt + (size_t)cur.pn * tstep;
    S.a_ready(cur);
    if constexpr (SP2) {
        PG8_STAGE(PG8_SB(0, 0), cB, voffB); PG8_STAGE(PG8_SB(0, 1), cB + hstep, voffB); PG8_STAGE(PG8_SA(0, 0), cA, voffA); PG8_STAGE(PG8_SA(0, 1), cA + hstep, voffA);
        if (wr == 1) PG8_BAR;
        PG8_WAIT_V(2); PG8_BAR;
        PG8_STAGE(PG8_SB(1, 0), cB + kstep, voffB); PG8_STAGE(PG8_SA(1, 0), cA + kstep, voffA); PG8_STAGE(PG8_SB(1, 1), cB + hstep + kstep, voffB);
        PG8_WAIT_V(6); PG8_BAR;
    } else {
        PG8_STAGE(PG8_SB(0, 0), cB, voffB); PG8_STAGE(PG8_SA(0, 0), cA, voffA); PG8_STAGE(PG8_SB(0, 1), cB + hstep, voffB); PG8_STAGE(PG8_SA(0, 1), cA + hstep, voffA);
        if (wr == 1) PG8_BAR;
        PG8_WAIT_V(4); PG8_BAR;
        PG8_STAGE(PG8_SB(1, 0), cB + kstep, voffB); PG8_STAGE(PG8_SA(1, 0), cA + kstep, voffA); PG8_STAGE(PG8_SB(1, 1), cB + hstep + kstep, voffB);
        PG8_WAIT_V(6); PG8_BAR;
    }
    for (;;) {
        const bool has_next = S.next(ui + 1, nxt);
        const char* nA = has_next ? (const char*)g.A + (size_t)nxt.pm * tstep : cA; const char* nB = has_next ? (const char*)g.Bt + (size_t)nxt.pn * tstep : cB;
        for (int t = 0; t < nt; t += 2) {
            const bool last = (t == nt - 2);
            const char* a1 = cA + (size_t)(t + 1) * kstep;
            const char* a2 = last ? nA : cA + (size_t)(t + 2) * kstep; const char* b2 = last ? nB : cB + (size_t)(t + 2) * kstep;
            const char* a3 = a2 + kstep; const char* b3 = b2 + kstep;
            if (last && has_next) S.a_ready(nxt);
            if constexpr (SP2) {
            PG8_LDB(B0, 0, 0); PG8_LDB(B1, 0, 1); PG8_SCHED; PG8_LDA(At, 0, 0); PG8_STAGE(PG8_SA(1, 1), a1 + hstep, voffA);
            PG8_WAIT_V(8); PG8_WAIT_L(0); PG8_BAR; PG8_MMA(0, 0, At, B0); PG8_MMA(0, 1, At, B1); PG8_BAR; PG8_SCHED;
            PG8_LDA(At, 0, 1); PG8_STAGE(PG8_SB(0, 0), b2, voffB); PG8_STAGE(PG8_SB(0, 1), b2 + hstep, voffB); PG8_STAGE(PG8_SA(0, 0), a2, voffA);
            PG8_WAIT_V(8); PG8_WAIT_L(0); PG8_BAR; PG8_MMA(1, 0, At, B0); PG8_MMA(1, 1, At, B1); PG8_BAR; PG8_SCHED;
            PG8_LDB(B0, 1, 0); PG8_LDB(B1, 1, 1); PG8_SCHED; PG8_LDA(At, 1, 0); PG8_STAGE(PG8_SA(0, 1), a2 + hstep, voffA);
            PG8_WAIT_V(8); PG8_WAIT_L(0); PG8_BAR; PG8_MMA(0, 0, At, B0); PG8_MMA(0, 1, At, B1); PG8_BAR; PG8_SCHED;
            PG8_LDA(At, 1, 1); PG8_STAGE(PG8_SB(1, 0), b3, voffB); PG8_STAGE(PG8_SB(1, 1), b3 + hstep, voffB); PG8_STAGE(PG8_SA(1, 0), a3, voffA);
            PG8_WAIT_V(8); PG8_WAIT_L(0); PG8_BAR; PG8_MMA(1, 0, At, B0); PG8_MMA(1, 1, At, B1); PG8_BAR; PG8_SCHED;
            } else {
            PG8_LDB(B0, 0, 0); PG8_SCHED; PG8_LDA(At, 0, 0); PG8_STAGE(PG8_SA(1, 1), a1 + hstep, voffA);
            PG8_WAIT_L(8); PG8_BAR; PG8_WAIT_L(0); PG8_MMA(0, 0, At, B0); PG8_BAR; PG8_SCHED;
            PG8_LDB(B1, 0, 1); PG8_STAGE(PG8_SB(0, 0), b2, voffB);
            PG8_BAR; PG8_WAIT_L(0); PG8_MMA(0, 1, At, B1); PG8_BAR;
            PG8_LDA(At, 0, 1); PG8_STAGE(PG8_SA(0, 0), a2, voffA);
            PG8_BAR; PG8_WAIT_L(0); PG8_MMA(1, 0, At, B0); PG8_BAR; PG8_SCHED;
            PG8_STAGE(PG8_SB(0, 1), b2 + hstep, voffB);
            PG8_WAIT_V(6); PG8_BAR; PG8_MMA(1, 1, At, B1); PG8_BAR;
            PG8_LDB(B0, 1, 0); PG8_SCHED; PG8_LDA(At, 1, 0); PG8_STAGE(PG8_SA(0, 1), a2 + hstep, voffA);
            PG8_WAIT_L(8); PG8_BAR; PG8_WAIT_L(0); PG8_MMA(0, 0, At, B0); PG8_BAR; PG8_SCHED;
            PG8_LDB(B1, 1, 1); PG8_STAGE(PG8_SB(1, 0), b3, voffB);
            PG8_BAR; PG8_WAIT_L(0); PG8_MMA(0, 1, At, B1); PG8_BAR;
            PG8_LDA(At, 1, 1); PG8_STAGE(PG8_SA(1, 0), a3, voffA);
            PG8_BAR; PG8_WAIT_L(0); PG8_MMA(1, 0, At, B0); PG8_BAR; PG8_SCHED;
            PG8_STAGE(PG8_SB(1, 1), b3 + hstep, voffB);
            PG8_WAIT_V(6); PG8_BAR; PG8_MMA(1, 1, At, B1); PG8_BAR;
            }
        }
        if constexpr (ALIGN_EPI) { if (wr == 0) PG8_BAR; }
        if constexpr (!Epi::AFTER_DRAIN) { E(acc, cur, wr, wc, fr, fq); S.done(cur); }
        if (!has_next) break;
#pragma unroll
        for (int a = 0; a < 2; ++a)
#pragma unroll
            for (int b = 0; b < 2; ++b)
#pragma unroll
                for (int m = 0; m < 4; ++m)
#pragma unroll
                    for (int n = 0; n < 2; ++n) acc[a][b][m][n] = (f32x4){0.f, 0.f, 0.f, 0.f};
        cur = nxt; cA = nA; cB = nB; ++ui;
        if constexpr (ALIGN_EPI) { if (wr == 1) PG8_BAR; }
    }
    PG8_WAIT_V(0);
    if constexpr (!ALIGN_EPI) { if (wr == 0) PG8_BAR; }
    PG8_BAR;
    if constexpr (Epi::AFTER_DRAIN) { E.fused(acc, cur, wr, wc, fr, fq, lds, wid, lane); S.done(cur); }
#undef PG8_SA
#undef PG8_SB
#undef PG8_STAGE
#undef PG8_LDA
#undef PG8_LDB
#undef PG8_MMA
#undef PG8_WAIT_V
#undef PG8_WAIT_L
#undef PG8_BAR
#undef PG8_SCHED
}
}

#define LAS __attribute__((address_space(3)))
typedef unsigned short bf16;
typedef short bf16x8 __attribute__((ext_vector_type(8)));
typedef short s16x4 __attribute__((ext_vector_type(4)));
typedef float f32x4 __attribute__((ext_vector_type(4)));
typedef unsigned v4u __attribute__((ext_vector_type(4)));
typedef unsigned v2u __attribute__((ext_vector_type(2)));
#define MFMA16(a, b, c) __builtin_amdgcn_mfma_f32_16x16x32_bf16((a), (b), (c), 0, 0, 0)
#define CAT8(lo, hi) __builtin_shufflevector((lo), (hi), 0, 1, 2, 3, 4, 5, 6, 7)
#define LDS_WAIT() asm volatile("s_waitcnt lgkmcnt(0)" ::: "memory")

constexpr int D = 1024, FF = 2816, MH = 32768, NPROJ = 3840, INW = 3600;
constexpr float EPS = 1e-6f;
constexpr size_t MiB = 1u << 20;
constexpr size_t WS_MOD = 1 * MiB, WS_ROPE = 2 * MiB;
constexpr size_t WS_WGU1 = 4 * MiB, WS_WD1 = 15 * MiB, WS_WIN = 15 * MiB + 5632 * 1024, WS_WOUT = 28 * MiB, WS_WGU2 = 30 * MiB, WS_WD2 = 41 * MiB;
constexpr size_t WS_H = 48 * MiB, WS_DQ = 48 * MiB, WS_DK = 80 * MiB, WS_DV = 112 * MiB, WS_OF = 80 * MiB, WS_OB = 112 * MiB;
constexpr size_t WS_ACT = 112 * MiB, WS_PA = 144 * MiB, WS_Z = 240 * MiB, WS_CH = 272 * MiB, WS_PD = 272 * MiB, WS_OG = 272 * MiB, WS_LSE = 368 * MiB, WS_MIX = 374 * MiB;
constexpr size_t WS_AB = 496 * MiB, WS_GB = 498 * MiB, WS_GC = 500 * MiB, WS_END = 501 * MiB;
constexpr int LDS_BYTES = 151552;
constexpr int CHJOB = 57344;

__device__ __forceinline__ float bf2f(unsigned short v) { return __uint_as_float(((unsigned)v) << 16); }
__device__ __forceinline__ float bflo(unsigned w) { return __uint_as_float(w << 16); }
__device__ __forceinline__ float bfhi(unsigned w) { return __uint_as_float(w & 0xffff0000u); }
__device__ __forceinline__ unsigned pk2(float lo, float hi) { return pg8::cvt_pk_bf16(lo, hi); }
__device__ __forceinline__ float opaque_one() { float o = 1.0f; asm volatile("" : "+v"(o)); return o; }
__device__ __forceinline__ float silu(float v) { return v * __builtin_amdgcn_rcpf(1.0f + __expf(-v)); }
__device__ __forceinline__ float wave_sum(float v) {
#pragma unroll
    for (int o = 1; o < 64; o <<= 1) v += __shfl_xor(v, o);
    return v;
}
__device__ __forceinline__ bf16x8 pack8(const f32x4 a, const f32x4 b) {
    v4u w; w.x = pk2(a[0], a[1]); w.y = pk2(a[2], a[3]); w.z = pk2(b[0], b[1]); w.w = pk2(b[2], b[3]);
    return __builtin_bit_cast(bf16x8, w);
}
__device__ __forceinline__ f32x4 ld_bf4(const bf16* p) { const v2u w = *(const v2u*)p; return (f32x4){bflo(w.x), bfhi(w.x), bflo(w.y), bfhi(w.y)}; }

__device__ __forceinline__ void ph_mod(const float* c_prompt, const float* c_sample, const float* ada_w, const float* ada_b, float* MOD, LAS unsigned char* lds) {
    const int tid = pg8::otid(), lane = tid & 63, wave = tid >> 6;
    LAS float* sc = (LAS float*)lds;
    LAS float* red = (LAS float*)(lds + 49152);
    for (int i = tid; i < 12 * 1024; i += 512) { const int b = i >> 10, k = i & 1023; const float v = b < 8 ? c_prompt[b * 1024 + k] : c_sample[(b - 8) * 1024 + k]; sc[i] = silu(v); }
    __syncthreads();
    const int cl = tid & 7, kg = tid >> 3;
    for (int item = blockIdx.x; item < 576; item += gridDim.x) {
        const int layer = item / 288, cg32 = item % 288, col = cg32 * 32 + cl * 4;
        float acc[12][4];
#pragma unroll
        for (int b = 0; b < 12; ++b)
#pragma unroll
            for (int j = 0; j < 4; ++j) acc[b][j] = 0.f;
        const float* wp = ada_w + (size_t)layer * 1024 * 9216 + col;
#pragma unroll 4
        for (int kk = 0; kk < 16; ++kk) { const int k = kg * 16 + kk; const f32x4 w = *(const f32x4*)(wp + (size_t)k * 9216);
#pragma unroll
            for (int b = 0; b < 12; ++b) { const float s = sc[b * 1024 + k];
#pragma unroll
                for (int j = 0; j < 4; ++j) acc[b][j] += s * w[j]; } }
#pragma unroll
        for (int b = 0; b < 12; ++b)
#pragma unroll
            for (int j = 0; j < 4; ++j) { float v = acc[b][j]; v += __shfl_xor(v, 8); v += __shfl_xor(v, 16); v += __shfl_xor(v, 32); if ((lane >> 3) == 0) red[(wave * 8 + cl) * 48 + b * 4 + j] = v; }
        __syncthreads();
        if (tid < 384) { const int b = tid >> 5, c = tid & 31; float s = 0.f;
#pragma unroll
            for (int w = 0; w < 8; ++w) s += red[(w * 8 + (c >> 2)) * 48 + b * 4 + (c & 3)];
            MOD[(size_t)(layer * 12 + b) * 9216 + cg32 * 32 + c] = s + ada_b[layer * 9216 + cg32 * 32 + c]; }
        __syncthreads();
    }
}
__device__ __forceinline__ void ph_rope(float* ROPE) {
    for (int idx = blockIdx.x * 512 + pg8::otid(); idx < 8192 * 8; idx += gridDim.x * 512) {
        const int s = idx >> 3, i = idx & 7;
        const float inv = exp2f(-(float)i * 0.125f * 18.931568569324174f);
        const float ang = (float)s * inv;
        double rev = (double)ang * 0.15915494309189535; rev -= __builtin_rint(rev);
        const float fr = (float)rev;
        ROPE[s * 16 + i] = __builtin_amdgcn_cosf(fr); ROPE[s * 16 + 8 + i] = __builtin_amdgcn_sinf(fr);
    }
}
__device__ __forceinline__ void tr_item(const float* W, int K, int N, bf16* WT, int k0, int n0, int dst_row0, LAS float* scr, int lane) {
#pragma unroll 8
    for (int i = 0; i < 32; ++i) { const int kk = 2 * i + (lane >> 5), n = n0 + (lane & 31); scr[kk * 33 + (lane & 31)] = (n < N) ? W[(size_t)(k0 + kk) * N + n] : 0.f; }
    LDS_WAIT();
    const int c = lane & 7;
#pragma unroll
    for (int j = 0; j < 4; ++j) { const int n = (lane >> 3) + 8 * j; const LAS float* s = scr + (8 * c) * 33 + n;
        v4u o; o.x = pk2(s[0 * 33], s[1 * 33]); o.y = pk2(s[2 * 33], s[3 * 33]); o.z = pk2(s[4 * 33], s[5 * 33]); o.w = pk2(s[6 * 33], s[7 * 33]);
        *(v4u*)(WT + (size_t)(dst_row0 + n) * K + k0 + 8 * c) = o; }
    LDS_WAIT();
}
__device__ __forceinline__ void ph_wconv(const float* wg1, const float* wu1, const float* wd1, const float* wg2, const float* wu2, const float* wd2, const float* win, const float* wout,
                                         int layer, unsigned char* ws, LAS unsigned char* lds) {
    const int tid_ = pg8::otid(), lane = tid_ & 63, wave = tid_ >> 6;
    LAS float* scr = (LAS float*)(lds + wave * 16384);
    const int gw = blockIdx.x * 8 + wave, NGW = gridDim.x * 8;
    constexpr int I_GU = 16 * 88, I_DN = 44 * 32, I_IN = 16 * 120, I_OUT = 16 * 32;
    constexpr int NIT = 6 * I_GU + I_IN + I_OUT;
    static_assert(I_DN == I_GU, "item counts");
    for (int it = gw; it < NIT; it += NGW) {
        int r = it;
        if (r < 6 * I_GU) {
            const int which = r / I_GU; r -= which * I_GU;
            const int f = which / 3, t = which % 3;
            if (t < 2) { const float* W = (f ? (t ? wu2 : wg2) : (t ? wu1 : wg1)) + (size_t)layer * D * FF; bf16* WT = (bf16*)(ws + (f ? WS_WGU2 : WS_WGU1));
                const int kb = r / 88, nb = r % 88, n0 = nb * 32; tr_item(W, D, FF, WT, kb * 64, n0, (n0 >> 7) * 256 + t * 128 + (n0 & 127), scr, lane); }
            else { const float* W = (f ? wd2 : wd1) + (size_t)layer * D * FF; bf16* WT = (bf16*)(ws + (f ? WS_WD2 : WS_WD1));
                const int kb = r / 32, nb = r % 32; tr_item(W, FF, D, WT, kb * 64, nb * 32, nb * 32, scr, lane); }
            continue;
        }
        r -= 6 * I_GU;
        if (r < I_IN) { const int kb = r / 120, nb = r % 120; tr_item(win + (size_t)layer * D * INW, D, INW, (bf16*)(ws + WS_WIN), kb * 64, nb * 32, nb * 32, scr, lane); continue; }
        r -= I_IN;
        { const int kb = r / 32, nb = r % 32; tr_item(wout + (size_t)layer * D * D, D, D, (bf16*)(ws + WS_WOUT), kb * 64, nb * 32, nb * 32, scr, lane); }
    }
}
__device__ __forceinline__ void ph_norm(const float* x, const float* nw, const float* modl, int sb, int half, bf16* H) {
    const int tid_ = pg8::otid(), lane = tid_ & 63, wave = tid_ >> 6;
    const int gw = blockIdx.x * 8 + wave, NGW = gridDim.x * 8;
    for (int r0 = gw * 16; r0 < MH; r0 += NGW * 16) {
        const int batch = half ? 8 + (r0 >> 13) : (r0 >> 12);
        const float* mp = modl + (size_t)batch * 9216 + sb * 3072;
        f32x4 A[4], B[4];
#pragma unroll
        for (int j = 0; j < 4; ++j) { const int c = 4 * lane + 256 * j; const f32x4 w = *(const f32x4*)(nw + c), sh = *(const f32x4*)(mp + c), scl = *(const f32x4*)(mp + 1024 + c); A[j] = w * (1.0f + scl); B[j] = sh; }
        for (int r = r0; r < r0 + 16; ++r) {
            const f32x4* xr = (const f32x4*)(x + (size_t)r * D) + lane;
            f32x4 v[4]; float s = 0.f;
#pragma unroll
            for (int j = 0; j < 4; ++j) { v[j] = xr[64 * j]; s += (v[j].x * v[j].x + v[j].y * v[j].y) + (v[j].z * v[j].z + v[j].w * v[j].w); }
            const float rstd = __builtin_amdgcn_rsqf(wave_sum(s) * (1.f / D) + EPS);
            v2u* o8 = (v2u*)(H + (size_t)r * D) + lane;
#pragma unroll
            for (int j = 0; j < 4; ++j) { const f32x4 h = v[j] * rstd * A[j] + B[j]; v2u w; w.x = pk2(h.x, h.y); w.y = pk2(h.z, h.w); o8[64 * j] = w; }
        }
    }
}
__device__ __forceinline__ void ph_final(float* x, const float* nw) {
    const int tid_ = pg8::otid(), lane = tid_ & 63, wave = tid_ >> 6;
    const int gw = blockIdx.x * 8 + wave, NGW = gridDim.x * 8;
    f32x4 A[4];
#pragma unroll
    for (int j = 0; j < 4; ++j) A[j] = *(const f32x4*)(nw + 4 * lane + 256 * j);
    for (int r = gw; r < 2 * MH; r += NGW) {
        f32x4* xr = (f32x4*)(x + (size_t)r * D) + lane;
        f32x4 v[4]; float s = 0.f;
#pragma unroll
        for (int j = 0; j < 4; ++j) { v[j] = xr[64 * j]; s += (v[j].x * v[j].x + v[j].y * v[j].y) + (v[j].z * v[j].z + v[j].w * v[j].w); }
        const float rstd = __builtin_amdgcn_rsqf(wave_sum(s) * (1.f / D) + EPS);
#pragma unroll
        for (int j = 0; j < 4; ++j) xr[64 * j] = v[j] * rstd * A[j];
    }
}
__device__ __forceinline__ void ph_dnpre(const bf16* PD, const float* AB, const float* conv_w, const float* a_log, const float* dt_bias,
                                         bf16* DQ, bf16* DK, bf16* DV, float* GB, int S) {
    const int tid_ = pg8::otid(), lane = tid_ & 63, wave = tid_ >> 6;
    const int gw = blockIdx.x * 8 + wave, NGW = gridDim.x * 8;
    for (int t0 = gw * 16; t0 < MH; t0 += NGW * 16) {
        const int s0 = t0 & (S - 1);
        for (int part = 0; part < 3; ++part) {
            const bf16* src = PD + part * 512 + lane * 8;
            bf16* dst = (part == 0 ? DQ : (part == 1 ? DK : DV)) + lane * 8;
            f32x4 w[5][2];
#pragma unroll
            for (int j = 0; j < 5; ++j) { const float* wp = conv_w + j * 1536 + part * 512 + lane * 8; w[j][0] = *(const f32x4*)wp; w[j][1] = *(const f32x4*)(wp + 4); }
            v4u r0, r1, r2, r3, r4;
            const v4u zero = {0u, 0u, 0u, 0u};
#define ROWLD(off) (((unsigned)(s0 + (off)) < (unsigned)S) ? *(const v4u*)(src + (size_t)(t0 + (off)) * 1536) : zero)
            r0 = ROWLD(-2); r1 = ROWLD(-1); r2 = ROWLD(0); r3 = ROWLD(1);
            for (int i = 0; i < 16; ++i) {
                r4 = ROWLD(i + 2);
                f32x4 y0, y1;
#define TAP(rr, j, first) { const f32x4 a = {bflo(rr.x), bfhi(rr.x), bflo(rr.y), bfhi(rr.y)}, b = {bflo(rr.z), bfhi(rr.z), bflo(rr.w), bfhi(rr.w)}; \
                    if (first) { y0 = a * w[j][0]; y1 = b * w[j][1]; } else { y0 += a * w[j][0]; y1 += b * w[j][1]; } }
                TAP(r0, 0, true) TAP(r1, 1, false) TAP(r2, 2, false) TAP(r3, 3, false) TAP(r4, 4, false)
#undef TAP
#pragma unroll
                for (int e = 0; e < 4; ++e) { y0[e] = silu(y0[e]); y1[e] = silu(y1[e]); }
                if (part < 2) {
                    float ss = (y0.x * y0.x + y0.y * y0.y) + (y0.z * y0.z + y0.w * y0.w) + (y1.x * y1.x + y1.y * y1.y) + (y1.z * y1.z + y1.w * y1.w);
                    ss += __shfl_xor(ss, 1); ss += __shfl_xor(ss, 2); ss += __shfl_xor(ss, 4); ss += __shfl_xor(ss, 8);
                    const float scl = __builtin_amdgcn_rsqf(ss + EPS) * (part == 0 ? 0.08838834764831845f : 1.0f);
                    y0 *= scl; y1 *= scl;
                }
                v4u o; o.x = pk2(y0.x, y0.y); o.y = pk2(y0.z, y0.w); o.z = pk2(y1.x, y1.y); o.w = pk2(y1.z, y1.w);
                *(v4u*)(dst + (size_t)(t0 + i) * 512) = o;
                r0 = r1; r1 = r2; r2 = r3; r3 = r4;
            }
#undef ROWLD
        }
#pragma unroll
        for (int jj = 0; jj < 4; ++jj) { const int idx = lane + 64 * jj, tok = t0 + (idx >> 4), c = idx & 15; const float v = AB[(size_t)tok * 16 + c];
            float res;
            if (c < 8) { const float xx = v + dt_bias[c]; const float sp = fmaxf(xx, 0.f) + __logf(1.0f + __expf(-fabsf(xx))); res = -__expf(a_log[c]) * sp; }
            else res = __builtin_amdgcn_rcpf(1.0f + __expf(-v));
            GB[(size_t)tok * 16 + c] = res; }
    }
}
__device__ __forceinline__ void ph_attn(const bf16* P, bf16* OG, float* LSE, int S, int lgS, LAS unsigned char* lds) {
    const int tid = pg8::otid(), lane = tid & 63, wave = tid >> 6, l15 = lane & 15, g = lane >> 4;
    const float one = opaque_one();
    LAS unsigned char* KL = lds; LAS unsigned char* VT = lds + 41472;
    for (int u = blockIdx.x; u < 3 * 8 * 256; u += gridDim.x) {
        const int tb = u & 255, h = (u >> 8) & 7, p = u >> 11;
        const int lgd = 2 * p, L = S >> lgd, nb = L >> 7, bps = S >> 7;
        const int seq = tb >> (lgS - 7), lb = tb & (bps - 1);
        const int r = lb / nb, ib = lb - r * nb, i0 = ib << 7;
        const int seqbase = seq << lgS;
        __syncthreads();
        for (int idx = tid; idx < 288 * 8; idx += 512) {
            const int kl = idx >> 3, pc = idx & 7, ik = i0 - 64 + kl;
            v4u kv = {0u, 0u, 0u, 0u}, vv = kv;
            if (ik >= 0 && ik < L) { const bf16* src = P + (size_t)(seqbase + (ik << lgd) + r) * 1536 + h * 64 + pc * 8; kv = *(const v4u*)(src + 512); vv = *(const v4u*)(src + 1024); }
            *(LAS v4u*)(KL + kl * 144 + pc * 16) = kv;
#pragma unroll
            for (int e = 0; e < 8; ++e) { const unsigned wv = vv[e >> 1]; *(LAS unsigned short*)(VT + (pc * 8 + e) * 592 + kl * 2) = (unsigned short)((e & 1) ? (wv >> 16) : (wv & 0xffffu)); }
        }
        __syncthreads();
        const int iq = i0 + 16 * wave + l15, tokq = seqbase + (iq << lgd) + r;
        bf16x8 qf[2];
#pragma unroll
        for (int ks = 0; ks < 2; ++ks) qf[ks] = *(const bf16x8*)(P + (size_t)tokq * 1536 + h * 64 + 32 * ks + 8 * g);
        f32x4 acc[4];
#pragma unroll
        for (int dt = 0; dt < 4; ++dt) acc[dt] = (f32x4){0.f, 0.f, 0.f, 0.f};
        float m = -1e30f, lsum = 0.f;
        for (int s = 0; s < 5; ++s) {
            const int kl0 = 16 * wave + 32 * s;
            f32x4 c[2];
#pragma unroll
            for (int t = 0; t < 2; ++t) { c[t] = (f32x4){0.f, 0.f, 0.f, 0.f};
#pragma unroll
                for (int ks = 0; ks < 2; ++ks) { const bf16x8 a = *(const LAS bf16x8*)(KL + (kl0 + 16 * t + l15) * 144 + (32 * ks + 8 * g) * 2); c[t] = MFMA16(a, qf[ks], c[t]); } }
            float sc[8]; float mx = -1e30f;
#pragma unroll
            for (int t = 0; t < 2; ++t)
#pragma unroll
                for (int rg = 0; rg < 4; ++rg) { const int ik = i0 - 64 + kl0 + 16 * t + 4 * g + rg, dl = ik - iq;
                    const bool valid = (ik >= 0) && (ik < L) && (dl <= 64) && (dl >= -64);
                    const float sv = valid ? c[t][rg] * 0.18033688011112042f : -1e30f; sc[t * 4 + rg] = sv; mx = fmaxf(mx, sv); }
            mx = fmaxf(mx, __shfl_xor(mx, 16)); mx = fmaxf(mx, __shfl_xor(mx, 32));
            const float mn = fmaxf(m, mx), alpha = __builtin_amdgcn_exp2f(m - mn); m = mn;
            float ps = 0.f; f32x4 p0, p1;
#pragma unroll
            for (int e = 0; e < 4; ++e) { p0[e] = __builtin_amdgcn_exp2f(sc[e] - mn); p1[e] = __builtin_amdgcn_exp2f(sc[4 + e] - mn); ps += p0[e] + p1[e]; }
            lsum = lsum * alpha + ps;
            const bf16x8 pf = pack8(p0 * one, p1 * one);
#pragma unroll
            for (int dt = 0; dt < 4; ++dt) { acc[dt] *= alpha;
                const s16x4 lo = *(const LAS s16x4*)(VT + (16 * dt + l15) * 592 + (kl0 + 4 * g) * 2), hi = *(const LAS s16x4*)(VT + (16 * dt + l15) * 592 + (kl0 + 16 + 4 * g) * 2);
                acc[dt] = MFMA16(CAT8(lo, hi), pf, acc[dt]); }
        }
        lsum += __shfl_xor(lsum, 16); lsum += __shfl_xor(lsum, 32);
        const float inv = 1.0f / lsum;
        bf16* og = OG + ((size_t)p * MH + tokq) * 512 + h * 64 + 4 * g;
#pragma unroll
        for (int dt = 0; dt < 4; ++dt) { v2u w; w.x = pk2(acc[dt][0] * inv, acc[dt][1] * inv); w.y = pk2(acc[dt][2] * inv, acc[dt][3] * inv); *(v2u*)(og + 16 * dt) = w; }
        if (g == 0) LSE[((size_t)p * MH + tokq) * 8 + h] = (m + __log2f(lsum)) * 0.6931471805599453f;
    }
}
__device__ __forceinline__ void ph_chunk(const bf16* DQ, const bf16* DK, const bf16* DV, const float* GB, unsigned char* CH, float* GC, int S, int lgS, LAS unsigned char* lds) {
    const int tid_ = pg8::otid(), lane = tid_ & 63, wave = tid_ >> 6, l15 = lane & 15, g = lane >> 4;
    const float one = opaque_one();
    LAS unsigned char* wl = lds + wave * 18432;
    LAS float* Al = (LAS float*)wl; LAS float* gcs = (LAS float*)(wl + 17408); LAS float* bts = gcs + 64;
    LAS bf16* TP = (LAS bf16*)wl; LAS bf16* TPP = (LAS bf16*)(wl + 8192);
    for (int job = blockIdx.x * 8 + wave; job < 4096; job += gridDim.x * 8) {
        const int dir = job & 1, h = (job >> 1) & 3, cgi = job >> 3, cps = S >> 6;
        const int seq = cgi >> (lgS - 6), n = cgi & (cps - 1), seqbase = seq << lgS;
#define TOK(c) (seqbase + (dir ? (S - 1 - (64 * n + (c))) : (64 * n + (c))))
        {   const int tokc = TOK(lane);
            const float gv = GB[(size_t)tokc * 16 + dir * 4 + h], bv = GB[(size_t)tokc * 16 + 8 + dir * 4 + h];
            float cs = gv;
#pragma unroll
            for (int o = 1; o < 64; o <<= 1) { const float t = __shfl_up(cs, o); if (lane >= o) cs += t; }
            gcs[lane] = cs; bts[lane] = bv; GC[(size_t)job * 64 + lane] = cs; }
        LDS_WAIT();
        bf16x8 kf[4][4];
#pragma unroll
        for (int t = 0; t < 4; ++t)
#pragma unroll
            for (int ks = 0; ks < 4; ++ks) kf[t][ks] = *(const bf16x8*)(DK + (size_t)TOK(16 * t + l15) * 512 + h * 128 + 32 * ks + 8 * g);
#pragma unroll
        for (int it = 0; it < 4; ++it) { const int i = 16 * it + l15; const float gi = gcs[i], bi = bts[i];
#pragma unroll
            for (int jt = 0; jt <= it; ++jt) { f32x4 c = {0.f, 0.f, 0.f, 0.f};
#pragma unroll
                for (int ks = 0; ks < 4; ++ks) c = MFMA16(kf[jt][ks], kf[it][ks], c);
                const f32x4 gj = *(const LAS f32x4*)(gcs + 16 * jt + 4 * g); f32x4 o;
#pragma unroll
                for (int rg = 0; rg < 4; ++rg) { const int j = 16 * jt + 4 * g + rg; o[rg] = (j < i) ? bi * c[rg] * __expf(gi - gj[rg]) : 0.f; }
                *(LAS f32x4*)(Al + i * 68 + 16 * jt + 4 * g) = o; } }
        unsigned char* chb = CH + (size_t)job * CHJOB;
        bf16* UT = (bf16*)chb; bf16* Wm = (bf16*)(chb + 16384); bf16* KT = (bf16*)(chb + 32768); bf16* QK = (bf16*)(chb + 49152);
#pragma unroll
        for (int it = 0; it < 4; ++it) { const int i = 16 * it + l15; const float gi = gcs[i];
            bf16x8 qfr[4];
#pragma unroll
            for (int ks = 0; ks < 4; ++ks) qfr[ks] = *(const bf16x8*)(DQ + (size_t)TOK(i) * 512 + h * 128 + 32 * ks + 8 * g);
#pragma unroll
            for (int jt = 0; jt < 4; ++jt) { v2u out = {0u, 0u};
                if (jt <= it) { f32x4 c = {0.f, 0.f, 0.f, 0.f};
#pragma unroll
                    for (int ks = 0; ks < 4; ++ks) c = MFMA16(kf[jt][ks], qfr[ks], c);
                    const f32x4 gj = *(const LAS f32x4*)(gcs + 16 * jt + 4 * g); f32x4 o;
#pragma unroll
                    for (int rg = 0; rg < 4; ++rg) { const int j = 16 * jt + 4 * g + rg; o[rg] = (j <= i) ? c[rg] * __expf(gi - gj[rg]) : 0.f; }
                    out.x = pk2(o[0], o[1]); out.y = pk2(o[2], o[3]); }
                *(v2u*)(QK + i * 64 + 16 * jt + 4 * g) = out; } }
        LDS_WAIT();
        float t[64];
#pragma unroll
        for (int i = 0; i < 64; ++i) { float a0 = 0.f, a1 = 0.f, a2 = 0.f, a3 = 0.f;
#pragma unroll
            for (int j4 = 0; j4 * 4 < i; ++j4) { const f32x4 a = *(const LAS f32x4*)(Al + i * 68 + 4 * j4);
                if (4 * j4 + 0 < i) a0 += a[0] * t[4 * j4 + 0];
                if (4 * j4 + 1 < i) a1 += a[1] * t[4 * j4 + 1];
                if (4 * j4 + 2 < i) a2 += a[2] * t[4 * j4 + 2];
                if (4 * j4 + 3 < i) a3 += a[3] * t[4 * j4 + 3]; }
            t[i] = ((lane == i) ? 1.f : 0.f) - ((a0 + a1) + (a2 + a3)); }
        const float bc = bts[lane], ec = bc * __expf(gcs[lane]);
        LDS_WAIT();
#pragma unroll
        for (int i = 0; i < 64; ++i) { const unsigned w = pk2(t[i] * bc, t[i] * ec); TP[i * 64 + lane] = (bf16)(w & 0xffffu); TPP[i * 64 + lane] = (bf16)(w >> 16); }
        LDS_WAIT();
        bf16x8 tf[4][2];
#pragma unroll
        for (int mt = 0; mt < 4; ++mt)
#pragma unroll
            for (int ks = 0; ks < 2; ++ks) tf[mt][ks] = *(const LAS bf16x8*)(TP + (16 * mt + l15) * 64 + 32 * ks + 8 * g);
        for (int nt = 0; nt < 8; ++nt) {
            bf16x8 vf[2];
#pragma unroll
            for (int ks = 0; ks < 2; ++ks)
#pragma unroll
                for (int e = 0; e < 8; ++e) vf[ks][e] = (short)DV[(size_t)TOK(32 * ks + 8 * g + e) * 512 + h * 128 + 16 * nt + l15];
#pragma unroll
            for (int mt = 0; mt < 4; ++mt) { f32x4 c = {0.f, 0.f, 0.f, 0.f};
#pragma unroll
                for (int ks = 0; ks < 2; ++ks) c = MFMA16(tf[mt][ks], vf[ks], c);
                c *= one;
                v2u w; w.x = pk2(c[0], c[1]); w.y = pk2(c[2], c[3]); *(v2u*)(UT + (16 * nt + l15) * 64 + 16 * mt + 4 * g) = w; }
        }
#pragma unroll
        for (int mt = 0; mt < 4; ++mt)
#pragma unroll
            for (int ks = 0; ks < 2; ++ks) tf[mt][ks] = *(const LAS bf16x8*)(TPP + (16 * mt + l15) * 64 + 32 * ks + 8 * g);
        for (int dt = 0; dt < 8; ++dt) {
            bf16x8 kt[2];
#pragma unroll
            for (int ks = 0; ks < 2; ++ks) {
#pragma unroll
                for (int e = 0; e < 8; ++e) kt[ks][e] = (short)DK[(size_t)TOK(32 * ks + 8 * g + e) * 512 + h * 128 + 16 * dt + l15];
                *(bf16x8*)(KT + (16 * dt + l15) * 64 + 32 * ks + 8 * g) = kt[ks]; }
#pragma unroll
            for (int mt = 0; mt < 4; ++mt) { f32x4 c = {0.f, 0.f, 0.f, 0.f};
#pragma unroll
                for (int ks = 0; ks < 2; ++ks) c = MFMA16(kt[ks], tf[mt][ks], c);
                c *= one;
                v2u w; w.x = pk2(c[0], c[1]); w.y = pk2(c[2], c[3]); *(v2u*)(Wm + (16 * mt + l15) * 128 + 16 * dt + 4 * g) = w; }
        }
        LDS_WAIT();
    }
}
#define TOKN(c, nn) (seqbase + (dir ? (S - 1 - (64 * (nn) + (c))) : (64 * (nn) + (c))))
constexpr int SC_W = 0, SC_Q = 17408, SC_QK = 34816, SC_KT = 44032, SC_BUF = 62464;
__device__ __forceinline__ void ph_scan(const bf16* DQ, const unsigned char* CH, const float* GC, bf16* OF, bf16* OB, int S, int lgS, int half, LAS unsigned char* lds) {
    const int tid = pg8::otid(), lane = tid & 63, wave = tid >> 6, l15 = lane & 15, g = lane >> 4;
    const float one = opaque_one();
    const int nchain = half ? 32 : 64, cps = S >> 6;
    for (int chain = blockIdx.x; chain < nchain; chain += gridDim.x) {
        const int dir = chain & 1, h = (chain >> 1) & 3, seq = chain >> 3, seqbase = seq << lgS, dv0 = wave * 16;
        bf16* OX = dir ? OB : OF;
        const int p0 = tid, p1 = tid + 512;
        const int wrow0 = p0 >> 4, wrow1 = p1 >> 4, wc = tid & 15;
        const int krow0 = tid >> 3, kc = tid & 7;
        f32x4 St[8];
#pragma unroll
        for (int t = 0; t < 8; ++t) St[t] = (f32x4){0.f, 0.f, 0.f, 0.f};
        v4u r[7]; v2u utn[4]; f32x4 gcn[4]; float gln;
#define SC_LOAD(n_) do { const int nn_ = (n_); const int job = ((seq * cps + nn_) << 3) | (h << 1) | dir; const unsigned char* chb = CH + (size_t)job * CHJOB; \
            const bf16* Wm_ = (const bf16*)(chb + 16384); const bf16* KT_ = (const bf16*)(chb + 32768); const bf16* QK_ = (const bf16*)(chb + 49152); const bf16* UT_ = (const bf16*)chb; \
            r[0] = *(const v4u*)(Wm_ + wrow0 * 128 + wc * 8); r[1] = *(const v4u*)(Wm_ + wrow1 * 128 + wc * 8); \
            r[2] = *(const v4u*)(DQ + (size_t)TOKN(wrow0, nn_) * 512 + h * 128 + wc * 8); r[3] = *(const v4u*)(DQ + (size_t)TOKN(wrow1, nn_) * 512 + h * 128 + wc * 8); \
            r[4] = *(const v4u*)(QK_ + krow0 * 64 + kc * 8); \
            r[5] = *(const v4u*)(KT_ + krow0 * 64 + kc * 8); r[6] = *(const v4u*)(KT_ + (krow0 + 64) * 64 + kc * 8); \
            _Pragma("unroll") for (int mt = 0; mt < 4; ++mt) { utn[mt] = *(const v2u*)(UT_ + (dv0 + l15) * 64 + 16 * mt + 4 * g); gcn[mt] = *(const f32x4*)(GC + (size_t)job * 64 + 16 * mt + 4 * g); } \
            gln = GC[(size_t)job * 64 + 63]; } while (0)
#define SC_STORE(buf) do { LAS unsigned char* b_ = (buf); \
            *(LAS v4u*)(b_ + SC_W + wrow0 * 272 + wc * 16) = r[0]; *(LAS v4u*)(b_ + SC_W + wrow1 * 272 + wc * 16) = r[1]; \
            *(LAS v4u*)(b_ + SC_Q + wrow0 * 272 + wc * 16) = r[2]; *(LAS v4u*)(b_ + SC_Q + wrow1 * 272 + wc * 16) = r[3]; \
            *(LAS v4u*)(b_ + SC_QK + krow0 * 144 + kc * 16) = r[4]; \
            *(LAS v4u*)(b_ + SC_KT + krow0 * 144 + kc * 16) = r[5]; *(LAS v4u*)(b_ + SC_KT + (krow0 + 64) * 144 + kc * 16) = r[6]; } while (0)
        __syncthreads();
        SC_LOAD(0);
        SC_STORE(lds);
        __syncthreads();
        for (int n = 0; n < cps; ++n) {
            LAS unsigned char* buf = lds + (n & 1) * SC_BUF;
            v2u ut[4]; f32x4 gcv[4];
#pragma unroll
            for (int mt = 0; mt < 4; ++mt) { ut[mt] = utn[mt]; gcv[mt] = gcn[mt]; }
            const float glast = gln;
            const int ncur = n;
            if (n + 1 < cps) SC_LOAD(n + 1);
            bf16x8 sb[4];
#pragma unroll
            for (int ks = 0; ks < 4; ++ks) sb[ks] = pack8(St[2 * ks] * one, St[2 * ks + 1] * one);
            f32x4 vnew[4], o[4];
#pragma unroll
            for (int mt = 0; mt < 4; ++mt) { const int i = 16 * mt + l15;
                const LAS unsigned char* wrow = buf + SC_W + i * 272 + 8 * g; const LAS unsigned char* qrow = buf + SC_Q + i * 272 + 8 * g;
                f32x4 ws = {0.f, 0.f, 0.f, 0.f}, o1 = ws;
#pragma unroll
                for (int ks = 0; ks < 4; ++ks) {
                    const s16x4 wlo = *(const LAS s16x4*)(wrow + 64 * ks), whi = *(const LAS s16x4*)(wrow + 64 * ks + 32);
                    ws = MFMA16(CAT8(wlo, whi), sb[ks], ws);
                    const s16x4 qlo = *(const LAS s16x4*)(qrow + 64 * ks), qhi = *(const LAS s16x4*)(qrow + 64 * ks + 32);
                    o1 = MFMA16(CAT8(qlo, qhi), sb[ks], o1); }
                const f32x4 u4 = {bflo(ut[mt].x), bfhi(ut[mt].x), bflo(ut[mt].y), bfhi(ut[mt].y)};
                vnew[mt] = u4 - ws;
#pragma unroll
                for (int rg = 0; rg < 4; ++rg) o1[rg] *= __expf(gcv[mt][rg]);
                o[mt] = o1; }
            bf16x8 vb[2];
#pragma unroll
            for (int k2 = 0; k2 < 2; ++k2) vb[k2] = pack8(vnew[2 * k2], vnew[2 * k2 + 1]);
#pragma unroll
            for (int mt = 0; mt < 4; ++mt) { const LAS unsigned char* qkrow = buf + SC_QK + (16 * mt + l15) * 144 + 8 * g;
#pragma unroll
                for (int k2 = 0; k2 < 2; ++k2) { const s16x4 lo = *(const LAS s16x4*)(qkrow + 64 * k2), hi = *(const LAS s16x4*)(qkrow + 64 * k2 + 32); o[mt] = MFMA16(CAT8(lo, hi), vb[k2], o[mt]); } }
            {
#pragma unroll
            for (int mt = 0; mt < 4; ++mt)
#pragma unroll
                for (int rg = 0; rg < 4; ++rg) { const int tk = TOKN(16 * mt + 4 * g + rg, ncur); OX[(size_t)tk * 512 + h * 128 + dv0 + l15] = (bf16)(pk2(o[mt][rg] * one, 0.f) & 0xffffu); } }
            const float eg = __expf(glast);
#pragma unroll
            for (int mt = 0; mt < 4; ++mt)
#pragma unroll
                for (int rg = 0; rg < 4; ++rg) vnew[mt][rg] *= __expf(glast - gcv[mt][rg]);
#pragma unroll
            for (int k2 = 0; k2 < 2; ++k2) vb[k2] = pack8(vnew[2 * k2], vnew[2 * k2 + 1]);
#pragma unroll
            for (int t = 0; t < 8; ++t) { St[t] *= eg; const LAS unsigned char* ktrow = buf + SC_KT + (16 * t + l15) * 144 + 8 * g;
#pragma unroll
                for (int k2 = 0; k2 < 2; ++k2) { const s16x4 lo = *(const LAS s16x4*)(ktrow + 64 * k2), hi = *(const LAS s16x4*)(ktrow + 64 * k2 + 32); St[t] = MFMA16(CAT8(lo, hi), vb[k2], St[t]); } }
            if (n + 1 < cps) SC_STORE(lds + ((n + 1) & 1) * SC_BUF);
            __syncthreads();
        }
#undef SC_LOAD
#undef SC_STORE
    }
#undef TOKN
#undef TOK
}
__device__ __forceinline__ void ph_post(const bf16* OG, const float* LSE, const bf16* OF, const bf16* OB, const bf16* Z, const float* dn_norm, bf16* MIX) {
    const int tid_ = pg8::otid(), lane = tid_ & 63, wave = tid_ >> 6;
    const int gw = blockIdx.x * 8 + wave, NGW = gridDim.x * 8;
    f32x4 nw0 = *(const f32x4*)(dn_norm + (lane & 15) * 8), nw1 = *(const f32x4*)(dn_norm + (lane & 15) * 8 + 4);
    for (int t = gw; t < MH; t += NGW) {
        {   const int hd = lane >> 3;
            const float l0 = LSE[((size_t)0 * MH + t) * 8 + hd], l1 = LSE[((size_t)1 * MH + t) * 8 + hd], l2 = LSE[((size_t)2 * MH + t) * 8 + hd];
            const float mx = fmaxf(l0, fmaxf(l1, l2));
            float w0 = __expf(l0 - mx), w1 = __expf(l1 - mx), w2 = __expf(l2 - mx); const float inv = 1.0f / (w0 + w1 + w2); w0 *= inv; w1 *= inv; w2 *= inv;
            const v4u a = *(const v4u*)(OG + ((size_t)0 * MH + t) * 512 + lane * 8), b = *(const v4u*)(OG + ((size_t)1 * MH + t) * 512 + lane * 8), c = *(const v4u*)(OG + ((size_t)2 * MH + t) * 512 + lane * 8);
            v4u o;
#pragma unroll
            for (int e = 0; e < 4; ++e) o[e] = pk2(w0 * bflo(a[e]) + w1 * bflo(b[e]) + w2 * bflo(c[e]), w0 * bfhi(a[e]) + w1 * bfhi(b[e]) + w2 * bfhi(c[e]));
            *(v4u*)(MIX + (size_t)t * 1024 + lane * 8) = o; }
        {   const v4u a = *(const v4u*)(OF + (size_t)t * 512 + lane * 8), b = *(const v4u*)(OB + (size_t)t * 512 + lane * 8), z = *(const v4u*)(Z + (size_t)t * 512 + lane * 8);
            float ov[8]; float ss = 0.f;
#pragma unroll
            for (int e = 0; e < 4; ++e) { ov[2 * e] = bflo(a[e]) + bflo(b[e]); ov[2 * e + 1] = bfhi(a[e]) + bfhi(b[e]); ss += ov[2 * e] * ov[2 * e] + ov[2 * e + 1] * ov[2 * e + 1]; }
            ss += __shfl_xor(ss, 1); ss += __shfl_xor(ss, 2); ss += __shfl_xor(ss, 4); ss += __shfl_xor(ss, 8);
            const float rs = __builtin_amdgcn_rsqf(ss * (1.0f / 128.0f) + EPS);
            v4u o;
#pragma unroll
            for (int e = 0; e < 4; ++e) { const float n0 = (e < 2) ? nw0[2 * e] : nw1[2 * e - 4], n1 = (e < 2) ? nw0[2 * e + 1] : nw1[2 * e - 3];
                o[e] = pk2(ov[2 * e] * rs * n0 * silu(bflo(z[e])), ov[2 * e + 1] * rs * n1 * silu(bfhi(z[e]))); }
            *(v4u*)(MIX + (size_t)t * 1024 + 512 + lane * 8) = o; }
    }
}
#ifndef DBG_SKIP_MIXER
#define DBG_SKIP_MIXER 0
#endif
#ifndef MK_MULTI
#define MK_MULTI 0
#endif
constexpr int NPH = 1 + 2 * (2 * 14) + 1 + 1;
static_assert(pg8::EpiProj::OFF_PA == WS_PA && pg8::EpiProj::OFF_PD == WS_PD && pg8::EpiProj::OFF_Z == WS_Z, "EpiProj offsets");
struct Args { const float* in[22]; float* out; unsigned char* ws; int lo, hi; };

__global__ void __launch_bounds__(512, 2) fwd(Args a) {
    extern __shared__ __attribute__((aligned(16))) unsigned char lds_raw[];
    LAS unsigned char* lds = (LAS unsigned char*)lds_raw;
    cg::grid_group grid = cg::this_grid();
    unsigned char* ws = a.ws;
    const int lo = a.lo, hi = a.hi; int pc = 0;
    const float* x_prompt = a.in[0]; const float* x_sample = a.in[1];
    float* MOD = (float*)(ws + WS_MOD); float* ROPE = (float*)(ws + WS_ROPE);
    bf16* H = (bf16*)(ws + WS_H); bf16* ACT = (bf16*)(ws + WS_ACT); bf16* PA = (bf16*)(ws + WS_PA); bf16* PD = (bf16*)(ws + WS_PD); bf16* Zb = (bf16*)(ws + WS_Z);
    bf16* DQ = (bf16*)(ws + WS_DQ); bf16* DK = (bf16*)(ws + WS_DK); bf16* DV = (bf16*)(ws + WS_DV); bf16* OF = (bf16*)(ws + WS_OF); bf16* OB = (bf16*)(ws + WS_OB);
    unsigned char* CH = ws + WS_CH; bf16* OG = (bf16*)(ws + WS_OG); float* LSE = (float*)(ws + WS_LSE); bf16* MIX = (bf16*)(ws + WS_MIX);
    float* AB = (float*)(ws + WS_AB); float* GB = (float*)(ws + WS_GB); float* GC = (float*)(ws + WS_GC);
#define PH_BEGIN if (pc >= lo && pc < hi) {
#define PH_END } ++pc; if (pc > lo && pc < hi) grid.sync();

    PH_BEGIN
        ph_mod(a.in[2], a.in[3], a.in[4], a.in[5], MOD, lds);
        ph_rope(ROPE);
        ph_wconv(a.in[7], a.in[8], a.in[9], a.in[18], a.in[19], a.in[20], a.in[11], a.in[16], 0, ws, lds);
    PH_END
    for (int layer = 0; layer < 2; ++layer) {
        if (layer == 1) {
            PH_BEGIN ph_wconv(a.in[7], a.in[8], a.in[9], a.in[18], a.in[19], a.in[20], a.in[11], a.in[16], 1, ws, lds); PH_END
        }
        const float* modl = MOD + (size_t)layer * 12 * 9216;
        for (int half = 0; half < 2; ++half) {
            const int S = half ? 8192 : 4096, lgS = half ? 13 : 12;
            float* X = a.out + (size_t)half * MH * D;
            const float* xin0 = half ? x_sample : x_prompt;
            for (int sb = 0; sb < 3; ++sb) {
                if (DBG_SKIP_MIXER && sb == 1) continue;
                const bool first = (layer == 0 && sb == 0);
                const float* xsrc = first ? xin0 : X;
                const float* nw = (sb == 0 ? a.in[6] : (sb == 1 ? a.in[10] : a.in[17])) + layer * D;
                PH_BEGIN ph_norm(xsrc, nw, modl, sb, half, H); PH_END
                if (sb != 1) {
                    PH_BEGIN
                        pg8::Gemm g{H, (const bf16*)(ws + (sb ? WS_WGU2 : WS_WGU1)), MH, 2 * FF, D}; pg8::StaticOrder So; So.init(MH, 2 * FF, gridDim.x, (int)blockIdx.x);
                        pg8::EpiSwiGLU E{ACT, FF};
                        pg8::gemm_phase<pg8::EpiSwiGLU, pg8::StaticOrder, true, true>(lds, g, So, E);
                    PH_END
                    PH_BEGIN
                        pg8::Gemm g{ACT, (const bf16*)(ws + (sb ? WS_WD2 : WS_WD1)), MH, D, FF}; pg8::StaticOrder So; So.init(MH, D, gridDim.x, (int)blockIdx.x);
                        pg8::EpiResid E{xsrc, X, modl + (3 * sb + 2) * 1024, 0.5f, half};
                        pg8::gemm_phase<pg8::EpiResid, pg8::StaticOrder, true, true>(lds, g, So, E);
                    PH_END
                } else {
                    PH_BEGIN
                        pg8::Gemm g{H, (const bf16*)(ws + WS_WIN), MH, NPROJ, D}; pg8::StaticOrder So; So.init(MH, NPROJ, gridDim.x, (int)blockIdx.x);
                        pg8::EpiProj E{ws, AB, ROPE, S - 1};
                        pg8::gemm_phase<pg8::EpiProj, pg8::StaticOrder, true, true>(lds, g, So, E);
                    PH_END
                    PH_BEGIN ph_dnpre(PD, AB, a.in[12] + (size_t)layer * 5 * 1536, a.in[13] + layer * 8, a.in[14] + layer * 8, DQ, DK, DV, GB, S); PH_END
                    PH_BEGIN ph_chunk(DQ, DK, DV, GB, CH, GC, S, lgS, lds); PH_END
                    PH_BEGIN ph_scan(DQ, CH, GC, OF, OB, S, lgS, half, lds); PH_END
                    PH_BEGIN ph_attn(PA, OG, LSE, S, lgS, lds); PH_END
                    PH_BEGIN ph_post(OG, LSE, OF, OB, Zb, a.in[15] + layer * 128, MIX); PH_END
                    PH_BEGIN
                        pg8::Gemm g{MIX, (const bf16*)(ws + WS_WOUT), MH, D, D}; pg8::StaticOrder So; So.init(MH, D, gridDim.x, (int)blockIdx.x);
                        pg8::EpiResid E{X, X, modl + 5 * 1024, 1.0f, half};
                        pg8::gemm_phase<pg8::EpiResid, pg8::StaticOrder, true, true>(lds, g, So, E);
                    PH_END
                }
            }
        }
    }
    PH_BEGIN ph_final(a.out, a.in[21]); PH_END
}

extern "C" void kernel_launch(void* const* d_in, const int* in_sizes, int n_in, void* d_out, int out_size, void* d_ws, size_t ws_size, hipStream_t stream) {
    static int grid = 0;
    if (grid == 0) {
        if (n_in != 22 || ws_size < WS_END) { fprintf(stderr, "kernel_launch: unexpected n_in %d / ws_size %zu\n", n_in, ws_size); grid = -1; return; }
        int dev = 0, cus = 0, per_cu = 0;
        hipGetDevice(&dev); hipDeviceGetAttribute(&cus, hipDeviceAttributeMultiprocessorCount, dev);
        if (hipFuncSetAttribute((const void*)fwd, hipFuncAttributeMaxDynamicSharedMemorySize, LDS_BYTES) != hipSuccess) { fprintf(stderr, "kernel_launch: hipFuncSetAttribute failed\n"); grid = -1; return; }
        if (hipOccupancyMaxActiveBlocksPerMultiprocessor(&per_cu, (const void*)fwd, 512, LDS_BYTES) != hipSuccess || per_cu < 1) { per_cu = 1; (void)hipGetLastError(); }
        grid = cus * per_cu;
        fprintf(stderr, "kernel_launch: grid %d (cus %d x %d), ws %zu MiB\n", grid, cus, per_cu, ws_size >> 20);
    }
    if (grid < 0) return;
    Args a{};
    for (int i = 0; i < 22; ++i) a.in[i] = (const float*)d_in[i];
    a.out = (float*)d_out; a.ws = (unsigned char*)d_ws;
#if MK_MULTI
    for (int p = 0; p < NPH; ++p) { a.lo = p; a.hi = p + 1; hipLaunchKernelGGL(fwd, dim3(grid), dim3(512), LDS_BYTES, stream, a); }
#else
    a.lo = 0; a.hi = NPH;
    void* args[] = {&a};
    hipError_t e = hipLaunchCooperativeKernel((const void*)fwd, dim3(grid), dim3(512), args, LDS_BYTES, stream);
    if (e != hipSuccess) fprintf(stderr, "cooperative launch failed: %s (grid %d)\n", hipGetErrorString(e), grid);
#endif
}
```

```cpp
#include <hip/hip_runtime.h>
#include <hip/hip_cooperative_groups.h>
#include <cstdio>
#include <cstdint>
namespace cg = cooperative_groups;
namespace pg8 {
#define PG8_LAS __attribute__((address_space(3)))
typedef unsigned short bf16_t;
typedef short bf16x8 __attribute__((ext_vector_type(8)));
typedef float f32x4 __attribute__((ext_vector_type(4)));
typedef unsigned u32x4 __attribute__((ext_vector_type(4)));
constexpr int BM = 256, BK = 64, HALF = 128, HTB = HALF * BK * 2  , STAGE_BYTES = 8 * HTB, NXCD = 8, WGM = 8;

__host__ __device__ __forceinline__ int lds_byte(int r, int c) { const int st = (r >> 4) * 2 + (c >> 5), rr = r & 15, cc = c & 31, ob = rr * 64 + cc * 2; return st * 1024 + (ob ^ (((ob >> 9) & 1) << 5)); }
__host__ __device__ __forceinline__ void stage_rc(int b, int& R, int& C) { const int st = b / 1024, sb = b % 1024, swz = sb ^ (((sb >> 9) & 1) << 5); R = (st >> 1) * 16 + swz / 64; C = (st & 1) * 32 + (swz % 64) / 2; }
__host__ __device__ __forceinline__ int perm32(int rho) { const int n = rho >> 4, i = rho & 15; return 8 * (i >> 2) + 4 * n + (i & 3); }

struct Unit { int pm, pn; };
struct Gemm { const bf16_t* A; const bf16_t* Bt; int M, N, K; };

struct StaticOrder {
    int nM, nN, nwg, G, c;
    __host__ __device__ void init(int M, int N, int G_, int c_) { nM = M / BM; nN = N / BM; nwg = nM * nN; G = G_; c = c_; }
    __host__ __device__ bool next(int i, Unit& u) const {
        const long L = (long)i * G + c; if (L >= nwg) return false;
        int wgid = (int)L; { const int q = nwg / NXCD, r = nwg % NXCD, xcd = wgid % NXCD, off = wgid / NXCD; wgid = (xcd < r ? xcd * (q + 1) : r * (q + 1) + (xcd - r) * q) + off; }
        const int nig = WGM * nN, gid = wgid / nig, fm = gid * WGM, gsz = (nM - fm) < WGM ? (nM - fm) : WGM;
        u.pm = fm + ((wgid % nig) % gsz); u.pn = (wgid % nig) / gsz; return true;
    }
    __device__ __forceinline__ void a_ready(const Unit&) const {}
    __device__ __forceinline__ void done(const Unit&) const {}
};
typedef __bf16 bf16x2_t __attribute__((ext_vector_type(2)));
typedef float f32x2_t __attribute__((ext_vector_type(2)));
__device__ __forceinline__ unsigned cvt_pk_bf16(float lo, float hi) { unsigned r; asm volatile("v_cvt_pk_bf16_f32 %0, %1, %2" : "=v"(r) : "v"(lo), "v"(hi)); return r; }
__device__ __forceinline__ unsigned cvt_pk_bf16_cv(float lo, float hi) { const f32x2_t v = {lo, hi}; const bf16x2_t b = __builtin_convertvector(v, bf16x2_t); return __builtin_bit_cast(unsigned, b); }
__device__ __forceinline__ int otid() { int t = threadIdx.x; asm volatile("" : "+v"(t)); return t; }
__device__ __forceinline__ float silu_f(float v) { return v * __builtin_amdgcn_rcpf(1.0f + __expf(-v)); }

#define EPI_PIN(p) asm volatile("" : "+v"(p))
struct EpiSwiGLU {
    static constexpr bool PERM = true, AFTER_DRAIN = false;
    bf16_t* O; int ldc;
    __device__ __forceinline__ void operator()(const f32x4 (&acc)[2][2][4][2], const Unit& u, int wr, int wc, int fr, int fq) const {
        const int row0 = u.pm * BM + wr * 64 + fr, col0 = u.pn * 128 + wc * 32 + 8 * fq;
        bf16_t* rowp = O + (size_t)row0 * ldc + col0;
#pragma unroll
        for (int ai = 0; ai < 2; ++ai) {
#pragma unroll
            for (int m = 0; m < 4; ++m) {
                const f32x4 g0 = acc[ai][0][m][0], g1 = acc[ai][0][m][1], u0 = acc[ai][1][m][0], u1 = acc[ai][1][m][1];
                u32x4 w;
                w.x = cvt_pk_bf16(silu_f(g0[0]) * u0[0], silu_f(g0[1]) * u0[1]); w.y = cvt_pk_bf16(silu_f(g0[2]) * u0[2], silu_f(g0[3]) * u0[3]);
                w.z = cvt_pk_bf16(silu_f(g1[0]) * u1[0], silu_f(g1[1]) * u1[1]); w.w = cvt_pk_bf16(silu_f(g1[2]) * u1[2], silu_f(g1[3]) * u1[3]);
                *(u32x4*)rowp = w;
                rowp += (size_t)16 * ldc; EPI_PIN(rowp);
            }
            rowp += (size_t)64 * ldc; EPI_PIN(rowp);
        }
    }
};
struct EpiResid {
    static constexpr bool PERM = false, AFTER_DRAIN = false;
    const float* xin; float* xout; const float* gate; float scale; int half;
    __device__ __forceinline__ void operator()(const f32x4 (&acc)[2][2][4][2], const Unit& u, int wr, int wc, int fr, int fq) const {
        const int row0 = u.pm * BM + wr * 64 + fr, col0 = u.pn * BM + wc * 32 + 4 * fq;
        const int batch = half ? 8 + (u.pm >> 5) : (u.pm >> 4);
        const float* gp = gate + (size_t)batch * 9216 + col0;
        f32x4 gv[2][2];
#pragma unroll
        for (int bj = 0; bj < 2; ++bj)
#pragma unroll
            for (int n = 0; n < 2; ++n) gv[bj][n] = *(const f32x4*)(gp + bj * HALF + n * 16) * scale;
        const float* xp = xin + (size_t)row0 * 1024 + col0; float* op = xout + (size_t)row0 * 1024 + col0;
#pragma unroll
        for (int ai = 0; ai < 2; ++ai) {
#pragma unroll
            for (int m = 0; m < 4; ++m) {
#pragma unroll
                for (int bj = 0; bj < 2; ++bj)
#pragma unroll
                    for (int n = 0; n < 2; ++n) { const f32x4 xi = *(const f32x4*)(xp + bj * HALF + n * 16); *(f32x4*)(op + bj * HALF + n * 16) = xi + gv[bj][n] * acc[ai][bj][m][n]; }
                xp += 16 * 1024; op += 16 * 1024; EPI_PIN(xp); EPI_PIN(op);
                asm volatile("" ::: "memory"); }
            xp += 64 * 1024; op += 64 * 1024; EPI_PIN(xp); EPI_PIN(op);
        }
    }
};
struct EpiProj {
    static constexpr bool PERM = true, AFTER_DRAIN = false;
    static constexpr size_t OFF_PA = (size_t)144 << 20, OFF_PD = (size_t)272 << 20, OFF_Z = (size_t)240 << 20;
    unsigned char* wsb; float* AB; const float* rope; int smask;
    __device__ __forceinline__ void operator()(const f32x4 (&acc)[2][2][4][2], const Unit& u, int wr, int wc, int fr, int fq) const {
        const int row0 = u.pm * BM + wr * 64 + fr, pn = u.pn;
        if (pn < 14) {
            const size_t poff = pn < 6 ? OFF_PA : (pn < 12 ? OFF_PD : OFF_Z); bf16_t* P = (bf16_t*)(wsb + poff); const int ldp = pn < 12 ? 1536 : 512;
            const int col0 = (pn < 6 ? pn : (pn < 12 ? pn - 6 : pn - 12)) * 256 + wc * 32 + 8 * fq;
            const bool rot = (pn < 4) && ((wc & 1) == 0) && (fq < 2);
            const float sgn = (fq & 1) ? 1.f : -1.f;
            bf16_t* rowp = P + (size_t)row0 * ldp + col0; int row = row0;
#pragma unroll
            for (int ai = 0; ai < 2; ++ai) {
#pragma unroll
                for (int m = 0; m < 4; ++m) {
                    f32x4 c0 = {0.f, 0.f, 0.f, 0.f}, c1 = c0, s0 = c0, s1 = c0;
                    if (pn < 4) { const float* rp = rope + (size_t)(row & smask) * 16; c0 = *(const f32x4*)rp; c1 = *(const f32x4*)(rp + 4); s0 = *(const f32x4*)(rp + 8); s1 = *(const f32x4*)(rp + 12); }
#pragma unroll
                    for (int bj = 0; bj < 2; ++bj) { f32x4 v0 = acc[ai][bj][m][0], v1 = acc[ai][bj][m][1];
                        if (pn < 4) { f32x4 p0, p1;
#pragma unroll
                            for (int j = 0; j < 4; ++j) { p0[j] = __shfl_xor(v0[j], 16); p1[j] = __shfl_xor(v1[j], 16); }
                            const f32x4 r0 = v0 * c0 + sgn * (p0 * s0), r1 = v1 * c1 + sgn * (p1 * s1);
                            if (rot) { v0 = r0; v1 = r1; } }
                        u32x4 w; w.x = cvt_pk_bf16(v0[0], v0[1]); w.y = cvt_pk_bf16(v0[2], v0[3]); w.z = cvt_pk_bf16(v1[0], v1[1]); w.w = cvt_pk_bf16(v1[2], v1[3]);
                        *(u32x4*)(rowp + bj * HALF) = w; }
                    rowp += (size_t)16 * ldp; row += 16; EPI_PIN(rowp); EPI_PIN(row);
                    asm volatile("" ::: "memory"); }
                rowp += (size_t)64 * ldp; row += 64; EPI_PIN(rowp); EPI_PIN(row);
            }
        } else {
            if (wc == 0 && fq < 2) {
                float* ap = AB + (size_t)row0 * 16 + 8 * fq;
#pragma unroll
                for (int ai = 0; ai < 2; ++ai) {
#pragma unroll
                    for (int m = 0; m < 4; ++m) { *(f32x4*)ap = acc[ai][0][m][0]; *(f32x4*)(ap + 4) = acc[ai][0][m][1]; ap += 16 * 16; EPI_PIN(ap); }
                    ap += 64 * 16; EPI_PIN(ap); }
            }
        }
    }
};

template <class Epi, class Sched, bool ALIGN_EPI = false, bool SP2 = false>
__device__ __forceinline__ void gemm_phase(PG8_LAS unsigned char* lds, const Gemm g, const Sched& S, const Epi& E) {
    const int tid = otid(), wid = __builtin_amdgcn_readfirstlane(tid >> 6), lane = tid & 63, wr = wid >> 2, wc = wid & 3, fr = lane & 15, fq = lane >> 4;
    const int K = g.K, nt = K / BK;
    unsigned voffA[2], voffB[2];
#pragma unroll
    for (int i = 0; i < 2; ++i) { int R, C; stage_rc(tid * 16 + i * 8192, R, C); const int Rb = Epi::PERM ? ((R & ~31) + perm32(R & 31)) : R;
        voffA[i] = (unsigned)(R * K + C) * 2u; voffB[i] = (unsigned)(Rb * K + C) * 2u; }
    const size_t kstep = (size_t)(BK * 2);
    const size_t hstep = (size_t)HALF * K * 2;
    const size_t tstep = 2 * hstep;
    const unsigned ldsw = (unsigned)wid * 1024u;
    const int aoff = lds_byte(wr * 64 + fr, fq * 8), boff = lds_byte(wc * 32 + fr, fq * 8);
#define PG8_SA(b, h) (((b) * 2 + (h)) * HTB)
#define PG8_SB(b, h) ((4 + (b) * 2 + (h)) * HTB)
#define PG8_STAGE(bufoff, gbase, voff) do { _Pragma("unroll") for (int _i = 0; _i < 2; ++_i) \
        __builtin_amdgcn_global_load_lds((const unsigned*)((const char*)(gbase) + (voff)[_i]), (PG8_LAS unsigned*)(lds + (bufoff) + ldsw + _i * 8192), 16, 0, 0); } while (0)
#define PG8_LDA(dst, b, h) do { _Pragma("unroll") for (int m = 0; m < 4; ++m) _Pragma("unroll") for (int k = 0; k < 2; ++k) dst[m][k] = *(const PG8_LAS bf16x8*)(lds + PG8_SA(b, h) + aoff + m * 2048 + k * 1024); } while (0)
#define PG8_LDB(dst, b, h) do { _Pragma("unroll") for (int n = 0; n < 2; ++n) _Pragma("unroll") for (int k = 0; k < 2; ++k) dst[n][k] = *(const PG8_LAS bf16x8*)(lds + PG8_SB(b, h) + boff + n * 2048 + k * 1024); } while (0)
#define PG8_MMA(ai, bj, At, Bt) do { __builtin_amdgcn_s_setprio(1); _Pragma("unroll") for (int m = 0; m < 4; ++m) _Pragma("unroll") for (int n = 0; n < 2; ++n) _Pragma("unroll") for (int k = 0; k < 2; ++k) \
        acc[ai][bj][m][n] = __builtin_amdgcn_mfma_f32_16x16x32_bf16(Bt[n][k], At[m][k], acc[ai][bj][m][n], 0, 0, 0); __builtin_amdgcn_s_setprio(0); } while (0)
#define PG8_WAIT_V(n) asm volatile("s_waitcnt vmcnt(" #n ")" ::: "memory")
#define PG8_WAIT_L(n) asm volatile("s_waitcnt lgkmcnt(" #n ")" ::: "memory")
#define PG8_BAR __builtin_amdgcn_s_barrier()
#define PG8_SCHED __builtin_amdgcn_sched_barrier(0)
    Unit cur, nxt; int ui = 0;
    if (!S.next(0, cur)) return;
    f32x4 acc[2][2][4][2];
#pragma unroll
    for (int a = 0; a < 2; ++a)
#pragma unroll
        for (int b = 0; b < 2; ++b)
#pragma unroll
            for (int m = 0; m < 4; ++m)
#pragma unroll
                for (int n = 0; n < 2; ++n) acc[a][b][m][n] = (f32x4){0.f, 0.f, 0.f, 0.f};
    bf16x8 At[4][2], B0[2][2], B1[2][2];
    const char* cA = (const char*)g.A + (size_t)cur.pm * tstep; const char* cB = (const char*)g.Bt + (size_t)cur.pn * tstep;
    S.a_ready(cur);
    if constexpr (SP2) {
        PG8_STAGE(PG8_SB(0, 0), cB, voffB); PG8_STAGE(PG8_SB(0, 1), cB + hstep, voffB); PG8_STAGE(PG8_SA(0, 0), cA, voffA); PG8_STAGE(PG8_SA(0, 1), cA + hstep, voffA);
        if (wr == 1) PG8_BAR;
        PG8_WAIT_V(2); PG8_BAR;
        PG8_STAGE(PG8_SB(1, 0), cB + kstep, voffB); PG8_STAGE(PG8_SA(1, 0), cA + kstep, voffA); PG8_STAGE(PG8_SB(1, 1), cB + hstep + kstep, voffB);
        PG8_WAIT_V(6); PG8_BAR;
    } else {
        PG8_STAGE(PG8_SB(0, 0), cB, voffB); PG8_STAGE(PG8_SA(0, 0), cA, voffA); PG8_STAGE(PG8_SB(0, 1), cB + hstep, voffB); PG8_STAGE(PG8_SA(0, 1), cA + hstep, voffA);
        if (wr == 1) PG8_BAR;
        PG8_WAIT_V(4); PG8_BAR;
        PG8_STAGE(PG8_SB(1, 0), cB + kstep, voffB); PG8_STAGE(PG8_SA(1, 0), cA + kstep, voffA); PG8_STAGE(PG8_SB(1, 1), cB + hstep + kstep, voffB);
        PG8_WAIT_V(6); PG8_BAR;
    }
    for (;;) {
        const bool has_next = S.next(ui + 1, nxt);
        const char* nA = has_next ? (const char*)g.A + (size_t)nxt.pm * tstep : cA; const char* nB = has_next ? (const char*)g.Bt + (size_t)nxt.pn * tstep : cB;
        for (int t = 0; t < nt; t += 2) {
            const bool last = (t == nt - 2);
            const char* a1 = cA + (size_t)(t + 1) * kstep;
            const char* a2 = last ? nA : cA + (size_t)(t + 2) * kstep; const char* b2 = last ? nB : cB + (size_t)(t + 2) * kstep;
            const char* a3 = a2 + kstep; const char* b3 = b2 + kstep;
            if (last && has_next) S.a_ready(nxt);
            if constexpr (SP2) {
            PG8_LDB(B0, 0, 0); PG8_LDB(B1, 0, 1); PG8_SCHED; PG8_LDA(At, 0, 0); PG8_STAGE(PG8_SA(1, 1), a1 + hstep, voffA);
            PG8_WAIT_V(8); PG8_WAIT_L(0); PG8_BAR; PG8_MMA(0, 0, At, B0); PG8_MMA(0, 1, At, B1); PG8_BAR; PG8_SCHED;
            PG8_LDA(At, 0, 1); PG8_STAGE(PG8_SB(0, 0), b2, voffB); PG8_STAGE(PG8_SB(0, 1), b2 + hstep, voffB); PG8_STAGE(PG8_SA(0, 0), a2, voffA);
            PG8_WAIT_V(8); PG8_WAIT_L(0); PG8_BAR; PG8_MMA(1, 0, At, B0); PG8_MMA(1, 1, At, B1); PG8_BAR; PG8_SCHED;
            PG8_LDB(B0, 1, 0); PG8_LDB(B1, 1, 1); PG8_SCHED; PG8_LDA(At, 1, 0); PG8_STAGE(PG8_SA(0, 1), a2 + hstep, voffA);
            PG8_WAIT_V(8); PG8_WAIT_L(0); PG8_BAR; PG8_MMA(0, 0, At, B0); PG8_MMA(0, 1, At, B1); PG8_BAR; PG8_SCHED;
            PG8_LDA(At, 1, 1); PG8_STAGE(PG8_SB(1, 0), b3, voffB); PG8_STAGE(PG8_SB(1, 1), b3 + hstep, voffB); PG8_STAGE(PG8_SA(1, 0), a3, voffA);
            PG8_WAIT_V(8); PG8_WAIT_L(0); PG8_BAR; PG8_MMA(1, 0, At, B0); PG8_MMA(1, 1, At, B1); PG8_BAR; PG8_SCHED;
            } else {
            PG8_LDB(B0, 0, 0); PG8_SCHED; PG8_LDA(At, 0, 0); PG8_STAGE(PG8_SA(1, 1), a1 + hstep, voffA);
            PG8_WAIT_L(8); PG8_BAR; PG8_WAIT_L(0); PG8_MMA(0, 0, At, B0); PG8_BAR; PG8_SCHED;
            PG8_LDB(B1, 0, 1); PG8_STAGE(PG8_SB(0, 0), b2, voffB);
            PG8_BAR; PG8_WAIT_L(0); PG8_MMA(0, 1, At, B1); PG8_BAR;
            PG8_LDA(At, 0, 1); PG8_STAGE(PG8_SA(0, 0), a2, voffA);
            PG8_BAR; PG8_WAIT_L(0); PG8_MMA(1, 0, At, B0); PG8_BAR; PG8_SCHED;
            PG8_STAGE(PG8_SB(0, 1), b2 + hstep, voffB);
            PG8_WAIT_V(6); PG8_BAR; PG8_MMA(1, 1, At, B1); PG8_BAR;
            PG8_LDB(B0, 1, 0); PG8_SCHED; PG8_LDA(At, 1, 0); PG8_STAGE(PG8_SA(0, 1), a2 + hstep, voffA);
            PG8_WAIT_L(8); PG8_BAR; PG8_WAIT_L(0); PG8_MMA(0, 0, At, B0); PG8_BAR; PG8_SCHED;
            PG8_LDB(B1, 1, 1); PG8_STAGE(PG8_SB(1, 0), b3, voffB);
            PG8_BAR; PG8_WAIT_L(0); PG8_MMA(0, 1, At, B1); PG8_BAR;
            PG8_LDA(At, 1, 1); PG8_STAGE(PG8_SA(1, 0), a3, voffA);
            PG8_BAR; PG8_WAIT_L(0); PG8_MMA(1, 0, At, B0); PG8_BAR; PG8_SCHED;
            PG8_STAGE(PG8_SB(1, 1), b3 + hstep, voffB);
            PG8_WAIT_V(6); PG8_BAR; PG8_MMA(1, 1, At, B1); PG8_BAR;
            }
        }
        if constexpr (ALIGN_EPI) { if (wr == 0) PG8_BAR; }
        if constexpr (!Epi::AFTER_DRAIN) { E(acc, cur, wr, wc, fr, fq); S.done(cur); }
        if (!has_next) break;
#pragma unroll
        for (int a = 0; a < 2; ++a)
#pragma unroll
            for (int b = 0; b < 2; ++b)
#pragma unroll
                for (int m = 0; m < 4; ++m)
#pragma unroll
                    for (int n = 0; n < 2; ++n) acc[a][b][m][n] = (f32x4){0.f, 0.f, 0.f, 0.f};
        cur = nxt; cA = nA; cB = nB; ++ui;
        if constexpr (ALIGN_EPI) { if (wr == 1) PG8_BAR; }
    }
    PG8_WAIT_V(0);
    if constexpr (!ALIGN_EPI) { if (wr == 0) PG8_BAR; }
    PG8_BAR;
    if constexpr (Epi::AFTER_DRAIN) { E.fused(acc, cur, wr, wc, fr, fq, lds, wid, lane); S.done(cur); }
#undef PG8_SA
#undef PG8_SB
#undef PG8_STAGE
#undef PG8_LDA
#undef PG8_LDB
#undef PG8_MMA
#undef PG8_WAIT_V
#undef PG8_WAIT_L
#undef PG8_BAR
#undef PG8_SCHED
}
}

#define LAS __attribute__((address_space(3)))
typedef unsigned short bf16;
typedef short bf16x8 __attribute__((ext_vector_type(8)));
typedef short s16x4 __attribute__((ext_vector_type(4)));
typedef float f32x4 __attribute__((ext_vector_type(4)));
typedef unsigned v4u __attribute__((ext_vector_type(4)));
typedef unsigned v2u __attribute__((ext_vector_type(2)));
#define MFMA16(a, b, c) __builtin_amdgcn_mfma_f32_16x16x32_bf16((a), (b), (c), 0, 0, 0)
#define CAT8(lo, hi) __builtin_shufflevector((lo), (hi), 0, 1, 2, 3, 4, 5, 6, 7)
#define LDS_WAIT() asm volatile("s_waitcnt lgkmcnt(0)" ::: "memory")

constexpr int D = 1024, FF = 2816, MH = 32768, NPROJ = 3840, INW = 3600;
constexpr float EPS = 1e-6f;
constexpr size_t MiB = 1u << 20;
constexpr size_t WS_MOD = 1 * MiB, WS_ROPE = 2 * MiB;
constexpr size_t WS_WGU1 = 4 * MiB, WS_WD1 = 15 * MiB, WS_WIN = 15 * MiB + 5632 * 1024, WS_WOUT = 28 * MiB, WS_WGU2 = 30 * MiB, WS_WD2 = 41 * MiB;
constexpr size_t WS_H = 48 * MiB, WS_DQ = 48 * MiB, WS_DK = 80 * MiB, WS_DV = 112 * MiB, WS_OF = 80 * MiB, WS_OB = 112 * MiB;
constexpr size_t WS_ACT = 112 * MiB, WS_PA = 144 * MiB, WS_Z = 240 * MiB, WS_CH = 272 * MiB, WS_PD = 272 * MiB, WS_OG = 272 * MiB, WS_LSE = 368 * MiB, WS_MIX = 374 * MiB;
constexpr size_t WS_AB = 496 * MiB, WS_GB = 498 * MiB, WS_GC = 500 * MiB, WS_END = 501 * MiB;
constexpr int LDS_BYTES = 151552;
constexpr int CHJOB = 57344;

__device__ __forceinline__ float bf2f(unsigned short v) { return __uint_as_float(((unsigned)v) << 16); }
__device__ __forceinline__ float bflo(unsigned w) { return __uint_as_float(w << 16); }
__device__ __forceinline__ float bfhi(unsigned w) { return __uint_as_float(w & 0xffff0000u); }
__device__ __forceinline__ unsigned pk2(float lo, float hi) { return pg8::cvt_pk_bf16(lo, hi); }
__device__ __forceinline__ float opaque_one() { float o = 1.0f; asm volatile("" : "+v"(o)); return o; }
__device__ __forceinline__ float silu(float v) { return v * __builtin_amdgcn_rcpf(1.0f + __expf(-v)); }
__device__ __forceinline__ float wave_sum(float v) {
#pragma unroll
    for (int o = 1; o < 64; o <<= 1) v += __shfl_xor(v, o);
    return v;
}
__device__ __forceinline__ bf16x8 pack8(const f32x4 a, const f32x4 b) {
    v4u w; w.x = pk2(a[0], a[1]); w.y = pk2(a[2], a[3]); w.z = pk2(b[0], b[1]); w.w = pk2(b[2], b[3]);
    return __builtin_bit_cast(bf16x8, w);
}
__device__ __forceinline__ f32x4 ld_bf4(const bf16* p) { const v2u w = *(const v2u*)p; return (f32x4){bflo(w.x), bfhi(w.x), bflo(w.y), bfhi(w.y)}; }

__device__ __forceinline__ void ph_mod(const float* c_prompt, const float* c_sample, const float* ada_w, const float* ada_b, float* MOD, LAS unsigned char* lds) {
    const int tid = pg8::otid(), lane = tid & 63, wave = tid >> 6;
    LAS float* sc = (LAS float*)lds;
    LAS float* red = (LAS float*)(lds + 49152);
    for (int i = tid; i < 12 * 1024; i += 512) { const int b = i >> 10, k = i & 1023; const float v = b < 8 ? c_prompt[b * 1024 + k] : c_sample[(b - 8) * 1024 + k]; sc[i] = silu(v); }
    __syncthreads();
    const int cl = tid & 7, kg = tid >> 3;
    for (int item = blockIdx.x; item < 576; item += gridDim.x) {
        const int layer = item / 288, cg32 = item % 288, col = cg32 * 32 + cl * 4;
        float acc[12][4];
#pragma unroll
        for (int b = 0; b < 12; ++b)
#pragma unroll
            for (int j = 0; j < 4; ++j) acc[b][j] = 0.f;
        const float* wp = ada_w + (size_t)layer * 1024 * 9216 + col;
#pragma unroll 4
        for (int kk = 0; kk < 16; ++kk) { const int k = kg * 16 + kk; const f32x4 w = *(const f32x4*)(wp + (size_t)k * 9216);
#pragma unroll
            for (int b = 0; b < 12; ++b) { const float s = sc[b * 1024 + k];
#pragma unroll
                for (int j = 0; j < 4; ++j) acc[b][j] += s * w[j]; } }
#pragma unroll
        for (int b = 0; b < 12; ++b)
#pragma unroll
            for (int j = 0; j < 4; ++j) { float v = acc[b][j]; v += __shfl_xor(v, 8); v += __shfl_xor(v, 16); v += __shfl_xor(v, 32); if ((lane >> 3) == 0) red[(wave * 8 + cl) * 48 + b * 4 + j] = v; }
        __syncthreads();
        if (tid < 384) { const int b = tid >> 5, c = tid & 31; float s = 0.f;
#pragma unroll
            for (int w = 0; w < 8; ++w) s += red[(w * 8 + (c >> 2)) * 48 + b * 4 + (c & 3)];
            MOD[(size_t)(layer * 12 + b) * 9216 + cg32 * 32 + c] = s + ada_b[layer * 9216 + cg32 * 32 + c]; }
        __syncthreads();
    }
}
__device__ __forceinline__ void ph_rope(float* ROPE) {
    for (int idx = blockIdx.x * 512 + pg8::otid(); idx < 8192 * 8; idx += gridDim.x * 512) {
        const int s = idx >> 3, i = idx & 7;
        const float inv = exp2f(-(float)i * 0.125f * 18.931568569324174f);
        const float ang = (float)s * inv;
        double rev = (double)ang * 0.15915494309189535; rev -= __builtin_rint(rev);
        const float fr = (float)rev;
        ROPE[s * 16 + i] = __builtin_amdgcn_cosf(fr); ROPE[s * 16 + 8 + i] = __builtin_amdgcn_sinf(fr);
    }
}
__device__ __forceinline__ void tr_item(const float* W, int K, int N, bf16* WT, int k0, int n0, int dst_row0, LAS float* scr, int lane) {
#pragma unroll 8
    for (int i = 0; i < 32; ++i) { const int kk = 2 * i + (lane >> 5), n = n0 + (lane & 31); scr[kk * 33 + (lane & 31)] = (n < N) ? W[(size_t)(k0 + kk) * N + n] : 0.f; }
    LDS_WAIT();
    const int c = lane & 7;
#pragma unroll
    for (int j = 0; j < 4; ++j) { const int n = (lane >> 3) + 8 * j; const LAS float* s = scr + (8 * c) * 33 + n;
        v4u o; o.x = pk2(s[0 * 33], s[1 * 33]); o.y = pk2(s[2 * 33], s[3 * 33]); o.z = pk2(s[4 * 33], s[5 * 33]); o.w = pk2(s[6 * 33], s[7 * 33]);
        *(v4u*)(WT + (size_t)(dst_row0 + n) * K + k0 + 8 * c) = o; }
    LDS_WAIT();
}
__device__ __forceinline__ void ph_wconv(const float* wg1, const float* wu1, const float* wd1, const float* wg2, const float* wu2, const float* wd2, const float* win, const float* wout,
                                         int layer, unsigned char* ws, LAS unsigned char* lds) {
    const int tid_ = pg8::otid(), lane = tid_ & 63, wave = tid_ >> 6;
    LAS float* scr = (LAS float*)(lds + wave * 16384);
    const int gw = blockIdx.x * 8 + wave, NGW = gridDim.x * 8;
    constexpr int I_GU = 16 * 88, I_DN = 44 * 32, I_IN = 16 * 120, I_OUT = 16 * 32;
    constexpr int NIT = 6 * I_GU + I_IN + I_OUT;
    static_assert(I_DN == I_GU, "item counts");
    for (int it = gw; it < NIT; it += NGW) {
        int r = it;
        if (r < 6 * I_GU) {
            const int which = r / I_GU; r -= which * I_GU;
            const int f = which / 3, t = which % 3;
            if (t < 2) { const float* W = (f ? (t ? wu2 : wg2) : (t ? wu1 : wg1)) + (size_t)layer * D * FF; bf16* WT = (bf16*)(ws + (f ? WS_WGU2 : WS_WGU1));
                const int kb = r / 88, nb = r % 88, n0 = nb * 32; tr_item(W, D, FF, WT, kb * 64, n0, (n0 >> 7) * 256 + t * 128 + (n0 & 127), scr, lane); }
            else { const float* W = (f ? wd2 : wd1) + (size_t)layer * D * FF; bf16* WT = (bf16*)(ws + (f ? WS_WD2 : WS_WD1));
                const int kb = r / 32, nb = r % 32; tr_item(W, FF, D, WT, kb * 64, nb * 32, nb * 32, scr, lane); }
            continue;
        }
        r -= 6 * I_GU;
        if (r < I_IN) { const int kb = r / 120, nb = r % 120; tr_item(win + (size_t)layer * D * INW, D, INW, (bf16*)(ws + WS_WIN), kb * 64, nb * 32, nb * 32, scr, lane); continue; }
        r -= I_IN;
        { const int kb = r / 32, nb = r % 32; tr_item(wout + (size_t)layer * D * D, D, D, (bf16*)(ws + WS_WOUT), kb * 64, nb * 32, nb * 32, scr, lane); }
    }
}
__device__ __forceinline__ void ph_norm(const float* x, const float* nw, const float* modl, int sb, int half, bf16* H) {
    const int tid_ = pg8::otid(), lane = tid_ & 63, wave = tid_ >> 6;
    const int gw = blockIdx.x * 8 + wave, NGW = gridDim.x * 8;
    for (int r0 = gw * 16; r0 < MH; r0 += NGW * 16) {
        const int batch = half ? 8 + (r0 >> 13) : (r0 >> 12);
        const float* mp = modl + (size_t)batch * 9216 + sb * 3072;
        f32x4 A[4], B[4];
#pragma unroll
        for (int j = 0; j < 4; ++j) { const int c = 4 * lane + 256 * j; const f32x4 w = *(const f32x4*)(nw + c), sh = *(const f32x4*)(mp + c), scl = *(const f32x4*)(mp + 1024 + c); A[j] = w * (1.0f + scl); B[j] = sh; }
        for (int r = r0; r < r0 + 16; ++r) {
            const f32x4* xr = (const f32x4*)(x + (size_t)r * D) + lane;
            f32x4 v[4]; float s = 0.f;
#pragma unroll
            for (int j = 0; j < 4; ++j) { v[j] = xr[64 * j]; s += (v[j].x * v[j].x + v[j].y * v[j].y) + (v[j].z * v[j].z + v[j].w * v[j].w); }
            const float rstd = __builtin_amdgcn_rsqf(wave_sum(s) * (1.f / D) + EPS);
            v2u* o8 = (v2u*)(H + (size_t)r * D) + lane;
#pragma unroll
            for (int j = 0; j < 4; ++j) { const f32x4 h = v[j] * rstd * A[j] + B[j]; v2u w; w.x = pk2(h.x, h.y); w.y = pk2(h.z, h.w); o8[64 * j] = w; }
        }
    }
}
__device__ __forceinline__ void ph_final(float* x, const float* nw) {
    const int tid_ = pg8::otid(), lane = tid_ & 63, wave = tid_ >> 6;
    const int gw = blockIdx.x * 8 + wave, NGW = gridDim.x * 8;
    f32x4 A[4];
#pragma unroll
    for (int j = 0; j < 4; ++j) A[j] = *(const f32x4*)(nw + 4 * lane + 256 * j);
    for (int r = gw; r < 2 * MH; r += NGW) {
        f32x4* xr = (f32x4*)(x + (size_t)r * D) + lane;
        f32x4 v[4]; float s = 0.f;
#pragma unroll
        for (int j = 0; j < 4; ++j) { v[j] = xr[64 * j]; s += (v[j].x * v[j].x + v[j].y * v[j].y) + (v[j].z * v[j].z + v[j].w * v[j].w); }
        const float rstd = __builtin_amdgcn_rsqf(wave_sum(s) * (1.f / D) + EPS);
#pragma unroll
        for (int j = 0; j < 4; ++j) xr[64 * j] = v[j] * rstd * A[j];
    }
}
__device__ __forceinline__ void ph_dnpre(const bf16* PD, const float* AB, const float* conv_w, const float* a_log, const float* dt_bias,
                                         bf16* DQ, bf16* DK, bf16* DV, float* GB, int S) {
    const int tid_ = pg8::otid(), lane = tid_ & 63, wave = tid_ >> 6;
    const int gw = blockIdx.x * 8 + wave, NGW = gridDim.x * 8;
    for (int t0 = gw * 16; t0 < MH; t0 += NGW * 16) {
        const int s0 = t0 & (S - 1);
        for (int part = 0; part < 3; ++part) {
            const bf16* src = PD + part * 512 + lane * 8;
            bf16* dst = (part == 0 ? DQ : (part == 1 ? DK : DV)) + lane * 8;
            f32x4 w[5][2];
#pragma unroll
            for (int j = 0; j < 5; ++j) { const float* wp = conv_w + j * 1536 + part * 512 + lane * 8; w[j][0] = *(const f32x4*)wp; w[j][1] = *(const f32x4*)(wp + 4); }
            v4u r0, r1, r2, r3, r4;
            const v4u zero = {0u, 0u, 0u, 0u};
#define ROWLD(off) (((unsigned)(s0 + (off)) < (unsigned)S) ? *(const v4u*)(src + (size_t)(t0 + (off)) * 1536) : zero)
            r0 = ROWLD(-2); r1 = ROWLD(-1); r2 = ROWLD(0); r3 = ROWLD(1);
            for (int i = 0; i < 16; ++i) {
                r4 = ROWLD(i + 2);
                f32x4 y0, y1;
#define TAP(rr, j, first) { const f32x4 a = {bflo(rr.x), bfhi(rr.x), bflo(rr.y), bfhi(rr.y)}, b = {bflo(rr.z), bfhi(rr.z), bflo(rr.w), bfhi(rr.w)}; \
                    if (first) { y0 = a * w[j][0]; y1 = b * w[j][1]; } else { y0 += a * w[j][0]; y1 += b * w[j][1]; } }
                TAP(r0, 0, true) TAP(r1, 1, false) TAP(r2, 2, false) TAP(r3, 3, false) TAP(r4, 4, false)
#undef TAP
#pragma unroll
                for (int e = 0; e < 4; ++e) { y0[e] = silu(y0[e]); y1[e] = silu(y1[e]); }
                if (part < 2) {
                    float ss = (y0.x * y0.x + y0.y * y0.y) + (y0.z * y0.z + y0.w * y0.w) + (y1.x * y1.x + y1.y * y1.y) + (y1.z * y1.z + y1.w * y1.w);
                    ss += __shfl_xor(ss, 1); ss += __shfl_xor(ss, 2); ss += __shfl_xor(ss, 4); ss += __shfl_xor(ss, 8);
                    const float scl = __builtin_amdgcn_rsqf(ss + EPS) * (part == 0 ? 0.08838834764831845f : 1.0f);
                    y0 *= scl; y1 *= scl;
                }
                v4u o; o.x = pk2(y0.x, y0.y); o.y = pk2(y0.z, y0.w); o.z = pk2(y1.x, y1.y); o.w = pk2(y1.z, y1.w);
                *(v4u*)(dst + (size_t)(t0 + i) * 512) = o;
                r0 = r1; r1 = r2; r2 = r3; r3 = r4;
            }
#undef ROWLD
        }
#pragma unroll
        for (int jj = 0; jj < 4; ++jj) { const int idx = lane + 64 * jj, tok = t0 + (idx >> 4), c = idx & 15; const float v = AB[(size_t)tok * 16 + c];
            float res;
            if (c < 8) { const float xx = v + dt_bias[c]; const float sp = fmaxf(xx, 0.f) + __logf(1.0f + __expf(-fabsf(xx))); res = -__expf(a_log[c]) * sp; }
            else res = __builtin_amdgcn_rcpf(1.0f + __expf(-v));
            GB[(size_t)tok * 16 + c] = res; }
    }
}
__device__ __forceinline__ void ph_attn(const bf16* P, bf16* OG, float* LSE, int S, int lgS, LAS unsigned char* lds) {
    const int tid = pg8::otid(), lane = tid & 63, wave = tid >> 6, l15 = lane & 15, g = lane >> 4;
    const float one = opaque_one();
    LAS unsigned char* KL = lds; LAS unsigned char* VT = lds + 41472;
    for (int u = blockIdx.x; u < 3 * 8 * 256; u += gridDim.x) {
        const int tb = u & 255, h = (u >> 8) & 7, p = u >> 11;
        const int lgd = 2 * p, L = S >> lgd, nb = L >> 7, bps = S >> 7;
        const int seq = tb >> (lgS - 7), lb = tb & (bps - 1);
        const int r = lb / nb, ib = lb - r * nb, i0 = ib << 7;
        const int seqbase = seq << lgS;
        __syncthreads();
        for (int idx = tid; idx < 288 * 8; idx += 512) {
            const int kl = idx >> 3, pc = idx & 7, ik = i0 - 64 + kl;
            v4u kv = {0u, 0u, 0u, 0u}, vv = kv;
            if (ik >= 0 && ik < L) { const bf16* src = P + (size_t)(seqbase + (ik << lgd) + r) * 1536 + h * 64 + pc * 8; kv = *(const v4u*)(src + 512); vv = *(const v4u*)(src + 1024); }
            *(LAS v4u*)(KL + kl * 144 + pc * 16) = kv;
#pragma unroll
            for (int e = 0; e < 8; ++e) { const unsigned wv = vv[e >> 1]; *(LAS unsigned short*)(VT + (pc * 8 + e) * 592 + kl * 2) = (unsigned short)((e & 1) ? (wv >> 16) : (wv & 0xffffu)); }
        }
        __syncthreads();
        const int iq = i0 + 16 * wave + l15, tokq = seqbase + (iq << lgd) + r;
        bf16x8 qf[2];
#pragma unroll
        for (int ks = 0; ks < 2; ++ks) qf[ks] = *(const bf16x8*)(P + (size_t)tokq * 1536 + h * 64 + 32 * ks + 8 * g);
        f32x4 acc[4];
#pragma unroll
        for (int dt = 0; dt < 4; ++dt) acc[dt] = (f32x4){0.f, 0.f, 0.f, 0.f};
        float m = -1e30f, lsum = 0.f;
        for (int s = 0; s < 5; ++s) {
            const int kl0 = 16 * wave + 32 * s;
            f32x4 c[2];
#pragma unroll
            for (int t = 0; t < 2; ++t) { c[t] = (f32x4){0.f, 0.f, 0.f, 0.f};
#pragma unroll
                for (int ks = 0; ks < 2; ++ks) { const bf16x8 a = *(const LAS bf16x8*)(KL + (kl0 + 16 * t + l15) * 144 + (32 * ks + 8 * g) * 2); c[t] = MFMA16(a, qf[ks], c[t]); } }
            float sc[8]; float mx = -1e30f;
#pragma unroll
            for (int t = 0; t < 2; ++t)
#pragma unroll
                for (int rg = 0; rg < 4; ++rg) { const int ik = i0 - 64 + kl0 + 16 * t + 4 * g + rg, dl = ik - iq;
                    const bool valid = (ik >= 0) && (ik < L) && (dl <= 64) && (dl >= -64);
                    const float sv = valid ? c[t][rg] * 0.18033688011112042f : -1e30f; sc[t * 4 + rg] = sv; mx = fmaxf(mx, sv); }
            mx = fmaxf(mx, __shfl_xor(mx, 16)); mx = fmaxf(mx, __shfl_xor(mx, 32));
            const float mn = fmaxf(m, mx), alpha = __builtin_amdgcn_exp2f(m - mn); m = mn;
            float ps = 0.f; f32x4 p0, p1;
#pragma unroll
            for (int e = 0; e < 4; ++e) { p0[e] = __builtin_amdgcn_exp2f(sc[e] - mn); p1[e] = __builtin_amdgcn_exp2f(sc[4 + e] - mn); ps += p0[e] + p1[e]; }
            lsum = lsum * alpha + ps;
            const bf16x8 pf = pack8(p0 * one, p1 * one);
#pragma unroll
            for (int dt = 0; dt < 4; ++dt) { acc[dt] *= alpha;
                const s16x4 lo = *(const LAS s16x4*)(VT + (16 * dt + l15) * 592 + (kl0 + 4 * g) * 2), hi = *(const LAS s16x4*)(VT + (16 * dt + l15) * 592 + (kl0 + 16 + 4 * g) * 2);
                acc[dt] = MFMA16(CAT8(lo, hi), pf, acc[dt]); }
        }
        lsum += __shfl_xor(lsum, 16); lsum += __shfl_xor(lsum, 32);
        const float inv = 1.0f / lsum;
        bf16* og = OG + ((size_t)p * MH + tokq) * 512 + h * 64 + 4 * g;
#pragma unroll
        for (int dt = 0; dt < 4; ++dt) { v2u w; w.x = pk2(acc[dt][0] * inv, acc[dt][1] * inv); w.y = pk2(acc[dt][2] * inv, acc[dt][3] * inv); *(v2u*)(og + 16 * dt) = w; }
        if (g == 0) LSE[((size_t)p * MH + tokq) * 8 + h] = (m + __log2f(lsum)) * 0.6931471805599453f;
    }
}
__device__ __forceinline__ void ph_chunk(const bf16* DQ, const bf16* DK, const bf16* DV, const float* GB, unsigned char* CH, float* GC, int S, int lgS, LAS unsigned char* lds) {
    const int tid_ = pg8::otid(), lane = tid_ & 63, wave = tid_ >> 6, l15 = lane & 15, g = lane >> 4;
    const float one = opaque_one();
    LAS unsigned char* wl = lds + wave * 18432;
    LAS float* Al = (LAS float*)wl; LAS float* gcs = (LAS float*)(wl + 17408); LAS float* bts = gcs + 64;
    LAS bf16* TP = (LAS bf16*)wl; LAS bf16* TPP = (LAS bf16*)(wl + 8192);
    for (int job = blockIdx.x * 8 + wave; job < 4096; job += gridDim.x * 8) {
        const int dir = job & 1, h = (job >> 1) & 3, cgi = job >> 3, cps = S >> 6;
        const int seq = cgi >> (lgS - 6), n = cgi & (cps - 1), seqbase = seq << lgS;
#define TOK(c) (seqbase + (dir ? (S - 1 - (64 * n + (c))) : (64 * n + (c))))
        {   const int tokc = TOK(lane);
            const float gv = GB[(size_t)tokc * 16 + dir * 4 + h], bv = GB[(size_t)tokc * 16 + 8 + dir * 4 + h];
            float cs = gv;
#pragma unroll
            for (int o = 1; o < 64; o <<= 1) { const float t = __shfl_up(cs, o); if (lane >= o) cs += t; }
            gcs[lane] = cs; bts[lane] = bv; GC[(size_t)job * 64 + lane] = cs; }
        LDS_WAIT();
        bf16x8 kf[4][4];
#pragma unroll
        for (int t = 0; t < 4; ++t)
#pragma unroll
            for (int ks = 0; ks < 4; ++ks) kf[t][ks] = *(const bf16x8*)(DK + (size_t)TOK(16 * t + l15) * 512 + h * 128 + 32 * ks + 8 * g);
#pragma unroll
        for (int it = 0; it < 4; ++it) { const int i = 16 * it + l15; const float gi = gcs[i], bi = bts[i];
#pragma unroll
            for (int jt = 0; jt <= it; ++jt) { f32x4 c = {0.f, 0.f, 0.f, 0.f};
#pragma unroll
                for (int ks = 0; ks < 4; ++ks) c = MFMA16(kf[jt][ks], kf[it][ks], c);
                const f32x4 gj = *(const LAS f32x4*)(gcs + 16 * jt + 4 * g); f32x4 o;
#pragma unroll
                for (int rg = 0; rg < 4; ++rg) { const int j = 16 * jt + 4 * g + rg; o[rg] = (j < i) ? bi * c[rg] * __expf(gi - gj[rg]) : 0.f; }
                *(LAS f32x4*)(Al + i * 68 + 16 * jt + 4 * g) = o; } }
        unsigned char* chb = CH + (size_t)job * CHJOB;
        bf16* UT = (bf16*)chb; bf16* Wm = (bf16*)(chb + 16384); bf16* KT = (bf16*)(chb + 32768); bf16* QK = (bf16*)(chb + 49152);
#pragma unroll
        for (int it = 0; it < 4; ++it) { const int i = 16 * it + l15; const float gi = gcs[i];
            bf16x8 qfr[4];
#pragma unroll
            for (int ks = 0; ks < 4; ++ks) qfr[ks] = *(const bf16x8*)(DQ + (size_t)TOK(i) * 512 + h * 128 + 32 * ks + 8 * g);
#pragma unroll
            for (int jt = 0; jt < 4; ++jt) { v2u out = {0u, 0u};
                if (jt <= it) { f32x4 c = {0.f, 0.f, 0.f, 0.f};
#pragma unroll
                    for (int ks = 0; ks < 4; ++ks) c = MFMA16(kf[jt][ks], qfr[ks], c);
                    const f32x4 gj = *(const LAS f32x4*)(gcs + 16 * jt + 4 * g); f32x4 o;
#pragma unroll
                    for (int rg = 0; rg < 4; ++rg) { const int j = 16 * jt + 4 * g + rg; o[rg] = (j <= i) ? c[rg] * __expf(gi - gj[rg]) : 0.f; }
                    out.x = pk2(o[0], o[1]); out.y = pk2(o[2], o[3]); }
                *(v2u*)(QK + i * 64 + 16 * jt + 4 * g) = out; } }
        LDS_WAIT();
        float t[64];
#pragma unroll
        for (int i = 0; i < 64; ++i) { float a0 = 0.f, a1 = 0.f, a2 = 0.f, a3 = 0.f;
#pragma unroll
            for (int j4 = 0; j4 * 4 < i; ++j4) { const f32x4 a = *(const LAS f32x4*)(Al + i * 68 + 4 * j4);
                if (4 * j4 + 0 < i) a0 += a[0] * t[4 * j4 + 0];
                if (4 * j4 + 1 < i) a1 += a[1] * t[4 * j4 + 1];
                if (4 * j4 + 2 < i) a2 += a[2] * t[4 * j4 + 2];
                if (4 * j4 + 3 < i) a3 += a[3] * t[4 * j4 + 3]; }
            t[i] = ((lane == i) ? 1.f : 0.f) - ((a0 + a1) + (a2 + a3)); }
        const float bc = bts[lane], ec = bc * __expf(gcs[lane]);
        LDS_WAIT();
#pragma unroll
        for (int i = 0; i < 64; ++i) { const unsigned w = pk2(t[i] * bc, t[i] * ec); TP[i * 64 + lane] = (bf16)(w & 0xffffu); TPP[i * 64 + lane] = (bf16)(w >> 16); }
        LDS_WAIT();
        bf16x8 tf[4][2];
#pragma unroll
        for (int mt = 0; mt < 4; ++mt)
#pragma unroll
            for (int ks = 0; ks < 2; ++ks) tf[mt][ks] = *(const LAS bf16x8*)(TP + (16 * mt + l15) * 64 + 32 * ks + 8 * g);
        for (int nt = 0; nt < 8; ++nt) {
            bf16x8 vf[2];
#pragma unroll
            for (int ks = 0; ks < 2; ++ks)
#pragma unroll
                for (int e = 0; e < 8; ++e) vf[ks][e] = (short)DV[(size_t)TOK(32 * ks + 8 * g + e) * 512 + h * 128 + 16 * nt + l15];
#pragma unroll
            for (int mt = 0; mt < 4; ++mt) { f32x4 c = {0.f, 0.f, 0.f, 0.f};
#pragma unroll
                for (int ks = 0; ks < 2; ++ks) c = MFMA16(tf[mt][ks], vf[ks], c);
                c *= one;
                v2u w; w.x = pk2(c[0], c[1]); w.y = pk2(c[2], c[3]); *(v2u*)(UT + (16 * nt + l15) * 64 + 16 * mt + 4 * g) = w; }
        }
#pragma unroll
        for (int mt = 0; mt < 4; ++mt)
#pragma unroll
            for (int ks = 0; ks < 2; ++ks) tf[mt][ks] = *(const LAS bf16x8*)(TPP + (16 * mt + l15) * 64 + 32 * ks + 8 * g);
        for (int dt = 0; dt < 8; ++dt) {
            bf16x8 kt[2];
#pragma unroll
            for (int ks = 0; ks < 2; ++ks) {
#pragma unroll
                for (int e = 0; e < 8; ++e) kt[ks][e] = (short)DK[(size_t)TOK(32 * ks + 8 * g + e) * 512 + h * 128 + 16 * dt + l15];
                *(bf16x8*)(KT + (16 * dt + l15) * 64 + 32 * ks + 8 * g) = kt[ks]; }
#pragma unroll
            for (int mt = 0; mt < 4; ++mt) { f32x4 c = {0.f, 0.f, 0.f, 0.f};
#pragma unroll
                for (int ks = 0; ks < 2; ++ks) c = MFMA16(kt[ks], tf[mt][ks], c);
                c *= one;
                v2u w; w.x = pk2(c[0], c[1]); w.y = pk2(c[2], c[3]); *(v2u*)(Wm + (16 * mt + l15) * 128 + 16 * dt + 4 * g) = w; }
        }
        LDS_WAIT();
    }
}
#define TOKN(c, nn) (seqbase + (dir ? (S - 1 - (64 * (nn) + (c))) : (64 * (nn) + (c))))
constexpr int SC_W = 0, SC_Q = 17408, SC_QK = 34816, SC_KT = 44032, SC_BUF = 62464;
__device__ __forceinline__ void ph_scan(const bf16* DQ, const unsigned char* CH, const float* GC, bf16* OF, bf16* OB, int S, int lgS, int half, LAS unsigned char* lds) {
    const int tid = pg8::otid(), lane = tid & 63, wave = tid >> 6, l15 = lane & 15, g = lane >> 4;
    const float one = opaque_one();
    const int nchain = half ? 32 : 64, cps = S >> 6;
    for (int chain = blockIdx.x; chain < nchain; chain += gridDim.x) {
        const int dir = chain & 1, h = (chain >> 1) & 3, seq = chain >> 3, seqbase = seq << lgS, dv0 = wave * 16;
        bf16* OX = dir ? OB : OF;
        const int p0 = tid, p1 = tid + 512;
        const int wrow0 = p0 >> 4, wrow1 = p1 >> 4, wc = tid & 15;
        const int krow0 = tid >> 3, kc = tid & 7;
        f32x4 St[8];
#pragma unroll
        for (int t = 0; t < 8; ++t) St[t] = (f32x4){0.f, 0.f, 0.f, 0.f};
        v4u r[7]; v2u utn[4]; f32x4 gcn[4]; float gln;
#define SC_LOAD(n_) do { const int nn_ = (n_); const int job = ((seq * cps + nn_) << 3) | (h << 1) | dir; const unsigned char* chb = CH + (size_t)job * CHJOB; \
            const bf16* Wm_ = (const bf16*)(chb + 16384); const bf16* KT_ = (const bf16*)(chb + 32768); const bf16* QK_ = (const bf16*)(chb + 49152); const bf16* UT_ = (const bf16*)chb; \
            r[0] = *(const v4u*)(Wm_ + wrow0 * 128 + wc * 8); r[1] = *(const v4u*)(Wm_ + wrow1 * 128 + wc * 8); \
            r[2] = *(const v4u*)(DQ + (size_t)TOKN(wrow0, nn_) * 512 + h * 128 + wc * 8); r[3] = *(const v4u*)(DQ + (size_t)TOKN(wrow1, nn_) * 512 + h * 128 + wc * 8); \
            r[4] = *(const v4u*)(QK_ + krow0 * 64 + kc * 8); \
            r[5] = *(const v4u*)(KT_ + krow0 * 64 + kc * 8); r[6] = *(const v4u*)(KT_ + (krow0 + 64) * 64 + kc * 8); \
            _Pragma("unroll") for (int mt = 0; mt < 4; ++mt) { utn[mt] = *(const v2u*)(UT_ + (dv0 + l15) * 64 + 16 * mt + 4 * g); gcn[mt] = *(const f32x4*)(GC + (size_t)job * 64 + 16 * mt + 4 * g); } \
            gln = GC[(size_t)job * 64 + 63]; } while (0)
#define SC_STORE(buf) do { LAS unsigned char* b_ = (buf); \
            *(LAS v4u*)(b_ + SC_W + wrow0 * 272 + wc * 16) = r[0]; *(LAS v4u*)(b_ + SC_W + wrow1 * 272 + wc * 16) = r[1]; \
            *(LAS v4u*)(b_ + SC_Q + wrow0 * 272 + wc * 16) = r[2]; *(LAS v4u*)(b_ + SC_Q + wrow1 * 272 + wc * 16) = r[3]; \
            *(LAS v4u*)(b_ + SC_QK + krow0 * 144 + kc * 16) = r[4]; \
            *(LAS v4u*)(b_ + SC_KT + krow0 * 144 + kc * 16) = r[5]; *(LAS v4u*)(b_ + SC_KT + (krow0 + 64) * 144 + kc * 16) = r[6]; } while (0)
        __syncthreads();
        SC_LOAD(0);
        SC_STORE(lds);
        __syncthreads();
        for (int n = 0; n < cps; ++n) {
            LAS unsigned char* buf = lds + (n & 1) * SC_BUF;
            v2u ut[4]; f32x4 gcv[4];
#pragma unroll
            for (int mt = 0; mt < 4; ++mt) { ut[mt] = utn[mt]; gcv[mt] = gcn[mt]; }
            const float glast = gln;
            const int ncur = n;
            if (n + 1 < cps) SC_LOAD(n + 1);
            bf16x8 sb[4];
#pragma unroll
            for (int ks = 0; ks < 4; ++ks) sb[ks] = pack8(St[2 * ks] * one, St[2 * ks + 1] * one);
            f32x4 vnew[4], o[4];
#pragma unroll
            for (int mt = 0; mt < 4; ++mt) { const int i = 16 * mt + l15;
                const LAS unsigned char* wrow = buf + SC_W + i * 272 + 8 * g; const LAS unsigned char* qrow = buf + SC_Q + i * 272 + 8 * g;
                f32x4 ws = {0.f, 0.f, 0.f, 0.f}, o1 = ws;
#pragma unroll
                for (int ks = 0; ks < 4; ++ks) {
                    const s16x4 wlo = *(const LAS s16x4*)(wrow + 64 * ks), whi = *(const LAS s16x4*)(wrow + 64 * ks + 32);
                    ws = MFMA16(CAT8(wlo, whi), sb[ks], ws);
                    const s16x4 qlo = *(const LAS s16x4*)(qrow + 64 * ks), qhi = *(const LAS s16x4*)(qrow + 64 * ks + 32);
                    o1 = MFMA16(CAT8(qlo, qhi), sb[ks], o1); }
                const f32x4 u4 = {bflo(ut[mt].x), bfhi(ut[mt].x), bflo(ut[mt].y), bfhi(ut[mt].y)};
                vnew[mt] = u4 - ws;
#pragma unroll
                for (int rg = 0; rg < 4; ++rg) o1[rg] *= __expf(gcv[mt][rg]);
                o[mt] = o1; }
            bf16x8 vb[2];
#pragma unroll
            for (int k2 = 0; k2 < 2; ++k2) vb[k2] = pack8(vnew[2 * k2], vnew[2 * k2 + 1]);
#pragma unroll
            for (int mt = 0; mt < 4; ++mt) { const LAS unsigned char* qkrow = buf + SC_QK + (16 * mt + l15) * 144 + 8 * g;
#pragma unroll
                for (int k2 = 0; k2 < 2; ++k2) { const s16x4 lo = *(const LAS s16x4*)(qkrow + 64 * k2), hi = *(const LAS s16x4*)(qkrow + 64 * k2 + 32); o[mt] = MFMA16(CAT8(lo, hi), vb[k2], o[mt]); } }
            {
#pragma unroll
            for (int mt = 0; mt < 4; ++mt)
#pragma unroll
                for (int rg = 0; rg < 4; ++rg) { const int tk = TOKN(16 * mt + 4 * g + rg, ncur); OX[(size_t)tk * 512 + h * 128 + dv0 + l15] = (bf16)(pk2(o[mt][rg] * one, 0.f) & 0xffffu); } }
            const float eg = __expf(glast);
#pragma unroll
            for (int mt = 0; mt < 4; ++mt)
#pragma unroll
                for (int rg = 0; rg < 4; ++rg) vnew[mt][rg] *= __expf(glast - gcv[mt][rg]);
#pragma unroll
            for (int k2 = 0; k2 < 2; ++k2) vb[k2] = pack8(vnew[2 * k2], vnew[2 * k2 + 1]);
#pragma unroll
            for (int t = 0; t < 8; ++t) { St[t] *= eg; const LAS unsigned char* ktrow = buf + SC_KT + (16 * t + l15) * 144 + 8 * g;
#pragma unroll
                for (int k2 = 0; k2 < 2; ++k2) { const s16x4 lo = *(const LAS s16x4*)(ktrow + 64 * k2), hi = *(const LAS s16x4*)(ktrow + 64 * k2 + 32); St[t] = MFMA16(CAT8(lo, hi), vb[k2], St[t]); } }
            if (n + 1 < cps) SC_STORE(lds + ((n + 1) & 1) * SC_BUF);
            __syncthreads();
        }
#undef SC_LOAD
#undef SC_STORE
    }
#undef TOKN
#undef TOK
}
__device__ __forceinline__ void ph_post(const bf16* OG, const float* LSE, const bf16* OF, const bf16* OB, const bf16* Z, const float* dn_norm, bf16* MIX) {
    const int tid_ = pg8::otid(), lane = tid_ & 63, wave = tid_ >> 6;
    const int gw = blockIdx.x * 8 + wave, NGW = gridDim.x * 8;
    f32x4 nw0 = *(const f32x4*)(dn_norm + (lane & 15) * 8), nw1 = *(const f32x4*)(dn_norm + (lane & 15) * 8 + 4);
    for (int t = gw; t < MH; t += NGW) {
        {   const int hd = lane >> 3;
            const float l0 = LSE[((size_t)0 * MH + t) * 8 + hd], l1 = LSE[((size_t)1 * MH + t) * 8 + hd], l2 = LSE[((size_t)2 * MH + t) * 8 + hd];
            const float mx = fmaxf(l0, fmaxf(l1, l2));
            float w0 = __expf(l0 - mx), w1 = __expf(l1 - mx), w2 = __expf(l2 - mx); const float inv = 1.0f / (w0 + w1 + w2); w0 *= inv; w1 *= inv; w2 *= inv;
            const v4u a = *(const v4u*)(OG + ((size_t)0 * MH + t) * 512 + lane * 8), b = *(const v4u*)(OG + ((size_t)1 * MH + t) * 512 + lane * 8), c = *(const v4u*)(OG + ((size_t)2 * MH + t) * 512 + lane * 8);
            v4u o;
#pragma unroll
            for (int e = 0; e < 4; ++e) o[e] = pk2(w0 * bflo(a[e]) + w1 * bflo(b[e]) + w2 * bflo(c[e]), w0 * bfhi(a[e]) + w1 * bfhi(b[e]) + w2 * bfhi(c[e]));
            *(v4u*)(MIX + (size_t)t * 1024 + lane * 8) = o; }
        {   const v4u a = *(const v4u*)(OF + (size_t)t * 512 + lane * 8), b = *(const v4u*)(OB + (size_t)t * 512 + lane * 8), z = *(const v4u*)(Z + (size_t)t * 512 + lane * 8);
            float ov[8]; float ss = 0.f;
#pragma unroll
            for (int e = 0; e < 4; ++e) { ov[2 * e] = bflo(a[e]) + bflo(b[e]); ov[2 * e + 1] = bfhi(a[e]) + bfhi(b[e]); ss += ov[2 * e] * ov[2 * e] + ov[2 * e + 1] * ov[2 * e + 1]; }
            ss += __shfl_xor(ss, 1); ss += __shfl_xor(ss, 2); ss += __shfl_xor(ss, 4); ss += __shfl_xor(ss, 8);
            const float rs = __builtin_amdgcn_rsqf(ss * (1.0f / 128.0f) + EPS);
            v4u o;
#pragma unroll
            for (int e = 0; e < 4; ++e) { const float n0 = (e < 2) ? nw0[2 * e] : nw1[2 * e - 4], n1 = (e < 2) ? nw0[2 * e + 1] : nw1[2 * e - 3];
                o[e] = pk2(ov[2 * e] * rs * n0 * silu(bflo(z[e])), ov[2 * e + 1] * rs * n1 * silu(bfhi(z[e]))); }
            *(v4u*)(MIX + (size_t)t * 1024 + 512 + lane * 8) = o; }
    }
}
#define XB_TMO      128
#define XB_XCNT(j)  (256  + 64 * (j))
#define XB_XSUB(j)  (1280 + 64 * (j))
#define XB_XGEN(j)  (2304 + 64 * (j))
#define XB_TOP      3328
#define XB_TOPGEN   3392
#define XCD_BAR_WORDS 3456
#define XB_SPIN_CAP (1u << 18)

__device__ __forceinline__ unsigned xb_ld(unsigned* p)              { return __hip_atomic_load(p, __ATOMIC_RELAXED, __HIP_MEMORY_SCOPE_AGENT); }
__device__ __forceinline__ unsigned xb_add(unsigned* p, unsigned v) { return __hip_atomic_fetch_add(p, v, __ATOMIC_RELAXED, __HIP_MEMORY_SCOPE_AGENT); }
__device__ __forceinline__ unsigned xb_xcc_id() { return (unsigned)__builtin_amdgcn_s_getreg((3 << 11) | 20) & 0xFu; }
#define XB_SPIN(cond, bar) do { unsigned _sp = 0; while (cond) { __builtin_amdgcn_s_sleep(1); \
    if ((++_sp & 255u) == 0u) { if (xb_ld(&(bar)[XB_TMO])) break; if (_sp > XB_SPIN_CAP) { atomicAdd(&(bar)[XB_TMO], 1u); break; } } } } while (0)

struct XcdBarrier {
    unsigned* bar; unsigned x;
    volatile LAS unsigned* st;
};

__device__ __forceinline__ XcdBarrier xcd_barrier_post(unsigned* bar, volatile LAS unsigned* st) {
    XcdBarrier b; b.bar = bar; b.x = xb_xcc_id(); b.st = st;
    if (threadIdx.x == 0) (void)xb_add(&bar[XB_XCNT(b.x)], 1u);
    return b;
}
__device__ __forceinline__ void xcd_barrier_complete(unsigned* bar, unsigned x, unsigned& nloc, unsigned& nx) {
    const unsigned G = gridDim.x * gridDim.y * gridDim.z;
    unsigned sum, cnt, mine, sp = 0u;
    for (;;) {
        sum = 0u; cnt = 0u; mine = 0u;
#pragma unroll
        for (unsigned j = 0; j < 16; ++j) { const unsigned c = xb_ld(&bar[XB_XCNT(j)]); sum += c; cnt += (c > 0u) ? 1u : 0u; mine = (j == x) ? c : mine; }
        if (sum == G) break;
        __builtin_amdgcn_s_sleep(1);
        if ((++sp & 255u) == 0u) { if (xb_ld(&bar[XB_TMO])) break; if (sp > XB_SPIN_CAP) { atomicAdd(&bar[XB_TMO], 1u); break; } }
    }
    nloc = mine > 0u ? mine : 1u; nx = cnt > 0u ? cnt : 1u;
}

__device__ __forceinline__ void xcd_barrier(const XcdBarrier& b) {
    asm volatile("s_waitcnt vmcnt(0)" ::: "memory");
    __syncthreads();
    if (threadIdx.x == 0) {
        unsigned* bar = b.bar;
        __builtin_amdgcn_s_waitcnt(0);
        unsigned nloc = b.st[0], nx = b.st[1];
        if (nloc == 0u) { xcd_barrier_complete(bar, b.x, nloc, nx); b.st[0] = nloc; b.st[1] = nx; }
        const unsigned old = xb_add(&bar[XB_XSUB(b.x)], 1u);
        const unsigned gen = old / nloc;
        if (old + 1u == (gen + 1u) * nloc) {
            __builtin_amdgcn_fence(__ATOMIC_RELEASE, "agent");
            asm volatile("s_waitcnt vmcnt(0)" ::: "memory");
            const unsigned og = xb_add(&bar[XB_TOP], 1u);
            const unsigned tg = og / nx;
            if (og + 1u == (tg + 1u) * nx) xb_add(&bar[XB_TOPGEN], 1u);
            else XB_SPIN(xb_ld(&bar[XB_TOPGEN]) == tg, bar);
            __builtin_amdgcn_fence(__ATOMIC_ACQUIRE, "agent");
            xb_add(&bar[XB_XGEN(b.x)], 1u);
            asm volatile("s_waitcnt vmcnt(0)" ::: "memory");
        } else {
            XB_SPIN(xb_ld(&bar[XB_XGEN(b.x)]) == gen, bar);
            __builtin_amdgcn_fence(__ATOMIC_ACQUIRE, "agent");
            asm volatile("s_waitcnt vmcnt(0)" ::: "memory");
        }
    }
    __syncthreads();
}

#ifndef DBG_SKIP_MIXER
#define DBG_SKIP_MIXER 0
#endif
#ifndef MK_MULTI
#define MK_MULTI 0
#endif
constexpr int NPH = 1 + 2 * (2 * 14) + 1 + 1;
static_assert(pg8::EpiProj::OFF_PA == WS_PA && pg8::EpiProj::OFF_PD == WS_PD && pg8::EpiProj::OFF_Z == WS_Z, "EpiProj offsets");
struct Args { const float* in[22]; float* out; unsigned char* ws; int lo, hi; };

__global__ void __launch_bounds__(512, 2) fwd(Args a) {
    extern __shared__ __attribute__((aligned(16))) unsigned char lds_raw[];
    LAS unsigned char* lds = (LAS unsigned char*)lds_raw;
    cg::grid_group grid = cg::this_grid();
    unsigned char* ws = a.ws;
    const int lo = a.lo, hi = a.hi; int pc = 0;
    const float* x_prompt = a.in[0]; const float* x_sample = a.in[1];
    float* MOD = (float*)(ws + WS_MOD); float* ROPE = (float*)(ws + WS_ROPE);
    bf16* H = (bf16*)(ws + WS_H); bf16* ACT = (bf16*)(ws + WS_ACT); bf16* PA = (bf16*)(ws + WS_PA); bf16* PD = (bf16*)(ws + WS_PD); bf16* Zb = (bf16*)(ws + WS_Z);
    bf16* DQ = (bf16*)(ws + WS_DQ); bf16* DK = (bf16*)(ws + WS_DK); bf16* DV = (bf16*)(ws + WS_DV); bf16* OF = (bf16*)(ws + WS_OF); bf16* OB = (bf16*)(ws + WS_OB);
    unsigned char* CH = ws + WS_CH; bf16* OG = (bf16*)(ws + WS_OG); float* LSE = (float*)(ws + WS_LSE); bf16* MIX = (bf16*)(ws + WS_MIX);
    float* AB = (float*)(ws + WS_AB); float* GB = (float*)(ws + WS_GB); float* GC = (float*)(ws + WS_GC);
#define PH_BEGIN if (pc >= lo && pc < hi) {
    { volatile LAS unsigned* st = (volatile LAS unsigned*)(lds + LDS_BYTES - 256); if (pg8::otid() < 2) st[pg8::otid()] = 0u; }
    __syncthreads();
    XcdBarrier bar = xcd_barrier_post((unsigned*)ws, (volatile LAS unsigned*)(lds + LDS_BYTES - 256));
#define PH_END } ++pc; if (pc > lo && pc < hi) { if (pc == 1) grid.sync(); else xcd_barrier(bar); }

    PH_BEGIN
        ph_mod(a.in[2], a.in[3], a.in[4], a.in[5], MOD, lds);
        ph_rope(ROPE);
        ph_wconv(a.in[7], a.in[8], a.in[9], a.in[18], a.in[19], a.in[20], a.in[11], a.in[16], 0, ws, lds);
    PH_END
    for (int layer = 0; layer < 2; ++layer) {
        if (layer == 1) {
            PH_BEGIN ph_wconv(a.in[7], a.in[8], a.in[9], a.in[18], a.in[19], a.in[20], a.in[11], a.in[16], 1, ws, lds); PH_END
        }
        const float* modl = MOD + (size_t)layer * 12 * 9216;
        for (int half = 0; half < 2; ++half) {
            const int S = half ? 8192 : 4096, lgS = half ? 13 : 12;
            float* X = a.out + (size_t)half * MH * D;
            const float* xin0 = half ? x_sample : x_prompt;
            for (int sb = 0; sb < 3; ++sb) {
                if (DBG_SKIP_MIXER && sb == 1) continue;
                const bool first = (layer == 0 && sb == 0);
                const float* xsrc = first ? xin0 : X;
                const float* nw = (sb == 0 ? a.in[6] : (sb == 1 ? a.in[10] : a.in[17])) + layer * D;
                PH_BEGIN ph_norm(xsrc, nw, modl, sb, half, H); PH_END
                if (sb != 1) {
                    PH_BEGIN
                        pg8::Gemm g{H, (const bf16*)(ws + (sb ? WS_WGU2 : WS_WGU1)), MH, 2 * FF, D}; pg8::StaticOrder So; So.init(MH, 2 * FF, gridDim.x, (int)blockIdx.x);
                        pg8::EpiSwiGLU E{ACT, FF};
                        pg8::gemm_phase<pg8::EpiSwiGLU, pg8::StaticOrder, true, true>(lds, g, So, E);
                    PH_END
                    PH_BEGIN
                        pg8::Gemm g{ACT, (const bf16*)(ws + (sb ? WS_WD2 : WS_WD1)), MH, D, FF}; pg8::StaticOrder So; So.init(MH, D, gridDim.x, (int)blockIdx.x);
                        pg8::EpiResid E{xsrc, X, modl + (3 * sb + 2) * 1024, 0.5f, half};
                        pg8::gemm_phase<pg8::EpiResid, pg8::StaticOrder, true, true>(lds, g, So, E);
                    PH_END
                } else {
                    PH_BEGIN
                        pg8::Gemm g{H, (const bf16*)(ws + WS_WIN), MH, NPROJ, D}; pg8::StaticOrder So; So.init(MH, NPROJ, gridDim.x, (int)blockIdx.x);
                        pg8::EpiProj E{ws, AB, ROPE, S - 1};
                        pg8::gemm_phase<pg8::EpiProj, pg8::StaticOrder, true, true>(lds, g, So, E);
                    PH_END
                    PH_BEGIN ph_dnpre(PD, AB, a.in[12] + (size_t)layer * 5 * 1536, a.in[13] + layer * 8, a.in[14] + layer * 8, DQ, DK, DV, GB, S); PH_END
                    PH_BEGIN ph_chunk(DQ, DK, DV, GB, CH, GC, S, lgS, lds); PH_END
                    PH_BEGIN ph_scan(DQ, CH, GC, OF, OB, S, lgS, half, lds); PH_END
                    PH_BEGIN ph_attn(PA, OG, LSE, S, lgS, lds); PH_END
                    PH_BEGIN ph_post(OG, LSE, OF, OB, Zb, a.in[15] + layer * 128, MIX); PH_END
                    PH_BEGIN
                        pg8::Gemm g{MIX, (const bf16*)(ws + WS_WOUT), MH, D, D}; pg8::StaticOrder So; So.init(MH, D, gridDim.x, (int)blockIdx.x);
                        pg8::EpiResid E{X, X, modl + 5 * 1024, 1.0f, half};
                        pg8::gemm_phase<pg8::EpiResid, pg8::StaticOrder, true, true>(lds, g, So, E);
                    PH_END
                }
            }
        }
    }
    PH_BEGIN ph_final(a.out, a.in[21]); PH_END
}

extern "C" void kernel_launch(void* const* d_in, const int* in_sizes, int n_in, void* d_out, int out_size, void* d_ws, size_t ws_size, hipStream_t stream) {
    static int grid = 0;
    if (grid == 0) {
        if (n_in != 22 || ws_size < WS_END) { fprintf(stderr, "kernel_launch: unexpected n_in %d / ws_size %zu\n", n_in, ws_size); grid = -1; return; }
        int dev = 0, cus = 0, per_cu = 0;
        hipGetDevice(&dev); hipDeviceGetAttribute(&cus, hipDeviceAttributeMultiprocessorCount, dev);
        if (hipFuncSetAttribute((const void*)fwd, hipFuncAttributeMaxDynamicSharedMemorySize, LDS_BYTES) != hipSuccess) { fprintf(stderr, "kernel_launch: hipFuncSetAttribute failed\n"); grid = -1; return; }
        if (hipOccupancyMaxActiveBlocksPerMultiprocessor(&per_cu, (const void*)fwd, 512, LDS_BYTES) != hipSuccess || per_cu < 1) { per_cu = 1; (void)hipGetLastError(); }
        grid = cus * per_cu;
        fprintf(stderr, "kernel_launch: grid %d (cus %d x %d), ws %zu MiB\n", grid, cus, per_cu, ws_size >> 20);
    }
    if (grid < 0) return;
    if (hipMemsetAsync(d_ws, 0, 16384, stream) != hipSuccess) { fprintf(stderr, "kernel_launch: memset failed\n"); return; }
    Args a{};
    for (int i = 0; i < 22; ++i) a.in[i] = (const float*)d_in[i];
    a.out = (float*)d_out; a.ws = (unsigned char*)d_ws;
#if MK_MULTI
    for (int p = 0; p < NPH; ++p) { a.lo = p; a.hi = p + 1; hipLaunchKernelGGL(fwd, dim3(grid), dim3(512), LDS_BYTES, stream, a); }
#else
    a.lo = 0; a.hi = NPH;
    void* args[] = {&a};
    hipError_t e = hipLaunchCooperativeKernel((const void*)fwd, dim3(grid), dim3(512), args, LDS_BYTES, stream);
    if (e != hipSuccess) fprintf(stderr, "cooperative launch failed: %s (grid %d)\n", hipGetErrorString(e), grid);
#endif
}
```

```cpp
#include <hip/hip_runtime.h>
#include <hip/hip_cooperative_groups.h>
#include <cstdio>
#include <cstdint>
namespace cg = cooperative_groups;
namespace pg8 {
#define PG8_LAS __attribute__((address_space(3)))
typedef unsigned short bf16_t;
typedef short bf16x8 __attribute__((ext_vector_type(8)));
typedef float f32x4 __attribute__((ext_vector_type(4)));
typedef unsigned u32x4 __attribute__((ext_vector_type(4)));
constexpr int BM = 256, BK = 64, HALF = 128, HTB = HALF * BK * 2  , STAGE_BYTES = 8 * HTB, NXCD = 8, WGM = 8;

__host__ __device__ __forceinline__ int lds_byte(int r, int c) { const int st = (r >> 4) * 2 + (c >> 5), rr = r & 15, cc = c & 31, ob = rr * 64 + cc * 2; return st * 1024 + (ob ^ (((ob >> 9) & 1) << 5)); }
__host__ __device__ __forceinline__ void stage_rc(int b, int& R, int& C) { const int st = b / 1024, sb = b % 1024, swz = sb ^ (((sb >> 9) & 1) << 5); R = (st >> 1) * 16 + swz / 64; C = (st & 1) * 32 + (swz % 64) / 2; }
__host__ __device__ __forceinline__ int perm32(int rho) { const int n = rho >> 4, i = rho & 15; return 8 * (i >> 2) + 4 * n + (i & 3); }

struct Unit { int pm, pn; };
struct Gemm { const bf16_t* A; const bf16_t* Bt; int M, N, K; };

struct StaticOrder {
    int nM, nN, nwg, G, c;
    __host__ __device__ void init(int M, int N, int G_, int c_) { nM = M / BM; nN = N / BM; nwg = nM * nN; G = G_; c = c_; }
    __host__ __device__ bool next(int i, Unit& u) const {
        const long L = (long)i * G + c; if (L >= nwg) return false;
        int wgid = (int)L; { const int q = nwg / NXCD, r = nwg % NXCD, xcd = wgid % NXCD, off = wgid / NXCD; wgid = (xcd < r ? xcd * (q + 1) : r * (q + 1) + (xcd - r) * q) + off; }
        const int nig = WGM * nN, gid = wgid / nig, fm = gid * WGM, gsz = (nM - fm) < WGM ? (nM - fm) : WGM;
        u.pm = fm + ((wgid % nig) % gsz); u.pn = (wgid % nig) / gsz; return true;
    }
    __device__ __forceinline__ void a_ready(const Unit&) const {}
    __device__ __forceinline__ void done(const Unit&) const {}
};
typedef __bf16 bf16x2_t __attribute__((ext_vector_type(2)));
typedef float f32x2_t __attribute__((ext_vector_type(2)));
__device__ __forceinline__ unsigned cvt_pk_bf16(float lo, float hi) { unsigned r; asm volatile("v_cvt_pk_bf16_f32 %0, %1, %2" : "=v"(r) : "v"(lo), "v"(hi)); return r; }
__device__ __forceinline__ unsigned cvt_pk_bf16_cv(float lo, float hi) { const f32x2_t v = {lo, hi}; const bf16x2_t b = __builtin_convertvector(v, bf16x2_t); return __builtin_bit_cast(unsigned, b); }
__device__ __forceinline__ int otid() { int t = threadIdx.x; asm volatile("" : "+v"(t)); return t; }
__device__ __forceinline__ float silu_f(float v) { return v * __builtin_amdgcn_rcpf(1.0f + __expf(-v)); }

#define EPI_PIN(p) asm volatile("" : "+v"(p))
struct EpiSwiGLU {
    static constexpr bool PERM = true, AFTER_DRAIN = false;
    bf16_t* O; int ldc;
    __device__ __forceinline__ void operator()(const f32x4 (&acc)[2][2][4][2], const Unit& u, int wr, int wc, int fr, int fq) const {
        const int row0 = u.pm * BM + wr * 64 + fr, col0 = u.pn * 128 + wc * 32 + 8 * fq;
        bf16_t* rowp = O + (size_t)row0 * ldc + col0;
#pragma unroll
        for (int ai = 0; ai < 2; ++ai) {
#pragma unroll
            for (int m = 0; m < 4; ++m) {
                const f32x4 g0 = acc[ai][0][m][0], g1 = acc[ai][0][m][1], u0 = acc[ai][1][m][0], u1 = acc[ai][1][m][1];
                u32x4 w;
                w.x = cvt_pk_bf16(silu_f(g0[0]) * u0[0], silu_f(g0[1]) * u0[1]); w.y = cvt_pk_bf16(silu_f(g0[2]) * u0[2], silu_f(g0[3]) * u0[3]);
                w.z = cvt_pk_bf16(silu_f(g1[0]) * u1[0], silu_f(g1[1]) * u1[1]); w.w = cvt_pk_bf16(silu_f(g1[2]) * u1[2], silu_f(g1[3]) * u1[3]);
                *(u32x4*)rowp = w;
                rowp += (size_t)16 * ldc; EPI_PIN(rowp);
            }
            rowp += (size_t)64 * ldc; EPI_PIN(rowp);
        }
    }
};
struct EpiResid {
    static constexpr bool PERM = false, AFTER_DRAIN = false;
    const float* xin; float* xout; const float* gate; float scale; int half;
    __device__ __forceinline__ void operator()(const f32x4 (&acc)[2][2][4][2], const Unit& u, int wr, int wc, int fr, int fq) const {
        const int row0 = u.pm * BM + wr * 64 + fr, col0 = u.pn * BM + wc * 32 + 4 * fq;
        const int batch = half ? 8 + (u.pm >> 5) : (u.pm >> 4);
        const float* gp = gate + (size_t)batch * 9216 + col0;
        f32x4 gv[2][2];
#pragma unroll
        for (int bj = 0; bj < 2; ++bj)
#pragma unroll
            for (int n = 0; n < 2; ++n) gv[bj][n] = *(const f32x4*)(gp + bj * HALF + n * 16) * scale;
        const float* xp = xin + (size_t)row0 * 1024 + col0; float* op = xout + (size_t)row0 * 1024 + col0;
#pragma unroll
        for (int ai = 0; ai < 2; ++ai) {
#pragma unroll
            for (int m = 0; m < 4; ++m) {
#pragma unroll
                for (int bj = 0; bj < 2; ++bj)
#pragma unroll
                    for (int n = 0; n < 2; ++n) { const f32x4 xi = *(const f32x4*)(xp + bj * HALF + n * 16); *(f32x4*)(op + bj * HALF + n * 16) = xi + gv[bj][n] * acc[ai][bj][m][n]; }
                xp += 16 * 1024; op += 16 * 1024; EPI_PIN(xp); EPI_PIN(op);
                asm volatile("" ::: "memory"); }
            xp += 64 * 1024; op += 64 * 1024; EPI_PIN(xp); EPI_PIN(op);
        }
    }
};
struct EpiProj {
    static constexpr bool PERM = true, AFTER_DRAIN = false;
    static constexpr size_t OFF_PA = (size_t)144 << 20, OFF_PD = (size_t)272 << 20, OFF_Z = (size_t)240 << 20;
    unsigned char* wsb; float* AB; const float* rope; int smask;
    __device__ __forceinline__ void operator()(const f32x4 (&acc)[2][2][4][2], const Unit& u, int wr, int wc, int fr, int fq) const {
        const int row0 = u.pm * BM + wr * 64 + fr, pn = u.pn;
        if (pn < 14) {
            const size_t poff = pn < 6 ? OFF_PA : (pn < 12 ? OFF_PD : OFF_Z); bf16_t* P = (bf16_t*)(wsb + poff); const int ldp = pn < 12 ? 1536 : 512;
            const int col0 = (pn < 6 ? pn : (pn < 12 ? pn - 6 : pn - 12)) * 256 + wc * 32 + 8 * fq;
            const bool rot = (pn < 4) && ((wc & 1) == 0) && (fq < 2);
            const float sgn = (fq & 1) ? 1.f : -1.f;
            bf16_t* rowp = P + (size_t)row0 * ldp + col0; int row = row0;
#pragma unroll
            for (int ai = 0; ai < 2; ++ai) {
#pragma unroll
                for (int m = 0; m < 4; ++m) {
                    f32x4 c0 = {0.f, 0.f, 0.f, 0.f}, c1 = c0, s0 = c0, s1 = c0;
                    if (pn < 4) { const float* rp = rope + (size_t)(row & smask) * 16; c0 = *(const f32x4*)rp; c1 = *(const f32x4*)(rp + 4); s0 = *(const f32x4*)(rp + 8); s1 = *(const f32x4*)(rp + 12); }
#pragma unroll
                    for (int bj = 0; bj < 2; ++bj) { f32x4 v0 = acc[ai][bj][m][0], v1 = acc[ai][bj][m][1];
                        if (pn < 4) { f32x4 p0, p1;
#pragma unroll
                            for (int j = 0; j < 4; ++j) { p0[j] = __shfl_xor(v0[j], 16); p1[j] = __shfl_xor(v1[j], 16); }
                            const f32x4 r0 = v0 * c0 + sgn * (p0 * s0), r1 = v1 * c1 + sgn * (p1 * s1);
                            if (rot) { v0 = r0; v1 = r1; } }
                        u32x4 w; w.x = cvt_pk_bf16(v0[0], v0[1]); w.y = cvt_pk_bf16(v0[2], v0[3]); w.z = cvt_pk_bf16(v1[0], v1[1]); w.w = cvt_pk_bf16(v1[2], v1[3]);
                        *(u32x4*)(rowp + bj * HALF) = w; }
                    rowp += (size_t)16 * ldp; row += 16; EPI_PIN(rowp); EPI_PIN(row);
                    asm volatile("" ::: "memory"); }
                rowp += (size_t)64 * ldp; row += 64; EPI_PIN(rowp); EPI_PIN(row);
            }
        } else {
            if (wc == 0 && fq < 2) {
                float* ap = AB + (size_t)row0 * 16 + 8 * fq;
#pragma unroll
                for (int ai = 0; ai < 2; ++ai) {
#pragma unroll
                    for (int m = 0; m < 4; ++m) { *(f32x4*)ap = acc[ai][0][m][0]; *(f32x4*)(ap + 4) = acc[ai][0][m][1]; ap += 16 * 16; EPI_PIN(ap); }
                    ap += 64 * 16; EPI_PIN(ap); }
            }
        }
    }
};

template <class Epi, class Sched, bool ALIGN_EPI = false, bool SP2 = false>
__device__ __forceinline__ void gemm_phase(PG8_LAS unsigned char* lds, const Gemm g, const Sched& S, const Epi& E) {
    const int tid = otid(), wid = __builtin_amdgcn_readfirstlane(tid >> 6), lane = tid & 63, wr = wid >> 2, wc = wid & 3, fr = lane & 15, fq = lane >> 4;
    const int K = g.K, nt = K / BK;
    unsigned voffA[2], voffB[2];
#pragma unroll
    for (int i = 0; i < 2; ++i) { int R, C; stage_rc(tid * 16 + i * 8192, R, C); const int Rb = Epi::PERM ? ((R & ~31) + perm32(R & 31)) : R;
        voffA[i] = (unsigned)(R * K + C) * 2u; voffB[i] = (unsigned)(Rb * K + C) * 2u; }
    const size_t kstep = (size_t)(BK * 2);
    const size_t hstep = (size_t)HALF * K * 2;
    const size_t tstep = 2 * hstep;
    const unsigned ldsw = (unsigned)wid * 1024u;
    const int aoff = lds_byte(wr * 64 + fr, fq * 8), boff = lds_byte(wc * 32 + fr, fq * 8);
#define PG8_SA(b, h) (((b) * 2 + (h)) * HTB)
#define PG8_SB(b, h) ((4 + (b) * 2 + (h)) * HTB)
#define PG8_STAGE(bufoff, gbase, voff) do { _Pragma("unroll") for (int _i = 0; _i < 2; ++_i) \
        __builtin_amdgcn_global_load_lds((const unsigned*)((const char*)(gbase) + (voff)[_i]), (PG8_LAS unsigned*)(lds + (bufoff) + ldsw + _i * 8192), 16, 0, 0); } while (0)
#define PG8_LDA(dst, b, h) do { _Pragma("unroll") for (int m = 0; m < 4; ++m) _Pragma("unroll") for (int k = 0; k < 2; ++k) dst[m][k] = *(const PG8_LAS bf16x8*)(lds + PG8_SA(b, h) + aoff + m * 2048 + k * 1024); } while (0)
#define PG8_LDB(dst, b, h) do { _Pragma("unroll") for (int n = 0; n < 2; ++n) _Pragma("unroll") for (int k = 0; k < 2; ++k) dst[n][k] = *(const PG8_LAS bf16x8*)(lds + PG8_SB(b, h) + boff + n * 2048 + k * 1024); } while (0)
#define PG8_MMA(ai, bj, At, Bt) do { __builtin_amdgcn_s_setprio(1); _Pragma("unroll") for (int m = 0; m < 4; ++m) _Pragma("unroll") for (int n = 0; n < 2; ++n) _Pragma("unroll") for (int k = 0; k < 2; ++k) \
        acc[ai][bj][m][n] = __builtin_amdgcn_mfma_f32_16x16x32_bf16(Bt[n][k], At[m][k], acc[ai][bj][m][n], 0, 0, 0); __builtin_amdgcn_s_setprio(0); } while (0)
#define PG8_WAIT_V(n) asm volatile("s_waitcnt vmcnt(" #n ")" ::: "memory")
#define PG8_WAIT_L(n) asm volatile("s_waitcnt lgkmcnt(" #n ")" ::: "memory")
#define PG8_BAR __builtin_amdgcn_s_barrier()
#define PG8_SCHED __builtin_amdgcn_sched_barrier(0)
    Unit cur, nxt; int ui = 0;
    if (!S.next(0, cur)) return;
    f32x4 acc[2][2][4][2];
#pragma unroll
    for (int a = 0; a < 2; ++a)
#pragma unroll
        for (int b = 0; b < 2; ++b)
#pragma unroll
            for (int m = 0; m < 4; ++m)
#pragma unroll
                for (int n = 0; n < 2; ++n) acc[a][b][m][n] = (f32x4){0.f, 0.f, 0.f, 0.f};
    bf16x8 At[4][2], B0[2][2], B1[2][2];
    const char* cA = (const char*)g.A + (size_t)cur.pm * tstep; const char* cB = (const char*)g.Bt + (size_t)cur.pn * tstep;
    S.a_ready(cur);
    if constexpr (SP2) {
        PG8_STAGE(PG8_SB(0, 0), cB, voffB); PG8_STAGE(PG8_SB(0, 1), cB + hstep, voffB); PG8_STAGE(PG8_SA(0, 0), cA, voffA); PG8_STAGE(PG8_SA(0, 1), cA + hstep, voffA);
        if (wr == 1) PG8_BAR;
        PG8_WAIT_V(2); PG8_BAR;
        PG8_STAGE(PG8_SB(1, 0), cB + kstep, voffB); PG8_STAGE(PG8_SA(1, 0), cA + kstep, voffA); PG8_STAGE(PG8_SB(1, 1), cB + hstep + kstep, voffB);
        PG8_WAIT_V(6); PG8_BAR;
    } else {
        PG8_STAGE(PG8_SB(0, 0), cB, voffB); PG8_STAGE(PG8_SA(0, 0), cA, voffA); PG8_STAGE(PG8_SB(0, 1), cB + hstep, voffB); PG8_STAGE(PG8_SA(0, 1), cA + hstep, voffA);
        if (wr == 1) PG8_BAR;
        PG8_WAIT_V(4); PG8_BAR;
        PG8_STAGE(PG8_SB(1, 0), cB + kstep, voffB); PG8_STAGE(PG8_SA(1, 0), cA + kstep, voffA); PG8_STAGE(PG8_SB(1, 1), cB + hstep + kstep, voffB);
        PG8_WAIT_V(6); PG8_BAR;
    }
    for (;;) {
        const bool has_next = S.next(ui + 1, nxt);
        const char* nA = has_next ? (const char*)g.A + (size_t)nxt.pm * tstep : cA; const char* nB = has_next ? (const char*)g.Bt + (size_t)nxt.pn * tstep : cB;
        for (int t = 0; t < nt; t += 2) {
            const bool last = (t == nt - 2);
            const char* a1 = cA + (size_t)(t + 1) * kstep;
            const char* a2 = last ? nA : cA + (size_t)(t + 2) * kstep; const char* b2 = last ? nB : cB + (size_t)(t + 2) * kstep;
            const char* a3 = a2 + kstep; const char* b3 = b2 + kstep;
            if (last && has_next) S.a_ready(nxt);
            if constexpr (SP2) {
            PG8_LDB(B0, 0, 0); PG8_LDB(B1, 0, 1); PG8_SCHED; PG8_LDA(At, 0, 0); PG8_STAGE(PG8_SA(1, 1), a1 + hstep, voffA);
            PG8_WAIT_V(8); PG8_WAIT_L(0); PG8_BAR; PG8_MMA(0, 0, At, B0); PG8_MMA(0, 1, At, B1); PG8_BAR; PG8_SCHED;
            PG8_LDA(At, 0, 1); PG8_STAGE(PG8_SB(0, 0), b2, voffB); PG8_STAGE(PG8_SB(0, 1), b2 + hstep, voffB); PG8_STAGE(PG8_SA(0, 0), a2, voffA);
            PG8_WAIT_V(8); PG8_WAIT_L(0); PG8_BAR; PG8_MMA(1, 0, At, B0); PG8_MMA(1, 1, At, B1); PG8_BAR; PG8_SCHED;
            PG8_LDB(B0, 1, 0); PG8_LDB(B1, 1, 1); PG8_SCHED; PG8_LDA(At, 1, 0); PG8_STAGE(PG8_SA(0, 1), a2 + hstep, voffA);
            PG8_WAIT_V(8); PG8_WAIT_L(0); PG8_BAR; PG8_MMA(0, 0, At, B0); PG8_MMA(0, 1, At, B1); PG8_BAR; PG8_SCHED;
            PG8_LDA(At, 1, 1); PG8_STAGE(PG8_SB(1, 0), b3, voffB); PG8_STAGE(PG8_SB(1, 1), b3 + hstep, voffB); PG8_STAGE(PG8_SA(1, 0), a3, voffA);
            PG8_WAIT_V(8); PG8_WAIT_L(0); PG8_BAR; PG8_MMA(1, 0, At, B0); PG8_MMA(1, 1, At, B1); PG8_BAR; PG8_SCHED;
            } else {
            PG8_LDB(B0, 0, 0); PG8_SCHED; PG8_LDA(At, 0, 0); PG8_STAGE(PG8_SA(1, 1), a1 + hstep, voffA);
            PG8_WAIT_L(8); PG8_BAR; PG8_WAIT_L(0); PG8_MMA(0, 0, At, B0); PG8_BAR; PG8_SCHED;
            PG8_LDB(B1, 0, 1); PG8_STAGE(PG8_SB(0, 0), b2, voffB);
            PG8_BAR; PG8_WAIT_L(0); PG8_MMA(0, 1, At, B1); PG8_BAR;
            PG8_LDA(At, 0, 1); PG8_STAGE(PG8_SA(0, 0), a2, voffA);
            PG8_BAR; PG8_WAIT_L(0); PG8_MMA(1, 0, At, B0); PG8_BAR; PG8_SCHED;
            PG8_STAGE(PG8_SB(0, 1), b2 + hstep, voffB);
            PG8_WAIT_V(6); PG8_BAR; PG8_MMA(1, 1, At, B1); PG8_BAR;
            PG8_LDB(B0, 1, 0); PG8_SCHED; PG8_LDA(At, 1, 0); PG8_STAGE(PG8_SA(0, 1), a2 + hstep, voffA);
            PG8_WAIT_L(8); PG8_BAR; PG8_WAIT_L(0); PG8_MMA(0, 0, At, B0); PG8_BAR; PG8_SCHED;
            PG8_LDB(B1, 1, 1); PG8_STAGE(PG8_SB(1, 0), b3, voffB);
            PG8_BAR; PG8_WAIT_L(0); PG8_MMA(0, 1, At, B1); PG8_BAR;
            PG8_LDA(At, 1, 1); PG8_STAGE(PG8_SA(1, 0), a3, voffA);
            PG8_BAR; PG8_WAIT_L(0); PG8_MMA(1, 0, At, B0); PG8_BAR; PG8_SCHED;
            PG8_STAGE(PG8_SB(1, 1), b3 + hstep, voffB);
            PG8_WAIT_V(6); PG8_BAR; PG8_MMA(1, 1, At, B1); PG8_BAR;
            }
        }
        if constexpr (ALIGN_EPI) { if (wr == 0) PG8_BAR; }
        if constexpr (!Epi::AFTER_DRAIN) { E(acc, cur, wr, wc, fr, fq); S.done(cur); }
        if (!has_next) break;
#pragma unroll
        for (int a = 0; a < 2; ++a)
#pragma unroll
            for (int b = 0; b < 2; ++b)
#pragma unroll
                for (int m = 0; m < 4; ++m)
#pragma unroll
                    for (int n = 0; n < 2; ++n) acc[a][b][m][n] = (f32x4){0.f, 0.f, 0.f, 0.f};
        cur = nxt; cA = nA; cB = nB; ++ui;
        if constexpr (ALIGN_EPI) { if (wr == 1) PG8_BAR; }
    }
    PG8_WAIT_V(0);
    if constexpr (!ALIGN_EPI) { if (wr == 0) PG8_BAR; }
    PG8_BAR;
    if constexpr (Epi::AFTER_DRAIN) { E.fused(acc, cur, wr, wc, fr, fq, lds, wid, lane); S.done(cur); }
#undef PG8_SA
#undef PG8_SB
#undef PG8_STAGE
#undef PG8_LDA
#undef PG8_LDB
#undef PG8_MMA
#undef PG8_WAIT_V
#undef PG8_WAIT_L
#undef PG8_BAR
#undef PG8_SCHED
}
}

#define LAS __attribute__((address_space(3)))
typedef unsigned short bf16;
typedef short bf16x8 __attribute__((ext_vector_type(8)));
typedef short s16x4 __attribute__((ext_vector_type(4)));
typedef float f32x4 __attribute__((ext_vector_type(4)));
typedef unsigned v4u __attribute__((ext_vector_type(4)));
typedef unsigned v2u __attribute__((ext_vector_type(2)));
#define MFMA16(a, b, c) __builtin_amdgcn_mfma_f32_16x16x32_bf16((a), (b), (c), 0, 0, 0)
#define CAT8(lo, hi) __builtin_shufflevector((lo), (hi), 0, 1, 2, 3, 4, 5, 6, 7)
#define LDS_WAIT() asm volatile("s_waitcnt lgkmcnt(0)" ::: "memory")

constexpr int D = 1024, FF = 2816, MH = 32768, NPROJ = 3840, INW = 3600;
constexpr float EPS = 1e-6f;
constexpr size_t MiB = 1u << 20;
constexpr size_t WS_MOD = 1 * MiB, WS_ROPE = 2 * MiB;
constexpr size_t WS_WGU1 = 4 * MiB, WS_WD1 = 15 * MiB, WS_WIN = 15 * MiB + 5632 * 1024, WS_WOUT = 28 * MiB, WS_WGU2 = 30 * MiB, WS_WD2 = 41 * MiB;
constexpr size_t WS_H = 48 * MiB, WS_DQ = 48 * MiB, WS_DK = 80 * MiB, WS_DV = 112 * MiB, WS_OF = 80 * MiB, WS_OB = 112 * MiB;
constexpr size_t WS_ACT = 112 * MiB, WS_PA = 144 * MiB, WS_Z = 240 * MiB, WS_CH = 272 * MiB, WS_PD = 272 * MiB, WS_OG = 272 * MiB, WS_LSE = 368 * MiB, WS_MIX = 374 * MiB;
constexpr size_t WS_AB = 496 * MiB, WS_GB = 498 * MiB, WS_GC = 500 * MiB, WS_END = 501 * MiB;
constexpr int LDS_BYTES = 163840;
constexpr int CHJOB = 57344;

__device__ __forceinline__ float bf2f(unsigned short v) { return __uint_as_float(((unsigned)v) << 16); }
__device__ __forceinline__ float bflo(unsigned w) { return __uint_as_float(w << 16); }
__device__ __forceinline__ float bfhi(unsigned w) { return __uint_as_float(w & 0xffff0000u); }
__device__ __forceinline__ unsigned pk2(float lo, float hi) { return pg8::cvt_pk_bf16(lo, hi); }
__device__ __forceinline__ float opaque_one() { float o = 1.0f; asm volatile("" : "+v"(o)); return o; }
__device__ __forceinline__ float silu(float v) { return v * __builtin_amdgcn_rcpf(1.0f + __expf(-v)); }
__device__ __forceinline__ float wave_sum(float v) {
#pragma unroll
    for (int o = 1; o < 64; o <<= 1) v += __shfl_xor(v, o);
    return v;
}
__device__ __forceinline__ bf16x8 pack8(const f32x4 a, const f32x4 b) {
    v4u w; w.x = pk2(a[0], a[1]); w.y = pk2(a[2], a[3]); w.z = pk2(b[0], b[1]); w.w = pk2(b[2], b[3]);
    return __builtin_bit_cast(bf16x8, w);
}
__device__ __forceinline__ f32x4 ld_bf4(const bf16* p) { const v2u w = *(const v2u*)p; return (f32x4){bflo(w.x), bfhi(w.x), bflo(w.y), bfhi(w.y)}; }

__device__ __forceinline__ void ph_mod(const float* c_prompt, const float* c_sample, const float* ada_w, const float* ada_b, float* MOD, LAS unsigned char* lds) {
    const int tid = pg8::otid(), lane = tid & 63, wave = tid >> 6;
    LAS float* sc = (LAS float*)lds;
    LAS float* red = (LAS float*)(lds + 49152);
    for (int i = tid; i < 12 * 1024; i += 512) { const int b = i >> 10, k = i & 1023; const float v = b < 8 ? c_prompt[b * 1024 + k] : c_sample[(b - 8) * 1024 + k]; sc[i] = silu(v); }
    __syncthreads();
    const int cl = tid & 7, kg = tid >> 3;
    for (int item = blockIdx.x; item < 576; item += gridDim.x) {
        const int layer = item / 288, cg32 = item % 288, col = cg32 * 32 + cl * 4;
        float acc[12][4];
#pragma unroll
        for (int b = 0; b < 12; ++b)
#pragma unroll
            for (int j = 0; j < 4; ++j) acc[b][j] = 0.f;
        const float* wp = ada_w + (size_t)layer * 1024 * 9216 + col;
#pragma unroll 4
        for (int kk = 0; kk < 16; ++kk) { const int k = kg * 16 + kk; const f32x4 w = *(const f32x4*)(wp + (size_t)k * 9216);
#pragma unroll
            for (int b = 0; b < 12; ++b) { const float s = sc[b * 1024 + k];
#pragma unroll
                for (int j = 0; j < 4; ++j) acc[b][j] += s * w[j]; } }
#pragma unroll
        for (int b = 0; b < 12; ++b)
#pragma unroll
            for (int j = 0; j < 4; ++j) { float v = acc[b][j]; v += __shfl_xor(v, 8); v += __shfl_xor(v, 16); v += __shfl_xor(v, 32); if ((lane >> 3) == 0) red[(wave * 8 + cl) * 48 + b * 4 + j] = v; }
        __syncthreads();
        if (tid < 384) { const int b = tid >> 5, c = tid & 31; float s = 0.f;
#pragma unroll
            for (int w = 0; w < 8; ++w) s += red[(w * 8 + (c >> 2)) * 48 + b * 4 + (c & 3)];
            MOD[(size_t)(layer * 12 + b) * 9216 + cg32 * 32 + c] = s + ada_b[layer * 9216 + cg32 * 32 + c]; }
        __syncthreads();
    }
}
__device__ __forceinline__ void ph_rope(float* ROPE) {
    for (int idx = blockIdx.x * 512 + pg8::otid(); idx < 8192 * 8; idx += gridDim.x * 512) {
        const int s = idx >> 3, i = idx & 7;
        const float inv = exp2f(-(float)i * 0.125f * 18.931568569324174f);
        const float ang = (float)s * inv;
        double rev = (double)ang * 0.15915494309189535; rev -= __builtin_rint(rev);
        const float fr = (float)rev;
        ROPE[s * 16 + i] = __builtin_amdgcn_cosf(fr); ROPE[s * 16 + 8 + i] = __builtin_amdgcn_sinf(fr);
    }
}
__device__ __forceinline__ void tr_item(const float* W, int K, int N, bf16* WT, int k0, int n0, int dst_row0, LAS float* scr, int lane) {
#pragma unroll 8
    for (int i = 0; i < 32; ++i) { const int kk = 2 * i + (lane >> 5), n = n0 + (lane & 31); scr[kk * 33 + (lane & 31)] = (n < N) ? W[(size_t)(k0 + kk) * N + n] : 0.f; }
    LDS_WAIT();
    const int c = lane & 7;
#pragma unroll
    for (int j = 0; j < 4; ++j) { const int n = (lane >> 3) + 8 * j; const LAS float* s = scr + (8 * c) * 33 + n;
        v4u o; o.x = pk2(s[0 * 33], s[1 * 33]); o.y = pk2(s[2 * 33], s[3 * 33]); o.z = pk2(s[4 * 33], s[5 * 33]); o.w = pk2(s[6 * 33], s[7 * 33]);
        *(v4u*)(WT + (size_t)(dst_row0 + n) * K + k0 + 8 * c) = o; }
    LDS_WAIT();
}
__device__ __forceinline__ void ph_wconv(const float* wg1, const float* wu1, const float* wd1, const float* wg2, const float* wu2, const float* wd2, const float* win, const float* wout,
                                         int layer, unsigned char* ws, LAS unsigned char* lds) {
    const int tid_ = pg8::otid(), lane = tid_ & 63, wave = tid_ >> 6;
    LAS float* scr = (LAS float*)(lds + wave * 16384);
    const int gw = blockIdx.x * 8 + wave, NGW = gridDim.x * 8;
    constexpr int I_GU = 16 * 88, I_DN = 44 * 32, I_IN = 16 * 120, I_OUT = 16 * 32;
    constexpr int NIT = 6 * I_GU + I_IN + I_OUT;
    static_assert(I_DN == I_GU, "item counts");
    for (int it = gw; it < NIT; it += NGW) {
        int r = it;
        if (r < 6 * I_GU) {
            const int which = r / I_GU; r -= which * I_GU;
            const int f = which / 3, t = which % 3;
            if (t < 2) { const float* W = (f ? (t ? wu2 : wg2) : (t ? wu1 : wg1)) + (size_t)layer * D * FF; bf16* WT = (bf16*)(ws + (f ? WS_WGU2 : WS_WGU1));
                const int kb = r / 88, nb = r % 88, n0 = nb * 32; tr_item(W, D, FF, WT, kb * 64, n0, (n0 >> 7) * 256 + t * 128 + (n0 & 127), scr, lane); }
            else { const float* W = (f ? wd2 : wd1) + (size_t)layer * D * FF; bf16* WT = (bf16*)(ws + (f ? WS_WD2 : WS_WD1));
                const int kb = r / 32, nb = r % 32; tr_item(W, FF, D, WT, kb * 64, nb * 32, nb * 32, scr, lane); }
            continue;
        }
        r -= 6 * I_GU;
        if (r < I_IN) { const int kb = r / 120, nb = r % 120; tr_item(win + (size_t)layer * D * INW, D, INW, (bf16*)(ws + WS_WIN), kb * 64, nb * 32, nb * 32, scr, lane); continue; }
        r -= I_IN;
        { const int kb = r / 32, nb = r % 32; tr_item(wout + (size_t)layer * D * D, D, D, (bf16*)(ws + WS_WOUT), kb * 64, nb * 32, nb * 32, scr, lane); }
    }
}
__device__ __forceinline__ void ph_norm(const float* x, const float* nw, const float* modl, int sb, int half, bf16* H) {
    const int tid_ = pg8::otid(), lane = tid_ & 63, wave = tid_ >> 6;
    const int gw = blockIdx.x * 8 + wave, NGW = gridDim.x * 8;
    for (int r0 = gw * 16; r0 < MH; r0 += NGW * 16) {
        const int batch = half ? 8 + (r0 >> 13) : (r0 >> 12);
        const float* mp = modl + (size_t)batch * 9216 + sb * 3072;
        f32x4 A[4], B[4];
#pragma unroll
        for (int j = 0; j < 4; ++j) { const int c = 4 * lane + 256 * j; const f32x4 w = *(const f32x4*)(nw + c), sh = *(const f32x4*)(mp + c), scl = *(const f32x4*)(mp + 1024 + c); A[j] = w * (1.0f + scl); B[j] = sh; }
        for (int r = r0; r < r0 + 16; ++r) {
            const f32x4* xr = (const f32x4*)(x + (size_t)r * D) + lane;
            f32x4 v[4]; float s = 0.f;
#pragma unroll
            for (int j = 0; j < 4; ++j) { v[j] = xr[64 * j]; s += (v[j].x * v[j].x + v[j].y * v[j].y) + (v[j].z * v[j].z + v[j].w * v[j].w); }
            const float rstd = __builtin_amdgcn_rsqf(wave_sum(s) * (1.f / D) + EPS);
            v2u* o8 = (v2u*)(H + (size_t)r * D) + lane;
#pragma unroll
            for (int j = 0; j < 4; ++j) { const f32x4 h = v[j] * rstd * A[j] + B[j]; v2u w; w.x = pk2(h.x, h.y); w.y = pk2(h.z, h.w); o8[64 * j] = w; }
        }
    }
}
__device__ __forceinline__ void ph_final(float* x, const float* nw) {
    const int tid_ = pg8::otid(), lane = tid_ & 63, wave = tid_ >> 6;
    const int gw = blockIdx.x * 8 + wave, NGW = gridDim.x * 8;
    f32x4 A[4];
#pragma unroll
    for (int j = 0; j < 4; ++j) A[j] = *(const f32x4*)(nw + 4 * lane + 256 * j);
    for (int r = gw; r < 2 * MH; r += NGW) {
        f32x4* xr = (f32x4*)(x + (size_t)r * D) + lane;
        f32x4 v[4]; float s = 0.f;
#pragma unroll
        for (int j = 0; j < 4; ++j) { v[j] = xr[64 * j]; s += (v[j].x * v[j].x + v[j].y * v[j].y) + (v[j].z * v[j].z + v[j].w * v[j].w); }
        const float rstd = __builtin_amdgcn_rsqf(wave_sum(s) * (1.f / D) + EPS);
#pragma unroll
        for (int j = 0; j < 4; ++j) xr[64 * j] = v[j] * rstd * A[j];
    }
}
__device__ __forceinline__ void ph_dnpre(const bf16* PD, const float* AB, const float* conv_w, const float* a_log, const float* dt_bias,
                                         bf16* DQ, bf16* DK, bf16* DV, float* GB, int S) {
    const int tid_ = pg8::otid(), lane = tid_ & 63, wave = tid_ >> 6;
    const int gw = blockIdx.x * 8 + wave, NGW = gridDim.x * 8;
    for (int t0 = gw * 16; t0 < MH; t0 += NGW * 16) {
        const int s0 = t0 & (S - 1);
        for (int part = 0; part < 3; ++part) {
            const bf16* src = PD + part * 512 + lane * 8;
            bf16* dst = (part == 0 ? DQ : (part == 1 ? DK : DV)) + lane * 8;
            f32x4 w[5][2];
#pragma unroll
            for (int j = 0; j < 5; ++j) { const float* wp = conv_w + j * 1536 + part * 512 + lane * 8; w[j][0] = *(const f32x4*)wp; w[j][1] = *(const f32x4*)(wp + 4); }
            v4u r0, r1, r2, r3, r4;
            const v4u zero = {0u, 0u, 0u, 0u};
#define ROWLD(off) (((unsigned)(s0 + (off)) < (unsigned)S) ? *(const v4u*)(src + (size_t)(t0 + (off)) * 1536) : zero)
            r0 = ROWLD(-2); r1 = ROWLD(-1); r2 = ROWLD(0); r3 = ROWLD(1);
            for (int i = 0; i < 16; ++i) {
                r4 = ROWLD(i + 2);
                f32x4 y0, y1;
#define TAP(rr, j, first) { const f32x4 a = {bflo(rr.x), bfhi(rr.x), bflo(rr.y), bfhi(rr.y)}, b = {bflo(rr.z), bfhi(rr.z), bflo(rr.w), bfhi(rr.w)}; \
                    if (first) { y0 = a * w[j][0]; y1 = b * w[j][1]; } else { y0 += a * w[j][0]; y1 += b * w[j][1]; } }
                TAP(r0, 0, true) TAP(r1, 1, false) TAP(r2, 2, false) TAP(r3, 3, false) TAP(r4, 4, false)
#undef TAP
#pragma unroll
                for (int e = 0; e < 4; ++e) { y0[e] = silu(y0[e]); y1[e] = silu(y1[e]); }
                if (part < 2) {
                    float ss = (y0.x * y0.x + y0.y * y0.y) + (y0.z * y0.z + y0.w * y0.w) + (y1.x * y1.x + y1.y * y1.y) + (y1.z * y1.z + y1.w * y1.w);
                    ss += __shfl_xor(ss, 1); ss += __shfl_xor(ss, 2); ss += __shfl_xor(ss, 4); ss += __shfl_xor(ss, 8);
                    const float scl = __builtin_amdgcn_rsqf(ss + EPS) * (part == 0 ? 0.08838834764831845f : 1.0f);
                    y0 *= scl; y1 *= scl;
                }
                v4u o; o.x = pk2(y0.x, y0.y); o.y = pk2(y0.z, y0.w); o.z = pk2(y1.x, y1.y); o.w = pk2(y1.z, y1.w);
                *(v4u*)(dst + (size_t)(t0 + i) * 512) = o;
                r0 = r1; r1 = r2; r2 = r3; r3 = r4;
            }
#undef ROWLD
        }
#pragma unroll
        for (int jj = 0; jj < 4; ++jj) { const int idx = lane + 64 * jj, tok = t0 + (idx >> 4), c = idx & 15; const float v = AB[(size_t)tok * 16 + c];
            float res;
            if (c < 8) { const float xx = v + dt_bias[c]; const float sp = fmaxf(xx, 0.f) + __logf(1.0f + __expf(-fabsf(xx))); res = -__expf(a_log[c]) * sp; }
            else res = __builtin_amdgcn_rcpf(1.0f + __expf(-v));
            GB[(size_t)tok * 16 + c] = res; }
    }
}
__device__ __forceinline__ void ph_attn(const bf16* P, bf16* OG, float* LSE, int S, int lgS, LAS unsigned char* lds) {
    const int tid = pg8::otid(), lane = tid & 63, wave = tid >> 6, l15 = lane & 15, g = lane >> 4;
    const float one = opaque_one();
    LAS unsigned char* KL = lds; LAS unsigned char* VT = lds + 41472;
    for (int u = blockIdx.x; u < 3 * 8 * 256; u += gridDim.x) {
        const int tb = u & 255, h = (u >> 8) & 7, p = u >> 11;
        const int lgd = 2 * p, L = S >> lgd, nb = L >> 7, bps = S >> 7;
        const int seq = tb >> (lgS - 7), lb = tb & (bps - 1);
        const int r = lb / nb, ib = lb - r * nb, i0 = ib << 7;
        const int seqbase = seq << lgS;
        __syncthreads();
        for (int idx = tid; idx < 288 * 8; idx += 512) {
            const int kl = idx >> 3, pc = idx & 7, ik = i0 - 64 + kl;
            v4u kv = {0u, 0u, 0u, 0u}, vv = kv;
            if (ik >= 0 && ik < L) { const bf16* src = P + (size_t)(seqbase + (ik << lgd) + r) * 1536 + h * 64 + pc * 8; kv = *(const v4u*)(src + 512); vv = *(const v4u*)(src + 1024); }
            *(LAS v4u*)(KL + kl * 144 + pc * 16) = kv;
#pragma unroll
            for (int e = 0; e < 8; ++e) { const unsigned wv = vv[e >> 1]; *(LAS unsigned short*)(VT + (pc * 8 + e) * 592 + kl * 2) = (unsigned short)((e & 1) ? (wv >> 16) : (wv & 0xffffu)); }
        }
        __syncthreads();
        const int iq = i0 + 16 * wave + l15, tokq = seqbase + (iq << lgd) + r;
        bf16x8 qf[2];
#pragma unroll
        for (int ks = 0; ks < 2; ++ks) qf[ks] = *(const bf16x8*)(P + (size_t)tokq * 1536 + h * 64 + 32 * ks + 8 * g);
        f32x4 acc[4];
#pragma unroll
        for (int dt = 0; dt < 4; ++dt) acc[dt] = (f32x4){0.f, 0.f, 0.f, 0.f};
        float m = -1e30f, lsum = 0.f;
        for (int s = 0; s < 5; ++s) {
            const int kl0 = 16 * wave + 32 * s;
            f32x4 c[2];
#pragma unroll
            for (int t = 0; t < 2; ++t) { c[t] = (f32x4){0.f, 0.f, 0.f, 0.f};
#pragma unroll
                for (int ks = 0; ks < 2; ++ks) { const bf16x8 a = *(const LAS bf16x8*)(KL + (kl0 + 16 * t + l15) * 144 + (32 * ks + 8 * g) * 2); c[t] = MFMA16(a, qf[ks], c[t]); } }
            float sc[8]; float mx = -1e30f;
#pragma unroll
            for (int t = 0; t < 2; ++t)
#pragma unroll
                for (int rg = 0; rg < 4; ++rg) { const int ik = i0 - 64 + kl0 + 16 * t + 4 * g + rg, dl = ik - iq;
                    const bool valid = (ik >= 0) && (ik < L) && (dl <= 64) && (dl >= -64);
                    const float sv = valid ? c[t][rg] * 0.18033688011112042f : -1e30f; sc[t * 4 + rg] = sv; mx = fmaxf(mx, sv); }
            mx = fmaxf(mx, __shfl_xor(mx, 16)); mx = fmaxf(mx, __shfl_xor(mx, 32));
            const float mn = fmaxf(m, mx), alpha = __builtin_amdgcn_exp2f(m - mn); m = mn;
            float ps = 0.f; f32x4 p0, p1;
#pragma unroll
            for (int e = 0; e < 4; ++e) { p0[e] = __builtin_amdgcn_exp2f(sc[e] - mn); p1[e] = __builtin_amdgcn_exp2f(sc[4 + e] - mn); ps += p0[e] + p1[e]; }
            lsum = lsum * alpha + ps;
            const bf16x8 pf = pack8(p0 * one, p1 * one);
#pragma unroll
            for (int dt = 0; dt < 4; ++dt) { acc[dt] *= alpha;
                const s16x4 lo = *(const LAS s16x4*)(VT + (16 * dt + l15) * 592 + (kl0 + 4 * g) * 2), hi = *(const LAS s16x4*)(VT + (16 * dt + l15) * 592 + (kl0 + 16 + 4 * g) * 2);
                acc[dt] = MFMA16(CAT8(lo, hi), pf, acc[dt]); }
        }
        lsum += __shfl_xor(lsum, 16); lsum += __shfl_xor(lsum, 32);
        const float inv = 1.0f / lsum;
        bf16* og = OG + ((size_t)p * MH + tokq) * 512 + h * 64 + 4 * g;
#pragma unroll
        for (int dt = 0; dt < 4; ++dt) { v2u w; w.x = pk2(acc[dt][0] * inv, acc[dt][1] * inv); w.y = pk2(acc[dt][2] * inv, acc[dt][3] * inv); *(v2u*)(og + 16 * dt) = w; }
        if (g == 0) LSE[((size_t)p * MH + tokq) * 8 + h] = (m + __log2f(lsum)) * 0.6931471805599453f;
    }
}
__device__ __forceinline__ void ph_chunk(const bf16* DQ, const bf16* DK, const bf16* DV, const float* GB, unsigned char* CH, float* GC, int S, int lgS, LAS unsigned char* lds) {
    const int tid_ = pg8::otid(), lane = tid_ & 63, wave = tid_ >> 6, l15 = lane & 15, g = lane >> 4;
    const float one = opaque_one();
    LAS unsigned char* wl = lds + wave * 18432;
    LAS float* Al = (LAS float*)wl; LAS float* gcs = (LAS float*)(wl + 17408); LAS float* bts = gcs + 64;
    LAS bf16* TP = (LAS bf16*)wl; LAS bf16* TPP = (LAS bf16*)(wl + 8192);
    for (int job = blockIdx.x * 8 + wave; job < 4096; job += gridDim.x * 8) {
        const int dir = job & 1, h = (job >> 1) & 3, cgi = job >> 3, cps = S >> 6;
        const int seq = cgi >> (lgS - 6), n = cgi & (cps - 1), seqbase = seq << lgS;
#define TOK(c) (seqbase + (dir ? (S - 1 - (64 * n + (c))) : (64 * n + (c))))
        {   const int tokc = TOK(lane);
            const float gv = GB[(size_t)tokc * 16 + dir * 4 + h], bv = GB[(size_t)tokc * 16 + 8 + dir * 4 + h];
            float cs = gv;
#pragma unroll
            for (int o = 1; o < 64; o <<= 1) { const float t = __shfl_up(cs, o); if (lane >= o) cs += t; }
            gcs[lane] = cs; bts[lane] = bv; GC[(size_t)job * 64 + lane] = cs; }
        LDS_WAIT();
        bf16x8 kf[4][4];
#pragma unroll
        for (int t = 0; t < 4; ++t)
#pragma unroll
            for (int ks = 0; ks < 4; ++ks) kf[t][ks] = *(const bf16x8*)(DK + (size_t)TOK(16 * t + l15) * 512 + h * 128 + 32 * ks + 8 * g);
#pragma unroll
        for (int it = 0; it < 4; ++it) { const int i = 16 * it + l15; const float gi = gcs[i], bi = bts[i];
#pragma unroll
            for (int jt = 0; jt <= it; ++jt) { f32x4 c = {0.f, 0.f, 0.f, 0.f};
#pragma unroll
                for (int ks = 0; ks < 4; ++ks) c = MFMA16(kf[jt][ks], kf[it][ks], c);
                const f32x4 gj = *(const LAS f32x4*)(gcs + 16 * jt + 4 * g); f32x4 o;
#pragma unroll
                for (int rg = 0; rg < 4; ++rg) { const int j = 16 * jt + 4 * g + rg; o[rg] = (j < i) ? bi * c[rg] * __expf(gi - gj[rg]) : 0.f; }
                *(LAS f32x4*)(Al + i * 68 + 16 * jt + 4 * g) = o; } }
        unsigned char* chb = CH + (size_t)job * CHJOB;
        bf16* UT = (bf16*)chb; bf16* Wm = (bf16*)(chb + 16384); bf16* KT = (bf16*)(chb + 32768); bf16* QK = (bf16*)(chb + 49152);
#pragma unroll
        for (int it = 0; it < 4; ++it) { const int i = 16 * it + l15; const float gi = gcs[i];
            bf16x8 qfr[4];
#pragma unroll
            for (int ks = 0; ks < 4; ++ks) qfr[ks] = *(const bf16x8*)(DQ + (size_t)TOK(i) * 512 + h * 128 + 32 * ks + 8 * g);
#pragma unroll
            for (int jt = 0; jt < 4; ++jt) { v2u out = {0u, 0u};
                if (jt <= it) { f32x4 c = {0.f, 0.f, 0.f, 0.f};
#pragma unroll
                    for (int ks = 0; ks < 4; ++ks) c = MFMA16(kf[jt][ks], qfr[ks], c);
                    const f32x4 gj = *(const LAS f32x4*)(gcs + 16 * jt + 4 * g); f32x4 o;
#pragma unroll
                    for (int rg = 0; rg < 4; ++rg) { const int j = 16 * jt + 4 * g + rg; o[rg] = (j <= i) ? c[rg] * __expf(gi - gj[rg]) : 0.f; }
                    out.x = pk2(o[0], o[1]); out.y = pk2(o[2], o[3]); }
                *(v2u*)(QK + i * 64 + 16 * jt + 4 * g) = out; } }
        LDS_WAIT();
        float t[64];
#pragma unroll
        for (int i = 0; i < 64; ++i) { float a0 = 0.f, a1 = 0.f, a2 = 0.f, a3 = 0.f;
#pragma unroll
            for (int j4 = 0; j4 * 4 < i; ++j4) { const f32x4 a = *(const LAS f32x4*)(Al + i * 68 + 4 * j4);
                if (4 * j4 + 0 < i) a0 += a[0] * t[4 * j4 + 0];
                if (4 * j4 + 1 < i) a1 += a[1] * t[4 * j4 + 1];
                if (4 * j4 + 2 < i) a2 += a[2] * t[4 * j4 + 2];
                if (4 * j4 + 3 < i) a3 += a[3] * t[4 * j4 + 3]; }
            t[i] = ((lane == i) ? 1.f : 0.f) - ((a0 + a1) + (a2 + a3)); }
        const float bc = bts[lane], ec = bc * __expf(gcs[lane]);
        LDS_WAIT();
#pragma unroll
        for (int i = 0; i < 64; ++i) { const unsigned w = pk2(t[i] * bc, t[i] * ec); TP[i * 64 + lane] = (bf16)(w & 0xffffu); TPP[i * 64 + lane] = (bf16)(w >> 16); }
        LDS_WAIT();
        bf16x8 tf[4][2];
#pragma unroll
        for (int mt = 0; mt < 4; ++mt)
#pragma unroll
            for (int ks = 0; ks < 2; ++ks) tf[mt][ks] = *(const LAS bf16x8*)(TP + (16 * mt + l15) * 64 + 32 * ks + 8 * g);
        for (int nt = 0; nt < 8; ++nt) {
            bf16x8 vf[2];
#pragma unroll
            for (int ks = 0; ks < 2; ++ks)
#pragma unroll
                for (int e = 0; e < 8; ++e) vf[ks][e] = (short)DV[(size_t)TOK(32 * ks + 8 * g + e) * 512 + h * 128 + 16 * nt + l15];
#pragma unroll
            for (int mt = 0; mt < 4; ++mt) { f32x4 c = {0.f, 0.f, 0.f, 0.f};
#pragma unroll
                for (int ks = 0; ks < 2; ++ks) c = MFMA16(tf[mt][ks], vf[ks], c);
                c *= one;
                v2u w; w.x = pk2(c[0], c[1]); w.y = pk2(c[2], c[3]); *(v2u*)(UT + (16 * nt + l15) * 64 + 16 * mt + 4 * g) = w; }
        }
#pragma unroll
        for (int mt = 0; mt < 4; ++mt)
#pragma unroll
            for (int ks = 0; ks < 2; ++ks) tf[mt][ks] = *(const LAS bf16x8*)(TPP + (16 * mt + l15) * 64 + 32 * ks + 8 * g);
        for (int dt = 0; dt < 8; ++dt) {
            bf16x8 kt[2];
#pragma unroll
            for (int ks = 0; ks < 2; ++ks) {
#pragma unroll
                for (int e = 0; e < 8; ++e) kt[ks][e] = (short)DK[(size_t)TOK(32 * ks + 8 * g + e) * 512 + h * 128 + 16 * dt + l15];
                *(bf16x8*)(KT + (16 * dt + l15) * 64 + 32 * ks + 8 * g) = kt[ks]; }
#pragma unroll
            for (int mt = 0; mt < 4; ++mt) { f32x4 c = {0.f, 0.f, 0.f, 0.f};
#pragma unroll
                for (int ks = 0; ks < 2; ++ks) c = MFMA16(kt[ks], tf[mt][ks], c);
                c *= one;
                v2u w; w.x = pk2(c[0], c[1]); w.y = pk2(c[2], c[3]); *(v2u*)(Wm + (16 * mt + l15) * 128 + 16 * dt + 4 * g) = w; }
        }
        LDS_WAIT();
    }
}
#define TOKN(c, nn) (seqbase + (dir ? (S - 1 - (64 * (nn) + (c))) : (64 * (nn) + (c))))
constexpr int SC_PW = 288, SC_PK = 160;
constexpr int SC_W = 0, SC_Q = 64 * SC_PW, SC_QK = 2 * 64 * SC_PW, SC_KT = SC_QK + 64 * SC_PK, SC_GC = SC_KT + 128 * SC_PK, SC_BUF = SC_GC + 256;
static_assert(2 * SC_BUF + 4 * 5120 <= LDS_BYTES - 256, "scan LDS image");
__device__ __forceinline__ void ph_scan(const bf16* DQ, const unsigned char* CH, const float* GC, bf16* OF, bf16* OB, int S, int lgS, int half, LAS unsigned char* lds) {
    const int wave = __builtin_amdgcn_readfirstlane(pg8::otid() >> 6);
    const float one = opaque_one();
#define SC_BAR() do { asm volatile("s_waitcnt lgkmcnt(0)" ::: "memory"); __builtin_amdgcn_s_barrier(); asm volatile("" ::: "memory"); } while (0)
    const int nchain = half ? 32 : 64, cps = S >> 6;
    for (int chain = blockIdx.x; chain < nchain; chain += gridDim.x) {
        const int dir = chain & 1, h = (chain >> 1) & 3, seq = chain >> 3, seqbase = seq << lgS;
        __syncthreads();
        if (wave >= 4) {
            const int lt = pg8::otid() - 256;
            const int wr0 = lt >> 4, wc = lt & 15, kr0 = lt >> 3, kc = lt & 7;
            v4u rwA[4], rqA[4], rkA[2], rtA[4], rwB[4], rqB[4], rkB[2], rtB[4]; f32x4 rgA = {0.f, 0.f, 0.f, 0.f}, rgB = rgA;
#define SC_LD(rw, rq, rk, rt, rg, n_) do { const int nn_ = (n_); const int job = ((seq * cps + nn_) << 3) | (h << 1) | dir; const unsigned char* chb = CH + (size_t)job * CHJOB; \
                const bf16* Wm_ = (const bf16*)(chb + 16384); const bf16* KT_ = (const bf16*)(chb + 32768); const bf16* QK_ = (const bf16*)(chb + 49152); \
                _Pragma("unroll") for (int k = 0; k < 4; ++k) { rw[k] = *(const v4u*)(Wm_ + (wr0 + 16 * k) * 128 + wc * 8); rq[k] = *(const v4u*)(DQ + (size_t)TOKN(wr0 + 16 * k, nn_) * 512 + h * 128 + wc * 8); rt[k] = *(const v4u*)(KT_ + (kr0 + 32 * k) * 64 + kc * 8); } \
                _Pragma("unroll") for (int k = 0; k < 2; ++k) rk[k] = *(const v4u*)(QK_ + (kr0 + 32 * k) * 64 + kc * 8); \
                if (lt < 16) rg = *(const f32x4*)(GC + (size_t)job * 64 + 4 * lt); } while (0)
#define SC_ST(rw, rq, rk, rt, rg, n_) do { LAS unsigned char* b_ = lds + ((n_) & 1) * SC_BUF; \
                _Pragma("unroll") for (int k = 0; k < 4; ++k) { *(LAS v4u*)(b_ + SC_W + (wr0 + 16 * k) * SC_PW + wc * 16) = rw[k]; *(LAS v4u*)(b_ + SC_Q + (wr0 + 16 * k) * SC_PW + wc * 16) = rq[k]; *(LAS v4u*)(b_ + SC_KT + (kr0 + 32 * k) * SC_PK + kc * 16) = rt[k]; } \
                _Pragma("unroll") for (int k = 0; k < 2; ++k) *(LAS v4u*)(b_ + SC_QK + (kr0 + 32 * k) * SC_PK + kc * 16) = rk[k]; \
                if (lt < 16) *(LAS f32x4*)(b_ + SC_GC + 16 * lt) = rg; } while (0)
            SC_LD(rwA, rqA, rkA, rtA, rgA, 0);
            for (int n = 0; n < cps; n += 2) {
                SC_LD(rwB, rqB, rkB, rtB, rgB, n + 1);
                SC_ST(rwA, rqA, rkA, rtA, rgA, n);
                SC_BAR();
                if (n + 2 < cps) SC_LD(rwA, rqA, rkA, rtA, rgA, n + 2);
                SC_ST(rwB, rqB, rkB, rtB, rgB, n + 1);
                SC_BAR();
            }
#undef SC_LD
#undef SC_ST
            SC_BAR();
        } else {
            const int tidc = pg8::otid(), lane = tidc & 63, l15 = lane & 15, g = lane >> 4;
            const int dv0 = wave * 32;
            LAS unsigned char* ost = lds + 2 * SC_BUF + wave * 5120;
            bf16* OX = dir ? OB : OF;
            f32x4 St[8][2];
#pragma unroll
            for (int t = 0; t < 8; ++t) { St[t][0] = (f32x4){0.f, 0.f, 0.f, 0.f}; St[t][1] = St[t][0]; }
            v2u utA[4][2];
#define SC_UT(UT__, n_) do { const int jb_ = ((seq * cps + (n_)) << 3) | (h << 1) | dir; const bf16* UT_ = (const bf16*)(CH + (size_t)jb_ * CHJOB); \
                _Pragma("unroll") for (int mt = 0; mt < 4; ++mt) _Pragma("unroll") for (int nt = 0; nt < 2; ++nt) UT__[mt][nt] = *(const v2u*)(UT_ + (dv0 + 16 * nt + l15) * 64 + 16 * mt + 4 * g); } while (0)
            SC_UT(utA, 0);
            SC_BAR();
#define SC_FRAG(p_) CAT8(*(const LAS s16x4*)(p_), *(const LAS s16x4*)((p_) + 32))
            for (int n = 0; n < cps; ++n) {
                const LAS unsigned char* buf = lds + (n & 1) * SC_BUF;
                const LAS float* gcl = (const LAS float*)(buf + SC_GC);
                const float glast = gcl[63];
                bf16x8 sb[4][2];
#pragma unroll
                for (int ks = 0; ks < 4; ++ks)
#pragma unroll
                    for (int nt = 0; nt < 2; ++nt) sb[ks][nt] = pack8(St[2 * ks][nt] * one, St[2 * ks + 1][nt] * one);
                f32x4 vnew[4][2];
#pragma unroll
                for (int mt = 0; mt < 4; ++mt) { const LAS unsigned char* wrow = buf + SC_W + (16 * mt + l15) * SC_PW + 8 * g;
                    bf16x8 wf[4];
#pragma unroll
                    for (int ks = 0; ks < 4; ++ks) wf[ks] = SC_FRAG(wrow + 64 * ks);
                    __builtin_amdgcn_sched_barrier(0);
                    f32x4 ws0 = {0.f, 0.f, 0.f, 0.f}, ws1 = ws0;
#pragma unroll
                    for (int ks = 0; ks < 4; ++ks) { ws0 = MFMA16(wf[ks], sb[ks][0], ws0); ws1 = MFMA16(wf[ks], sb[ks][1], ws1); }
                    vnew[mt][0] = (f32x4){bflo(utA[mt][0].x), bfhi(utA[mt][0].x), bflo(utA[mt][0].y), bfhi(utA[mt][0].y)} - ws0;
                    vnew[mt][1] = (f32x4){bflo(utA[mt][1].x), bfhi(utA[mt][1].x), bflo(utA[mt][1].y), bfhi(utA[mt][1].y)} - ws1;
                    __builtin_amdgcn_sched_barrier(0);
                }
                if (n + 1 < cps) SC_UT(utA, n + 1);
                bf16x8 vb[2][2], vbs[2][2];
#pragma unroll
                for (int k2 = 0; k2 < 2; ++k2)
#pragma unroll
                    for (int nt = 0; nt < 2; ++nt) vb[k2][nt] = pack8(vnew[2 * k2][nt], vnew[2 * k2 + 1][nt]);
#pragma unroll
                for (int mt = 0; mt < 4; ++mt) { const LAS unsigned char* qrow = buf + SC_Q + (16 * mt + l15) * SC_PW + 8 * g; const LAS unsigned char* qkrow = buf + SC_QK + (16 * mt + l15) * SC_PK + 8 * g;
                    bf16x8 qf[4], kf2[2];
#pragma unroll
                    for (int ks = 0; ks < 4; ++ks) qf[ks] = SC_FRAG(qrow + 64 * ks);
#pragma unroll
                    for (int k2 = 0; k2 < 2; ++k2) kf2[k2] = SC_FRAG(qkrow + 64 * k2);
                    const f32x4 gv = *(const LAS f32x4*)(gcl + 16 * mt + 4 * g);
                    __builtin_amdgcn_sched_barrier(0);
                    f32x4 o0 = {0.f, 0.f, 0.f, 0.f}, o1 = o0;
#pragma unroll
                    for (int ks = 0; ks < 4; ++ks) { o0 = MFMA16(qf[ks], sb[ks][0], o0); o1 = MFMA16(qf[ks], sb[ks][1], o1); }
#pragma unroll
                    for (int rg = 0; rg < 4; ++rg) { const float e = __expf(gv[rg]); o0[rg] *= e; o1[rg] *= e; }
#pragma unroll
                    for (int k2 = 0; k2 < 2; ++k2) { o0 = MFMA16(kf2[k2], vb[k2][0], o0); o1 = MFMA16(kf2[k2], vb[k2][1], o1); }
#pragma unroll
                    for (int rg = 0; rg < 4; ++rg) { LAS bf16* osp = (LAS bf16*)(ost + (16 * mt + 4 * g + rg) * 80) + l15;
                        osp[0] = (bf16)(pk2(o0[rg] * one, 0.f) & 0xffffu); osp[16] = (bf16)(pk2(o1[rg] * one, 0.f) & 0xffffu); }
                    __builtin_amdgcn_sched_barrier(0); }
                const float eg = __expf(glast);
#pragma unroll
                for (int mt = 0; mt < 4; ++mt) { const f32x4 gv = *(const LAS f32x4*)(gcl + 16 * mt + 4 * g);
#pragma unroll
                    for (int rg = 0; rg < 4; ++rg) { const float f = __expf(glast - gv[rg]); vnew[mt][0][rg] *= f; vnew[mt][1][rg] *= f; } }
#pragma unroll
                for (int k2 = 0; k2 < 2; ++k2)
#pragma unroll
                    for (int nt = 0; nt < 2; ++nt) vbs[k2][nt] = pack8(vnew[2 * k2][nt], vnew[2 * k2 + 1][nt]);
#pragma unroll
                for (int tp = 0; tp < 4; ++tp) { bf16x8 kt4[2][2];
#pragma unroll
                    for (int tt = 0; tt < 2; ++tt) { const LAS unsigned char* ktrow = buf + SC_KT + (16 * (2 * tp + tt) + l15) * SC_PK + 8 * g; kt4[tt][0] = SC_FRAG(ktrow); kt4[tt][1] = SC_FRAG(ktrow + 64); }
                    __builtin_amdgcn_sched_barrier(0);
#pragma unroll
                    for (int tt = 0; tt < 2; ++tt) { const int t = 2 * tp + tt; St[t][0] *= eg; St[t][1] *= eg;
#pragma unroll
                        for (int k2 = 0; k2 < 2; ++k2) { St[t][0] = MFMA16(kt4[tt][k2], vbs[k2][0], St[t][0]); St[t][1] = MFMA16(kt4[tt][k2], vbs[k2][1], St[t][1]); } }
                    __builtin_amdgcn_sched_barrier(0); }
                asm volatile("s_waitcnt lgkmcnt(0)" ::: "memory");
#pragma unroll
                for (int j = 0; j < 4; ++j) { const int c_ = (lane >> 2) + 16 * j; const v4u ov = *(const LAS v4u*)(ost + c_ * 80 + (lane & 3) * 16);
                    *(v4u*)(OX + (size_t)TOKN(c_, n) * 512 + h * 128 + dv0 + (lane & 3) * 8) = ov; }
                SC_BAR();
            }
#undef SC_FRAG
#undef SC_UT
        }
    }
#undef SC_BAR
#undef TOKN
#undef TOK
}
__device__ __forceinline__ void ph_post(const bf16* OG, const float* LSE, const bf16* OF, const bf16* OB, const bf16* Z, const float* dn_norm, bf16* MIX) {
    const int tid_ = pg8::otid(), lane = tid_ & 63, wave = tid_ >> 6;
    const int gw = blockIdx.x * 8 + wave, NGW = gridDim.x * 8;
    f32x4 nw0 = *(const f32x4*)(dn_norm + (lane & 15) * 8), nw1 = *(const f32x4*)(dn_norm + (lane & 15) * 8 + 4);
    for (int t = gw; t < MH; t += NGW) {
        {   const int hd = lane >> 3;
            const float l0 = LSE[((size_t)0 * MH + t) * 8 + hd], l1 = LSE[((size_t)1 * MH + t) * 8 + hd], l2 = LSE[((size_t)2 * MH + t) * 8 + hd];
            const float mx = fmaxf(l0, fmaxf(l1, l2));
            float w0 = __expf(l0 - mx), w1 = __expf(l1 - mx), w2 = __expf(l2 - mx); const float inv = 1.0f / (w0 + w1 + w2); w0 *= inv; w1 *= inv; w2 *= inv;
            const v4u a = *(const v4u*)(OG + ((size_t)0 * MH + t) * 512 + lane * 8), b = *(const v4u*)(OG + ((size_t)1 * MH + t) * 512 + lane * 8), c = *(const v4u*)(OG + ((size_t)2 * MH + t) * 512 + lane * 8);
            v4u o;
#pragma unroll
            for (int e = 0; e < 4; ++e) o[e] = pk2(w0 * bflo(a[e]) + w1 * bflo(b[e]) + w2 * bflo(c[e]), w0 * bfhi(a[e]) + w1 * bfhi(b[e]) + w2 * bfhi(c[e]));
            *(v4u*)(MIX + (size_t)t * 1024 + lane * 8) = o; }
        {   const v4u a = *(const v4u*)(OF + (size_t)t * 512 + lane * 8), b = *(const v4u*)(OB + (size_t)t * 512 + lane * 8), z = *(const v4u*)(Z + (size_t)t * 512 + lane * 8);
            float ov[8]; float ss = 0.f;
#pragma unroll
            for (int e = 0; e < 4; ++e) { ov[2 * e] = bflo(a[e]) + bflo(b[e]); ov[2 * e + 1] = bfhi(a[e]) + bfhi(b[e]); ss += ov[2 * e] * ov[2 * e] + ov[2 * e + 1] * ov[2 * e + 1]; }
            ss += __shfl_xor(ss, 1); ss += __shfl_xor(ss, 2); ss += __shfl_xor(ss, 4); ss += __shfl_xor(ss, 8);
            const float rs = __builtin_amdgcn_rsqf(ss * (1.0f / 128.0f) + EPS);
            v4u o;
#pragma unroll
            for (int e = 0; e < 4; ++e) { const float n0 = (e < 2) ? nw0[2 * e] : nw1[2 * e - 4], n1 = (e < 2) ? nw0[2 * e + 1] : nw1[2 * e - 3];
                o[e] = pk2(ov[2 * e] * rs * n0 * silu(bflo(z[e])), ov[2 * e + 1] * rs * n1 * silu(bfhi(z[e]))); }
            *(v4u*)(MIX + (size_t)t * 1024 + 512 + lane * 8) = o; }
    }
}
#define XB_TMO      128
#define XB_XCNT(j)  (256  + 64 * (j))
#define XB_XSUB(j)  (1280 + 64 * (j))
#define XB_XGEN(j)  (2304 + 64 * (j))
#define XB_TOP      3328
#define XB_TOPGEN   3392
#define XCD_BAR_WORDS 3456
#define XB_SPIN_CAP (1u << 18)

__device__ __forceinline__ unsigned xb_ld(unsigned* p)              { return __hip_atomic_load(p, __ATOMIC_RELAXED, __HIP_MEMORY_SCOPE_AGENT); }
__device__ __forceinline__ unsigned xb_add(unsigned* p, unsigned v) { return __hip_atomic_fetch_add(p, v, __ATOMIC_RELAXED, __HIP_MEMORY_SCOPE_AGENT); }
__device__ __forceinline__ unsigned xb_xcc_id() { return (unsigned)__builtin_amdgcn_s_getreg((3 << 11) | 20) & 0xFu; }
#define XB_SPIN(cond, bar) do { unsigned _sp = 0; while (cond) { __builtin_amdgcn_s_sleep(1); \
    if ((++_sp & 255u) == 0u) { if (xb_ld(&(bar)[XB_TMO])) break; if (_sp > XB_SPIN_CAP) { atomicAdd(&(bar)[XB_TMO], 1u); break; } } } } while (0)

struct XcdBarrier {
    unsigned* bar; unsigned x;
    volatile LAS unsigned* st;
};

__device__ __forceinline__ XcdBarrier xcd_barrier_post(unsigned* bar, volatile LAS unsigned* st) {
    XcdBarrier b; b.bar = bar; b.x = xb_xcc_id(); b.st = st;
    if (threadIdx.x == 0) (void)xb_add(&bar[XB_XCNT(b.x)], 1u);
    return b;
}
__device__ __forceinline__ void xcd_barrier_complete(unsigned* bar, unsigned x, unsigned& nloc, unsigned& nx) {
    const unsigned G = gridDim.x * gridDim.y * gridDim.z;
    unsigned sum, cnt, mine, sp = 0u;
    for (;;) {
        sum = 0u; cnt = 0u; mine = 0u;
#pragma unroll
        for (unsigned j = 0; j < 16; ++j) { const unsigned c = xb_ld(&bar[XB_XCNT(j)]); sum += c; cnt += (c > 0u) ? 1u : 0u; mine = (j == x) ? c : mine; }
        if (sum == G) break;
        __builtin_amdgcn_s_sleep(1);
        if ((++sp & 255u) == 0u) { if (xb_ld(&bar[XB_TMO])) break; if (sp > XB_SPIN_CAP) { atomicAdd(&bar[XB_TMO], 1u); break; } }
    }
    nloc = mine > 0u ? mine : 1u; nx = cnt > 0u ? cnt : 1u;
}

__device__ __forceinline__ void xcd_barrier(const XcdBarrier& b) {
    asm volatile("s_waitcnt vmcnt(0)" ::: "memory");
    __syncthreads();
    if (threadIdx.x == 0) {
        unsigned* bar = b.bar;
        __builtin_amdgcn_s_waitcnt(0);
        unsigned nloc = b.st[0], nx = b.st[1];
        if (nloc == 0u) { xcd_barrier_complete(bar, b.x, nloc, nx); b.st[0] = nloc; b.st[1] = nx; }
        const unsigned old = xb_add(&bar[XB_XSUB(b.x)], 1u);
        const unsigned gen = old / nloc;
        if (old + 1u == (gen + 1u) * nloc) {
            __builtin_amdgcn_fence(__ATOMIC_RELEASE, "agent");
            asm volatile("s_waitcnt vmcnt(0)" ::: "memory");
            const unsigned og = xb_add(&bar[XB_TOP], 1u);
            const unsigned tg = og / nx;
            if (og + 1u == (tg + 1u) * nx) xb_add(&bar[XB_TOPGEN], 1u);
            else XB_SPIN(xb_ld(&bar[XB_TOPGEN]) == tg, bar);
            __builtin_amdgcn_fence(__ATOMIC_ACQUIRE, "agent");
            xb_add(&bar[XB_XGEN(b.x)], 1u);
            asm volatile("s_waitcnt vmcnt(0)" ::: "memory");
        } else {
            XB_SPIN(xb_ld(&bar[XB_XGEN(b.x)]) == gen, bar);
            __builtin_amdgcn_fence(__ATOMIC_ACQUIRE, "agent");
            asm volatile("s_waitcnt vmcnt(0)" ::: "memory");
        }
    }
    __syncthreads();
}

#ifndef DBG_SKIP_MIXER
#define DBG_SKIP_MIXER 0
#endif
#ifndef MK_MULTI
#define MK_MULTI 0
#endif
constexpr int NPH = 1 + 2 * (2 * 14) + 1 + 1;
static_assert(pg8::EpiProj::OFF_PA == WS_PA && pg8::EpiProj::OFF_PD == WS_PD && pg8::EpiProj::OFF_Z == WS_Z, "EpiProj offsets");
struct Args { const float* in[22]; float* out; unsigned char* ws; int lo, hi; };

__global__ void __launch_bounds__(512, 2) fwd(Args a) {
    extern __shared__ __attribute__((aligned(16))) unsigned char lds_raw[];
    LAS unsigned char* lds = (LAS unsigned char*)lds_raw;
    cg::grid_group grid = cg::this_grid();
    unsigned char* ws = a.ws;
    const int lo = a.lo, hi = a.hi; int pc = 0;
    const float* x_prompt = a.in[0]; const float* x_sample = a.in[1];
    float* MOD = (float*)(ws + WS_MOD); float* ROPE = (float*)(ws + WS_ROPE);
    bf16* H = (bf16*)(ws + WS_H); bf16* ACT = (bf16*)(ws + WS_ACT); bf16* PA = (bf16*)(ws + WS_PA); bf16* PD = (bf16*)(ws + WS_PD); bf16* Zb = (bf16*)(ws + WS_Z);
    bf16* DQ = (bf16*)(ws + WS_DQ); bf16* DK = (bf16*)(ws + WS_DK); bf16* DV = (bf16*)(ws + WS_DV); bf16* OF = (bf16*)(ws + WS_OF); bf16* OB = (bf16*)(ws + WS_OB);
    unsigned char* CH = ws + WS_CH; bf16* OG = (bf16*)(ws + WS_OG); float* LSE = (float*)(ws + WS_LSE); bf16* MIX = (bf16*)(ws + WS_MIX);
    float* AB = (float*)(ws + WS_AB); float* GB = (float*)(ws + WS_GB); float* GC = (float*)(ws + WS_GC);
#define PH_BEGIN if (pc >= lo && pc < hi) {
    { volatile LAS unsigned* st = (volatile LAS unsigned*)(lds + LDS_BYTES - 256); if (pg8::otid() < 2) st[pg8::otid()] = 0u; }
    __syncthreads();
    XcdBarrier bar = xcd_barrier_post((unsigned*)ws, (volatile LAS unsigned*)(lds + LDS_BYTES - 256));
#define PH_END } ++pc; if (pc > lo && pc < hi) { if (pc == 1) grid.sync(); else xcd_barrier(bar); }

    PH_BEGIN
        ph_mod(a.in[2], a.in[3], a.in[4], a.in[5], MOD, lds);
        ph_rope(ROPE);
        ph_wconv(a.in[7], a.in[8], a.in[9], a.in[18], a.in[19], a.in[20], a.in[11], a.in[16], 0, ws, lds);
    PH_END
    for (int layer = 0; layer < 2; ++layer) {
        if (layer == 1) {
            PH_BEGIN ph_wconv(a.in[7], a.in[8], a.in[9], a.in[18], a.in[19], a.in[20], a.in[11], a.in[16], 1, ws, lds); PH_END
        }
        const float* modl = MOD + (size_t)layer * 12 * 9216;
        for (int half = 0; half < 2; ++half) {
            const int S = half ? 8192 : 4096, lgS = half ? 13 : 12;
            float* X = a.out + (size_t)half * MH * D;
            const float* xin0 = half ? x_sample : x_prompt;
            for (int sb = 0; sb < 3; ++sb) {
                if (DBG_SKIP_MIXER && sb == 1) continue;
                const bool first = (layer == 0 && sb == 0);
                const float* xsrc = first ? xin0 : X;
                const float* nw = (sb == 0 ? a.in[6] : (sb == 1 ? a.in[10] : a.in[17])) + layer * D;
                PH_BEGIN ph_norm(xsrc, nw, modl, sb, half, H); PH_END
                if (sb != 1) {
                    PH_BEGIN
                        pg8::Gemm g{H, (const bf16*)(ws + (sb ? WS_WGU2 : WS_WGU1)), MH, 2 * FF, D}; pg8::StaticOrder So; So.init(MH, 2 * FF, gridDim.x, (int)blockIdx.x);
                        pg8::EpiSwiGLU E{ACT, FF};
                        pg8::gemm_phase<pg8::EpiSwiGLU, pg8::StaticOrder, true, true>(lds, g, So, E);
                    PH_END
                    PH_BEGIN
                        pg8::Gemm g{ACT, (const bf16*)(ws + (sb ? WS_WD2 : WS_WD1)), MH, D, FF}; pg8::StaticOrder So; So.init(MH, D, gridDim.x, (int)blockIdx.x);
                        pg8::EpiResid E{xsrc, X, modl + (3 * sb + 2) * 1024, 0.5f, half};
                        pg8::gemm_phase<pg8::EpiResid, pg8::StaticOrder, true, true>(lds, g, So, E);
                    PH_END
                } else {
                    PH_BEGIN
                        pg8::Gemm g{H, (const bf16*)(ws + WS_WIN), MH, NPROJ, D}; pg8::StaticOrder So; So.init(MH, NPROJ, gridDim.x, (int)blockIdx.x);
                        pg8::EpiProj E{ws, AB, ROPE, S - 1};
                        pg8::gemm_phase<pg8::EpiProj, pg8::StaticOrder, true, true>(lds, g, So, E);
                    PH_END
                    PH_BEGIN ph_dnpre(PD, AB, a.in[12] + (size_t)layer * 5 * 1536, a.in[13] + layer * 8, a.in[14] + layer * 8, DQ, DK, DV, GB, S); PH_END
                    PH_BEGIN ph_chunk(DQ, DK, DV, GB, CH, GC, S, lgS, lds); PH_END
                    PH_BEGIN ph_scan(DQ, CH, GC, OF, OB, S, lgS, half, lds); PH_END
                    PH_BEGIN ph_attn(PA, OG, LSE, S, lgS, lds); PH_END
                    PH_BEGIN ph_post(OG, LSE, OF, OB, Zb, a.in[15] + layer * 128, MIX); PH_END
                    PH_BEGIN
                        pg8::Gemm g{MIX, (const bf16*)(ws + WS_WOUT), MH, D, D}; pg8::StaticOrder So; So.init(MH, D, gridDim.x, (int)blockIdx.x);
                        pg8::EpiResid E{X, X, modl + 5 * 1024, 1.0f, half};
                        pg8::gemm_phase<pg8::EpiResid, pg8::StaticOrder, true, true>(lds, g, So, E);
                    PH_END
                }
            }
        }
    }
    PH_BEGIN ph_final(a.out, a.in[21]); PH_END
}

extern "C" void kernel_launch(void* const* d_in, const int* in_sizes, int n_in, void* d_out, int out_size, void* d_ws, size_t ws_size, hipStream_t stream) {
    static int grid = 0;
    if (grid == 0) {
        if (n_in != 22 || ws_size < WS_END) { fprintf(stderr, "kernel_launch: unexpected n_in %d / ws_size %zu\n", n_in, ws_size); grid = -1; return; }
        int dev = 0, cus = 0, per_cu = 0;
        hipGetDevice(&dev); hipDeviceGetAttribute(&cus, hipDeviceAttributeMultiprocessorCount, dev);
        if (hipFuncSetAttribute((const void*)fwd, hipFuncAttributeMaxDynamicSharedMemorySize, LDS_BYTES) != hipSuccess) { fprintf(stderr, "kernel_launch: hipFuncSetAttribute failed\n"); grid = -1; return; }
        if (hipOccupancyMaxActiveBlocksPerMultiprocessor(&per_cu, (const void*)fwd, 512, LDS_BYTES) != hipSuccess || per_cu < 1) { per_cu = 1; (void)hipGetLastError(); }
        grid = cus * per_cu;
        fprintf(stderr, "kernel_launch: grid %d (cus %d x %d), ws %zu MiB\n", grid, cus, per_cu, ws_size >> 20);
    }
    if (grid < 0) return;
    if (hipMemsetAsync(d_ws, 0, 16384, stream) != hipSuccess) { fprintf(stderr, "kernel_launch: memset failed\n"); return; }
    Args a{};
    for (int i = 0; i < 22; ++i) a.in[i] = (const float*)d_in[i];
    a.out = (float*)d_out; a.ws = (unsigned char*)d_ws;
#if MK_MULTI
    for (int p = 0; p < NPH; ++p) { a.lo = p; a.hi = p + 1; hipLaunchKernelGGL(fwd, dim3(grid), dim3(512), LDS_BYTES, stream, a); }
#else
    a.lo = 0; a.hi = NPH;
    void* args[] = {&a};
    hipError_t e = hipLaunchCooperativeKernel((const void*)fwd, dim3(grid), dim3(512), args, LDS_BYTES, stream);
    if (e != hipSuccess) fprintf(stderr, "cooperative launch failed: %s (grid %d)\n", hipGetErrorString(e), grid);
#endif
}
```

```cpp
#include <hip/hip_runtime.h>
#include <hip/hip_cooperative_groups.h>
#include <cstdio>
#include <cstdint>
namespace cg = cooperative_groups;
namespace pg8 {
#define PG8_LAS __attribute__((address_space(3)))
typedef unsigned short bf16_t;
typedef short bf16x8 __attribute__((ext_vector_type(8)));
typedef float f32x4 __attribute__((ext_vector_type(4)));
typedef unsigned u32x4 __attribute__((ext_vector_type(4)));
constexpr int BM = 256, BK = 64, HALF = 128, HTB = HALF * BK * 2  , STAGE_BYTES = 8 * HTB, NXCD = 8, WGM = 8;

__host__ __device__ __forceinline__ int lds_byte(int r, int c) { const int st = (r >> 4) * 2 + (c >> 5), rr = r & 15, cc = c & 31, ob = rr * 64 + cc * 2; return st * 1024 + (ob ^ (((ob >> 9) & 1) << 5)); }
__host__ __device__ __forceinline__ void stage_rc(int b, int& R, int& C) { const int st = b / 1024, sb = b % 1024, swz = sb ^ (((sb >> 9) & 1) << 5); R = (st >> 1) * 16 + swz / 64; C = (st & 1) * 32 + (swz % 64) / 2; }
__host__ __device__ __forceinline__ int perm32(int rho) { const int n = rho >> 4, i = rho & 15; return 8 * (i >> 2) + 4 * n + (i & 3); }

struct Unit { int pm, pn; };
struct Gemm { const bf16_t* A; const bf16_t* Bt; int M, N, K; };

struct StaticOrder {
    int nM, nN, nwg, G, c;
    __host__ __device__ void init(int M, int N, int G_, int c_) { nM = M / BM; nN = N / BM; nwg = nM * nN; G = G_; c = c_; }
    __host__ __device__ bool next(int i, Unit& u) const {
        const long L = (long)i * G + c; if (L >= nwg) return false;
        int wgid = (int)L; { const int q = nwg / NXCD, r = nwg % NXCD, xcd = wgid % NXCD, off = wgid / NXCD; wgid = (xcd < r ? xcd * (q + 1) : r * (q + 1) + (xcd - r) * q) + off; }
        const int nig = WGM * nN, gid = wgid / nig, fm = gid * WGM, gsz = (nM - fm) < WGM ? (nM - fm) : WGM;
        u.pm = fm + ((wgid % nig) % gsz); u.pn = (wgid % nig) / gsz; return true;
    }
    __device__ __forceinline__ void a_ready(const Unit&) const {}
    __device__ __forceinline__ void done(const Unit&) const {}
};
typedef __bf16 bf16x2_t __attribute__((ext_vector_type(2)));
typedef float f32x2_t __attribute__((ext_vector_type(2)));
__device__ __forceinline__ unsigned cvt_pk_bf16(float lo, float hi) { unsigned r; asm volatile("v_cvt_pk_bf16_f32 %0, %1, %2" : "=v"(r) : "v"(lo), "v"(hi)); return r; }
__device__ __forceinline__ unsigned cvt_pk_bf16_cv(float lo, float hi) { const f32x2_t v = {lo, hi}; const bf16x2_t b = __builtin_convertvector(v, bf16x2_t); return __builtin_bit_cast(unsigned, b); }
__device__ __forceinline__ int otid() { int t = threadIdx.x; asm volatile("" : "+v"(t)); return t; }
__device__ __forceinline__ float silu_f(float v) { return v * __builtin_amdgcn_rcpf(1.0f + __expf(-v)); }

#define EPI_PIN(p) asm volatile("" : "+v"(p))
struct EpiSwiGLU {
    static constexpr bool PERM = true, AFTER_DRAIN = false;
    bf16_t* O; int ldc;
    __device__ __forceinline__ void operator()(const f32x4 (&acc)[2][2][4][2], const Unit& u, int wr, int wc, int fr, int fq) const {
        const int row0 = u.pm * BM + wr * 64 + fr, col0 = u.pn * 128 + wc * 32 + 8 * fq;
        bf16_t* rowp = O + (size_t)row0 * ldc + col0;
#pragma unroll
        for (int ai = 0; ai < 2; ++ai) {
#pragma unroll
            for (int m = 0; m < 4; ++m) {
                const f32x4 g0 = acc[ai][0][m][0], g1 = acc[ai][0][m][1], u0 = acc[ai][1][m][0], u1 = acc[ai][1][m][1];
                u32x4 w;
                w.x = cvt_pk_bf16(silu_f(g0[0]) * u0[0], silu_f(g0[1]) * u0[1]); w.y = cvt_pk_bf16(silu_f(g0[2]) * u0[2], silu_f(g0[3]) * u0[3]);
                w.z = cvt_pk_bf16(silu_f(g1[0]) * u1[0], silu_f(g1[1]) * u1[1]); w.w = cvt_pk_bf16(silu_f(g1[2]) * u1[2], silu_f(g1[3]) * u1[3]);
                *(u32x4*)rowp = w;
                rowp += (size_t)16 * ldc; EPI_PIN(rowp);
            }
            rowp += (size_t)64 * ldc; EPI_PIN(rowp);
        }
    }
};
struct EpiResid {
    static constexpr bool PERM = false, AFTER_DRAIN = false;
    const float* xin; float* xout; const float* gate; float scale; int half;
    __device__ __forceinline__ void operator()(const f32x4 (&acc)[2][2][4][2], const Unit& u, int wr, int wc, int fr, int fq) const {
        const int row0 = u.pm * BM + wr * 64 + fr, col0 = u.pn * BM + wc * 32 + 4 * fq;
        const int batch = half ? 8 + (u.pm >> 5) : (u.pm >> 4);
        const float* gp = gate + (size_t)batch * 9216 + col0;
        f32x4 gv[2][2];
#pragma unroll
        for (int bj = 0; bj < 2; ++bj)
#pragma unroll
            for (int n = 0; n < 2; ++n) gv[bj][n] = *(const f32x4*)(gp + bj * HALF + n * 16) * scale;
        const float* xp = xin + (size_t)row0 * 1024 + col0; float* op = xout + (size_t)row0 * 1024 + col0;
#pragma unroll
        for (int ai = 0; ai < 2; ++ai) {
#pragma unroll
            for (int m = 0; m < 4; ++m) {
#pragma unroll
                for (int bj = 0; bj < 2; ++bj)
#pragma unroll
                    for (int n = 0; n < 2; ++n) { const f32x4 xi = *(const f32x4*)(xp + bj * HALF + n * 16); *(f32x4*)(op + bj * HALF + n * 16) = xi + gv[bj][n] * acc[ai][bj][m][n]; }
                xp += 16 * 1024; op += 16 * 1024; EPI_PIN(xp); EPI_PIN(op);
                asm volatile("" ::: "memory"); }
            xp += 64 * 1024; op += 64 * 1024; EPI_PIN(xp); EPI_PIN(op);
        }
    }
};
struct EpiProj {
    static constexpr bool PERM = true, AFTER_DRAIN = false;
    static constexpr size_t OFF_PA = (size_t)144 << 20, OFF_PD = (size_t)272 << 20, OFF_Z = (size_t)240 << 20;
    unsigned char* wsb; float* AB; const float* rope; int smask;
    __device__ __forceinline__ void operator()(const f32x4 (&acc)[2][2][4][2], const Unit& u, int wr, int wc, int fr, int fq) const {
        const int row0 = u.pm * BM + wr * 64 + fr, pn = u.pn;
        if (pn < 14) {
            const size_t poff = pn < 6 ? OFF_PA : (pn < 12 ? OFF_PD : OFF_Z); bf16_t* P = (bf16_t*)(wsb + poff); const int ldp = pn < 12 ? 1536 : 512;
            const int col0 = (pn < 6 ? pn : (pn < 12 ? pn - 6 : pn - 12)) * 256 + wc * 32 + 8 * fq;
            const bool rot = (pn < 4) && ((wc & 1) == 0) && (fq < 2);
            const float sgn = (fq & 1) ? 1.f : -1.f;
            bf16_t* rowp = P + (size_t)row0 * ldp + col0; int row = row0;
#pragma unroll
            for (int ai = 0; ai < 2; ++ai) {
#pragma unroll
                for (int m = 0; m < 4; ++m) {
                    f32x4 c0 = {0.f, 0.f, 0.f, 0.f}, c1 = c0, s0 = c0, s1 = c0;
                    if (pn < 4) { const float* rp = rope + (size_t)(row & smask) * 16; c0 = *(const f32x4*)rp; c1 = *(const f32x4*)(rp + 4); s0 = *(const f32x4*)(rp + 8); s1 = *(const f32x4*)(rp + 12); }
#pragma unroll
                    for (int bj = 0; bj < 2; ++bj) { f32x4 v0 = acc[ai][bj][m][0], v1 = acc[ai][bj][m][1];
                        if (pn < 4) { f32x4 p0, p1;
#pragma unroll
                            for (int j = 0; j < 4; ++j) { p0[j] = __shfl_xor(v0[j], 16); p1[j] = __shfl_xor(v1[j], 16); }
                            const f32x4 r0 = v0 * c0 + sgn * (p0 * s0), r1 = v1 * c1 + sgn * (p1 * s1);
                            if (rot) { v0 = r0; v1 = r1; } }
                        u32x4 w; w.x = cvt_pk_bf16(v0[0], v0[1]); w.y = cvt_pk_bf16(v0[2], v0[3]); w.z = cvt_pk_bf16(v1[0], v1[1]); w.w = cvt_pk_bf16(v1[2], v1[3]);
                        *(u32x4*)(rowp + bj * HALF) = w; }
                    rowp += (size_t)16 * ldp; row += 16; EPI_PIN(rowp); EPI_PIN(row);
                    asm volatile("" ::: "memory"); }
                rowp += (size_t)64 * ldp; row += 64; EPI_PIN(rowp); EPI_PIN(row);
            }
        } else {
            if (wc == 0 && fq < 2) {
                float* ap = AB + (size_t)row0 * 16 + 8 * fq;
#pragma unroll
                for (int ai = 0; ai < 2; ++ai) {
#pragma unroll
                    for (int m = 0; m < 4; ++m) { *(f32x4*)ap = acc[ai][0][m][0]; *(f32x4*)(ap + 4) = acc[ai][0][m][1]; ap += 16 * 16; EPI_PIN(ap); }
                    ap += 64 * 16; EPI_PIN(ap); }
            }
        }
    }
};

template <class Epi, class Sched, bool ALIGN_EPI = false, bool SP2 = false>
__device__ __forceinline__ void gemm_phase(PG8_LAS unsigned char* lds, const Gemm g, const Sched& S, const Epi& E) {
    const int tid = otid(), wid = __builtin_amdgcn_readfirstlane(tid >> 6), lane = tid & 63, wr = wid >> 2, wc = wid & 3, fr = lane & 15, fq = lane >> 4;
    const int K = g.K, nt = K / BK;
    unsigned voffA[2], voffB[2];
#pragma unroll
    for (int i = 0; i < 2; ++i) { int R, C; stage_rc(tid * 16 + i * 8192, R, C); const int Rb = Epi::PERM ? ((R & ~31) + perm32(R & 31)) : R;
        voffA[i] = (unsigned)(R * K + C) * 2u; voffB[i] = (unsigned)(Rb * K + C) * 2u; }
    const size_t kstep = (size_t)(BK * 2);
    const size_t hstep = (size_t)HALF * K * 2;
    const size_t tstep = 2 * hstep;
    const unsigned ldsw = (unsigned)wid * 1024u;
    const int aoff = lds_byte(wr * 64 + fr, fq * 8), boff = lds_byte(wc * 32 + fr, fq * 8);
#define PG8_SA(b, h) (((b) * 2 + (h)) * HTB)
#define PG8_SB(b, h) ((4 + (b) * 2 + (h)) * HTB)
#define PG8_STAGE(bufoff, gbase, voff) do { _Pragma("unroll") for (int _i = 0; _i < 2; ++_i) \
        __builtin_amdgcn_global_load_lds((const unsigned*)((const char*)(gbase) + (voff)[_i]), (PG8_LAS unsigned*)(lds + (bufoff) + ldsw + _i * 8192), 16, 0, 0); } while (0)
#define PG8_LDA(dst, b, h) do { _Pragma("unroll") for (int m = 0; m < 4; ++m) _Pragma("unroll") for (int k = 0; k < 2; ++k) dst[m][k] = *(const PG8_LAS bf16x8*)(lds + PG8_SA(b, h) + aoff + m * 2048 + k * 1024); } while (0)
#define PG8_LDB(dst, b, h) do { _Pragma("unroll") for (int n = 0; n < 2; ++n) _Pragma("unroll") for (int k = 0; k < 2; ++k) dst[n][k] = *(const PG8_LAS bf16x8*)(lds + PG8_SB(b, h) + boff + n * 2048 + k * 1024); } while (0)
#define PG8_MMA(ai, bj, At, Bt) do { __builtin_amdgcn_s_setprio(1); _Pragma("unroll") for (int m = 0; m < 4; ++m) _Pragma("unroll") for (int n = 0; n < 2; ++n) _Pragma("unroll") for (int k = 0; k < 2; ++k) \
        acc[ai][bj][m][n] = __builtin_amdgcn_mfma_f32_16x16x32_bf16(Bt[n][k], At[m][k], acc[ai][bj][m][n], 0, 0, 0); __builtin_amdgcn_s_setprio(0); } while (0)
#define PG8_WAIT_V(n) asm volatile("s_waitcnt vmcnt(" #n ")" ::: "memory")
#define PG8_WAIT_L(n) asm volatile("s_waitcnt lgkmcnt(" #n ")" ::: "memory")
#define PG8_BAR __builtin_amdgcn_s_barrier()
#define PG8_SCHED __builtin_amdgcn_sched_barrier(0)
    Unit cur, nxt; int ui = 0;
    if (!S.next(0, cur)) return;
    f32x4 acc[2][2][4][2];
#pragma unroll
    for (int a = 0; a < 2; ++a)
#pragma unroll
        for (int b = 0; b < 2; ++b)
#pragma unroll
            for (int m = 0; m < 4; ++m)
#pragma unroll
                for (int n = 0; n < 2; ++n) acc[a][b][m][n] = (f32x4){0.f, 0.f, 0.f, 0.f};
    bf16x8 At[4][2], B0[2][2], B1[2][2];
    const char* cA = (const char*)g.A + (size_t)cur.pm * tstep; const char* cB = (const char*)g.Bt + (size_t)cur.pn * tstep;
    S.a_ready(cur);
    if constexpr (SP2) {
        PG8_STAGE(PG8_SB(0, 0), cB, voffB); PG8_STAGE(PG8_SB(0, 1), cB + hstep, voffB); PG8_STAGE(PG8_SA(0, 0), cA, voffA); PG8_STAGE(PG8_SA(0, 1), cA + hstep, voffA);
        if (wr == 1) PG8_BAR;
        PG8_WAIT_V(2); PG8_BAR;
        PG8_STAGE(PG8_SB(1, 0), cB + kstep, voffB); PG8_STAGE(PG8_SA(1, 0), cA + kstep, voffA); PG8_STAGE(PG8_SB(1, 1), cB + hstep + kstep, voffB);
        PG8_WAIT_V(6); PG8_BAR;
    } else {
        PG8_STAGE(PG8_SB(0, 0), cB, voffB); PG8_STAGE(PG8_SA(0, 0), cA, voffA); PG8_STAGE(PG8_SB(0, 1), cB + hstep, voffB); PG8_STAGE(PG8_SA(0, 1), cA + hstep, voffA);
        if (wr == 1) PG8_BAR;
        PG8_WAIT_V(4); PG8_BAR;
        PG8_STAGE(PG8_SB(1, 0), cB + kstep, voffB); PG8_STAGE(PG8_SA(1, 0), cA + kstep, voffA); PG8_STAGE(PG8_SB(1, 1), cB + hstep + kstep, voffB);
        PG8_WAIT_V(6); PG8_BAR;
    }
    for (;;) {
        const bool has_next = S.next(ui + 1, nxt);
        const char* nA = has_next ? (const char*)g.A + (size_t)nxt.pm * tstep : cA; const char* nB = has_next ? (const char*)g.Bt + (size_t)nxt.pn * tstep : cB;
        for (int t = 0; t < nt; t += 2) {
            const bool last = (t == nt - 2);
            const char* a1 = cA + (size_t)(t + 1) * kstep;
            const char* a2 = last ? nA : cA + (size_t)(t + 2) * kstep; const char* b2 = last ? nB : cB + (size_t)(t + 2) * kstep;
            const char* a3 = a2 + kstep; const char* b3 = b2 + kstep;
            if (last && has_next) S.a_ready(nxt);
            if constexpr (SP2) {
            PG8_LDB(B0, 0, 0); PG8_LDB(B1, 0, 1); PG8_SCHED; PG8_LDA(At, 0, 0); PG8_STAGE(PG8_SA(1, 1), a1 + hstep, voffA);
            PG8_WAIT_V(8); PG8_WAIT_L(0); PG8_BAR; PG8_MMA(0, 0, At, B0); PG8_MMA(0, 1, At, B1); PG8_BAR; PG8_SCHED;
            PG8_LDA(At, 0, 1); PG8_STAGE(PG8_SB(0, 0), b2, voffB); PG8_STAGE(PG8_SB(0, 1), b2 + hstep, voffB); PG8_STAGE(PG8_SA(0, 0), a2, voffA);
            PG8_WAIT_V(8); PG8_WAIT_L(0); PG8_BAR; PG8_MMA(1, 0, At, B0); PG8_MMA(1, 1, At, B1); PG8_BAR; PG8_SCHED;
            PG8_LDB(B0, 1, 0); PG8_LDB(B1, 1, 1); PG8_SCHED; PG8_LDA(At, 1, 0); PG8_STAGE(PG8_SA(0, 1), a2 + hstep, voffA);
            PG8_WAIT_V(8); PG8_WAIT_L(0); PG8_BAR; PG8_MMA(0, 0, At, B0); PG8_MMA(0, 1, At, B1); PG8_BAR; PG8_SCHED;
            PG8_LDA(At, 1, 1); PG8_STAGE(PG8_SB(1, 0), b3, voffB); PG8_STAGE(PG8_SB(1, 1), b3 + hstep, voffB); PG8_STAGE(PG8_SA(1, 0), a3, voffA);
            PG8_WAIT_V(8); PG8_WAIT_L(0); PG8_BAR; PG8_MMA(1, 0, At, B0); PG8_MMA(1, 1, At, B1); PG8_BAR; PG8_SCHED;
            } else {
            PG8_LDB(B0, 0, 0); PG8_SCHED; PG8_LDA(At, 0, 0); PG8_STAGE(PG8_SA(1, 1), a1 + hstep, voffA);
            PG8_WAIT_L(8); PG8_BAR; PG8_WAIT_L(0); PG8_MMA(0, 0, At, B0); PG8_BAR; PG8_SCHED;
            PG8_LDB(B1, 0, 1); PG8_STAGE(PG8_SB(0, 0), b2, voffB);
            PG8_BAR; PG8_WAIT_L(0); PG8_MMA(0, 1, At, B1); PG8_BAR;
            PG8_LDA(At, 0, 1); PG8_STAGE(PG8_SA(0, 0), a2, voffA);
            PG8_BAR; PG8_WAIT_L(0); PG8_MMA(1, 0, At, B0); PG8_BAR; PG8_SCHED;
            PG8_STAGE(PG8_SB(0, 1), b2 + hstep, voffB);
            PG8_WAIT_V(6); PG8_BAR; PG8_MMA(1, 1, At, B1); PG8_BAR;
            PG8_LDB(B0, 1, 0); PG8_SCHED; PG8_LDA(At, 1, 0); PG8_STAGE(PG8_SA(0, 1), a2 + hstep, voffA);
            PG8_WAIT_L(8); PG8_BAR; PG8_WAIT_L(0); PG8_MMA(0, 0, At, B0); PG8_BAR; PG8_SCHED;
            PG8_LDB(B1, 1, 1); PG8_STAGE(PG8_SB(1, 0), b3, voffB);
            PG8_BAR; PG8_WAIT_L(0); PG8_MMA(0, 1, At, B1); PG8_BAR;
            PG8_LDA(At, 1, 1); PG8_STAGE(PG8_SA(1, 0), a3, voffA);
            PG8_BAR; PG8_WAIT_L(0); PG8_MMA(1, 0, At, B0); PG8_BAR; PG8_SCHED;
            PG8_STAGE(PG8_SB(1, 1), b3 + hstep, voffB);
            PG8_WAIT_V(6); PG8_BAR; PG8_MMA(1, 1, At, B1); PG8_BAR;
            }
        }
        if constexpr (ALIGN_EPI) { if (wr == 0) PG8_BAR; }
        if constexpr (!Epi::AFTER_DRAIN) { E(acc, cur, wr, wc, fr, fq); S.done(cur); }
        if (!has_next) break;
#pragma unroll
        for (int a = 0; a < 2; ++a)
#pragma unroll
            for (int b = 0; b < 2; ++b)
#pragma unroll
                for (int m = 0; m < 4; ++m)
#pragma unroll
                    for (int n = 0; n < 2; ++n) acc[a][b][m][n] = (f32x4){0.f, 0.f, 0.f, 0.f};
        cur = nxt; cA = nA; cB = nB; ++ui;
        if constexpr (ALIGN_EPI) { if (wr == 1) PG8_BAR; }
    }
    PG8_WAIT_V(0);
    if constexpr (!ALIGN_EPI) { if (wr == 0) PG8_BAR; }
    PG8_BAR;
    if constexpr (Epi::AFTER_DRAIN) { E.fused(acc, cur, wr, wc, fr, fq, lds, wid, lane); S.done(cur); }
#undef PG8_SA
#undef PG8_SB
#undef PG8_STAGE
#undef PG8_LDA
#undef PG8_LDB
#undef PG8_MMA
#undef PG8_WAIT_V
#undef PG8_WAIT_L
#undef PG8_BAR
#undef PG8_SCHED
}
}

#define LAS __attribute__((address_space(3)))
typedef unsigned short bf16;
typedef short bf16x8 __attribute__((ext_vector_type(8)));
typedef short s16x4 __attribute__((ext_vector_type(4)));
typedef float f32x4 __attribute__((ext_vector_type(4)));
typedef unsigned v4u __attribute__((ext_vector_type(4)));
typedef unsigned v2u __attribute__((ext_vector_type(2)));
#define MFMA16(a, b, c) __builtin_amdgcn_mfma_f32_16x16x32_bf16((a), (b), (c), 0, 0, 0)
#define CAT8(lo, hi) __builtin_shufflevector((lo), (hi), 0, 1, 2, 3, 4, 5, 6, 7)
#define LDS_WAIT() asm volatile("s_waitcnt lgkmcnt(0)" ::: "memory")

constexpr int D = 1024, FF = 2816, MH = 32768, NPROJ = 3840, INW = 3600;
constexpr float EPS = 1e-6f;
constexpr size_t MiB = 1u << 20;
constexpr size_t WS_MOD = 1 * MiB, WS_ROPE = 2 * MiB;
constexpr size_t WS_WGU1 = 4 * MiB, WS_WD1 = 15 * MiB, WS_WIN = 15 * MiB + 5632 * 1024, WS_WOUT = 28 * MiB, WS_WGU2 = 30 * MiB, WS_WD2 = 41 * MiB;
constexpr size_t WS_H = 48 * MiB, WS_DQ = 48 * MiB, WS_DK = 80 * MiB, WS_DV = 112 * MiB, WS_OF = 80 * MiB, WS_OB = 112 * MiB;
constexpr size_t WS_ACT = 112 * MiB, WS_PA = 144 * MiB, WS_Z = 240 * MiB, WS_CH = 272 * MiB, WS_PD = 272 * MiB, WS_OG = 272 * MiB, WS_LSE = 368 * MiB, WS_MIX = 374 * MiB;
constexpr size_t WS_AB = 496 * MiB, WS_GB = 498 * MiB, WS_GC = 500 * MiB, WS_END = 501 * MiB;
constexpr int LDS_BYTES = 163840;
constexpr int CHJOB = 57344;

__device__ __forceinline__ float bf2f(unsigned short v) { return __uint_as_float(((unsigned)v) << 16); }
__device__ __forceinline__ float bflo(unsigned w) { return __uint_as_float(w << 16); }
__device__ __forceinline__ float bfhi(unsigned w) { return __uint_as_float(w & 0xffff0000u); }
__device__ __forceinline__ unsigned pk2(float lo, float hi) { return pg8::cvt_pk_bf16(lo, hi); }
__device__ __forceinline__ float opaque_one() { float o = 1.0f; asm volatile("" : "+v"(o)); return o; }
__device__ __forceinline__ float silu(float v) { return v * __builtin_amdgcn_rcpf(1.0f + __expf(-v)); }
__device__ __forceinline__ float wave_sum(float v) {
#pragma unroll
    for (int o = 1; o < 64; o <<= 1) v += __shfl_xor(v, o);
    return v;
}
__device__ __forceinline__ bf16x8 pack8(const f32x4 a, const f32x4 b) {
    v4u w; w.x = pk2(a[0], a[1]); w.y = pk2(a[2], a[3]); w.z = pk2(b[0], b[1]); w.w = pk2(b[2], b[3]);
    return __builtin_bit_cast(bf16x8, w);
}
__device__ __forceinline__ bf16x8 pack8cv(const f32x4 a, const f32x4 b) {
    v4u w; w.x = pg8::cvt_pk_bf16_cv(a[0], a[1]); w.y = pg8::cvt_pk_bf16_cv(a[2], a[3]); w.z = pg8::cvt_pk_bf16_cv(b[0], b[1]); w.w = pg8::cvt_pk_bf16_cv(b[2], b[3]);
    return __builtin_bit_cast(bf16x8, w);
}
__device__ __forceinline__ f32x4 ld_bf4(const bf16* p) { const v2u w = *(const v2u*)p; return (f32x4){bflo(w.x), bfhi(w.x), bflo(w.y), bfhi(w.y)}; }

__device__ __forceinline__ void ph_mod(const float* c_prompt, const float* c_sample, const float* ada_w, const float* ada_b, float* MOD, LAS unsigned char* lds) {
    const int tid = pg8::otid(), lane = tid & 63, wave = tid >> 6;
    LAS float* sc = (LAS float*)lds;
    LAS float* red = (LAS float*)(lds + 49152);
    for (int i = tid; i < 12 * 1024; i += 512) { const int b = i >> 10, k = i & 1023; const float v = b < 8 ? c_prompt[b * 1024 + k] : c_sample[(b - 8) * 1024 + k]; sc[i] = silu(v); }
    __syncthreads();
    const int cl = tid & 7, kg = tid >> 3;
    for (int item = blockIdx.x; item < 576; item += gridDim.x) {
        const int layer = item / 288, cg32 = item % 288, col = cg32 * 32 + cl * 4;
        float acc[12][4];
#pragma unroll
        for (int b = 0; b < 12; ++b)
#pragma unroll
            for (int j = 0; j < 4; ++j) acc[b][j] = 0.f;
        const float* wp = ada_w + (size_t)layer * 1024 * 9216 + col;
#pragma unroll 4
        for (int kk = 0; kk < 16; ++kk) { const int k = kg * 16 + kk; const f32x4 w = *(const f32x4*)(wp + (size_t)k * 9216);
#pragma unroll
            for (int b = 0; b < 12; ++b) { const float s = sc[b * 1024 + k];
#pragma unroll
                for (int j = 0; j < 4; ++j) acc[b][j] += s * w[j]; } }
#pragma unroll
        for (int b = 0; b < 12; ++b)
#pragma unroll
            for (int j = 0; j < 4; ++j) { float v = acc[b][j]; v += __shfl_xor(v, 8); v += __shfl_xor(v, 16); v += __shfl_xor(v, 32); if ((lane >> 3) == 0) red[(wave * 8 + cl) * 48 + b * 4 + j] = v; }
        __syncthreads();
        if (tid < 384) { const int b = tid >> 5, c = tid & 31; float s = 0.f;
#pragma unroll
            for (int w = 0; w < 8; ++w) s += red[(w * 8 + (c >> 2)) * 48 + b * 4 + (c & 3)];
            MOD[(size_t)(layer * 12 + b) * 9216 + cg32 * 32 + c] = s + ada_b[layer * 9216 + cg32 * 32 + c]; }
        __syncthreads();
    }
}
__device__ __forceinline__ void ph_rope(float* ROPE) {
    for (int idx = blockIdx.x * 512 + pg8::otid(); idx < 8192 * 8; idx += gridDim.x * 512) {
        const int s = idx >> 3, i = idx & 7;
        const float inv = exp2f(-(float)i * 0.125f * 18.931568569324174f);
        const float ang = (float)s * inv;
        double rev = (double)ang * 0.15915494309189535; rev -= __builtin_rint(rev);
        const float fr = (float)rev;
        ROPE[s * 16 + i] = __builtin_amdgcn_cosf(fr); ROPE[s * 16 + 8 + i] = __builtin_amdgcn_sinf(fr);
    }
}
__device__ __forceinline__ void tr_item(const float* W, int K, int N, bf16* WT, int k0, int n0, int dst_row0, LAS float* scr, int lane) {
#pragma unroll 8
    for (int i = 0; i < 32; ++i) { const int kk = 2 * i + (lane >> 5), n = n0 + (lane & 31); scr[kk * 33 + (lane & 31)] = (n < N) ? W[(size_t)(k0 + kk) * N + n] : 0.f; }
    LDS_WAIT();
    const int c = lane & 7;
#pragma unroll
    for (int j = 0; j < 4; ++j) { const int n = (lane >> 3) + 8 * j; const LAS float* s = scr + (8 * c) * 33 + n;
        v4u o; o.x = pk2(s[0 * 33], s[1 * 33]); o.y = pk2(s[2 * 33], s[3 * 33]); o.z = pk2(s[4 * 33], s[5 * 33]); o.w = pk2(s[6 * 33], s[7 * 33]);
        *(v4u*)(WT + (size_t)(dst_row0 + n) * K + k0 + 8 * c) = o; }
    LDS_WAIT();
}
__device__ __forceinline__ void ph_wconv(const float* wg1, const float* wu1, const float* wd1, const float* wg2, const float* wu2, const float* wd2, const float* win, const float* wout,
                                         int layer, unsigned char* ws, LAS unsigned char* lds) {
    const int tid_ = pg8::otid(), lane = tid_ & 63, wave = tid_ >> 6;
    LAS float* scr = (LAS float*)(lds + wave * 16384);
    const int gw = blockIdx.x * 8 + wave, NGW = gridDim.x * 8;
    constexpr int I_GU = 16 * 88, I_DN = 44 * 32, I_IN = 16 * 120, I_OUT = 16 * 32;
    constexpr int NIT = 6 * I_GU + I_IN + I_OUT;
    static_assert(I_DN == I_GU, "item counts");
    for (int it = gw; it < NIT; it += NGW) {
        int r = it;
        if (r < 6 * I_GU) {
            const int which = r / I_GU; r -= which * I_GU;
            const int f = which / 3, t = which % 3;
            if (t < 2) { const float* W = (f ? (t ? wu2 : wg2) : (t ? wu1 : wg1)) + (size_t)layer * D * FF; bf16* WT = (bf16*)(ws + (f ? WS_WGU2 : WS_WGU1));
                const int kb = r / 88, nb = r % 88, n0 = nb * 32; tr_item(W, D, FF, WT, kb * 64, n0, (n0 >> 7) * 256 + t * 128 + (n0 & 127), scr, lane); }
            else { const float* W = (f ? wd2 : wd1) + (size_t)layer * D * FF; bf16* WT = (bf16*)(ws + (f ? WS_WD2 : WS_WD1));
                const int kb = r / 32, nb = r % 32; tr_item(W, FF, D, WT, kb * 64, nb * 32, nb * 32, scr, lane); }
            continue;
        }
        r -= 6 * I_GU;
        if (r < I_IN) { const int kb = r / 120, nb = r % 120; tr_item(win + (size_t)layer * D * INW, D, INW, (bf16*)(ws + WS_WIN), kb * 64, nb * 32, nb * 32, scr, lane); continue; }
        r -= I_IN;
        { const int kb = r / 32, nb = r % 32; tr_item(wout + (size_t)layer * D * D, D, D, (bf16*)(ws + WS_WOUT), kb * 64, nb * 32, nb * 32, scr, lane); }
    }
}
__device__ __forceinline__ void ph_norm(const float* x, const float* nw, const float* modl, int sb, int half, bf16* H) {
    const int tid_ = pg8::otid(), lane = tid_ & 63, wave = tid_ >> 6;
    const int gw = blockIdx.x * 8 + wave, NGW = gridDim.x * 8;
    for (int r0 = gw * 16; r0 < MH; r0 += NGW * 16) {
        const int batch = half ? 8 + (r0 >> 13) : (r0 >> 12);
        const float* mp = modl + (size_t)batch * 9216 + sb * 3072;
        f32x4 A[4], B[4];
#pragma unroll
        for (int j = 0; j < 4; ++j) { const int c = 4 * lane + 256 * j; const f32x4 w = *(const f32x4*)(nw + c), sh = *(const f32x4*)(mp + c), scl = *(const f32x4*)(mp + 1024 + c); A[j] = w * (1.0f + scl); B[j] = sh; }
        for (int r = r0; r < r0 + 16; ++r) {
            const f32x4* xr = (const f32x4*)(x + (size_t)r * D) + lane;
            f32x4 v[4]; float s = 0.f;
#pragma unroll
            for (int j = 0; j < 4; ++j) { v[j] = xr[64 * j]; s += (v[j].x * v[j].x + v[j].y * v[j].y) + (v[j].z * v[j].z + v[j].w * v[j].w); }
            const float rstd = __builtin_amdgcn_rsqf(wave_sum(s) * (1.f / D) + EPS);
            v2u* o8 = (v2u*)(H + (size_t)r * D) + lane;
#pragma unroll
            for (int j = 0; j < 4; ++j) { const f32x4 h = v[j] * rstd * A[j] + B[j]; v2u w; w.x = pk2(h.x, h.y); w.y = pk2(h.z, h.w); o8[64 * j] = w; }
        }
    }
}
__device__ __forceinline__ void ph_final(float* x, const float* nw) {
    const int tid_ = pg8::otid(), lane = tid_ & 63, wave = tid_ >> 6;
    const int gw = blockIdx.x * 8 + wave, NGW = gridDim.x * 8;
    f32x4 A[4];
#pragma unroll
    for (int j = 0; j < 4; ++j) A[j] = *(const f32x4*)(nw + 4 * lane + 256 * j);
    for (int r = gw; r < 2 * MH; r += NGW) {
        f32x4* xr = (f32x4*)(x + (size_t)r * D) + lane;
        f32x4 v[4]; float s = 0.f;
#pragma unroll
        for (int j = 0; j < 4; ++j) { v[j] = xr[64 * j]; s += (v[j].x * v[j].x + v[j].y * v[j].y) + (v[j].z * v[j].z + v[j].w * v[j].w); }
        const float rstd = __builtin_amdgcn_rsqf(wave_sum(s) * (1.f / D) + EPS);
#pragma unroll
        for (int j = 0; j < 4; ++j) xr[64 * j] = v[j] * rstd * A[j];
    }
}
__device__ __forceinline__ void ph_dnpre(const bf16* PD, const float* AB, const float* conv_w, const float* a_log, const float* dt_bias,
                                         bf16* DQ, bf16* DK, bf16* DV, float* GB, int S) {
    const int tid_ = pg8::otid(), lane = tid_ & 63, wave = tid_ >> 6;
    const int gw = blockIdx.x * 8 + wave, NGW = gridDim.x * 8;
    for (int t0 = gw * 16; t0 < MH; t0 += NGW * 16) {
        const int s0 = t0 & (S - 1);
        for (int part = 0; part < 3; ++part) {
            const bf16* src = PD + part * 512 + lane * 8;
            bf16* dst = (part == 0 ? DQ : (part == 1 ? DK : DV)) + lane * 8;
            f32x4 w[5][2];
#pragma unroll
            for (int j = 0; j < 5; ++j) { const float* wp = conv_w + j * 1536 + part * 512 + lane * 8; w[j][0] = *(const f32x4*)wp; w[j][1] = *(const f32x4*)(wp + 4); }
            v4u r0, r1, r2, r3, r4;
            const v4u zero = {0u, 0u, 0u, 0u};
#define ROWLD(off) (((unsigned)(s0 + (off)) < (unsigned)S) ? *(const v4u*)(src + (size_t)(t0 + (off)) * 1536) : zero)
            r0 = ROWLD(-2); r1 = ROWLD(-1); r2 = ROWLD(0); r3 = ROWLD(1);
            for (int i = 0; i < 16; ++i) {
                r4 = ROWLD(i + 2);
                f32x4 y0, y1;
#define TAP(rr, j, first) { const f32x4 a = {bflo(rr.x), bfhi(rr.x), bflo(rr.y), bfhi(rr.y)}, b = {bflo(rr.z), bfhi(rr.z), bflo(rr.w), bfhi(rr.w)}; \
                    if (first) { y0 = a * w[j][0]; y1 = b * w[j][1]; } else { y0 += a * w[j][0]; y1 += b * w[j][1]; } }
                TAP(r0, 0, true) TAP(r1, 1, false) TAP(r2, 2, false) TAP(r3, 3, false) TAP(r4, 4, false)
#undef TAP
#pragma unroll
                for (int e = 0; e < 4; ++e) { y0[e] = silu(y0[e]); y1[e] = silu(y1[e]); }
                if (part < 2) {
                    float ss = (y0.x * y0.x + y0.y * y0.y) + (y0.z * y0.z + y0.w * y0.w) + (y1.x * y1.x + y1.y * y1.y) + (y1.z * y1.z + y1.w * y1.w);
                    ss += __shfl_xor(ss, 1); ss += __shfl_xor(ss, 2); ss += __shfl_xor(ss, 4); ss += __shfl_xor(ss, 8);
                    const float scl = __builtin_amdgcn_rsqf(ss + EPS) * (part == 0 ? 0.08838834764831845f : 1.0f);
                    y0 *= scl; y1 *= scl;
                }
                v4u o; o.x = pk2(y0.x, y0.y); o.y = pk2(y0.z, y0.w); o.z = pk2(y1.x, y1.y); o.w = pk2(y1.z, y1.w);
                *(v4u*)(dst + (size_t)(t0 + i) * 512) = o;
                r0 = r1; r1 = r2; r2 = r3; r3 = r4;
            }
#undef ROWLD
        }
#pragma unroll
        for (int jj = 0; jj < 4; ++jj) { const int idx = lane + 64 * jj, tok = t0 + (idx >> 4), c = idx & 15; const float v = AB[(size_t)tok * 16 + c];
            float res;
            if (c < 8) { const float xx = v + dt_bias[c]; const float sp = fmaxf(xx, 0.f) + __logf(1.0f + __expf(-fabsf(xx))); res = -__expf(a_log[c]) * sp; }
            else res = __builtin_amdgcn_rcpf(1.0f + __expf(-v));
            GB[(size_t)tok * 16 + c] = res; }
    }
}
__device__ __forceinline__ void ph_attn(const bf16* P, bf16* OG, float* LSE, int S, int lgS, LAS unsigned char* lds) {
    const int tid = pg8::otid(), lane = tid & 63, wave = tid >> 6, l15 = lane & 15, g = lane >> 4;
    const float one = opaque_one();
    LAS unsigned char* KL = lds; LAS unsigned char* VT = lds + 41472;
    for (int u = blockIdx.x; u < 3 * 8 * 256; u += gridDim.x) {
        const int tb = u & 255, h = (u >> 8) & 7, p = u >> 11;
        const int lgd = 2 * p, L = S >> lgd, nb = L >> 7, bps = S >> 7;
        const int seq = tb >> (lgS - 7), lb = tb & (bps - 1);
        const int r = lb / nb, ib = lb - r * nb, i0 = ib << 7;
        const int seqbase = seq << lgS;
        __syncthreads();
        for (int idx = tid; idx < 288 * 8; idx += 512) {
            const int kl = idx >> 3, pc = idx & 7, ik = i0 - 64 + kl;
            v4u kv = {0u, 0u, 0u, 0u}, vv = kv;
            if (ik >= 0 && ik < L) { const bf16* src = P + (size_t)(seqbase + (ik << lgd) + r) * 1536 + h * 64 + pc * 8; kv = *(const v4u*)(src + 512); vv = *(const v4u*)(src + 1024); }
            *(LAS v4u*)(KL + kl * 144 + pc * 16) = kv;
#pragma unroll
            for (int e = 0; e < 8; ++e) { const unsigned wv = vv[e >> 1]; *(LAS unsigned short*)(VT + (pc * 8 + e) * 592 + kl * 2) = (unsigned short)((e & 1) ? (wv >> 16) : (wv & 0xffffu)); }
        }
        __syncthreads();
        const int iq = i0 + 16 * wave + l15, tokq = seqbase + (iq << lgd) + r;
        bf16x8 qf[2];
#pragma unroll
        for (int ks = 0; ks < 2; ++ks) qf[ks] = *(const bf16x8*)(P + (size_t)tokq * 1536 + h * 64 + 32 * ks + 8 * g);
        f32x4 acc[4];
#pragma unroll
        for (int dt = 0; dt < 4; ++dt) acc[dt] = (f32x4){0.f, 0.f, 0.f, 0.f};
        float m = -1e30f, lsum = 0.f;
        for (int s = 0; s < 5; ++s) {
            const int kl0 = 16 * wave + 32 * s;
            f32x4 c[2];
#pragma unroll
            for (int t = 0; t < 2; ++t) { c[t] = (f32x4){0.f, 0.f, 0.f, 0.f};
#pragma unroll
                for (int ks = 0; ks < 2; ++ks) { const bf16x8 a = *(const LAS bf16x8*)(KL + (kl0 + 16 * t + l15) * 144 + (32 * ks + 8 * g) * 2); c[t] = MFMA16(a, qf[ks], c[t]); } }
            float sc[8]; float mx = -1e30f;
#pragma unroll
            for (int t = 0; t < 2; ++t)
#pragma unroll
                for (int rg = 0; rg < 4; ++rg) { const int ik = i0 - 64 + kl0 + 16 * t + 4 * g + rg, dl = ik - iq;
                    const bool valid = (ik >= 0) && (ik < L) && (dl <= 64) && (dl >= -64);
                    const float sv = valid ? c[t][rg] * 0.18033688011112042f : -1e30f; sc[t * 4 + rg] = sv; mx = fmaxf(mx, sv); }
            mx = fmaxf(mx, __shfl_xor(mx, 16)); mx = fmaxf(mx, __shfl_xor(mx, 32));
            const float mn = fmaxf(m, mx), alpha = __builtin_amdgcn_exp2f(m - mn); m = mn;
            float ps = 0.f; f32x4 p0, p1;
#pragma unroll
            for (int e = 0; e < 4; ++e) { p0[e] = __builtin_amdgcn_exp2f(sc[e] - mn); p1[e] = __builtin_amdgcn_exp2f(sc[4 + e] - mn); ps += p0[e] + p1[e]; }
            lsum = lsum * alpha + ps;
            const bf16x8 pf = pack8(p0 * one, p1 * one);
#pragma unroll
            for (int dt = 0; dt < 4; ++dt) { acc[dt] *= alpha;
                const s16x4 lo = *(const LAS s16x4*)(VT + (16 * dt + l15) * 592 + (kl0 + 4 * g) * 2), hi = *(const LAS s16x4*)(VT + (16 * dt + l15) * 592 + (kl0 + 16 + 4 * g) * 2);
                acc[dt] = MFMA16(CAT8(lo, hi), pf, acc[dt]); }
        }
        lsum += __shfl_xor(lsum, 16); lsum += __shfl_xor(lsum, 32);
        const float inv = 1.0f / lsum;
        bf16* og = OG + ((size_t)p * MH + tokq) * 512 + h * 64 + 4 * g;
#pragma unroll
        for (int dt = 0; dt < 4; ++dt) { v2u w; w.x = pk2(acc[dt][0] * inv, acc[dt][1] * inv); w.y = pk2(acc[dt][2] * inv, acc[dt][3] * inv); *(v2u*)(og + 16 * dt) = w; }
        if (g == 0) LSE[((size_t)p * MH + tokq) * 8 + h] = (m + __log2f(lsum)) * 0.6931471805599453f;
    }
}
__device__ __forceinline__ void ph_chunk(const bf16* DQ, const bf16* DK, const bf16* DV, const float* GB, unsigned char* CH, float* GC, int S, int lgS, LAS unsigned char* lds) {
    const int tid_ = pg8::otid(), lane = tid_ & 63, wave = tid_ >> 6, l15 = lane & 15, g = lane >> 4;
    const float one = opaque_one();
    LAS unsigned char* wl = lds + wave * 18432;
    LAS float* Al = (LAS float*)wl; LAS float* gcs = (LAS float*)(wl + 17408); LAS float* bts = gcs + 64;
    LAS bf16* TP = (LAS bf16*)wl; LAS bf16* TPP = (LAS bf16*)(wl + 8192);
    for (int job = blockIdx.x * 8 + wave; job < 4096; job += gridDim.x * 8) {
        const int dir = job & 1, h = (job >> 1) & 3, cgi = job >> 3, cps = S >> 6;
        const int seq = cgi >> (lgS - 6), n = cgi & (cps - 1), seqbase = seq << lgS;
#define TOK(c) (seqbase + (dir ? (S - 1 - (64 * n + (c))) : (64 * n + (c))))
        {   const int tokc = TOK(lane);
            const float gv = GB[(size_t)tokc * 16 + dir * 4 + h], bv = GB[(size_t)tokc * 16 + 8 + dir * 4 + h];
            float cs = gv;
#pragma unroll
            for (int o = 1; o < 64; o <<= 1) { const float t = __shfl_up(cs, o); if (lane >= o) cs += t; }
            gcs[lane] = cs; bts[lane] = bv; GC[(size_t)job * 64 + lane] = cs; }
        LDS_WAIT();
        bf16x8 kf[4][4];
#pragma unroll
        for (int t = 0; t < 4; ++t)
#pragma unroll
            for (int ks = 0; ks < 4; ++ks) kf[t][ks] = *(const bf16x8*)(DK + (size_t)TOK(16 * t + l15) * 512 + h * 128 + 32 * ks + 8 * g);
#pragma unroll
        for (int it = 0; it < 4; ++it) { const int i = 16 * it + l15; const float gi = gcs[i], bi = bts[i];
#pragma unroll
            for (int jt = 0; jt <= it; ++jt) { f32x4 c = {0.f, 0.f, 0.f, 0.f};
#pragma unroll
                for (int ks = 0; ks < 4; ++ks) c = MFMA16(kf[jt][ks], kf[it][ks], c);
                const f32x4 gj = *(const LAS f32x4*)(gcs + 16 * jt + 4 * g); f32x4 o;
#pragma unroll
                for (int rg = 0; rg < 4; ++rg) { const int j = 16 * jt + 4 * g + rg; o[rg] = (j < i) ? bi * c[rg] * __expf(gi - gj[rg]) : 0.f; }
                *(LAS f32x4*)(Al + i * 68 + 16 * jt + 4 * g) = o; } }
        unsigned char* chb = CH + (size_t)job * CHJOB;
        bf16* UT = (bf16*)chb; bf16* Wm = (bf16*)(chb + 16384); bf16* KT = (bf16*)(chb + 32768); bf16* QK = (bf16*)(chb + 49152);
#pragma unroll
        for (int it = 0; it < 4; ++it) { const int i = 16 * it + l15; const float gi = gcs[i];
            bf16x8 qfr[4];
#pragma unroll
            for (int ks = 0; ks < 4; ++ks) qfr[ks] = *(const bf16x8*)(DQ + (size_t)TOK(i) * 512 + h * 128 + 32 * ks + 8 * g);
#pragma unroll
            for (int jt = 0; jt < 4; ++jt) { v2u out = {0u, 0u};
                if (jt <= it) { f32x4 c = {0.f, 0.f, 0.f, 0.f};
#pragma unroll
                    for (int ks = 0; ks < 4; ++ks) c = MFMA16(kf[jt][ks], qfr[ks], c);
                    const f32x4 gj = *(const LAS f32x4*)(gcs + 16 * jt + 4 * g); f32x4 o;
#pragma unroll
                    for (int rg = 0; rg < 4; ++rg) { const int j = 16 * jt + 4 * g + rg; o[rg] = (j <= i) ? c[rg] * __expf(gi - gj[rg]) : 0.f; }
                    out.x = pk2(o[0], o[1]); out.y = pk2(o[2], o[3]); }
                *(v2u*)(QK + i * 64 + 16 * jt + 4 * g) = out; } }
        LDS_WAIT();
        float t[64];
#pragma unroll
        for (int i = 0; i < 64; ++i) { float a0 = 0.f, a1 = 0.f, a2 = 0.f, a3 = 0.f;
#pragma unroll
            for (int j4 = 0; j4 * 4 < i; ++j4) { const f32x4 a = *(const LAS f32x4*)(Al + i * 68 + 4 * j4);
                if (4 * j4 + 0 < i) a0 += a[0] * t[4 * j4 + 0];
                if (4 * j4 + 1 < i) a1 += a[1] * t[4 * j4 + 1];
                if (4 * j4 + 2 < i) a2 += a[2] * t[4 * j4 + 2];
                if (4 * j4 + 3 < i) a3 += a[3] * t[4 * j4 + 3]; }
            t[i] = ((lane == i) ? 1.f : 0.f) - ((a0 + a1) + (a2 + a3)); }
        const float bc = bts[lane], ec = bc * __expf(gcs[lane]);
        LDS_WAIT();
#pragma unroll
        for (int i = 0; i < 64; ++i) { const unsigned w = pk2(t[i] * bc, t[i] * ec); TP[i * 64 + lane] = (bf16)(w & 0xffffu); TPP[i * 64 + lane] = (bf16)(w >> 16); }
        LDS_WAIT();
        bf16x8 tf[4][2];
#pragma unroll
        for (int mt = 0; mt < 4; ++mt)
#pragma unroll
            for (int ks = 0; ks < 2; ++ks) tf[mt][ks] = *(const LAS bf16x8*)(TP + (16 * mt + l15) * 64 + 32 * ks + 8 * g);
        for (int nt = 0; nt < 8; ++nt) {
            bf16x8 vf[2];
#pragma unroll
            for (int ks = 0; ks < 2; ++ks)
#pragma unroll
                for (int e = 0; e < 8; ++e) vf[ks][e] = (short)DV[(size_t)TOK(32 * ks + 8 * g + e) * 512 + h * 128 + 16 * nt + l15];
#pragma unroll
            for (int mt = 0; mt < 4; ++mt) { f32x4 c = {0.f, 0.f, 0.f, 0.f};
#pragma unroll
                for (int ks = 0; ks < 2; ++ks) c = MFMA16(tf[mt][ks], vf[ks], c);
                c *= one;
                v2u w; w.x = pk2(c[0], c[1]); w.y = pk2(c[2], c[3]); *(v2u*)(UT + (16 * nt + l15) * 64 + 16 * mt + 4 * g) = w; }
        }
#pragma unroll
        for (int mt = 0; mt < 4; ++mt)
#pragma unroll
            for (int ks = 0; ks < 2; ++ks) tf[mt][ks] = *(const LAS bf16x8*)(TPP + (16 * mt + l15) * 64 + 32 * ks + 8 * g);
        for (int dt = 0; dt < 8; ++dt) {
            bf16x8 kt[2];
#pragma unroll
            for (int ks = 0; ks < 2; ++ks) {
#pragma unroll
                for (int e = 0; e < 8; ++e) kt[ks][e] = (short)DK[(size_t)TOK(32 * ks + 8 * g + e) * 512 + h * 128 + 16 * dt + l15];
                *(bf16x8*)(KT + (16 * dt + l15) * 64 + 32 * ks + 8 * g) = kt[ks]; }
#pragma unroll
            for (int mt = 0; mt < 4; ++mt) { f32x4 c = {0.f, 0.f, 0.f, 0.f};
#pragma unroll
                for (int ks = 0; ks < 2; ++ks) c = MFMA16(kt[ks], tf[mt][ks], c);
                c *= one;
                v2u w; w.x = pk2(c[0], c[1]); w.y = pk2(c[2], c[3]); *(v2u*)(Wm + (16 * mt + l15) * 128 + 16 * dt + 4 * g) = w; }
        }
        LDS_WAIT();
    }
}
#define TOKN(c, nn) (seqbase + (dir ? (S - 1 - (64 * (nn) + (c))) : (64 * (nn) + (c))))
constexpr int SC_PW = 288, SC_PK = 160;
constexpr int SC_W = 0, SC_Q = 64 * SC_PW, SC_QK = 2 * 64 * SC_PW, SC_KT = SC_QK + 64 * SC_PK, SC_GC = SC_KT + 128 * SC_PK, SC_BUF = SC_GC + 256;
static_assert(2 * SC_BUF + 4 * 5120 <= LDS_BYTES - 256, "scan LDS image");
__device__ __forceinline__ void ph_scan(const bf16* DQ, const unsigned char* CH, const float* GC, bf16* OF, bf16* OB, int S, int lgS, int half, LAS unsigned char* lds) {
    const int wave = __builtin_amdgcn_readfirstlane(pg8::otid() >> 6);
    const float one = opaque_one();
#define SC_BAR() do { asm volatile("s_waitcnt lgkmcnt(0)" ::: "memory"); __builtin_amdgcn_s_barrier(); asm volatile("" ::: "memory"); } while (0)
    const int nchain = half ? 32 : 64, cps = S >> 6;
    for (int ub = blockIdx.x; ub < 2 * nchain; ub += gridDim.x) {
        const int chain = (ub & 7) + 8 * (ub >> 4), part = (ub >> 3) & 1;
        const int dir = chain & 1, h = (chain >> 1) & 3, seq = chain >> 3, seqbase = seq << lgS;
        __syncthreads();
        if (wave >= 4) {
            const int lt = pg8::otid() - 256;
            const int wr0 = lt >> 4, wc = lt & 15, kr0 = lt >> 3, kc = lt & 7;
            const int woff = (wc >> 2) * 64 + (wc & 1) * 32 + ((wc >> 1) & 1) * 8, koff = (kc >> 2) * 64 + (kc & 1) * 32 + ((kc >> 1) & 1) * 8;
            v4u rwA[4], rqA[4], rkA[2], rtA[4], rwB[4], rqB[4], rkB[2], rtB[4]; f32x4 rgA = {0.f, 0.f, 0.f, 0.f}, rgB = rgA;
#define SC_LD(rw, rq, rk, rt, rg, n_) do { const int nn_ = (n_); const int job = ((seq * cps + nn_) << 3) | (h << 1) | dir; const unsigned char* chb = CH + (size_t)job * CHJOB; \
                const bf16* Wm_ = (const bf16*)(chb + 16384); const bf16* KT_ = (const bf16*)(chb + 32768); const bf16* QK_ = (const bf16*)(chb + 49152); \
                _Pragma("unroll") for (int k = 0; k < 4; ++k) { rw[k] = *(const v4u*)(Wm_ + (wr0 + 16 * k) * 128 + wc * 8); rq[k] = *(const v4u*)(DQ + (size_t)TOKN(wr0 + 16 * k, nn_) * 512 + h * 128 + wc * 8); rt[k] = *(const v4u*)(KT_ + (kr0 + 32 * k) * 64 + kc * 8); } \
                _Pragma("unroll") for (int k = 0; k < 2; ++k) rk[k] = *(const v4u*)(QK_ + (kr0 + 32 * k) * 64 + kc * 8); \
                if (lt < 16) rg = *(const f32x4*)(GC + (size_t)job * 64 + 4 * lt); } while (0)
#define SC_ST8(dst_, v_) do { LAS unsigned char* d_ = (dst_); *(LAS v2u*)d_ = (v2u){(v_).x, (v_).y}; *(LAS v2u*)(d_ + 16) = (v2u){(v_).z, (v_).w}; } while (0)
#define SC_ST(rw, rq, rk, rt, rg, n_) do { LAS unsigned char* b_ = lds + ((n_) & 1) * SC_BUF; \
                _Pragma("unroll") for (int k = 0; k < 4; ++k) { SC_ST8(b_ + SC_W + (wr0 + 16 * k) * SC_PW + woff, rw[k]); SC_ST8(b_ + SC_Q + (wr0 + 16 * k) * SC_PW + woff, rq[k]); SC_ST8(b_ + SC_KT + (kr0 + 32 * k) * SC_PK + koff, rt[k]); } \
                _Pragma("unroll") for (int k = 0; k < 2; ++k) SC_ST8(b_ + SC_QK + (kr0 + 32 * k) * SC_PK + koff, rk[k]); \
                if (lt < 16) *(LAS f32x4*)(b_ + SC_GC + 16 * lt) = rg; } while (0)
            unsigned pfa = 0u, t00 = 0u, t01 = 0u, t02 = 0u, t10 = 0u, t11 = 0u, t12 = 0u, t20 = 0u, t21 = 0u, t22 = 0u, t30 = 0u, t31 = 0u, t32 = 0u;
#define SC_TOUCH(p0_, p1_, p2_, n_) do { const int nn_ = (n_); pfa += p0_ + p1_ + p2_; if (nn_ < cps) { const int jb_ = ((seq * cps + nn_) << 3) | (h << 1) | dir; const unsigned* cb_ = (const unsigned*)(CH + (size_t)jb_ * CHJOB); \
                p0_ = cb_[lt * 32]; if (lt < 192) p1_ = cb_[(lt + 256) * 32]; if (lt < 128) p2_ = *(const unsigned*)(DQ + (size_t)TOKN(lt >> 1, nn_) * 512 + h * 128 + (lt & 1) * 64); } } while (0)
            SC_LD(rwA, rqA, rkA, rtA, rgA, 0);
            SC_TOUCH(t10, t11, t12, 1); SC_TOUCH(t20, t21, t22, 2); SC_TOUCH(t30, t31, t32, 3);
            for (int n = 0; n < cps; n += 4) {
                SC_LD(rwB, rqB, rkB, rtB, rgB, n + 1); SC_TOUCH(t00, t01, t02, n + 4); SC_ST(rwA, rqA, rkA, rtA, rgA, n); SC_BAR();
                SC_LD(rwA, rqA, rkA, rtA, rgA, n + 2); SC_TOUCH(t10, t11, t12, n + 5); SC_ST(rwB, rqB, rkB, rtB, rgB, n + 1); SC_BAR();
                SC_LD(rwB, rqB, rkB, rtB, rgB, n + 3); SC_TOUCH(t20, t21, t22, n + 6); SC_ST(rwA, rqA, rkA, rtA, rgA, n + 2); SC_BAR();
                if (n + 4 < cps) SC_LD(rwA, rqA, rkA, rtA, rgA, n + 4); SC_TOUCH(t30, t31, t32, n + 7); SC_ST(rwB, rqB, rkB, rtB, rgB, n + 3); SC_BAR();
            }
            pfa += t00 + t01 + t02 + t10 + t11 + t12 + t20 + t21 + t22 + t30 + t31 + t32;
            if (pfa == 0x9e3779b9u && lt == 100000) OF[0] = (bf16)pfa;
#undef SC_TOUCH
#undef SC_LD
#undef SC_ST
#undef SC_ST8
            SC_BAR();
        } else {
            const int tidc = pg8::otid(), lane = tidc & 63, l15 = lane & 15, g = lane >> 4;
            const int dv0 = part * 64 + wave * 16;
            bf16* OX = dir ? OB : OF;
            f32x4 St[8];
#pragma unroll
            for (int t = 0; t < 8; ++t) St[t] = (f32x4){0.f, 0.f, 0.f, 0.f};
            v2u utA[4], utN[4];
#define SC_UT(UT__, n_) do { const int jb_ = ((seq * cps + (n_)) << 3) | (h << 1) | dir; const bf16* UT_ = (const bf16*)(CH + (size_t)jb_ * CHJOB); \
                _Pragma("unroll") for (int mt = 0; mt < 4; ++mt) UT__[mt] = *(const v2u*)(UT_ + (dv0 + l15) * 64 + 16 * mt + 4 * g); } while (0)
            SC_UT(utA, 0);
            SC_BAR();
#define SC_FRAG(p_) (*(const LAS bf16x8*)(p_))
            for (int n = 0; n < cps; ++n) {
                const LAS unsigned char* buf = lds + (n & 1) * SC_BUF;
                const LAS float* gcl = (const LAS float*)(buf + SC_GC);
                if (n + 1 < cps) SC_UT(utN, n + 1);
                const float glast = gcl[63];
                bf16x8 sb[4];
#pragma unroll
                for (int ks = 0; ks < 4; ++ks) sb[ks] = pack8cv(St[2 * ks], St[2 * ks + 1]);
                f32x4 vnew[4];
#pragma unroll
                for (int mp = 0; mp < 2; ++mp) { bf16x8 wf[2][4];
#pragma unroll
                    for (int mm = 0; mm < 2; ++mm) { const LAS unsigned char* wrow = buf + SC_W + (16 * (2 * mp + mm) + l15) * SC_PW + 16 * g;
#pragma unroll
                        for (int ks = 0; ks < 4; ++ks) wf[mm][ks] = SC_FRAG(wrow + 64 * ks); }
                    __builtin_amdgcn_sched_barrier(0);
                    f32x4 ws0 = {0.f, 0.f, 0.f, 0.f}, ws1 = ws0;
#pragma unroll
                    for (int ks = 0; ks < 4; ++ks) { ws0 = MFMA16(wf[0][ks], sb[ks], ws0); ws1 = MFMA16(wf[1][ks], sb[ks], ws1); }
                    vnew[2 * mp] = (f32x4){bflo(utA[2 * mp].x), bfhi(utA[2 * mp].x), bflo(utA[2 * mp].y), bfhi(utA[2 * mp].y)} - ws0;
                    vnew[2 * mp + 1] = (f32x4){bflo(utA[2 * mp + 1].x), bfhi(utA[2 * mp + 1].x), bflo(utA[2 * mp + 1].y), bfhi(utA[2 * mp + 1].y)} - ws1;
                    __builtin_amdgcn_sched_barrier(0);
                }
                bf16x8 vb[2], vbs[2];
#pragma unroll
                for (int k2 = 0; k2 < 2; ++k2) vb[k2] = pack8(vnew[2 * k2], vnew[2 * k2 + 1]);
#pragma unroll
                for (int mp = 0; mp < 2; ++mp) { bf16x8 qf[2][4], kf2[2][2]; float egi[2];
#pragma unroll
                    for (int mm = 0; mm < 2; ++mm) { const int mt = 2 * mp + mm; const LAS unsigned char* qrow = buf + SC_Q + (16 * mt + l15) * SC_PW + 16 * g; const LAS unsigned char* qkrow = buf + SC_QK + (16 * mt + l15) * SC_PK + 16 * g;
#pragma unroll
                        for (int ks = 0; ks < 4; ++ks) qf[mm][ks] = SC_FRAG(qrow + 64 * ks);
#pragma unroll
                        for (int k2 = 0; k2 < 2; ++k2) kf2[mm][k2] = SC_FRAG(qkrow + 64 * k2);
                        egi[mm] = __expf(gcl[16 * mt + l15]); }
                    __builtin_amdgcn_sched_barrier(0);
                    f32x4 o0 = {0.f, 0.f, 0.f, 0.f}, o1 = o0;
#pragma unroll
                    for (int ks = 0; ks < 4; ++ks) { o0 = MFMA16(sb[ks], qf[0][ks], o0); o1 = MFMA16(sb[ks], qf[1][ks], o1); }
                    o0 *= egi[0]; o1 *= egi[1];
#pragma unroll
                    for (int k2 = 0; k2 < 2; ++k2) { o0 = MFMA16(vb[k2], kf2[0][k2], o0); o1 = MFMA16(vb[k2], kf2[1][k2], o1); }
                    o0 *= one; o1 *= one;
                    v2u w0, w1; w0.x = pk2(o0[0], o0[1]); w0.y = pk2(o0[2], o0[3]); w1.x = pk2(o1[0], o1[1]); w1.y = pk2(o1[2], o1[3]);
                    *(v2u*)(OX + (size_t)TOKN(16 * (2 * mp) + l15, n) * 512 + h * 128 + dv0 + 4 * g) = w0;
                    *(v2u*)(OX + (size_t)TOKN(16 * (2 * mp + 1) + l15, n) * 512 + h * 128 + dv0 + 4 * g) = w1;
                    __builtin_amdgcn_sched_barrier(0); }
                const float eg = __expf(glast);
#pragma unroll
                for (int mt = 0; mt < 4; ++mt) { const f32x4 gv = *(const LAS f32x4*)(gcl + 16 * mt + 4 * g);
#pragma unroll
                    for (int rg = 0; rg < 4; ++rg) vnew[mt][rg] *= __expf(glast - gv[rg]); }
#pragma unroll
                for (int k2 = 0; k2 < 2; ++k2) vbs[k2] = pack8(vnew[2 * k2], vnew[2 * k2 + 1]);
#pragma unroll
                for (int tp = 0; tp < 2; ++tp) { bf16x8 kt4[4][2];
#pragma unroll
                    for (int tt = 0; tt < 4; ++tt) { const LAS unsigned char* ktrow = buf + SC_KT + (16 * (4 * tp + tt) + l15) * SC_PK + 16 * g; kt4[tt][0] = SC_FRAG(ktrow); kt4[tt][1] = SC_FRAG(ktrow + 64); }
                    __builtin_amdgcn_sched_barrier(0);
#pragma unroll
                    for (int tt = 0; tt < 4; ++tt) St[4 * tp + tt] *= eg;
#pragma unroll
                    for (int k2 = 0; k2 < 2; ++k2)
#pragma unroll
                        for (int tt = 0; tt < 4; ++tt) St[4 * tp + tt] = MFMA16(kt4[tt][k2], vbs[k2], St[4 * tp + tt]);
                    __builtin_amdgcn_sched_barrier(0); }
#pragma unroll
                for (int mt = 0; mt < 4; ++mt) utA[mt] = utN[mt];
                SC_BAR();
            }
#undef SC_FRAG
#undef SC_UT
        }
    }
#undef SC_BAR
#undef TOKN
#undef TOK
}
__device__ __forceinline__ void ph_post(const bf16* OG, const float* LSE, const bf16* OF, const bf16* OB, const bf16* Z, const float* dn_norm, bf16* MIX) {
    const int tid_ = pg8::otid(), lane = tid_ & 63, wave = tid_ >> 6;
    const int gw = blockIdx.x * 8 + wave, NGW = gridDim.x * 8;
    f32x4 nw0 = *(const f32x4*)(dn_norm + (lane & 15) * 8), nw1 = *(const f32x4*)(dn_norm + (lane & 15) * 8 + 4);
    for (int t = gw; t < MH; t += NGW) {
        {   const int hd = lane >> 3;
            const float l0 = LSE[((size_t)0 * MH + t) * 8 + hd], l1 = LSE[((size_t)1 * MH + t) * 8 + hd], l2 = LSE[((size_t)2 * MH + t) * 8 + hd];
            const float mx = fmaxf(l0, fmaxf(l1, l2));
            float w0 = __expf(l0 - mx), w1 = __expf(l1 - mx), w2 = __expf(l2 - mx); const float inv = 1.0f / (w0 + w1 + w2); w0 *= inv; w1 *= inv; w2 *= inv;
            const v4u a = *(const v4u*)(OG + ((size_t)0 * MH + t) * 512 + lane * 8), b = *(const v4u*)(OG + ((size_t)1 * MH + t) * 512 + lane * 8), c = *(const v4u*)(OG + ((size_t)2 * MH + t) * 512 + lane * 8);
            v4u o;
#pragma unroll
            for (int e = 0; e < 4; ++e) o[e] = pk2(w0 * bflo(a[e]) + w1 * bflo(b[e]) + w2 * bflo(c[e]), w0 * bfhi(a[e]) + w1 * bfhi(b[e]) + w2 * bfhi(c[e]));
            *(v4u*)(MIX + (size_t)t * 1024 + lane * 8) = o; }
        {   const v4u a = *(const v4u*)(OF + (size_t)t * 512 + lane * 8), b = *(const v4u*)(OB + (size_t)t * 512 + lane * 8), z = *(const v4u*)(Z + (size_t)t * 512 + lane * 8);
            float ov[8]; float ss = 0.f;
#pragma unroll
            for (int e = 0; e < 4; ++e) { ov[2 * e] = bflo(a[e]) + bflo(b[e]); ov[2 * e + 1] = bfhi(a[e]) + bfhi(b[e]); ss += ov[2 * e] * ov[2 * e] + ov[2 * e + 1] * ov[2 * e + 1]; }
            ss += __shfl_xor(ss, 1); ss += __shfl_xor(ss, 2); ss += __shfl_xor(ss, 4); ss += __shfl_xor(ss, 8);
            const float rs = __builtin_amdgcn_rsqf(ss * (1.0f / 128.0f) + EPS);
            v4u o;
#pragma unroll
            for (int e = 0; e < 4; ++e) { const float n0 = (e < 2) ? nw0[2 * e] : nw1[2 * e - 4], n1 = (e < 2) ? nw0[2 * e + 1] : nw1[2 * e - 3];
                o[e] = pk2(ov[2 * e] * rs * n0 * silu(bflo(z[e])), ov[2 * e + 1] * rs * n1 * silu(bfhi(z[e]))); }
            *(v4u*)(MIX + (size_t)t * 1024 + 512 + lane * 8) = o; }
    }
}
#define XB_TMO      128
#define XB_XCNT(j)  (256  + 64 * (j))
#define XB_XSUB(j)  (1280 + 64 * (j))
#define XB_XGEN(j)  (2304 + 64 * (j))
#define XB_TOP      3328
#define XB_TOPGEN   3392
#define XCD_BAR_WORDS 3456
#define XB_SPIN_CAP (1u << 18)

__device__ __forceinline__ unsigned xb_ld(unsigned* p)              { return __hip_atomic_load(p, __ATOMIC_RELAXED, __HIP_MEMORY_SCOPE_AGENT); }
__device__ __forceinline__ unsigned xb_add(unsigned* p, unsigned v) { return __hip_atomic_fetch_add(p, v, __ATOMIC_RELAXED, __HIP_MEMORY_SCOPE_AGENT); }
__device__ __forceinline__ unsigned xb_xcc_id() { return (unsigned)__builtin_amdgcn_s_getreg((3 << 11) | 20) & 0xFu; }
#define XB_SPIN(cond, bar) do { unsigned _sp = 0; while (cond) { __builtin_amdgcn_s_sleep(1); \
    if ((++_sp & 255u) == 0u) { if (xb_ld(&(bar)[XB_TMO])) break; if (_sp > XB_SPIN_CAP) { atomicAdd(&(bar)[XB_TMO], 1u); break; } } } } while (0)

struct XcdBarrier {
    unsigned* bar; unsigned x;
    volatile LAS unsigned* st;
};

__device__ __forceinline__ XcdBarrier xcd_barrier_post(unsigned* bar, volatile LAS unsigned* st) {
    XcdBarrier b; b.bar = bar; b.x = xb_xcc_id(); b.st = st;
    if (threadIdx.x == 0) (void)xb_add(&bar[XB_XCNT(b.x)], 1u);
    return b;
}
__device__ __forceinline__ void xcd_barrier_complete(unsigned* bar, unsigned x, unsigned& nloc, unsigned& nx) {
    const unsigned G = gridDim.x * gridDim.y * gridDim.z;
    unsigned sum, cnt, mine, sp = 0u;
    for (;;) {
        sum = 0u; cnt = 0u; mine = 0u;
#pragma unroll
        for (unsigned j = 0; j < 16; ++j) { const unsigned c = xb_ld(&bar[XB_XCNT(j)]); sum += c; cnt += (c > 0u) ? 1u : 0u; mine = (j == x) ? c : mine; }
        if (sum == G) break;
        __builtin_amdgcn_s_sleep(1);
        if ((++sp & 255u) == 0u) { if (xb_ld(&bar[XB_TMO])) break; if (sp > XB_SPIN_CAP) { atomicAdd(&bar[XB_TMO], 1u); break; } }
    }
    nloc = mine > 0u ? mine : 1u; nx = cnt > 0u ? cnt : 1u;
}

__device__ __forceinline__ void xcd_barrier(const XcdBarrier& b) {
    asm volatile("s_waitcnt vmcnt(0)" ::: "memory");
    __syncthreads();
    if (threadIdx.x == 0) {
        unsigned* bar = b.bar;
        __builtin_amdgcn_s_waitcnt(0);
        unsigned nloc = b.st[0], nx = b.st[1];
        if (nloc == 0u) { xcd_barrier_complete(bar, b.x, nloc, nx); b.st[0] = nloc; b.st[1] = nx; }
        const unsigned old = xb_add(&bar[XB_XSUB(b.x)], 1u);
        const unsigned gen = old / nloc;
        if (old + 1u == (gen + 1u) * nloc) {
            __builtin_amdgcn_fence(__ATOMIC_RELEASE, "agent");
            asm volatile("s_waitcnt vmcnt(0)" ::: "memory");
            const unsigned og = xb_add(&bar[XB_TOP], 1u);
            const unsigned tg = og / nx;
            if (og + 1u == (tg + 1u) * nx) xb_add(&bar[XB_TOPGEN], 1u);
            else XB_SPIN(xb_ld(&bar[XB_TOPGEN]) == tg, bar);
            __builtin_amdgcn_fence(__ATOMIC_ACQUIRE, "agent");
            xb_add(&bar[XB_XGEN(b.x)], 1u);
            asm volatile("s_waitcnt vmcnt(0)" ::: "memory");
        } else {
            XB_SPIN(xb_ld(&bar[XB_XGEN(b.x)]) == gen, bar);
            __builtin_amdgcn_fence(__ATOMIC_ACQUIRE, "agent");
            asm volatile("s_waitcnt vmcnt(0)" ::: "memory");
        }
    }
    __syncthreads();
}

#ifndef DBG_SKIP_MIXER
#define DBG_SKIP_MIXER 0
#endif
#ifndef MK_MULTI
#define MK_MULTI 0
#endif
constexpr int NPH = 1 + 2 * (2 * 14) + 1 + 1;
static_assert(pg8::EpiProj::OFF_PA == WS_PA && pg8::EpiProj::OFF_PD == WS_PD && pg8::EpiProj::OFF_Z == WS_Z, "EpiProj offsets");
struct Args { const float* in[22]; float* out; unsigned char* ws; int lo, hi; };

__global__ void __launch_bounds__(512, 2) fwd(Args a) {
    extern __shared__ __attribute__((aligned(16))) unsigned char lds_raw[];
    LAS unsigned char* lds = (LAS unsigned char*)lds_raw;
    cg::grid_group grid = cg::this_grid();
    unsigned char* ws = a.ws;
    const int lo = a.lo, hi = a.hi; int pc = 0;
    const float* x_prompt = a.in[0]; const float* x_sample = a.in[1];
    float* MOD = (float*)(ws + WS_MOD); float* ROPE = (float*)(ws + WS_ROPE);
    bf16* H = (bf16*)(ws + WS_H); bf16* ACT = (bf16*)(ws + WS_ACT); bf16* PA = (bf16*)(ws + WS_PA); bf16* PD = (bf16*)(ws + WS_PD); bf16* Zb = (bf16*)(ws + WS_Z);
    bf16* DQ = (bf16*)(ws + WS_DQ); bf16* DK = (bf16*)(ws + WS_DK); bf16* DV = (bf16*)(ws + WS_DV); bf16* OF = (bf16*)(ws + WS_OF); bf16* OB = (bf16*)(ws + WS_OB);
    unsigned char* CH = ws + WS_CH; bf16* OG = (bf16*)(ws + WS_OG); float* LSE = (float*)(ws + WS_LSE); bf16* MIX = (bf16*)(ws + WS_MIX);
    float* AB = (float*)(ws + WS_AB); float* GB = (float*)(ws + WS_GB); float* GC = (float*)(ws + WS_GC);
#define PH_BEGIN if (pc >= lo && pc < hi) {
    { volatile LAS unsigned* st = (volatile LAS unsigned*)(lds + LDS_BYTES - 256); if (pg8::otid() < 2) st[pg8::otid()] = 0u; }
    __syncthreads();
    XcdBarrier bar = xcd_barrier_post((unsigned*)ws, (volatile LAS unsigned*)(lds + LDS_BYTES - 256));
#define PH_END } ++pc; if (pc > lo && pc < hi) { if (pc == 1) grid.sync(); else xcd_barrier(bar); }

    PH_BEGIN
        ph_mod(a.in[2], a.in[3], a.in[4], a.in[5], MOD, lds);
        ph_rope(ROPE);
        ph_wconv(a.in[7], a.in[8], a.in[9], a.in[18], a.in[19], a.in[20], a.in[11], a.in[16], 0, ws, lds);
    PH_END
    for (int layer = 0; layer < 2; ++layer) {
        if (layer == 1) {
            PH_BEGIN ph_wconv(a.in[7], a.in[8], a.in[9], a.in[18], a.in[19], a.in[20], a.in[11], a.in[16], 1, ws, lds); PH_END
        }
        const float* modl = MOD + (size_t)layer * 12 * 9216;
        for (int half = 0; half < 2; ++half) {
            const int S = half ? 8192 : 4096, lgS = half ? 13 : 12;
            float* X = a.out + (size_t)half * MH * D;
            const float* xin0 = half ? x_sample : x_prompt;
            for (int sb = 0; sb < 3; ++sb) {
                if (DBG_SKIP_MIXER && sb == 1) continue;
                const bool first = (layer == 0 && sb == 0);
                const float* xsrc = first ? xin0 : X;
                const float* nw = (sb == 0 ? a.in[6] : (sb == 1 ? a.in[10] : a.in[17])) + layer * D;
                PH_BEGIN ph_norm(xsrc, nw, modl, sb, half, H); PH_END
                if (sb != 1) {
                    PH_BEGIN
                        pg8::Gemm g{H, (const bf16*)(ws + (sb ? WS_WGU2 : WS_WGU1)), MH, 2 * FF, D}; pg8::StaticOrder So; So.init(MH, 2 * FF, gridDim.x, (int)blockIdx.x);
                        pg8::EpiSwiGLU E{ACT, FF};
                        pg8::gemm_phase<pg8::EpiSwiGLU, pg8::StaticOrder, true, true>(lds, g, So, E);
                    PH_END
                    PH_BEGIN
                        pg8::Gemm g{ACT, (const bf16*)(ws + (sb ? WS_WD2 : WS_WD1)), MH, D, FF}; pg8::StaticOrder So; So.init(MH, D, gridDim.x, (int)blockIdx.x);
                        pg8::EpiResid E{xsrc, X, modl + (3 * sb + 2) * 1024, 0.5f, half};
                        pg8::gemm_phase<pg8::EpiResid, pg8::StaticOrder, true, true>(lds, g, So, E);
                    PH_END
                } else {
                    PH_BEGIN
                        pg8::Gemm g{H, (const bf16*)(ws + WS_WIN), MH, NPROJ, D}; pg8::StaticOrder So; So.init(MH, NPROJ, gridDim.x, (int)blockIdx.x);
                        pg8::EpiProj E{ws, AB, ROPE, S - 1};
                        pg8::gemm_phase<pg8::EpiProj, pg8::StaticOrder, true, true>(lds, g, So, E);
                    PH_END
                    PH_BEGIN ph_dnpre(PD, AB, a.in[12] + (size_t)layer * 5 * 1536, a.in[13] + layer * 8, a.in[14] + layer * 8, DQ, DK, DV, GB, S); PH_END
                    PH_BEGIN ph_chunk(DQ, DK, DV, GB, CH, GC, S, lgS, lds); PH_END
                    PH_BEGIN ph_scan(DQ, CH, GC, OF, OB, S, lgS, half, lds); PH_END
                    PH_BEGIN ph_attn(PA, OG, LSE, S, lgS, lds); PH_END
                    PH_BEGIN ph_post(OG, LSE, OF, OB, Zb, a.in[15] + layer * 128, MIX); PH_END
                    PH_BEGIN
                        pg8::Gemm g{MIX, (const bf16*)(ws + WS_WOUT), MH, D, D}; pg8::StaticOrder So; So.init(MH, D, gridDim.x, (int)blockIdx.x);
                        pg8::EpiResid E{X, X, modl + 5 * 1024, 1.0f, half};
                        pg8::gemm_phase<pg8::EpiResid, pg8::StaticOrder, true, true>(lds, g, So, E);
                    PH_END
                }
            }
        }
    }
    PH_BEGIN ph_final(a.out, a.in[21]); PH_END
}

extern "C" void kernel_launch(void* const* d_in, const int* in_sizes, int n_in, void* d_out, int out_size, void* d_ws, size_t ws_size, hipStream_t stream) {
    static int grid = 0;
    if (grid == 0) {
        if (n_in != 22 || ws_size < WS_END) { fprintf(stderr, "kernel_launch: unexpected n_in %d / ws_size %zu\n", n_in, ws_size); grid = -1; return; }
        int dev = 0, cus = 0, per_cu = 0;
        hipGetDevice(&dev); hipDeviceGetAttribute(&cus, hipDeviceAttributeMultiprocessorCount, dev);
        if (hipFuncSetAttribute((const void*)fwd, hipFuncAttributeMaxDynamicSharedMemorySize, LDS_BYTES) != hipSuccess) { fprintf(stderr, "kernel_launch: hipFuncSetAttribute failed\n"); grid = -1; return; }
        if (hipOccupancyMaxActiveBlocksPerMultiprocessor(&per_cu, (const void*)fwd, 512, LDS_BYTES) != hipSuccess || per_cu < 1) { per_cu = 1; (void)hipGetLastError(); }
        grid = cus * per_cu;
        fprintf(stderr, "kernel_launch: grid %d (cus %d x %d), ws %zu MiB\n", grid, cus, per_cu, ws_size >> 20);
    }
    if (grid < 0) return;
    if (hipMemsetAsync(d_ws, 0, 16384, stream) != hipSuccess) { fprintf(stderr, "kernel_launch: memset failed\n"); return; }
    Args a{};
    for (int i = 0; i < 22; ++i) a.in[i] = (const float*)d_in[i];
    a.out = (float*)d_out; a.ws = (unsigned char*)d_ws;
#if MK_MULTI
    for (int p = 0; p < NPH; ++p) { a.lo = p; a.hi = p + 1; hipLaunchKernelGGL(fwd, dim3(grid), dim3(512), LDS_BYTES, stream, a); }
#else
    a.lo = 0; a.hi = NPH;
    void* args[] = {&a};
    hipError_t e = hipLaunchCooperativeKernel((const void*)fwd, dim3(grid), dim3(512), args, LDS_BYTES, stream);
    if (e != hipSuccess) fprintf(stderr, "cooperative launch failed: %s (grid %d)\n", hipGetErrorString(e), grid);
#endif
}
```

```cpp
#include <hip/hip_runtime.h>
#include <hip/hip_cooperative_groups.h>
#include <cstdio>
#include <cstdint>
namespace cg = cooperative_groups;
namespace pg8 {
#define PG8_LAS __attribute__((address_space(3)))
typedef unsigned short bf16_t;
typedef short bf16x8 __attribute__((ext_vector_type(8)));
typedef float f32x4 __attribute__((ext_vector_type(4)));
typedef unsigned u32x4 __attribute__((ext_vector_type(4)));
constexpr int BM = 256, BK = 64, HALF = 128, HTB = HALF * BK * 2  , STAGE_BYTES = 8 * HTB, NXCD = 8, WGM = 8;

__host__ __device__ __forceinline__ int lds_byte(int r, int c) { const int st = (r >> 4) * 2 + (c >> 5), rr = r & 15, cc = c & 31, ob = rr * 64 + cc * 2; return st * 1024 + (ob ^ (((ob >> 9) & 1) << 5)); }
__host__ __device__ __forceinline__ void stage_rc(int b, int& R, int& C) { const int st = b / 1024, sb = b % 1024, swz = sb ^ (((sb >> 9) & 1) << 5); R = (st >> 1) * 16 + swz / 64; C = (st & 1) * 32 + (swz % 64) / 2; }
__host__ __device__ __forceinline__ int perm32(int rho) { const int n = rho >> 4, i = rho & 15; return 8 * (i >> 2) + 4 * n + (i & 3); }

struct Unit { int pm, pn; };
struct Gemm { const bf16_t* A; const bf16_t* Bt; int M, N, K; };

struct StaticOrder {
    int nM, nN, nwg, G, c;
    __host__ __device__ void init(int M, int N, int G_, int c_) { nM = M / BM; nN = N / BM; nwg = nM * nN; G = G_; c = c_; }
    __host__ __device__ bool next(int i, Unit& u) const {
        const long L = (long)i * G + c; if (L >= nwg) return false;
        int wgid = (int)L; { const int q = nwg / NXCD, r = nwg % NXCD, xcd = wgid % NXCD, off = wgid / NXCD; wgid = (xcd < r ? xcd * (q + 1) : r * (q + 1) + (xcd - r) * q) + off; }
        const int nig = WGM * nN, gid = wgid / nig, fm = gid * WGM, gsz = (nM - fm) < WGM ? (nM - fm) : WGM;
        u.pm = fm + ((wgid % nig) % gsz); u.pn = (wgid % nig) / gsz; return true;
    }
    __device__ __forceinline__ void a_ready(const Unit&) const {}
    __device__ __forceinline__ void done(const Unit&) const {}
};
typedef __bf16 bf16x2_t __attribute__((ext_vector_type(2)));
typedef float f32x2_t __attribute__((ext_vector_type(2)));
__device__ __forceinline__ unsigned cvt_pk_bf16(float lo, float hi) { unsigned r; asm volatile("v_cvt_pk_bf16_f32 %0, %1, %2" : "=v"(r) : "v"(lo), "v"(hi)); return r; }
__device__ __forceinline__ unsigned cvt_pk_bf16_cv(float lo, float hi) { const f32x2_t v = {lo, hi}; const bf16x2_t b = __builtin_convertvector(v, bf16x2_t); return __builtin_bit_cast(unsigned, b); }
__device__ __forceinline__ int otid() { int t = threadIdx.x; asm volatile("" : "+v"(t)); return t; }
__device__ __forceinline__ float silu_f(float v) { return v * __builtin_amdgcn_rcpf(1.0f + __expf(-v)); }

#define EPI_PIN(p) asm volatile("" : "+v"(p))
struct EpiSwiGLU {
    static constexpr bool PERM = true, AFTER_DRAIN = false;
    bf16_t* O; int ldc;
    __device__ __forceinline__ void operator()(const f32x4 (&acc)[2][2][4][2], const Unit& u, int wr, int wc, int fr, int fq) const {
        const int row0 = u.pm * BM + wr * 64 + fr, col0 = u.pn * 128 + wc * 32 + 8 * fq;
        bf16_t* rowp = O + (size_t)row0 * ldc + col0;
#pragma unroll
        for (int ai = 0; ai < 2; ++ai) {
#pragma unroll
            for (int m = 0; m < 4; ++m) {
                const f32x4 g0 = acc[ai][0][m][0], g1 = acc[ai][0][m][1], u0 = acc[ai][1][m][0], u1 = acc[ai][1][m][1];
                u32x4 w;
                w.x = cvt_pk_bf16(silu_f(g0[0]) * u0[0], silu_f(g0[1]) * u0[1]); w.y = cvt_pk_bf16(silu_f(g0[2]) * u0[2], silu_f(g0[3]) * u0[3]);
                w.z = cvt_pk_bf16(silu_f(g1[0]) * u1[0], silu_f(g1[1]) * u1[1]); w.w = cvt_pk_bf16(silu_f(g1[2]) * u1[2], silu_f(g1[3]) * u1[3]);
                *(u32x4*)rowp = w;
                rowp += (size_t)16 * ldc; EPI_PIN(rowp);
            }
            rowp += (size_t)64 * ldc; EPI_PIN(rowp);
        }
    }
};
struct EpiResid {
    static constexpr bool PERM = false, AFTER_DRAIN = false;
    const float* xin; float* xout; const float* gate; float scale; int half;
    __device__ __forceinline__ void operator()(const f32x4 (&acc)[2][2][4][2], const Unit& u, int wr, int wc, int fr, int fq) const {
        const int row0 = u.pm * BM + wr * 64 + fr, col0 = u.pn * BM + wc * 32 + 4 * fq;
        const int batch = half ? 8 + (u.pm >> 5) : (u.pm >> 4);
        const float* gp = gate + (size_t)batch * 9216 + col0;
        f32x4 gv[2][2];
#pragma unroll
        for (int bj = 0; bj < 2; ++bj)
#pragma unroll
            for (int n = 0; n < 2; ++n) gv[bj][n] = *(const f32x4*)(gp + bj * HALF + n * 16) * scale;
        const float* lp = xin + (size_t)row0 * 1024 + col0; float* op = xout + (size_t)row0 * 1024 + col0;
        f32x4 xb[4][2][2];
#define EPI_LD(slot) do { _Pragma("unroll") for (int bj = 0; bj < 2; ++bj) _Pragma("unroll") for (int n = 0; n < 2; ++n) xb[slot][bj][n] = *(const f32x4*)(lp + bj * HALF + n * 16); } while (0)
#define EPI_LADV(grp) do { lp += (((grp) & 3) == 3 ? 80 : 16) * 1024; EPI_PIN(lp); } while (0)
        EPI_LD(0); EPI_LADV(0); EPI_LD(1); EPI_LADV(1); EPI_LD(2); EPI_LADV(2); EPI_LD(3); EPI_LADV(3);
#pragma unroll
        for (int grp = 0; grp < 8; ++grp) { const int ai = grp >> 2, m = grp & 3, slot = grp & 3;
#pragma unroll
            for (int bj = 0; bj < 2; ++bj)
#pragma unroll
                for (int n = 0; n < 2; ++n) *(f32x4*)(op + bj * HALF + n * 16) = xb[slot][bj][n] + gv[bj][n] * acc[ai][bj][m][n];
            op += (m == 3 ? 80 : 16) * 1024; EPI_PIN(op);
            if (grp + 4 < 8) { EPI_LD(slot); EPI_LADV(grp + 4); }
        }
#undef EPI_LD
#undef EPI_LADV
    }
};
struct EpiProj {
    static constexpr bool PERM = true, AFTER_DRAIN = false;
    static constexpr size_t OFF_PA = (size_t)144 << 20, OFF_PD = (size_t)272 << 20, OFF_Z = (size_t)240 << 20;
    unsigned char* wsb; float* AB; const float* rope; int smask;
    __device__ __forceinline__ void operator()(const f32x4 (&acc)[2][2][4][2], const Unit& u, int wr, int wc, int fr, int fq) const {
        const int row0 = u.pm * BM + wr * 64 + fr, pn = u.pn;
        if (pn < 14) {
            const size_t poff = pn < 6 ? OFF_PA : (pn < 12 ? OFF_PD : OFF_Z); bf16_t* P = (bf16_t*)(wsb + poff); const int ldp = pn < 12 ? 1536 : 512;
            const int col0 = (pn < 6 ? pn : (pn < 12 ? pn - 6 : pn - 12)) * 256 + wc * 32 + 8 * fq;
            const bool rot = (pn < 4) && ((wc & 1) == 0) && (fq < 2);
            const float sgn = (fq & 1) ? 1.f : -1.f;
            bf16_t* rowp = P + (size_t)row0 * ldp + col0; int row = row0;
#pragma unroll
            for (int ai = 0; ai < 2; ++ai) {
#pragma unroll
                for (int m = 0; m < 4; ++m) {
                    f32x4 c0 = {0.f, 0.f, 0.f, 0.f}, c1 = c0, s0 = c0, s1 = c0;
                    if (pn < 4) { const float* rp = rope + (size_t)(row & smask) * 16; c0 = *(const f32x4*)rp; c1 = *(const f32x4*)(rp + 4); s0 = *(const f32x4*)(rp + 8); s1 = *(const f32x4*)(rp + 12); }
#pragma unroll
                    for (int bj = 0; bj < 2; ++bj) { f32x4 v0 = acc[ai][bj][m][0], v1 = acc[ai][bj][m][1];
                        if (pn < 4) { f32x4 p0, p1;
#pragma unroll
                            for (int j = 0; j < 4; ++j) {
                                const auto s0 = __builtin_amdgcn_permlane16_swap(__float_as_uint(v0[j]), __float_as_uint(v0[j]), false, false), s1 = __builtin_amdgcn_permlane16_swap(__float_as_uint(v1[j]), __float_as_uint(v1[j]), false, false);
                                p0[j] = __uint_as_float((fq & 1) ? s0[0] : s0[1]); p1[j] = __uint_as_float((fq & 1) ? s1[0] : s1[1]); }
                            const f32x4 r0 = v0 * c0 + sgn * (p0 * s0), r1 = v1 * c1 + sgn * (p1 * s1);
                            if (rot) { v0 = r0; v1 = r1; } }
                        u32x4 w; w.x = cvt_pk_bf16(v0[0], v0[1]); w.y = cvt_pk_bf16(v0[2], v0[3]); w.z = cvt_pk_bf16(v1[0], v1[1]); w.w = cvt_pk_bf16(v1[2], v1[3]);
                        *(u32x4*)(rowp + bj * HALF) = w; }
                    rowp += (size_t)16 * ldp; row += 16; EPI_PIN(rowp); EPI_PIN(row);
                    asm volatile("" ::: "memory"); }
                rowp += (size_t)64 * ldp; row += 64; EPI_PIN(rowp); EPI_PIN(row);
            }
        } else {
            if (wc == 0 && fq < 2) {
                float* ap = AB + (size_t)row0 * 16 + 8 * fq;
#pragma unroll
                for (int ai = 0; ai < 2; ++ai) {
#pragma unroll
                    for (int m = 0; m < 4; ++m) { *(f32x4*)ap = acc[ai][0][m][0]; *(f32x4*)(ap + 4) = acc[ai][0][m][1]; ap += 16 * 16; EPI_PIN(ap); }
                    ap += 64 * 16; EPI_PIN(ap); }
            }
        }
    }
};

template <class Epi, class Sched, bool ALIGN_EPI = false, bool SP2 = false>
__device__ __forceinline__ void gemm_phase(PG8_LAS unsigned char* lds, const Gemm g, const Sched& S, const Epi& E) {
    const int tid = otid(), wid = __builtin_amdgcn_readfirstlane(tid >> 6), lane = tid & 63, wr = wid >> 2, wc = wid & 3, fr = lane & 15, fq = lane >> 4;
    const int K = g.K, nt = K / BK;
    unsigned voffA[2], voffB[2];
#pragma unroll
    for (int i = 0; i < 2; ++i) { int R, C; stage_rc(tid * 16 + i * 8192, R, C); const int Rb = Epi::PERM ? ((R & ~31) + perm32(R & 31)) : R;
        voffA[i] = (unsigned)(R * K + C) * 2u; voffB[i] = (unsigned)(Rb * K + C) * 2u; }
    const size_t kstep = (size_t)(BK * 2);
    const size_t hstep = (size_t)HALF * K * 2;
    const size_t tstep = 2 * hstep;
    const unsigned ldsw = (unsigned)wid * 1024u;
    const int aoff = lds_byte(wr * 64 + fr, fq * 8), boff = lds_byte(wc * 32 + fr, fq * 8);
#define PG8_SA(b, h) (((b) * 2 + (h)) * HTB)
#define PG8_SB(b, h) ((4 + (b) * 2 + (h)) * HTB)
#define PG8_STAGE(bufoff, gbase, voff) do { _Pragma("unroll") for (int _i = 0; _i < 2; ++_i) \
        __builtin_amdgcn_global_load_lds((const unsigned*)((const char*)(gbase) + (voff)[_i]), (PG8_LAS unsigned*)(lds + (bufoff) + ldsw + _i * 8192), 16, 0, 0); } while (0)
#define PG8_LDA(dst, b, h) do { _Pragma("unroll") for (int m = 0; m < 4; ++m) _Pragma("unroll") for (int k = 0; k < 2; ++k) dst[m][k] = *(const PG8_LAS bf16x8*)(lds + PG8_SA(b, h) + aoff + m * 2048 + k * 1024); } while (0)
#define PG8_LDB(dst, b, h) do { _Pragma("unroll") for (int n = 0; n < 2; ++n) _Pragma("unroll") for (int k = 0; k < 2; ++k) dst[n][k] = *(const PG8_LAS bf16x8*)(lds + PG8_SB(b, h) + boff + n * 2048 + k * 1024); } while (0)
#define PG8_MMA(ai, bj, At, Bt) do { __builtin_amdgcn_s_setprio(1); _Pragma("unroll") for (int m = 0; m < 4; ++m) _Pragma("unroll") for (int n = 0; n < 2; ++n) _Pragma("unroll") for (int k = 0; k < 2; ++k) \
        acc[ai][bj][m][n] = __builtin_amdgcn_mfma_f32_16x16x32_bf16(Bt[n][k], At[m][k], acc[ai][bj][m][n], 0, 0, 0); __builtin_amdgcn_s_setprio(0); } while (0)
#define PG8_WAIT_V(n) asm volatile("s_waitcnt vmcnt(" #n ")" ::: "memory")
#define PG8_WAIT_L(n) asm volatile("s_waitcnt lgkmcnt(" #n ")" ::: "memory")
#define PG8_BAR __builtin_amdgcn_s_barrier()
#define PG8_SCHED __builtin_amdgcn_sched_barrier(0)
    Unit cur, nxt; int ui = 0;
    if (!S.next(0, cur)) return;
    f32x4 acc[2][2][4][2];
#pragma unroll
    for (int a = 0; a < 2; ++a)
#pragma unroll
        for (int b = 0; b < 2; ++b)
#pragma unroll
            for (int m = 0; m < 4; ++m)
#pragma unroll
                for (int n = 0; n < 2; ++n) acc[a][b][m][n] = (f32x4){0.f, 0.f, 0.f, 0.f};
    bf16x8 At[4][2], B0[2][2], B1[2][2];
    const char* cA = (const char*)g.A + (size_t)cur.pm * tstep; const char* cB = (const char*)g.Bt + (size_t)cur.pn * tstep;
    S.a_ready(cur);
    if constexpr (SP2) {
        PG8_STAGE(PG8_SB(0, 0), cB, voffB); PG8_STAGE(PG8_SB(0, 1), cB + hstep, voffB); PG8_STAGE(PG8_SA(0, 0), cA, voffA); PG8_STAGE(PG8_SA(0, 1), cA + hstep, voffA);
        if (wr == 1) PG8_BAR;
        PG8_WAIT_V(2); PG8_BAR;
        PG8_STAGE(PG8_SB(1, 0), cB + kstep, voffB); PG8_STAGE(PG8_SA(1, 0), cA + kstep, voffA); PG8_STAGE(PG8_SB(1, 1), cB + hstep + kstep, voffB);
        PG8_WAIT_V(6); PG8_BAR;
    } else {
        PG8_STAGE(PG8_SB(0, 0), cB, voffB); PG8_STAGE(PG8_SA(0, 0), cA, voffA); PG8_STAGE(PG8_SB(0, 1), cB + hstep, voffB); PG8_STAGE(PG8_SA(0, 1), cA + hstep, voffA);
        if (wr == 1) PG8_BAR;
        PG8_WAIT_V(4); PG8_BAR;
        PG8_STAGE(PG8_SB(1, 0), cB + kstep, voffB); PG8_STAGE(PG8_SA(1, 0), cA + kstep, voffA); PG8_STAGE(PG8_SB(1, 1), cB + hstep + kstep, voffB);
        PG8_WAIT_V(6); PG8_BAR;
    }
    for (;;) {
        const bool has_next = S.next(ui + 1, nxt);
        const char* nA = has_next ? (const char*)g.A + (size_t)nxt.pm * tstep : cA; const char* nB = has_next ? (const char*)g.Bt + (size_t)nxt.pn * tstep : cB;
        for (int t = 0; t < nt; t += 2) {
            const bool last = (t == nt - 2);
            const char* a1 = cA + (size_t)(t + 1) * kstep;
            const char* a2 = last ? nA : cA + (size_t)(t + 2) * kstep; const char* b2 = last ? nB : cB + (size_t)(t + 2) * kstep;
            const char* a3 = a2 + kstep; const char* b3 = b2 + kstep;
            if (last && has_next) S.a_ready(nxt);
            if constexpr (SP2) {
            PG8_LDB(B0, 0, 0); PG8_LDB(B1, 0, 1); PG8_SCHED; PG8_LDA(At, 0, 0); PG8_STAGE(PG8_SA(1, 1), a1 + hstep, voffA);
            PG8_WAIT_V(8); PG8_WAIT_L(0); PG8_BAR; PG8_MMA(0, 0, At, B0); PG8_MMA(0, 1, At, B1); PG8_BAR; PG8_SCHED;
            PG8_LDA(At, 0, 1); PG8_STAGE(PG8_SB(0, 0), b2, voffB); PG8_STAGE(PG8_SB(0, 1), b2 + hstep, voffB); PG8_STAGE(PG8_SA(0, 0), a2, voffA);
            PG8_WAIT_V(8); PG8_WAIT_L(0); PG8_BAR; PG8_MMA(1, 0, At, B0); PG8_MMA(1, 1, At, B1); PG8_BAR; PG8_SCHED;
            PG8_LDB(B0, 1, 0); PG8_LDB(B1, 1, 1); PG8_SCHED; PG8_LDA(At, 1, 0); PG8_STAGE(PG8_SA(0, 1), a2 + hstep, voffA);
            PG8_WAIT_V(8); PG8_WAIT_L(0); PG8_BAR; PG8_MMA(0, 0, At, B0); PG8_MMA(0, 1, At, B1); PG8_BAR; PG8_SCHED;
            PG8_LDA(At, 1, 1); PG8_STAGE(PG8_SB(1, 0), b3, voffB); PG8_STAGE(PG8_SB(1, 1), b3 + hstep, voffB); PG8_STAGE(PG8_SA(1, 0), a3, voffA);
            PG8_WAIT_V(8); PG8_WAIT_L(0); PG8_BAR; PG8_MMA(1, 0, At, B0); PG8_MMA(1, 1, At, B1); PG8_BAR; PG8_SCHED;
            } else {
            PG8_LDB(B0, 0, 0); PG8_SCHED; PG8_LDA(At, 0, 0); PG8_STAGE(PG8_SA(1, 1), a1 + hstep, voffA);
            PG8_WAIT_L(8); PG8_BAR; PG8_WAIT_L(0); PG8_MMA(0, 0, At, B0); PG8_BAR; PG8_SCHED;
            PG8_LDB(B1, 0, 1); PG8_STAGE(PG8_SB(0, 0), b2, voffB);
            PG8_BAR; PG8_WAIT_L(0); PG8_MMA(0, 1, At, B1); PG8_BAR;
            PG8_LDA(At, 0, 1); PG8_STAGE(PG8_SA(0, 0), a2, voffA);
            PG8_BAR; PG8_WAIT_L(0); PG8_MMA(1, 0, At, B0); PG8_BAR; PG8_SCHED;
            PG8_STAGE(PG8_SB(0, 1), b2 + hstep, voffB);
            PG8_WAIT_V(6); PG8_BAR; PG8_MMA(1, 1, At, B1); PG8_BAR;
            PG8_LDB(B0, 1, 0); PG8_SCHED; PG8_LDA(At, 1, 0); PG8_STAGE(PG8_SA(0, 1), a2 + hstep, voffA);
            PG8_WAIT_L(8); PG8_BAR; PG8_WAIT_L(0); PG8_MMA(0, 0, At, B0); PG8_BAR; PG8_SCHED;
            PG8_LDB(B1, 1, 1); PG8_STAGE(PG8_SB(1, 0), b3, voffB);
            PG8_BAR; PG8_WAIT_L(0); PG8_MMA(0, 1, At, B1); PG8_BAR;
            PG8_LDA(At, 1, 1); PG8_STAGE(PG8_SA(1, 0), a3, voffA);
            PG8_BAR; PG8_WAIT_L(0); PG8_MMA(1, 0, At, B0); PG8_BAR; PG8_SCHED;
            PG8_STAGE(PG8_SB(1, 1), b3 + hstep, voffB);
            PG8_WAIT_V(6); PG8_BAR; PG8_MMA(1, 1, At, B1); PG8_BAR;
            }
        }
        if constexpr (ALIGN_EPI) { if (wr == 0) PG8_BAR; }
        if constexpr (!Epi::AFTER_DRAIN) { E(acc, cur, wr, wc, fr, fq); S.done(cur); }
        if (!has_next) break;
#pragma unroll
        for (int a = 0; a < 2; ++a)
#pragma unroll
            for (int b = 0; b < 2; ++b)
#pragma unroll
                for (int m = 0; m < 4; ++m)
#pragma unroll
                    for (int n = 0; n < 2; ++n) acc[a][b][m][n] = (f32x4){0.f, 0.f, 0.f, 0.f};
        cur = nxt; cA = nA; cB = nB; ++ui;
        if constexpr (ALIGN_EPI) { if (wr == 1) PG8_BAR; }
    }
    PG8_WAIT_V(0);
    if constexpr (!ALIGN_EPI) { if (wr == 0) PG8_BAR; }
    PG8_BAR;
    if constexpr (Epi::AFTER_DRAIN) { E.fused(acc, cur, wr, wc, fr, fq, lds, wid, lane); S.done(cur); }
#undef PG8_SA
#undef PG8_SB
#undef PG8_STAGE
#undef PG8_LDA
#undef PG8_LDB
#undef PG8_MMA
#undef PG8_WAIT_V
#undef PG8_WAIT_L
#undef PG8_BAR
#undef PG8_SCHED
}
}

#define LAS __attribute__((address_space(3)))
typedef unsigned short bf16;
typedef short bf16x8 __attribute__((ext_vector_type(8)));
typedef short s16x4 __attribute__((ext_vector_type(4)));
typedef float f32x4 __attribute__((ext_vector_type(4)));
typedef unsigned v4u __attribute__((ext_vector_type(4)));
typedef unsigned v2u __attribute__((ext_vector_type(2)));
#define MFMA16(a, b, c) __builtin_amdgcn_mfma_f32_16x16x32_bf16((a), (b), (c), 0, 0, 0)
#define CAT8(lo, hi) __builtin_shufflevector((lo), (hi), 0, 1, 2, 3, 4, 5, 6, 7)
#define LDS_WAIT() asm volatile("s_waitcnt lgkmcnt(0)" ::: "memory")

constexpr int D = 1024, FF = 2816, MH = 32768, NPROJ = 3840, INW = 3600;
constexpr float EPS = 1e-6f;
constexpr size_t MiB = 1u << 20;
constexpr size_t WS_MOD = 1 * MiB, WS_ROPE = 2 * MiB;
constexpr size_t WS_WGU1 = 4 * MiB, WS_WD1 = 15 * MiB, WS_WIN = 15 * MiB + 5632 * 1024, WS_WOUT = 28 * MiB, WS_WGU2 = 30 * MiB, WS_WD2 = 41 * MiB;
constexpr size_t WS_H = 48 * MiB, WS_DQ = 48 * MiB, WS_DK = 80 * MiB, WS_DV = 112 * MiB, WS_OF = 80 * MiB, WS_OB = 112 * MiB;
constexpr size_t WS_ACT = 112 * MiB, WS_PA = 144 * MiB, WS_Z = 240 * MiB, WS_CH = 272 * MiB, WS_PD = 272 * MiB, WS_OG = 272 * MiB, WS_LSE = 368 * MiB, WS_MIX = 374 * MiB;
constexpr size_t WS_AB = 496 * MiB, WS_GB = 498 * MiB, WS_GC = 500 * MiB, WS_END = 501 * MiB;
constexpr int LDS_BYTES = 163840;
constexpr int CHJOB = 57344;

__device__ __forceinline__ float bf2f(unsigned short v) { return __uint_as_float(((unsigned)v) << 16); }
__device__ __forceinline__ float bflo(unsigned w) { return __uint_as_float(w << 16); }
__device__ __forceinline__ float bfhi(unsigned w) { return __uint_as_float(w & 0xffff0000u); }
__device__ __forceinline__ unsigned pk2(float lo, float hi) { return pg8::cvt_pk_bf16(lo, hi); }
__device__ __forceinline__ float opaque_one() { float o = 1.0f; asm volatile("" : "+v"(o)); return o; }
__device__ __forceinline__ float silu(float v) { return v * __builtin_amdgcn_rcpf(1.0f + __expf(-v)); }
__device__ __forceinline__ float xmax16(float x) { auto r = __builtin_amdgcn_permlane16_swap(__float_as_uint(x), __float_as_uint(x), false, false); return fmaxf(__uint_as_float(r[0]), __uint_as_float(r[1])); }
__device__ __forceinline__ float xmax32(float x) { auto r = __builtin_amdgcn_permlane32_swap(__float_as_uint(x), __float_as_uint(x), false, false); return fmaxf(__uint_as_float(r[0]), __uint_as_float(r[1])); }
__device__ __forceinline__ float xsum16(float x) { auto r = __builtin_amdgcn_permlane16_swap(__float_as_uint(x), __float_as_uint(x), false, false); return __uint_as_float(r[0]) + __uint_as_float(r[1]); }
__device__ __forceinline__ float xsum32(float x) { auto r = __builtin_amdgcn_permlane32_swap(__float_as_uint(x), __float_as_uint(x), false, false); return __uint_as_float(r[0]) + __uint_as_float(r[1]); }
__device__ __forceinline__ float wave_sum(float v) {
#pragma unroll
    for (int o = 1; o < 64; o <<= 1) v += __shfl_xor(v, o);
    return v;
}
__device__ __forceinline__ bf16x8 pack8(const f32x4 a, const f32x4 b) {
    v4u w; w.x = pk2(a[0], a[1]); w.y = pk2(a[2], a[3]); w.z = pk2(b[0], b[1]); w.w = pk2(b[2], b[3]);
    return __builtin_bit_cast(bf16x8, w);
}
__device__ __forceinline__ bf16x8 pack8cv(const f32x4 a, const f32x4 b) {
    v4u w; w.x = pg8::cvt_pk_bf16_cv(a[0], a[1]); w.y = pg8::cvt_pk_bf16_cv(a[2], a[3]); w.z = pg8::cvt_pk_bf16_cv(b[0], b[1]); w.w = pg8::cvt_pk_bf16_cv(b[2], b[3]);
    return __builtin_bit_cast(bf16x8, w);
}
__device__ __forceinline__ f32x4 ld_bf4(const bf16* p) { const v2u w = *(const v2u*)p; return (f32x4){bflo(w.x), bfhi(w.x), bflo(w.y), bfhi(w.y)}; }

__device__ __forceinline__ void ph_mod(const float* c_prompt, const float* c_sample, const float* ada_w, const float* ada_b, float* MOD, LAS unsigned char* lds) {
    const int tid = pg8::otid(), lane = tid & 63, wave = tid >> 6;
    LAS float* sc = (LAS float*)lds;
    LAS float* red = (LAS float*)(lds + 49152);
    for (int i = tid; i < 12 * 1024; i += 512) { const int b = i >> 10, k = i & 1023; const float v = b < 8 ? c_prompt[b * 1024 + k] : c_sample[(b - 8) * 1024 + k]; sc[i] = silu(v); }
    __syncthreads();
    const int cl = tid & 7, kg = tid >> 3;
    for (int item = blockIdx.x; item < 576; item += gridDim.x) {
        const int layer = item / 288, cg32 = item % 288, col = cg32 * 32 + cl * 4;
        float acc[12][4];
#pragma unroll
        for (int b = 0; b < 12; ++b)
#pragma unroll
            for (int j = 0; j < 4; ++j) acc[b][j] = 0.f;
        const float* wp = ada_w + (size_t)layer * 1024 * 9216 + col;
#pragma unroll 4
        for (int kk = 0; kk < 16; ++kk) { const int k = kg * 16 + kk; const f32x4 w = *(const f32x4*)(wp + (size_t)k * 9216);
#pragma unroll
            for (int b = 0; b < 12; ++b) { const float s = sc[b * 1024 + k];
#pragma unroll
                for (int j = 0; j < 4; ++j) acc[b][j] += s * w[j]; } }
#pragma unroll
        for (int b = 0; b < 12; ++b)
#pragma unroll
            for (int j = 0; j < 4; ++j) { float v = acc[b][j]; v += __shfl_xor(v, 8); v += __shfl_xor(v, 16); v += __shfl_xor(v, 32); if ((lane >> 3) == 0) red[(wave * 8 + cl) * 48 + b * 4 + j] = v; }
        __syncthreads();
        if (tid < 384) { const int b = tid >> 5, c = tid & 31; float s = 0.f;
#pragma unroll
            for (int w = 0; w < 8; ++w) s += red[(w * 8 + (c >> 2)) * 48 + b * 4 + (c & 3)];
            MOD[(size_t)(layer * 12 + b) * 9216 + cg32 * 32 + c] = s + ada_b[layer * 9216 + cg32 * 32 + c]; }
        __syncthreads();
    }
}
__device__ __forceinline__ void ph_rope(float* ROPE) {
    for (int idx = blockIdx.x * 512 + pg8::otid(); idx < 8192 * 8; idx += gridDim.x * 512) {
        const int s = idx >> 3, i = idx & 7;
        const float inv = exp2f(-(float)i * 0.125f * 18.931568569324174f);
        const float ang = (float)s * inv;
        double rev = (double)ang * 0.15915494309189535; rev -= __builtin_rint(rev);
        const float fr = (float)rev;
        ROPE[s * 16 + i] = __builtin_amdgcn_cosf(fr); ROPE[s * 16 + 8 + i] = __builtin_amdgcn_sinf(fr);
    }
}
__device__ __forceinline__ void tr_item(const float* W, int K, int N, bf16* WT, int k0, int n0, int dst_row0, LAS float* scr, int lane) {
#pragma unroll 8
    for (int i = 0; i < 32; ++i) { const int kk = 2 * i + (lane >> 5), n = n0 + (lane & 31); scr[kk * 33 + (lane & 31)] = (n < N) ? W[(size_t)(k0 + kk) * N + n] : 0.f; }
    LDS_WAIT();
    const int c = lane & 7;
#pragma unroll
    for (int j = 0; j < 4; ++j) { const int n = (lane >> 3) + 8 * j; const LAS float* s = scr + (8 * c) * 33 + n;
        v4u o; o.x = pk2(s[0 * 33], s[1 * 33]); o.y = pk2(s[2 * 33], s[3 * 33]); o.z = pk2(s[4 * 33], s[5 * 33]); o.w = pk2(s[6 * 33], s[7 * 33]);
        *(v4u*)(WT + (size_t)(dst_row0 + n) * K + k0 + 8 * c) = o; }
    LDS_WAIT();
}
__device__ __forceinline__ void ph_wconv(const float* wg1, const float* wu1, const float* wd1, const float* wg2, const float* wu2, const float* wd2, const float* win, const float* wout,
                                         int layer, unsigned char* ws, LAS unsigned char* lds) {
    const int tid_ = pg8::otid(), lane = tid_ & 63, wave = tid_ >> 6;
    LAS float* scr = (LAS float*)(lds + wave * 16384);
    const int gw = blockIdx.x * 8 + wave, NGW = gridDim.x * 8;
    constexpr int I_GU = 16 * 88, I_DN = 44 * 32, I_IN = 16 * 120, I_OUT = 16 * 32;
    constexpr int NIT = 6 * I_GU + I_IN + I_OUT;
    static_assert(I_DN == I_GU, "item counts");
    for (int it = gw; it < NIT; it += NGW) {
        int r = it;
        if (r < 6 * I_GU) {
            const int which = r / I_GU; r -= which * I_GU;
            const int f = which / 3, t = which % 3;
            if (t < 2) { const float* W = (f ? (t ? wu2 : wg2) : (t ? wu1 : wg1)) + (size_t)layer * D * FF; bf16* WT = (bf16*)(ws + (f ? WS_WGU2 : WS_WGU1));
                const int kb = r / 88, nb = r % 88, n0 = nb * 32; tr_item(W, D, FF, WT, kb * 64, n0, (n0 >> 7) * 256 + t * 128 + (n0 & 127), scr, lane); }
            else { const float* W = (f ? wd2 : wd1) + (size_t)layer * D * FF; bf16* WT = (bf16*)(ws + (f ? WS_WD2 : WS_WD1));
                const int kb = r / 32, nb = r % 32; tr_item(W, FF, D, WT, kb * 64, nb * 32, nb * 32, scr, lane); }
            continue;
        }
        r -= 6 * I_GU;
        if (r < I_IN) { const int kb = r / 120, nb = r % 120; tr_item(win + (size_t)layer * D * INW, D, INW, (bf16*)(ws + WS_WIN), kb * 64, nb * 32, nb * 32, scr, lane); continue; }
        r -= I_IN;
        { const int kb = r / 32, nb = r % 32; tr_item(wout + (size_t)layer * D * D, D, D, (bf16*)(ws + WS_WOUT), kb * 64, nb * 32, nb * 32, scr, lane); }
    }
}
__device__ __forceinline__ void ph_norm(const float* x, const float* nw, const float* modl, int sb, int half, bf16* H) {
    const int tid_ = pg8::otid(), lane = tid_ & 63, wave = tid_ >> 6;
    const int gw = blockIdx.x * 8 + wave, NGW = gridDim.x * 8;
    for (int r0 = gw * 16; r0 < MH; r0 += NGW * 16) {
        const int batch = half ? 8 + (r0 >> 13) : (r0 >> 12);
        const float* mp = modl + (size_t)batch * 9216 + sb * 3072;
        f32x4 A[4], B[4];
#pragma unroll
        for (int j = 0; j < 4; ++j) { const int c = 4 * lane + 256 * j; const f32x4 w = *(const f32x4*)(nw + c), sh = *(const f32x4*)(mp + c), scl = *(const f32x4*)(mp + 1024 + c); A[j] = w * (1.0f + scl); B[j] = sh; }
        for (int r = r0; r < r0 + 16; ++r) {
            const f32x4* xr = (const f32x4*)(x + (size_t)r * D) + lane;
            f32x4 v[4]; float s = 0.f;
#pragma unroll
            for (int j = 0; j < 4; ++j) { v[j] = xr[64 * j]; s += (v[j].x * v[j].x + v[j].y * v[j].y) + (v[j].z * v[j].z + v[j].w * v[j].w); }
            const float rstd = __builtin_amdgcn_rsqf(wave_sum(s) * (1.f / D) + EPS);
            v2u* o8 = (v2u*)(H + (size_t)r * D) + lane;
#pragma unroll
            for (int j = 0; j < 4; ++j) { const f32x4 h = v[j] * rstd * A[j] + B[j]; v2u w; w.x = pk2(h.x, h.y); w.y = pk2(h.z, h.w); o8[64 * j] = w; }
        }
    }
}
__device__ __forceinline__ void ph_final(float* x, const float* nw) {
    const int tid_ = pg8::otid(), lane = tid_ & 63, wave = tid_ >> 6;
    const int gw = blockIdx.x * 8 + wave, NGW = gridDim.x * 8;
    f32x4 A[4];
#pragma unroll
    for (int j = 0; j < 4; ++j) A[j] = *(const f32x4*)(nw + 4 * lane + 256 * j);
    for (int r = gw; r < 2 * MH; r += NGW) {
        f32x4* xr = (f32x4*)(x + (size_t)r * D) + lane;
        f32x4 v[4]; float s = 0.f;
#pragma unroll
        for (int j = 0; j < 4; ++j) { v[j] = xr[64 * j]; s += (v[j].x * v[j].x + v[j].y * v[j].y) + (v[j].z * v[j].z + v[j].w * v[j].w); }
        const float rstd = __builtin_amdgcn_rsqf(wave_sum(s) * (1.f / D) + EPS);
#pragma unroll
        for (int j = 0; j < 4; ++j) xr[64 * j] = v[j] * rstd * A[j];
    }
}
__device__ __forceinline__ void ph_dnpre(const bf16* PD, const float* AB, const float* conv_w, const float* a_log, const float* dt_bias,
                                         bf16* DQ, bf16* DK, bf16* DV, float* GB, int S) {
    const int tid_ = pg8::otid(), lane = tid_ & 63, wave = tid_ >> 6;
    const int gw = blockIdx.x * 8 + wave, NGW = gridDim.x * 8;
    for (int t0 = gw * 16; t0 < MH; t0 += NGW * 16) {
        const int s0 = t0 & (S - 1);
        for (int part = 0; part < 3; ++part) {
            const bf16* src = PD + part * 512 + lane * 8;
            bf16* dst = (part == 0 ? DQ : (part == 1 ? DK : DV)) + lane * 8;
            f32x4 w[5][2];
#pragma unroll
            for (int j = 0; j < 5; ++j) { const float* wp = conv_w + j * 1536 + part * 512 + lane * 8; w[j][0] = *(const f32x4*)wp; w[j][1] = *(const f32x4*)(wp + 4); }
            v4u r0, r1, r2, r3, r4;
            const v4u zero = {0u, 0u, 0u, 0u};
#define ROWLD(off) (((unsigned)(s0 + (off)) < (unsigned)S) ? *(const v4u*)(src + (size_t)(t0 + (off)) * 1536) : zero)
            r0 = ROWLD(-2); r1 = ROWLD(-1); r2 = ROWLD(0); r3 = ROWLD(1);
            for (int i = 0; i < 16; ++i) {
                r4 = ROWLD(i + 2);
                f32x4 y0, y1;
#define TAP(rr, j, first) { const f32x4 a = {bflo(rr.x), bfhi(rr.x), bflo(rr.y), bfhi(rr.y)}, b = {bflo(rr.z), bfhi(rr.z), bflo(rr.w), bfhi(rr.w)}; \
                    if (first) { y0 = a * w[j][0]; y1 = b * w[j][1]; } else { y0 += a * w[j][0]; y1 += b * w[j][1]; } }
                TAP(r0, 0, true) TAP(r1, 1, false) TAP(r2, 2, false) TAP(r3, 3, false) TAP(r4, 4, false)
#undef TAP
#pragma unroll
                for (int e = 0; e < 4; ++e) { y0[e] = silu(y0[e]); y1[e] = silu(y1[e]); }
                if (part < 2) {
                    float ss = (y0.x * y0.x + y0.y * y0.y) + (y0.z * y0.z + y0.w * y0.w) + (y1.x * y1.x + y1.y * y1.y) + (y1.z * y1.z + y1.w * y1.w);
                    ss += __shfl_xor(ss, 1); ss += __shfl_xor(ss, 2); ss += __shfl_xor(ss, 4); ss += __shfl_xor(ss, 8);
                    const float scl = __builtin_amdgcn_rsqf(ss + EPS) * (part == 0 ? 0.08838834764831845f : 1.0f);
                    y0 *= scl; y1 *= scl;
                }
                v4u o; o.x = pk2(y0.x, y0.y); o.y = pk2(y0.z, y0.w); o.z = pk2(y1.x, y1.y); o.w = pk2(y1.z, y1.w);
                *(v4u*)(dst + (size_t)(t0 + i) * 512) = o;
                r0 = r1; r1 = r2; r2 = r3; r3 = r4;
            }
#undef ROWLD
        }
#pragma unroll
        for (int jj = 0; jj < 4; ++jj) { const int idx = lane + 64 * jj, tok = t0 + (idx >> 4), c = idx & 15; const float v = AB[(size_t)tok * 16 + c];
            float res;
            if (c < 8) { const float xx = v + dt_bias[c]; const float sp = fmaxf(xx, 0.f) + __logf(1.0f + __expf(-fabsf(xx))); res = -__expf(a_log[c]) * sp; }
            else res = __builtin_amdgcn_rcpf(1.0f + __expf(-v));
            GB[(size_t)tok * 16 + c] = res; }
    }
}
__device__ __forceinline__ void ph_attn(const bf16* P, bf16* OG, float* LSE, int S, int lgS, LAS unsigned char* lds) {
    const int tid = pg8::otid(), lane = tid & 63, wave = tid >> 6, l15 = lane & 15, g = lane >> 4;
    const float one = opaque_one();
    LAS unsigned char* KL = lds; LAS unsigned char* VT = lds + 46080;
    v4u kvr[5], vvr[5];
#define AT_DECODE(u_) const int tb = (u_) & 255, h = ((u_) >> 8) & 7, p = (u_) >> 11; const int lgd = 2 * p, L = S >> lgd, nb = L >> 7, bps = S >> 7; \
        const int seq = tb >> (lgS - 7), lb = tb & (bps - 1); const int r = lb / nb, ib = lb - r * nb, i0 = ib << 7; const int seqbase = seq << lgS;
#define AT_LOAD(u_) do { AT_DECODE(u_) _Pragma("unroll") for (int j = 0; j < 5; ++j) { const int idx = tid + 512 * j; const int kl = idx >> 3, pc = idx & 7, ik = i0 - 64 + kl; \
            kvr[j] = (v4u){0u, 0u, 0u, 0u}; vvr[j] = kvr[j]; \
            if (idx < 288 * 8 && ik >= 0 && ik < L) { const bf16* src = P + (size_t)(seqbase + (ik << lgd) + r) * 1536 + h * 64 + pc * 8; kvr[j] = *(const v4u*)(src + 512); vvr[j] = *(const v4u*)(src + 1024); } } } while (0)
    if ((int)blockIdx.x < 3 * 8 * 256) AT_LOAD((int)blockIdx.x);
    for (int u = blockIdx.x; u < 3 * 8 * 256; u += gridDim.x) {
        AT_DECODE(u)
        __syncthreads();
#pragma unroll
        for (int j = 0; j < 5; ++j) { const int idx = tid + 512 * j; const int kl = idx >> 3, pc = idx & 7;
            const int k5 = kl & 31, klp = (kl & ~31) + ((k5 & 16) ? (8 * ((k5 - 16) >> 2) + 4 + (k5 & 3)) : (8 * (k5 >> 2) + (k5 & 3)));
            if (idx < 288 * 8) { *(LAS v4u*)(KL + kl * 160 + pc * 16) = kvr[j];
#pragma unroll
                for (int e = 0; e < 8; ++e) { const unsigned wv = vvr[j][e >> 1]; *(LAS unsigned short*)(VT + (pc * 8 + e) * 608 + klp * 2) = (unsigned short)((e & 1) ? (wv >> 16) : (wv & 0xffffu)); } } }
        if (u + (int)gridDim.x < 3 * 8 * 256) AT_LOAD(u + (int)gridDim.x);
        __syncthreads();
        const int iq = i0 + 16 * wave + l15, tokq = seqbase + (iq << lgd) + r;
        bf16x8 qf[2];
#pragma unroll
        for (int ks = 0; ks < 2; ++ks) qf[ks] = *(const bf16x8*)(P + (size_t)tokq * 1536 + h * 64 + 32 * ks + 8 * g);
        f32x4 acc[4];
#pragma unroll
        for (int dt = 0; dt < 4; ++dt) acc[dt] = (f32x4){0.f, 0.f, 0.f, 0.f};
        float m = -1e30f, lsum = 0.f;
        for (int s = 0; s < 5; ++s) {
            const int kl0 = 32 * (wave >> 1) + 32 * s;
            bf16x8 ka[2][2], vfr[4];
#pragma unroll
            for (int t = 0; t < 2; ++t)
#pragma unroll
                for (int ks = 0; ks < 2; ++ks) ka[t][ks] = *(const LAS bf16x8*)(KL + (kl0 + 16 * t + l15) * 160 + (32 * ks + 8 * g) * 2);
#pragma unroll
            for (int dt = 0; dt < 4; ++dt) vfr[dt] = *(const LAS bf16x8*)(VT + (16 * dt + l15) * 608 + kl0 * 2 + 16 * g);
            __builtin_amdgcn_sched_barrier(0);
            f32x4 c[2];
#pragma unroll
            for (int t = 0; t < 2; ++t) { c[t] = (f32x4){0.f, 0.f, 0.f, 0.f};
#pragma unroll
                for (int ks = 0; ks < 2; ++ks) c[t] = MFMA16(ka[t][ks], qf[ks], c[t]); }
            float sc[8]; float mx = -1e30f;
#pragma unroll
            for (int t = 0; t < 2; ++t)
#pragma unroll
                for (int rg = 0; rg < 4; ++rg) { const int ik = i0 - 64 + kl0 + 16 * t + 4 * g + rg, dl = ik - iq;
                    const bool valid = (ik >= 0) && (ik < L) && (dl <= 64) && (dl >= -64);
                    const float sv = valid ? c[t][rg] * 0.18033688011112042f : -1e30f; sc[t * 4 + rg] = sv; mx = fmaxf(mx, sv); }
            mx = xmax32(xmax16(mx));
            const float mn = fmaxf(m, mx), alpha = __builtin_amdgcn_exp2f(m - mn); m = mn;
            float ps = 0.f; f32x4 p0, p1;
#pragma unroll
            for (int e = 0; e < 4; ++e) { p0[e] = __builtin_amdgcn_exp2f(sc[e] - mn); p1[e] = __builtin_amdgcn_exp2f(sc[4 + e] - mn); ps += p0[e] + p1[e]; }
            lsum = lsum * alpha + ps;
            const bf16x8 pf = pack8(p0 * one, p1 * one);
#pragma unroll
            for (int dt = 0; dt < 4; ++dt) { acc[dt] *= alpha;
                acc[dt] = MFMA16(vfr[dt], pf, acc[dt]); }
        }
        lsum = xsum32(xsum16(lsum));
        const float inv = 1.0f / lsum;
        bf16* og = OG + ((size_t)p * MH + tokq) * 512 + h * 64 + 4 * g;
#pragma unroll
        for (int dt = 0; dt < 4; ++dt) { v2u w; w.x = pk2(acc[dt][0] * inv, acc[dt][1] * inv); w.y = pk2(acc[dt][2] * inv, acc[dt][3] * inv); *(v2u*)(og + 16 * dt) = w; }
        if (g == 0) LSE[((size_t)p * MH + tokq) * 8 + h] = (m + __log2f(lsum)) * 0.6931471805599453f;
    }
#undef AT_LOAD
#undef AT_DECODE
}
__device__ __forceinline__ void ph_chunk(const bf16* DQ, const bf16* DK, const bf16* DV, const float* GB, unsigned char* CH, float* GC, int S, int lgS, LAS unsigned char* lds) {
    const int tid_ = pg8::otid(), lane = tid_ & 63, wave = tid_ >> 6, l15 = lane & 15, g = lane >> 4;
    const float one = opaque_one();
    LAS unsigned char* wl = lds + wave * 18432;
    LAS float* Al = (LAS float*)wl; LAS float* gcs = (LAS float*)(wl + 17408); LAS float* bts = gcs + 64;
    LAS bf16* TP = (LAS bf16*)wl; LAS bf16* TPP = (LAS bf16*)(wl + 8192);
    for (int job = blockIdx.x * 8 + wave; job < 4096; job += gridDim.x * 8) {
        const int dir = job & 1, h = (job >> 1) & 3, cgi = job >> 3, cps = S >> 6;
        const int seq = cgi >> (lgS - 6), n = cgi & (cps - 1), seqbase = seq << lgS;
#define TOK(c) (seqbase + (dir ? (S - 1 - (64 * n + (c))) : (64 * n + (c))))
        {   const int tokc = TOK(lane);
            const float gv = GB[(size_t)tokc * 16 + dir * 4 + h], bv = GB[(size_t)tokc * 16 + 8 + dir * 4 + h];
            float cs = gv;
#pragma unroll
            for (int o = 1; o < 64; o <<= 1) { const float t = __shfl_up(cs, o); if (lane >= o) cs += t; }
            gcs[lane] = cs; bts[lane] = bv; GC[(size_t)job * 64 + lane] = cs; }
        LDS_WAIT();
        bf16x8 kf[4][4];
#pragma unroll
        for (int t = 0; t < 4; ++t)
#pragma unroll
            for (int ks = 0; ks < 4; ++ks) kf[t][ks] = *(const bf16x8*)(DK + (size_t)TOK(16 * t + l15) * 512 + h * 128 + 32 * ks + 8 * g);
#pragma unroll
        for (int it = 0; it < 4; ++it) { const int i = 16 * it + l15; const float gi = gcs[i], bi = bts[i];
#pragma unroll
            for (int jt = 0; jt <= it; ++jt) { f32x4 c = {0.f, 0.f, 0.f, 0.f};
#pragma unroll
                for (int ks = 0; ks < 4; ++ks) c = MFMA16(kf[jt][ks], kf[it][ks], c);
                const f32x4 gj = *(const LAS f32x4*)(gcs + 16 * jt + 4 * g); f32x4 o;
#pragma unroll
                for (int rg = 0; rg < 4; ++rg) { const int j = 16 * jt + 4 * g + rg; o[rg] = (j < i) ? bi * c[rg] * __expf(gi - gj[rg]) : 0.f; }
                *(LAS f32x4*)(Al + i * 68 + 16 * jt + 4 * g) = o; } }
        unsigned char* chb = CH + (size_t)job * CHJOB;
        bf16* UT = (bf16*)chb; bf16* Wm = (bf16*)(chb + 16384); bf16* KT = (bf16*)(chb + 32768); bf16* QK = (bf16*)(chb + 49152);
#pragma unroll
        for (int it = 0; it < 4; ++it) { const int i = 16 * it + l15; const float gi = gcs[i];
            bf16x8 qfr[4];
#pragma unroll
            for (int ks = 0; ks < 4; ++ks) qfr[ks] = *(const bf16x8*)(DQ + (size_t)TOK(i) * 512 + h * 128 + 32 * ks + 8 * g);
#pragma unroll
            for (int jt = 0; jt < 4; ++jt) { v2u out = {0u, 0u};
                if (jt <= it) { f32x4 c = {0.f, 0.f, 0.f, 0.f};
#pragma unroll
                    for (int ks = 0; ks < 4; ++ks) c = MFMA16(kf[jt][ks], qfr[ks], c);
                    const f32x4 gj = *(const LAS f32x4*)(gcs + 16 * jt + 4 * g); f32x4 o;
#pragma unroll
                    for (int rg = 0; rg < 4; ++rg) { const int j = 16 * jt + 4 * g + rg; o[rg] = (j <= i) ? c[rg] * __expf(gi - gj[rg]) : 0.f; }
                    out.x = pk2(o[0], o[1]); out.y = pk2(o[2], o[3]); }
                *(v2u*)(QK + i * 64 + 16 * jt + 4 * g) = out; } }
        LDS_WAIT();
        float t[64];
#pragma unroll
        for (int i = 0; i < 64; ++i) { float a0 = 0.f, a1 = 0.f, a2 = 0.f, a3 = 0.f;
#pragma unroll
            for (int j4 = 0; j4 * 4 < i; ++j4) { const f32x4 a = *(const LAS f32x4*)(Al + i * 68 + 4 * j4);
                if (4 * j4 + 0 < i) a0 += a[0] * t[4 * j4 + 0];
                if (4 * j4 + 1 < i) a1 += a[1] * t[4 * j4 + 1];
                if (4 * j4 + 2 < i) a2 += a[2] * t[4 * j4 + 2];
                if (4 * j4 + 3 < i) a3 += a[3] * t[4 * j4 + 3]; }
            t[i] = ((lane == i) ? 1.f : 0.f) - ((a0 + a1) + (a2 + a3)); }
        const float bc = bts[lane], ec = bc * __expf(gcs[lane]);
        LDS_WAIT();
#pragma unroll
        for (int i = 0; i < 64; ++i) { const unsigned w = pk2(t[i] * bc, t[i] * ec); TP[i * 64 + lane] = (bf16)(w & 0xffffu); TPP[i * 64 + lane] = (bf16)(w >> 16); }
        LDS_WAIT();
        bf16x8 tf[4][2];
#pragma unroll
        for (int mt = 0; mt < 4; ++mt)
#pragma unroll
            for (int ks = 0; ks < 2; ++ks) tf[mt][ks] = *(const LAS bf16x8*)(TP + (16 * mt + l15) * 64 + 32 * ks + 8 * g);
        for (int nt = 0; nt < 8; ++nt) {
            bf16x8 vf[2];
#pragma unroll
            for (int ks = 0; ks < 2; ++ks)
#pragma unroll
                for (int e = 0; e < 8; ++e) vf[ks][e] = (short)DV[(size_t)TOK(32 * ks + 8 * g + e) * 512 + h * 128 + 16 * nt + l15];
#pragma unroll
            for (int mt = 0; mt < 4; ++mt) { f32x4 c = {0.f, 0.f, 0.f, 0.f};
#pragma unroll
                for (int ks = 0; ks < 2; ++ks) c = MFMA16(tf[mt][ks], vf[ks], c);
                c *= one;
                v2u w; w.x = pk2(c[0], c[1]); w.y = pk2(c[2], c[3]); *(v2u*)(UT + (16 * nt + l15) * 64 + 16 * mt + 4 * g) = w; }
        }
#pragma unroll
        for (int mt = 0; mt < 4; ++mt)
#pragma unroll
            for (int ks = 0; ks < 2; ++ks) tf[mt][ks] = *(const LAS bf16x8*)(TPP + (16 * mt + l15) * 64 + 32 * ks + 8 * g);
        for (int dt = 0; dt < 8; ++dt) {
            bf16x8 kt[2];
#pragma unroll
            for (int ks = 0; ks < 2; ++ks) {
#pragma unroll
                for (int e = 0; e < 8; ++e) kt[ks][e] = (short)DK[(size_t)TOK(32 * ks + 8 * g + e) * 512 + h * 128 + 16 * dt + l15];
                *(bf16x8*)(KT + (16 * dt + l15) * 64 + 32 * ks + 8 * g) = kt[ks]; }
#pragma unroll
            for (int mt = 0; mt < 4; ++mt) { f32x4 c = {0.f, 0.f, 0.f, 0.f};
#pragma unroll
                for (int ks = 0; ks < 2; ++ks) c = MFMA16(kt[ks], tf[mt][ks], c);
                c *= one;
                v2u w; w.x = pk2(c[0], c[1]); w.y = pk2(c[2], c[3]); *(v2u*)(Wm + (16 * mt + l15) * 128 + 16 * dt + 4 * g) = w; }
        }
        LDS_WAIT();
    }
}
#define TOKN(c, nn) (seqbase + (dir ? (S - 1 - (64 * (nn) + (c))) : (64 * (nn) + (c))))
constexpr int SC_PW = 288, SC_PK = 160;
constexpr int SC_W = 0, SC_Q = 64 * SC_PW, SC_QK = 2 * 64 * SC_PW, SC_KT = SC_QK + 64 * SC_PK, SC_GC = SC_KT + 128 * SC_PK, SC_BUF = SC_GC + 256;
static_assert(2 * SC_BUF + 4 * 5120 <= LDS_BYTES - 256, "scan LDS image");
__device__ __forceinline__ void ph_scan(const bf16* DQ, const unsigned char* CH, const float* GC, bf16* OF, bf16* OB, int S, int lgS, int half, LAS unsigned char* lds) {
    const int wave = __builtin_amdgcn_readfirstlane(pg8::otid() >> 6);
    const float one = opaque_one();
#define SC_BAR() do { asm volatile("s_waitcnt lgkmcnt(0)" ::: "memory"); __builtin_amdgcn_s_barrier(); asm volatile("" ::: "memory"); } while (0)
    const int nchain = half ? 32 : 64, cps = S >> 6;
    for (int ub = blockIdx.x; ub < 2 * nchain; ub += gridDim.x) {
        const int chain = (ub & 7) + 8 * (ub >> 4), part = (ub >> 3) & 1;
        const int dir = chain & 1, h = (chain >> 1) & 3, seq = chain >> 3, seqbase = seq << lgS;
        __syncthreads();
        if (wave >= 4) {
            const int lt = pg8::otid() - 256;
            const int wr0 = lt >> 4, wc = lt & 15, kr0 = lt >> 3, kc = lt & 7;
            const int woff = (wc >> 2) * 64 + (wc & 1) * 32 + ((wc >> 1) & 1) * 8, koff = (kc >> 2) * 64 + (kc & 1) * 32 + ((kc >> 1) & 1) * 8;
            v4u rwA[4], rqA[4], rkA[2], rtA[4], rwB[4], rqB[4], rkB[2], rtB[4]; f32x4 rgA = {0.f, 0.f, 0.f, 0.f}, rgB = rgA;
#define SC_LD(rw, rq, rk, rt, rg, n_) do { const int nn_ = (n_); const int job = ((seq * cps + nn_) << 3) | (h << 1) | dir; const unsigned char* chb = CH + (size_t)job * CHJOB; \
                const bf16* Wm_ = (const bf16*)(chb + 16384); const bf16* KT_ = (const bf16*)(chb + 32768); const bf16* QK_ = (const bf16*)(chb + 49152); \
                _Pragma("unroll") for (int k = 0; k < 4; ++k) { rw[k] = *(const v4u*)(Wm_ + (wr0 + 16 * k) * 128 + wc * 8); rq[k] = *(const v4u*)(DQ + (size_t)TOKN(wr0 + 16 * k, nn_) * 512 + h * 128 + wc * 8); rt[k] = *(const v4u*)(KT_ + (kr0 + 32 * k) * 64 + kc * 8); } \
                _Pragma("unroll") for (int k = 0; k < 2; ++k) rk[k] = *(const v4u*)(QK_ + (kr0 + 32 * k) * 64 + kc * 8); \
                if (lt < 16) rg = *(const f32x4*)(GC + (size_t)job * 64 + 4 * lt); } while (0)
#define SC_ST8(dst_, v_) do { LAS unsigned char* d_ = (dst_); *(LAS v2u*)d_ = (v2u){(v_).x, (v_).y}; *(LAS v2u*)(d_ + 16) = (v2u){(v_).z, (v_).w}; } while (0)
#define SC_ST(rw, rq, rk, rt, rg, n_) do { LAS unsigned char* b_ = lds + ((n_) & 1) * SC_BUF; \
                _Pragma("unroll") for (int k = 0; k < 4; ++k) { SC_ST8(b_ + SC_W + (wr0 + 16 * k) * SC_PW + woff, rw[k]); SC_ST8(b_ + SC_Q + (wr0 + 16 * k) * SC_PW + woff, rq[k]); SC_ST8(b_ + SC_KT + (kr0 + 32 * k) * SC_PK + koff, rt[k]); } \
                _Pragma("unroll") for (int k = 0; k < 2; ++k) SC_ST8(b_ + SC_QK + (kr0 + 32 * k) * SC_PK + koff, rk[k]); \
                if (lt < 16) *(LAS f32x4*)(b_ + SC_GC + 16 * lt) = rg; } while (0)
            unsigned pfa = 0u, t00 = 0u, t01 = 0u, t02 = 0u, t10 = 0u, t11 = 0u, t12 = 0u, t20 = 0u, t21 = 0u, t22 = 0u, t30 = 0u, t31 = 0u, t32 = 0u;
#define SC_TOUCH(p0_, p1_, p2_, n_) do { const int nn_ = (n_); pfa += p0_ + p1_ + p2_; if (nn_ < cps) { const int jb_ = ((seq * cps + nn_) << 3) | (h << 1) | dir; const unsigned* cb_ = (const unsigned*)(CH + (size_t)jb_ * CHJOB); \
                p0_ = cb_[lt * 32]; if (lt < 192) p1_ = cb_[(lt + 256) * 32]; if (lt < 128) p2_ = *(const unsigned*)(DQ + (size_t)TOKN(lt >> 1, nn_) * 512 + h * 128 + (lt & 1) * 64); } } while (0)
            SC_LD(rwA, rqA, rkA, rtA, rgA, 0);
            SC_TOUCH(t10, t11, t12, 1); SC_TOUCH(t20, t21, t22, 2); SC_TOUCH(t30, t31, t32, 3);
            for (int n = 0; n < cps; n += 4) {
                SC_LD(rwB, rqB, rkB, rtB, rgB, n + 1); SC_TOUCH(t00, t01, t02, n + 4); SC_ST(rwA, rqA, rkA, rtA, rgA, n); SC_BAR();
                SC_LD(rwA, rqA, rkA, rtA, rgA, n + 2); SC_TOUCH(t10, t11, t12, n + 5); SC_ST(rwB, rqB, rkB, rtB, rgB, n + 1); SC_BAR();
                SC_LD(rwB, rqB, rkB, rtB, rgB, n + 3); SC_TOUCH(t20, t21, t22, n + 6); SC_ST(rwA, rqA, rkA, rtA, rgA, n + 2); SC_BAR();
                if (n + 4 < cps) SC_LD(rwA, rqA, rkA, rtA, rgA, n + 4); SC_TOUCH(t30, t31, t32, n + 7); SC_ST(rwB, rqB, rkB, rtB, rgB, n + 3); SC_BAR();
            }
            pfa += t00 + t01 + t02 + t10 + t11 + t12 + t20 + t21 + t22 + t30 + t31 + t32;
            if (pfa == 0x9e3779b9u && lt == 100000) OF[0] = (bf16)pfa;
#undef SC_TOUCH
#undef SC_LD
#undef SC_ST
#undef SC_ST8
            SC_BAR();
        } else {
            const int tidc = pg8::otid(), lane = tidc & 63, l15 = lane & 15, g = lane >> 4;
            const int dv0 = part * 64 + wave * 16;
            bf16* OX = dir ? OB : OF;
            f32x4 St[8];
#pragma unroll
            for (int t = 0; t < 8; ++t) St[t] = (f32x4){0.f, 0.f, 0.f, 0.f};
            v2u utA[4], utN[4];
#define SC_UT(UT__, n_) do { const int jb_ = ((seq * cps + (n_)) << 3) | (h << 1) | dir; const bf16* UT_ = (const bf16*)(CH + (size_t)jb_ * CHJOB); \
                _Pragma("unroll") for (int mt = 0; mt < 4; ++mt) UT__[mt] = *(const v2u*)(UT_ + (dv0 + l15) * 64 + 16 * mt + 4 * g); } while (0)
            SC_UT(utA, 0);
            SC_BAR();
#define SC_FRAG(p_) (*(const LAS bf16x8*)(p_))
            for (int n = 0; n < cps; ++n) {
                const LAS unsigned char* buf = lds + (n & 1) * SC_BUF;
                const LAS float* gcl = (const LAS float*)(buf + SC_GC);
                if (n + 1 < cps) SC_UT(utN, n + 1);
                const float glast = gcl[63];
                bf16x8 sb[4];
#pragma unroll
                for (int ks = 0; ks < 4; ++ks) sb[ks] = pack8cv(St[2 * ks], St[2 * ks + 1]);
                f32x4 vnew[4];
#pragma unroll
                for (int mp = 0; mp < 2; ++mp) { bf16x8 wf[2][4];
#pragma unroll
                    for (int mm = 0; mm < 2; ++mm) { const LAS unsigned char* wrow = buf + SC_W + (16 * (2 * mp + mm) + l15) * SC_PW + 16 * g;
#pragma unroll
                        for (int ks = 0; ks < 4; ++ks) wf[mm][ks] = SC_FRAG(wrow + 64 * ks); }
                    __builtin_amdgcn_sched_barrier(0);
                    f32x4 ws0 = {0.f, 0.f, 0.f, 0.f}, ws1 = ws0;
#pragma unroll
                    for (int ks = 0; ks < 4; ++ks) { ws0 = MFMA16(wf[0][ks], sb[ks], ws0); ws1 = MFMA16(wf[1][ks], sb[ks], ws1); }
                    vnew[2 * mp] = (f32x4){bflo(utA[2 * mp].x), bfhi(utA[2 * mp].x), bflo(utA[2 * mp].y), bfhi(utA[2 * mp].y)} - ws0;
                    vnew[2 * mp + 1] = (f32x4){bflo(utA[2 * mp + 1].x), bfhi(utA[2 * mp + 1].x), bflo(utA[2 * mp + 1].y), bfhi(utA[2 * mp + 1].y)} - ws1;
                    __builtin_amdgcn_sched_barrier(0);
                }
                bf16x8 vb[2], vbs[2];
#pragma unroll
                for (int k2 = 0; k2 < 2; ++k2) vb[k2] = pack8(vnew[2 * k2], vnew[2 * k2 + 1]);
#pragma unroll
                for (int mp = 0; mp < 2; ++mp) { bf16x8 qf[2][4], kf2[2][2]; float egi[2];
#pragma unroll
                    for (int mm = 0; mm < 2; ++mm) { const int mt = 2 * mp + mm; const LAS unsigned char* qrow = buf + SC_Q + (16 * mt + l15) * SC_PW + 16 * g; const LAS unsigned char* qkrow = buf + SC_QK + (16 * mt + l15) * SC_PK + 16 * g;
#pragma unroll
                        for (int ks = 0; ks < 4; ++ks) qf[mm][ks] = SC_FRAG(qrow + 64 * ks);
#pragma unroll
                        for (int k2 = 0; k2 < 2; ++k2) kf2[mm][k2] = SC_FRAG(qkrow + 64 * k2);
                        egi[mm] = __expf(gcl[16 * mt + l15]); }
                    __builtin_amdgcn_sched_barrier(0);
                    f32x4 o0 = {0.f, 0.f, 0.f, 0.f}, o1 = o0;
#pragma unroll
                    for (int ks = 0; ks < 4; ++ks) { o0 = MFMA16(sb[ks], qf[0][ks], o0); o1 = MFMA16(sb[ks], qf[1][ks], o1); }
                    o0 *= egi[0]; o1 *= egi[1];
#pragma unroll
                    for (int k2 = 0; k2 < 2; ++k2) { o0 = MFMA16(vb[k2], kf2[0][k2], o0); o1 = MFMA16(vb[k2], kf2[1][k2], o1); }
                    o0 *= one; o1 *= one;
                    v2u w0, w1; w0.x = pk2(o0[0], o0[1]); w0.y = pk2(o0[2], o0[3]); w1.x = pk2(o1[0], o1[1]); w1.y = pk2(o1[2], o1[3]);
                    *(v2u*)(OX + (size_t)TOKN(16 * (2 * mp) + l15, n) * 512 + h * 128 + dv0 + 4 * g) = w0;
                    *(v2u*)(OX + (size_t)TOKN(16 * (2 * mp + 1) + l15, n) * 512 + h * 128 + dv0 + 4 * g) = w1;
                    __builtin_amdgcn_sched_barrier(0); }
                const float eg = __expf(glast);
#pragma unroll
                for (int mt = 0; mt < 4; ++mt) { const f32x4 gv = *(const LAS f32x4*)(gcl + 16 * mt + 4 * g);
#pragma unroll
                    for (int rg = 0; rg < 4; ++rg) vnew[mt][rg] *= __expf(glast - gv[rg]); }
#pragma unroll
                for (int k2 = 0; k2 < 2; ++k2) vbs[k2] = pack8(vnew[2 * k2], vnew[2 * k2 + 1]);
#pragma unroll
                for (int tp = 0; tp < 2; ++tp) { bf16x8 kt4[4][2];
#pragma unroll
                    for (int tt = 0; tt < 4; ++tt) { const LAS unsigned char* ktrow = buf + SC_KT + (16 * (4 * tp + tt) + l15) * SC_PK + 16 * g; kt4[tt][0] = SC_FRAG(ktrow); kt4[tt][1] = SC_FRAG(ktrow + 64); }
                    __builtin_amdgcn_sched_barrier(0);
#pragma unroll
                    for (int tt = 0; tt < 4; ++tt) St[4 * tp + tt] *= eg;
#pragma unroll
                    for (int k2 = 0; k2 < 2; ++k2)
#pragma unroll
                        for (int tt = 0; tt < 4; ++tt) St[4 * tp + tt] = MFMA16(kt4[tt][k2], vbs[k2], St[4 * tp + tt]);
                    __builtin_amdgcn_sched_barrier(0); }
#pragma unroll
                for (int mt = 0; mt < 4; ++mt) utA[mt] = utN[mt];
                SC_BAR();
            }
#undef SC_FRAG
#undef SC_UT
        }
    }
#undef SC_BAR
#undef TOKN
#undef TOK
}
__device__ __forceinline__ void ph_post(const bf16* OG, const float* LSE, const bf16* OF, const bf16* OB, const bf16* Z, const float* dn_norm, bf16* MIX) {
    const int tid_ = pg8::otid(), lane = tid_ & 63, wave = tid_ >> 6;
    const int gw = blockIdx.x * 8 + wave, NGW = gridDim.x * 8;
    f32x4 nw0 = *(const f32x4*)(dn_norm + (lane & 15) * 8), nw1 = *(const f32x4*)(dn_norm + (lane & 15) * 8 + 4);
    for (int t = gw; t < MH; t += NGW) {
        {   const int hd = lane >> 3;
            const float l0 = LSE[((size_t)0 * MH + t) * 8 + hd], l1 = LSE[((size_t)1 * MH + t) * 8 + hd], l2 = LSE[((size_t)2 * MH + t) * 8 + hd];
            const float mx = fmaxf(l0, fmaxf(l1, l2));
            float w0 = __expf(l0 - mx), w1 = __expf(l1 - mx), w2 = __expf(l2 - mx); const float inv = 1.0f / (w0 + w1 + w2); w0 *= inv; w1 *= inv; w2 *= inv;
            const v4u a = *(const v4u*)(OG + ((size_t)0 * MH + t) * 512 + lane * 8), b = *(const v4u*)(OG + ((size_t)1 * MH + t) * 512 + lane * 8), c = *(const v4u*)(OG + ((size_t)2 * MH + t) * 512 + lane * 8);
            v4u o;
#pragma unroll
            for (int e = 0; e < 4; ++e) o[e] = pk2(w0 * bflo(a[e]) + w1 * bflo(b[e]) + w2 * bflo(c[e]), w0 * bfhi(a[e]) + w1 * bfhi(b[e]) + w2 * bfhi(c[e]));
            *(v4u*)(MIX + (size_t)t * 1024 + lane * 8) = o; }
        {   const v4u a = *(const v4u*)(OF + (size_t)t * 512 + lane * 8), b = *(const v4u*)(OB + (size_t)t * 512 + lane * 8), z = *(const v4u*)(Z + (size_t)t * 512 + lane * 8);
            float ov[8]; float ss = 0.f;
#pragma unroll
            for (int e = 0; e < 4; ++e) { ov[2 * e] = bflo(a[e]) + bflo(b[e]); ov[2 * e + 1] = bfhi(a[e]) + bfhi(b[e]); ss += ov[2 * e] * ov[2 * e] + ov[2 * e + 1] * ov[2 * e + 1]; }
            ss += __shfl_xor(ss, 1); ss += __shfl_xor(ss, 2); ss += __shfl_xor(ss, 4); ss += __shfl_xor(ss, 8);
            const float rs = __builtin_amdgcn_rsqf(ss * (1.0f / 128.0f) + EPS);
            v4u o;
#pragma unroll
            for (int e = 0; e < 4; ++e) { const float n0 = (e < 2) ? nw0[2 * e] : nw1[2 * e - 4], n1 = (e < 2) ? nw0[2 * e + 1] : nw1[2 * e - 3];
                o[e] = pk2(ov[2 * e] * rs * n0 * silu(bflo(z[e])), ov[2 * e + 1] * rs * n1 * silu(bfhi(z[e]))); }
            *(v4u*)(MIX + (size_t)t * 1024 + 512 + lane * 8) = o; }
    }
}
#define XB_TMO      128
#define XB_XCNT(j)  (256  + 64 * (j))
#define XB_XSUB(j)  (1280 + 64 * (j))
#define XB_XGEN(j)  (2304 + 64 * (j))
#define XB_TOP      3328
#define XB_TOPGEN   3392
#define XCD_BAR_WORDS 3456
#define XB_SPIN_CAP (1u << 18)

__device__ __forceinline__ unsigned xb_ld(unsigned* p)              { return __hip_atomic_load(p, __ATOMIC_RELAXED, __HIP_MEMORY_SCOPE_AGENT); }
__device__ __forceinline__ unsigned xb_add(unsigned* p, unsigned v) { return __hip_atomic_fetch_add(p, v, __ATOMIC_RELAXED, __HIP_MEMORY_SCOPE_AGENT); }
__device__ __forceinline__ unsigned xb_xcc_id() { return (unsigned)__builtin_amdgcn_s_getreg((3 << 11) | 20) & 0xFu; }
#define XB_SPIN(cond, bar) do { unsigned _sp = 0; while (cond) { __builtin_amdgcn_s_sleep(1); \
    if ((++_sp & 255u) == 0u) { if (xb_ld(&(bar)[XB_TMO])) break; if (_sp > XB_SPIN_CAP) { atomicAdd(&(bar)[XB_TMO], 1u); break; } } } } while (0)

struct XcdBarrier {
    unsigned* bar; unsigned x;
    volatile LAS unsigned* st;
};

__device__ __forceinline__ XcdBarrier xcd_barrier_post(unsigned* bar, volatile LAS unsigned* st) {
    XcdBarrier b; b.bar = bar; b.x = xb_xcc_id(); b.st = st;
    if (threadIdx.x == 0) (void)xb_add(&bar[XB_XCNT(b.x)], 1u);
    return b;
}
__device__ __forceinline__ void xcd_barrier_complete(unsigned* bar, unsigned x, unsigned& nloc, unsigned& nx) {
    const unsigned G = gridDim.x * gridDim.y * gridDim.z;
    unsigned sum, cnt, mine, sp = 0u;
    for (;;) {
        sum = 0u; cnt = 0u; mine = 0u;
#pragma unroll
        for (unsigned j = 0; j < 16; ++j) { const unsigned c = xb_ld(&bar[XB_XCNT(j)]); sum += c; cnt += (c > 0u) ? 1u : 0u; mine = (j == x) ? c : mine; }
        if (sum == G) break;
        __builtin_amdgcn_s_sleep(1);
        if ((++sp & 255u) == 0u) { if (xb_ld(&bar[XB_TMO])) break; if (sp > XB_SPIN_CAP) { atomicAdd(&bar[XB_TMO], 1u); break; } }
    }
    nloc = mine > 0u ? mine : 1u; nx = cnt > 0u ? cnt : 1u;
}

__device__ __forceinline__ void xcd_barrier(const XcdBarrier& b) {
    asm volatile("s_waitcnt vmcnt(0)" ::: "memory");
    __syncthreads();
    if (threadIdx.x == 0) {
        unsigned* bar = b.bar;
        __builtin_amdgcn_s_waitcnt(0);
        unsigned nloc = b.st[0], nx = b.st[1];
        if (nloc == 0u) { xcd_barrier_complete(bar, b.x, nloc, nx); b.st[0] = nloc; b.st[1] = nx; }
        const unsigned old = xb_add(&bar[XB_XSUB(b.x)], 1u);
        const unsigned gen = old / nloc;
        if (old + 1u == (gen + 1u) * nloc) {
            __builtin_amdgcn_fence(__ATOMIC_RELEASE, "agent");
            asm volatile("s_waitcnt vmcnt(0)" ::: "memory");
            const unsigned og = xb_add(&bar[XB_TOP], 1u);
            const unsigned tg = og / nx;
            if (og + 1u == (tg + 1u) * nx) xb_add(&bar[XB_TOPGEN], 1u);
            else XB_SPIN(xb_ld(&bar[XB_TOPGEN]) == tg, bar);
            __builtin_amdgcn_fence(__ATOMIC_ACQUIRE, "agent");
            xb_add(&bar[XB_XGEN(b.x)], 1u);
            asm volatile("s_waitcnt vmcnt(0)" ::: "memory");
        } else {
            XB_SPIN(xb_ld(&bar[XB_XGEN(b.x)]) == gen, bar);
            __builtin_amdgcn_fence(__ATOMIC_ACQUIRE, "agent");
            asm volatile("s_waitcnt vmcnt(0)" ::: "memory");
        }
    }
    __syncthreads();
}

#ifndef DBG_SKIP_MIXER
#define DBG_SKIP_MIXER 0
#endif
#ifndef MK_MULTI
#define MK_MULTI 0
#endif
constexpr int NPH = 1 + 2 * (2 * 14) + 1 + 1;
static_assert(pg8::EpiProj::OFF_PA == WS_PA && pg8::EpiProj::OFF_PD == WS_PD && pg8::EpiProj::OFF_Z == WS_Z, "EpiProj offsets");
struct Args { const float* in[22]; float* out; unsigned char* ws; int lo, hi; };

__global__ void __launch_bounds__(512, 2) fwd(Args a) {
    extern __shared__ __attribute__((aligned(16))) unsigned char lds_raw[];
    LAS unsigned char* lds = (LAS unsigned char*)lds_raw;
    cg::grid_group grid = cg::this_grid();
    unsigned char* ws = a.ws;
    const int lo = a.lo, hi = a.hi; int pc = 0;
    const float* x_prompt = a.in[0]; const float* x_sample = a.in[1];
    float* MOD = (float*)(ws + WS_MOD); float* ROPE = (float*)(ws + WS_ROPE);
    bf16* H = (bf16*)(ws + WS_H); bf16* ACT = (bf16*)(ws + WS_ACT); bf16* PA = (bf16*)(ws + WS_PA); bf16* PD = (bf16*)(ws + WS_PD); bf16* Zb = (bf16*)(ws + WS_Z);
    bf16* DQ = (bf16*)(ws + WS_DQ); bf16* DK = (bf16*)(ws + WS_DK); bf16* DV = (bf16*)(ws + WS_DV); bf16* OF = (bf16*)(ws + WS_OF); bf16* OB = (bf16*)(ws + WS_OB);
    unsigned char* CH = ws + WS_CH; bf16* OG = (bf16*)(ws + WS_OG); float* LSE = (float*)(ws + WS_LSE); bf16* MIX = (bf16*)(ws + WS_MIX);
    float* AB = (float*)(ws + WS_AB); float* GB = (float*)(ws + WS_GB); float* GC = (float*)(ws + WS_GC);
#define PH_BEGIN if (pc >= lo && pc < hi) {
    { volatile LAS unsigned* st = (volatile LAS unsigned*)(lds + LDS_BYTES - 256); if (pg8::otid() < 2) st[pg8::otid()] = 0u; }
    __syncthreads();
    XcdBarrier bar = xcd_barrier_post((unsigned*)ws, (volatile LAS unsigned*)(lds + LDS_BYTES - 256));
#define PH_END } ++pc; if (pc > lo && pc < hi) { if (pc == 1) grid.sync(); else xcd_barrier(bar); }

    PH_BEGIN
        ph_mod(a.in[2], a.in[3], a.in[4], a.in[5], MOD, lds);
        ph_rope(ROPE);
        ph_wconv(a.in[7], a.in[8], a.in[9], a.in[18], a.in[19], a.in[20], a.in[11], a.in[16], 0, ws, lds);
    PH_END
    for (int layer = 0; layer < 2; ++layer) {
        if (layer == 1) {
            PH_BEGIN ph_wconv(a.in[7], a.in[8], a.in[9], a.in[18], a.in[19], a.in[20], a.in[11], a.in[16], 1, ws, lds); PH_END
        }
        const float* modl = MOD + (size_t)layer * 12 * 9216;
        for (int half = 0; half < 2; ++half) {
            const int S = half ? 8192 : 4096, lgS = half ? 13 : 12;
            float* X = a.out + (size_t)half * MH * D;
            const float* xin0 = half ? x_sample : x_prompt;
            for (int sb = 0; sb < 3; ++sb) {
                if (DBG_SKIP_MIXER && sb == 1) continue;
                const bool first = (layer == 0 && sb == 0);
                const float* xsrc = first ? xin0 : X;
                const float* nw = (sb == 0 ? a.in[6] : (sb == 1 ? a.in[10] : a.in[17])) + layer * D;
                PH_BEGIN ph_norm(xsrc, nw, modl, sb, half, H); PH_END
                if (sb != 1) {
                    PH_BEGIN
                        pg8::Gemm g{H, (const bf16*)(ws + (sb ? WS_WGU2 : WS_WGU1)), MH, 2 * FF, D}; pg8::StaticOrder So; So.init(MH, 2 * FF, gridDim.x, (int)blockIdx.x);
                        pg8::EpiSwiGLU E{ACT, FF};
                        pg8::gemm_phase<pg8::EpiSwiGLU, pg8::StaticOrder, true, true>(lds, g, So, E);
                    PH_END
                    PH_BEGIN
                        pg8::Gemm g{ACT, (const bf16*)(ws + (sb ? WS_WD2 : WS_WD1)), MH, D, FF}; pg8::StaticOrder So; So.init(MH, D, gridDim.x, (int)blockIdx.x);
                        pg8::EpiResid E{xsrc, X, modl + (3 * sb + 2) * 1024, 0.5f, half};
                        pg8::gemm_phase<pg8::EpiResid, pg8::StaticOrder, true, true>(lds, g, So, E);
                    PH_END
                } else {
                    PH_BEGIN
                        pg8::Gemm g{H, (const bf16*)(ws + WS_WIN), MH, NPROJ, D}; pg8::StaticOrder So; So.init(MH, NPROJ, gridDim.x, (int)blockIdx.x);
                        pg8::EpiProj E{ws, AB, ROPE, S - 1};
                        pg8::gemm_phase<pg8::EpiProj, pg8::StaticOrder, true, true>(lds, g, So, E);
                    PH_END
                    PH_BEGIN ph_dnpre(PD, AB, a.in[12] + (size_t)layer * 5 * 1536, a.in[13] + layer * 8, a.in[14] + layer * 8, DQ, DK, DV, GB, S); PH_END
                    PH_BEGIN ph_chunk(DQ, DK, DV, GB, CH, GC, S, lgS, lds); PH_END
                    PH_BEGIN ph_scan(DQ, CH, GC, OF, OB, S, lgS, half, lds); PH_END
                    PH_BEGIN ph_attn(PA, OG, LSE, S, lgS, lds); PH_END
                    PH_BEGIN ph_post(OG, LSE, OF, OB, Zb, a.in[15] + layer * 128, MIX); PH_END
                    PH_BEGIN
                        pg8::Gemm g{MIX, (const bf16*)(ws + WS_WOUT), MH, D, D}; pg8::StaticOrder So; So.init(MH, D, gridDim.x, (int)blockIdx.x);
                        pg8::EpiResid E{X, X, modl + 5 * 1024, 1.0f, half};
                        pg8::gemm_phase<pg8::EpiResid, pg8::StaticOrder, true, true>(lds, g, So, E);
                    PH_END
                }
            }
        }
    }
    PH_BEGIN ph_final(a.out, a.in[21]); PH_END
}

extern "C" void kernel_launch(void* const* d_in, const int* in_sizes, int n_in, void* d_out, int out_size, void* d_ws, size_t ws_size, hipStream_t stream) {
    static int grid = 0;
    if (grid == 0) {
        if (n_in != 22 || ws_size < WS_END) { fprintf(stderr, "kernel_launch: unexpected n_in %d / ws_size %zu\n", n_in, ws_size); grid = -1; return; }
        int dev = 0, cus = 0, per_cu = 0;
        hipGetDevice(&dev); hipDeviceGetAttribute(&cus, hipDeviceAttributeMultiprocessorCount, dev);
        if (hipFuncSetAttribute((const void*)fwd, hipFuncAttributeMaxDynamicSharedMemorySize, LDS_BYTES) != hipSuccess) { fprintf(stderr, "kernel_launch: hipFuncSetAttribute failed\n"); grid = -1; return; }
        if (hipOccupancyMaxActiveBlocksPerMultiprocessor(&per_cu, (const void*)fwd, 512, LDS_BYTES) != hipSuccess || per_cu < 1) { per_cu = 1; (void)hipGetLastError(); }
        grid = cus * per_cu;
        fprintf(stderr, "kernel_launch: grid %d (cus %d x %d), ws %zu MiB\n", grid, cus, per_cu, ws_size >> 20);
    }
    if (grid < 0) return;
    if (hipMemsetAsync(d_ws, 0, 16384, stream) != hipSuccess) { fprintf(stderr, "kernel_launch: memset failed\n"); return; }
    Args a{};
    for (int i = 0; i < 22; ++i) a.in[i] = (const float*)d_in[i];
    a.out = (float*)d_out; a.ws = (unsigned char*)d_ws;
#if MK_MULTI
    for (int p = 0; p < NPH; ++p) { a.lo = p; a.hi = p + 1; hipLaunchKernelGGL(fwd, dim3(grid), dim3(512), LDS_BYTES, stream, a); }
#else
    a.lo = 0; a.hi = NPH;
    void* args[] = {&a};
    hipError_t e = hipLaunchCooperativeKernel((const void*)fwd, dim3(grid), dim3(512), args, LDS_BYTES, stream);
    if (e != hipSuccess) fprintf(stderr, "cooperative launch failed: %s (grid %d)\n", hipGetErrorString(e), grid);
#endif
}
```

```cpp
#include <hip/hip_runtime.h>
#include <hip/hip_cooperative_groups.h>
#include <cstdio>
#include <cstdint>
namespace cg = cooperative_groups;
namespace pg8 {
#define PG8_LAS __attribute__((address_space(3)))
typedef unsigned short bf16_t;
typedef short bf16x8 __attribute__((ext_vector_type(8)));
typedef float f32x4 __attribute__((ext_vector_type(4)));
typedef unsigned u32x4 __attribute__((ext_vector_type(4)));
constexpr int BM = 256, BK = 64, HALF = 128, HTB = HALF * BK * 2  , STAGE_BYTES = 8 * HTB, NXCD = 8, WGM = 8;

__host__ __device__ __forceinline__ int lds_byte(int r, int c) { const int st = (r >> 4) * 2 + (c >> 5), rr = r & 15, cc = c & 31, ob = rr * 64 + cc * 2; return st * 1024 + (ob ^ (((ob >> 9) & 1) << 5)); }
__host__ __device__ __forceinline__ void stage_rc(int b, int& R, int& C) { const int st = b / 1024, sb = b % 1024, swz = sb ^ (((sb >> 9) & 1) << 5); R = (st >> 1) * 16 + swz / 64; C = (st & 1) * 32 + (swz % 64) / 2; }
__host__ __device__ __forceinline__ int perm32(int rho) { const int n = rho >> 4, i = rho & 15; return 8 * (i >> 2) + 4 * n + (i & 3); }

struct Unit { int pm, pn; };
struct Gemm { const bf16_t* A; const bf16_t* Bt; int M, N, K; };

struct StaticOrder {
    int nM, nN, nwg, G, c;
    __host__ __device__ void init(int M, int N, int G_, int c_) { nM = M / BM; nN = N / BM; nwg = nM * nN; G = G_; c = c_; }
    __host__ __device__ bool next(int i, Unit& u) const {
        const long L = (long)i * G + c; if (L >= nwg) return false;
        int wgid = (int)L; { const int q = nwg / NXCD, r = nwg % NXCD, xcd = wgid % NXCD, off = wgid / NXCD; wgid = (xcd < r ? xcd * (q + 1) : r * (q + 1) + (xcd - r) * q) + off; }
        const int nig = WGM * nN, gid = wgid / nig, fm = gid * WGM, gsz = (nM - fm) < WGM ? (nM - fm) : WGM;
        u.pm = fm + ((wgid % nig) % gsz); u.pn = (wgid % nig) / gsz; return true;
    }
    __device__ __forceinline__ void a_ready(const Unit&) const {}
    __device__ __forceinline__ void done(const Unit&) const {}
};
typedef __bf16 bf16x2_t __attribute__((ext_vector_type(2)));
typedef float f32x2_t __attribute__((ext_vector_type(2)));
__device__ __forceinline__ unsigned cvt_pk_bf16(float lo, float hi) { unsigned r; asm volatile("v_cvt_pk_bf16_f32 %0, %1, %2" : "=v"(r) : "v"(lo), "v"(hi)); return r; }
__device__ __forceinline__ unsigned cvt_pk_bf16_cv(float lo, float hi) { const f32x2_t v = {lo, hi}; const bf16x2_t b = __builtin_convertvector(v, bf16x2_t); return __builtin_bit_cast(unsigned, b); }
__device__ __forceinline__ int otid() { int t = threadIdx.x; asm volatile("" : "+v"(t)); return t; }
__device__ __forceinline__ float silu_f(float v) { return v * __builtin_amdgcn_rcpf(1.0f + __expf(-v)); }

#define EPI_PIN(p) asm volatile("" : "+v"(p))
struct EpiSwiGLU {
    static constexpr bool PERM = true, AFTER_DRAIN = false;
    bf16_t* O; int ldc;
    __device__ __forceinline__ void operator()(const f32x4 (&acc)[2][2][4][2], const Unit& u, int wr, int wc, int fr, int fq) const {
        const int row0 = u.pm * BM + wr * 64 + fr, col0 = u.pn * 128 + wc * 32 + 8 * fq;
        bf16_t* rowp = O + (size_t)row0 * ldc + col0;
#pragma unroll
        for (int ai = 0; ai < 2; ++ai) {
#pragma unroll
            for (int m = 0; m < 4; ++m) {
                const f32x4 g0 = acc[ai][0][m][0], g1 = acc[ai][0][m][1], u0 = acc[ai][1][m][0], u1 = acc[ai][1][m][1];
                u32x4 w;
                w.x = cvt_pk_bf16(silu_f(g0[0]) * u0[0], silu_f(g0[1]) * u0[1]); w.y = cvt_pk_bf16(silu_f(g0[2]) * u0[2], silu_f(g0[3]) * u0[3]);
                w.z = cvt_pk_bf16(silu_f(g1[0]) * u1[0], silu_f(g1[1]) * u1[1]); w.w = cvt_pk_bf16(silu_f(g1[2]) * u1[2], silu_f(g1[3]) * u1[3]);
                *(u32x4*)rowp = w;
                rowp += (size_t)16 * ldc; EPI_PIN(rowp);
            }
            rowp += (size_t)64 * ldc; EPI_PIN(rowp);
        }
    }
};
struct EpiResid {
    static constexpr bool PERM = false, AFTER_DRAIN = false;
    const float* xin; float* xout; const float* gate; float scale; int half;
    __device__ __forceinline__ void operator()(const f32x4 (&acc)[2][2][4][2], const Unit& u, int wr, int wc, int fr, int fq) const {
        const int row0 = u.pm * BM + wr * 64 + fr, col0 = u.pn * BM + wc * 32 + 4 * fq;
        const int batch = half ? 8 + (u.pm >> 5) : (u.pm >> 4);
        const float* gp = gate + (size_t)batch * 9216 + col0;
        f32x4 gv[2][2];
#pragma unroll
        for (int bj = 0; bj < 2; ++bj)
#pragma unroll
            for (int n = 0; n < 2; ++n) gv[bj][n] = *(const f32x4*)(gp + bj * HALF + n * 16) * scale;
        const float* lp = xin + (size_t)row0 * 1024 + col0; float* op = xout + (size_t)row0 * 1024 + col0;
        f32x4 xb[4][2][2];
#define EPI_LD(slot) do { _Pragma("unroll") for (int bj = 0; bj < 2; ++bj) _Pragma("unroll") for (int n = 0; n < 2; ++n) xb[slot][bj][n] = *(const f32x4*)(lp + bj * HALF + n * 16); } while (0)
#define EPI_LADV(grp) do { lp += (((grp) & 3) == 3 ? 80 : 16) * 1024; EPI_PIN(lp); } while (0)
        EPI_LD(0); EPI_LADV(0); EPI_LD(1); EPI_LADV(1); EPI_LD(2); EPI_LADV(2); EPI_LD(3); EPI_LADV(3);
#pragma unroll
        for (int grp = 0; grp < 8; ++grp) { const int ai = grp >> 2, m = grp & 3, slot = grp & 3;
#pragma unroll
            for (int bj = 0; bj < 2; ++bj)
#pragma unroll
                for (int n = 0; n < 2; ++n) *(f32x4*)(op + bj * HALF + n * 16) = xb[slot][bj][n] + gv[bj][n] * acc[ai][bj][m][n];
            op += (m == 3 ? 80 : 16) * 1024; EPI_PIN(op);
            if (grp + 4 < 8) { EPI_LD(slot); EPI_LADV(grp + 4); }
        }
#undef EPI_LD
#undef EPI_LADV
    }
};
struct EpiProj {
    static constexpr bool PERM = true, AFTER_DRAIN = false;
    static constexpr size_t OFF_PA = (size_t)144 << 20, OFF_PD = (size_t)272 << 20, OFF_Z = (size_t)240 << 20;
    unsigned char* wsb; float* AB; const float* rope; int smask;
    __device__ __forceinline__ void operator()(const f32x4 (&acc)[2][2][4][2], const Unit& u, int wr, int wc, int fr, int fq) const {
        const int row0 = u.pm * BM + wr * 64 + fr, pn = u.pn;
        if (pn < 14) {
            const size_t poff = pn < 6 ? OFF_PA : (pn < 12 ? OFF_PD : OFF_Z); bf16_t* P = (bf16_t*)(wsb + poff); const int ldp = pn < 12 ? 1536 : 512;
            const int col0 = (pn < 6 ? pn : (pn < 12 ? pn - 6 : pn - 12)) * 256 + wc * 32 + 8 * fq;
            const bool rot = (pn < 4) && ((wc & 1) == 0) && (fq < 2);
            const float sgn = (fq & 1) ? 1.f : -1.f;
            bf16_t* rowp = P + (size_t)row0 * ldp + col0; int row = row0;
#pragma unroll
            for (int ai = 0; ai < 2; ++ai) {
#pragma unroll
                for (int m = 0; m < 4; ++m) {
                    f32x4 c0 = {0.f, 0.f, 0.f, 0.f}, c1 = c0, s0 = c0, s1 = c0;
                    if (pn < 4) { const float* rp = rope + (size_t)(row & smask) * 16; c0 = *(const f32x4*)rp; c1 = *(const f32x4*)(rp + 4); s0 = *(const f32x4*)(rp + 8); s1 = *(const f32x4*)(rp + 12); }
#pragma unroll
                    for (int bj = 0; bj < 2; ++bj) { f32x4 v0 = acc[ai][bj][m][0], v1 = acc[ai][bj][m][1];
                        if (pn < 4) { f32x4 p0, p1;
#pragma unroll
                            for (int j = 0; j < 4; ++j) {
                                const auto s0 = __builtin_amdgcn_permlane16_swap(__float_as_uint(v0[j]), __float_as_uint(v0[j]), false, false), s1 = __builtin_amdgcn_permlane16_swap(__float_as_uint(v1[j]), __float_as_uint(v1[j]), false, false);
                                p0[j] = __uint_as_float((fq & 1) ? s0[0] : s0[1]); p1[j] = __uint_as_float((fq & 1) ? s1[0] : s1[1]); }
                            const f32x4 r0 = v0 * c0 + sgn * (p0 * s0), r1 = v1 * c1 + sgn * (p1 * s1);
                            if (rot) { v0 = r0; v1 = r1; } }
                        u32x4 w; w.x = cvt_pk_bf16(v0[0], v0[1]); w.y = cvt_pk_bf16(v0[2], v0[3]); w.z = cvt_pk_bf16(v1[0], v1[1]); w.w = cvt_pk_bf16(v1[2], v1[3]);
                        *(u32x4*)(rowp + bj * HALF) = w; }
                    rowp += (size_t)16 * ldp; row += 16; EPI_PIN(rowp); EPI_PIN(row);
                    asm volatile("" ::: "memory"); }
                rowp += (size_t)64 * ldp; row += 64; EPI_PIN(rowp); EPI_PIN(row);
            }
        } else {
            if (wc == 0 && fq < 2) {
                float* ap = AB + (size_t)row0 * 16 + 8 * fq;
#pragma unroll
                for (int ai = 0; ai < 2; ++ai) {
#pragma unroll
                    for (int m = 0; m < 4; ++m) { *(f32x4*)ap = acc[ai][0][m][0]; *(f32x4*)(ap + 4) = acc[ai][0][m][1]; ap += 16 * 16; EPI_PIN(ap); }
                    ap += 64 * 16; EPI_PIN(ap); }
            }
        }
    }
};

template <class Epi, class Sched, bool ALIGN_EPI = false, bool SP2 = false>
__device__ __forceinline__ void gemm_phase(PG8_LAS unsigned char* lds, const Gemm g, const Sched& S, const Epi& E) {
    const int tid = otid(), wid = __builtin_amdgcn_readfirstlane(tid >> 6), lane = tid & 63, wr = wid >> 2, wc = wid & 3, fr = lane & 15, fq = lane >> 4;
    const int K = g.K, nt = K / BK;
    unsigned voffA[2], voffB[2];
#pragma unroll
    for (int i = 0; i < 2; ++i) { int R, C; stage_rc(tid * 16 + i * 8192, R, C); const int Rb = Epi::PERM ? ((R & ~31) + perm32(R & 31)) : R;
        voffA[i] = (unsigned)(R * K + C) * 2u; voffB[i] = (unsigned)(Rb * K + C) * 2u; }
    const size_t kstep = (size_t)(BK * 2);
    const size_t hstep = (size_t)HALF * K * 2;
    const size_t tstep = 2 * hstep;
    const unsigned ldsw = (unsigned)wid * 1024u;
    const int aoff = lds_byte(wr * 64 + fr, fq * 8), boff = lds_byte(wc * 32 + fr, fq * 8);
#define PG8_SA(b, h) (((b) * 2 + (h)) * HTB)
#define PG8_SB(b, h) ((4 + (b) * 2 + (h)) * HTB)
#define PG8_STAGE(bufoff, gbase, voff) do { _Pragma("unroll") for (int _i = 0; _i < 2; ++_i) \
        __builtin_amdgcn_global_load_lds((const unsigned*)((const char*)(gbase) + (voff)[_i]), (PG8_LAS unsigned*)(lds + (bufoff) + ldsw + _i * 8192), 16, 0, 0); } while (0)
#define PG8_LDA(dst, b, h) do { _Pragma("unroll") for (int m = 0; m < 4; ++m) _Pragma("unroll") for (int k = 0; k < 2; ++k) dst[m][k] = *(const PG8_LAS bf16x8*)(lds + PG8_SA(b, h) + aoff + m * 2048 + k * 1024); } while (0)
#define PG8_LDB(dst, b, h) do { _Pragma("unroll") for (int n = 0; n < 2; ++n) _Pragma("unroll") for (int k = 0; k < 2; ++k) dst[n][k] = *(const PG8_LAS bf16x8*)(lds + PG8_SB(b, h) + boff + n * 2048 + k * 1024); } while (0)
#define PG8_MMA(ai, bj, At, Bt) do { __builtin_amdgcn_s_setprio(1); _Pragma("unroll") for (int m = 0; m < 4; ++m) _Pragma("unroll") for (int n = 0; n < 2; ++n) _Pragma("unroll") for (int k = 0; k < 2; ++k) \
        acc[ai][bj][m][n] = __builtin_amdgcn_mfma_f32_16x16x32_bf16(Bt[n][k], At[m][k], acc[ai][bj][m][n], 0, 0, 0); __builtin_amdgcn_s_setprio(0); } while (0)
#define PG8_WAIT_V(n) asm volatile("s_waitcnt vmcnt(" #n ")" ::: "memory")
#define PG8_WAIT_L(n) asm volatile("s_waitcnt lgkmcnt(" #n ")" ::: "memory")
#define PG8_BAR __builtin_amdgcn_s_barrier()
#define PG8_SCHED __builtin_amdgcn_sched_barrier(0)
    Unit cur, nxt; int ui = 0;
    if (!S.next(0, cur)) return;
    f32x4 acc[2][2][4][2];
#pragma unroll
    for (int a = 0; a < 2; ++a)
#pragma unroll
        for (int b = 0; b < 2; ++b)
#pragma unroll
            for (int m = 0; m < 4; ++m)
#pragma unroll
                for (int n = 0; n < 2; ++n) acc[a][b][m][n] = (f32x4){0.f, 0.f, 0.f, 0.f};
    bf16x8 At[4][2], B0[2][2], B1[2][2];
    const char* cA = (const char*)g.A + (size_t)cur.pm * tstep; const char* cB = (const char*)g.Bt + (size_t)cur.pn * tstep;
    S.a_ready(cur);
    if constexpr (SP2) {
        PG8_STAGE(PG8_SB(0, 0), cB, voffB); PG8_STAGE(PG8_SB(0, 1), cB + hstep, voffB); PG8_STAGE(PG8_SA(0, 0), cA, voffA); PG8_STAGE(PG8_SA(0, 1), cA + hstep, voffA);
        if (wr == 1) PG8_BAR;
        PG8_WAIT_V(2); PG8_BAR;
        PG8_STAGE(PG8_SB(1, 0), cB + kstep, voffB); PG8_STAGE(PG8_SA(1, 0), cA + kstep, voffA); PG8_STAGE(PG8_SB(1, 1), cB + hstep + kstep, voffB);
        PG8_WAIT_V(6); PG8_BAR;
    } else {
        PG8_STAGE(PG8_SB(0, 0), cB, voffB); PG8_STAGE(PG8_SA(0, 0), cA, voffA); PG8_STAGE(PG8_SB(0, 1), cB + hstep, voffB); PG8_STAGE(PG8_SA(0, 1), cA + hstep, voffA);
        if (wr == 1) PG8_BAR;
        PG8_WAIT_V(4); PG8_BAR;
        PG8_STAGE(PG8_SB(1, 0), cB + kstep, voffB); PG8_STAGE(PG8_SA(1, 0), cA + kstep, voffA); PG8_STAGE(PG8_SB(1, 1), cB + hstep + kstep, voffB);
        PG8_WAIT_V(6); PG8_BAR;
    }
    for (;;) {
        const bool has_next = S.next(ui + 1, nxt);
        const char* nA = has_next ? (const char*)g.A + (size_t)nxt.pm * tstep : cA; const char* nB = has_next ? (const char*)g.Bt + (size_t)nxt.pn * tstep : cB;
        for (int t = 0; t < nt; t += 2) {
            const bool last = (t == nt - 2);
            const char* a1 = cA + (size_t)(t + 1) * kstep;
            const char* a2 = last ? nA : cA + (size_t)(t + 2) * kstep; const char* b2 = last ? nB : cB + (size_t)(t + 2) * kstep;
            const char* a3 = a2 + kstep; const char* b3 = b2 + kstep;
            if (last && has_next) S.a_ready(nxt);
            if constexpr (SP2) {
            PG8_LDB(B0, 0, 0); PG8_LDB(B1, 0, 1); PG8_SCHED; PG8_LDA(At, 0, 0); PG8_STAGE(PG8_SA(1, 1), a1 + hstep, voffA);
            PG8_WAIT_V(8); PG8_WAIT_L(0); PG8_BAR; PG8_MMA(0, 0, At, B0); PG8_MMA(0, 1, At, B1); PG8_BAR; PG8_SCHED;
            PG8_LDA(At, 0, 1); PG8_STAGE(PG8_SB(0, 0), b2, voffB); PG8_STAGE(PG8_SB(0, 1), b2 + hstep, voffB); PG8_STAGE(PG8_SA(0, 0), a2, voffA);
            PG8_WAIT_V(8); PG8_WAIT_L(0); PG8_BAR; PG8_MMA(1, 0, At, B0); PG8_MMA(1, 1, At, B1); PG8_BAR; PG8_SCHED;
            PG8_LDB(B0, 1, 0); PG8_LDB(B1, 1, 1); PG8_SCHED; PG8_LDA(At, 1, 0); PG8_STAGE(PG8_SA(0, 1), a2 + hstep, voffA);
            PG8_WAIT_V(8); PG8_WAIT_L(0); PG8_BAR; PG8_MMA(0, 0, At, B0); PG8_MMA(0, 1, At, B1); PG8_BAR; PG8_SCHED;
            PG8_LDA(At, 1, 1); PG8_STAGE(PG8_SB(1, 0), b3, voffB); PG8_STAGE(PG8_SB(1, 1), b3 + hstep, voffB); PG8_STAGE(PG8_SA(1, 0), a3, voffA);
            PG8_WAIT_V(8); PG8_WAIT_L(0); PG8_BAR; PG8_MMA(1, 0, At, B0); PG8_MMA(1, 1, At, B1); PG8_BAR; PG8_SCHED;
            } else {
            PG8_LDB(B0, 0, 0); PG8_SCHED; PG8_LDA(At, 0, 0); PG8_STAGE(PG8_SA(1, 1), a1 + hstep, voffA);
            PG8_WAIT_L(8); PG8_BAR; PG8_WAIT_L(0); PG8_MMA(0, 0, At, B0); PG8_BAR; PG8_SCHED;
            PG8_LDB(B1, 0, 1); PG8_STAGE(PG8_SB(0, 0), b2, voffB);
            PG8_BAR; PG8_WAIT_L(0); PG8_MMA(0, 1, At, B1); PG8_BAR;
            PG8_LDA(At, 0, 1); PG8_STAGE(PG8_SA(0, 0), a2, voffA);
            PG8_BAR; PG8_WAIT_L(0); PG8_MMA(1, 0, At, B0); PG8_BAR; PG8_SCHED;
            PG8_STAGE(PG8_SB(0, 1), b2 + hstep, voffB);
            PG8_WAIT_V(6); PG8_BAR; PG8_MMA(1, 1, At, B1); PG8_BAR;
            PG8_LDB(B0, 1, 0); PG8_SCHED; PG8_LDA(At, 1, 0); PG8_STAGE(PG8_SA(0, 1), a2 + hstep, voffA);
            PG8_WAIT_L(8); PG8_BAR; PG8_WAIT_L(0); PG8_MMA(0, 0, At, B0); PG8_BAR; PG8_SCHED;
            PG8_LDB(B1, 1, 1); PG8_STAGE(PG8_SB(1, 0), b3, voffB);
            PG8_BAR; PG8_WAIT_L(0); PG8_MMA(0, 1, At, B1); PG8_BAR;
            PG8_LDA(At, 1, 1); PG8_STAGE(PG8_SA(1, 0), a3, voffA);
            PG8_BAR; PG8_WAIT_L(0); PG8_MMA(1, 0, At, B0); PG8_BAR; PG8_SCHED;
            PG8_STAGE(PG8_SB(1, 1), b3 + hstep, voffB);
            PG8_WAIT_V(6); PG8_BAR; PG8_MMA(1, 1, At, B1); PG8_BAR;
            }
        }
        if constexpr (ALIGN_EPI) { if (wr == 0) PG8_BAR; }
        if constexpr (!Epi::AFTER_DRAIN) { E(acc, cur, wr, wc, fr, fq); S.done(cur); }
        if (!has_next) break;
#pragma unroll
        for (int a = 0; a < 2; ++a)
#pragma unroll
            for (int b = 0; b < 2; ++b)
#pragma unroll
                for (int m = 0; m < 4; ++m)
#pragma unroll
                    for (int n = 0; n < 2; ++n) acc[a][b][m][n] = (f32x4){0.f, 0.f, 0.f, 0.f};
        cur = nxt; cA = nA; cB = nB; ++ui;
        if constexpr (ALIGN_EPI) { if (wr == 1) PG8_BAR; }
    }
    PG8_WAIT_V(0);
    if constexpr (!ALIGN_EPI) { if (wr == 0) PG8_BAR; }
    PG8_BAR;
    if constexpr (Epi::AFTER_DRAIN) { E.fused(acc, cur, wr, wc, fr, fq, lds, wid, lane); S.done(cur); }
#undef PG8_SA
#undef PG8_SB
#undef PG8_STAGE
#undef PG8_LDA
#undef PG8_LDB
#undef PG8_MMA
#undef PG8_WAIT_V
#undef PG8_WAIT_L
#undef PG8_BAR
#undef PG8_SCHED
}
}

#define LAS __attribute__((address_space(3)))
typedef unsigned short bf16;
typedef short bf16x8 __attribute__((ext_vector_type(8)));
typedef short s16x4 __attribute__((ext_vector_type(4)));
typedef float f32x4 __attribute__((ext_vector_type(4)));
typedef unsigned v4u __attribute__((ext_vector_type(4)));
typedef unsigned v2u __attribute__((ext_vector_type(2)));
#define MFMA16(a, b, c) __builtin_amdgcn_mfma_f32_16x16x32_bf16((a), (b), (c), 0, 0, 0)
#define CAT8(lo, hi) __builtin_shufflevector((lo), (hi), 0, 1, 2, 3, 4, 5, 6, 7)
#define LDS_WAIT() asm volatile("s_waitcnt lgkmcnt(0)" ::: "memory")

constexpr int D = 1024, FF = 2816, MH = 32768, NPROJ = 3840, INW = 3600;
constexpr float EPS = 1e-6f;
constexpr size_t MiB = 1u << 20;
constexpr size_t WS_MOD = 1 * MiB, WS_ROPE = 2 * MiB;
constexpr size_t WS_WGU1 = 4 * MiB, WS_WD1 = 15 * MiB, WS_WIN = 15 * MiB + 5632 * 1024, WS_WOUT = 28 * MiB, WS_WGU2 = 30 * MiB, WS_WD2 = 41 * MiB;
constexpr size_t WS_H = 48 * MiB, WS_DQ = 48 * MiB, WS_DK = 80 * MiB, WS_DV = 112 * MiB, WS_OF = 80 * MiB, WS_OB = 112 * MiB;
constexpr size_t WS_ACT = 112 * MiB, WS_PA = 144 * MiB, WS_Z = 240 * MiB, WS_CH = 272 * MiB, WS_PD = 272 * MiB, WS_OG = 272 * MiB, WS_LSE = 368 * MiB, WS_MIX = 374 * MiB;
constexpr size_t WS_AB = 496 * MiB, WS_GB = 498 * MiB, WS_GC = 500 * MiB, WS_END = 501 * MiB;
constexpr size_t WS_OG2 = 512 * MiB, WS_LSE2 = 608 * MiB, WS_OVL_END = 612 * MiB;
constexpr int ACTR_WORD = 3600;
constexpr int LDS_BYTES = 163840;
constexpr int CHJOB = 57344;

__device__ __forceinline__ float bf2f(unsigned short v) { return __uint_as_float(((unsigned)v) << 16); }
__device__ __forceinline__ float bflo(unsigned w) { return __uint_as_float(w << 16); }
__device__ __forceinline__ float bfhi(unsigned w) { return __uint_as_float(w & 0xffff0000u); }
__device__ __forceinline__ unsigned pk2(float lo, float hi) { return pg8::cvt_pk_bf16(lo, hi); }
__device__ __forceinline__ float opaque_one() { float o = 1.0f; asm volatile("" : "+v"(o)); return o; }
__device__ __forceinline__ float silu(float v) { return v * __builtin_amdgcn_rcpf(1.0f + __expf(-v)); }
__device__ __forceinline__ float xmax16(float x) { auto r = __builtin_amdgcn_permlane16_swap(__float_as_uint(x), __float_as_uint(x), false, false); return fmaxf(__uint_as_float(r[0]), __uint_as_float(r[1])); }
__device__ __forceinline__ float xmax32(float x) { auto r = __builtin_amdgcn_permlane32_swap(__float_as_uint(x), __float_as_uint(x), false, false); return fmaxf(__uint_as_float(r[0]), __uint_as_float(r[1])); }
__device__ __forceinline__ float xsum16(float x) { auto r = __builtin_amdgcn_permlane16_swap(__float_as_uint(x), __float_as_uint(x), false, false); return __uint_as_float(r[0]) + __uint_as_float(r[1]); }
__device__ __forceinline__ float xsum32(float x) { auto r = __builtin_amdgcn_permlane32_swap(__float_as_uint(x), __float_as_uint(x), false, false); return __uint_as_float(r[0]) + __uint_as_float(r[1]); }
__device__ __forceinline__ float wave_sum(float v) {
#pragma unroll
    for (int o = 1; o < 64; o <<= 1) v += __shfl_xor(v, o);
    return v;
}
__device__ __forceinline__ bf16x8 pack8(const f32x4 a, const f32x4 b) {
    v4u w; w.x = pk2(a[0], a[1]); w.y = pk2(a[2], a[3]); w.z = pk2(b[0], b[1]); w.w = pk2(b[2], b[3]);
    return __builtin_bit_cast(bf16x8, w);
}
__device__ __forceinline__ bf16x8 pack8cv(const f32x4 a, const f32x4 b) {
    v4u w; w.x = pg8::cvt_pk_bf16_cv(a[0], a[1]); w.y = pg8::cvt_pk_bf16_cv(a[2], a[3]); w.z = pg8::cvt_pk_bf16_cv(b[0], b[1]); w.w = pg8::cvt_pk_bf16_cv(b[2], b[3]);
    return __builtin_bit_cast(bf16x8, w);
}
__device__ __forceinline__ f32x4 ld_bf4(const bf16* p) { const v2u w = *(const v2u*)p; return (f32x4){bflo(w.x), bfhi(w.x), bflo(w.y), bfhi(w.y)}; }

__device__ __forceinline__ void ph_mod(const float* c_prompt, const float* c_sample, const float* ada_w, const float* ada_b, float* MOD, LAS unsigned char* lds) {
    const int tid = pg8::otid(), lane = tid & 63, wave = tid >> 6;
    LAS float* sc = (LAS float*)lds;
    LAS float* red = (LAS float*)(lds + 49152);
    for (int i = tid; i < 12 * 1024; i += 512) { const int b = i >> 10, k = i & 1023; const float v = b < 8 ? c_prompt[b * 1024 + k] : c_sample[(b - 8) * 1024 + k]; sc[i] = silu(v); }
    __syncthreads();
    const int cl = tid & 7, kg = tid >> 3;
    for (int item = blockIdx.x; item < 576; item += gridDim.x) {
        const int layer = item / 288, cg32 = item % 288, col = cg32 * 32 + cl * 4;
        float acc[12][4];
#pragma unroll
        for (int b = 0; b < 12; ++b)
#pragma unroll
            for (int j = 0; j < 4; ++j) acc[b][j] = 0.f;
        const float* wp = ada_w + (size_t)layer * 1024 * 9216 + col;
#pragma unroll 4
        for (int kk = 0; kk < 16; ++kk) { const int k = kg * 16 + kk; const f32x4 w = *(const f32x4*)(wp + (size_t)k * 9216);
#pragma unroll
            for (int b = 0; b < 12; ++b) { const float s = sc[b * 1024 + k];
#pragma unroll
                for (int j = 0; j < 4; ++j) acc[b][j] += s * w[j]; } }
#pragma unroll
        for (int b = 0; b < 12; ++b)
#pragma unroll
            for (int j = 0; j < 4; ++j) { float v = acc[b][j]; v += __shfl_xor(v, 8); v += __shfl_xor(v, 16); v += __shfl_xor(v, 32); if ((lane >> 3) == 0) red[(wave * 8 + cl) * 48 + b * 4 + j] = v; }
        __syncthreads();
        if (tid < 384) { const int b = tid >> 5, c = tid & 31; float s = 0.f;
#pragma unroll
            for (int w = 0; w < 8; ++w) s += red[(w * 8 + (c >> 2)) * 48 + b * 4 + (c & 3)];
            MOD[(size_t)(layer * 12 + b) * 9216 + cg32 * 32 + c] = s + ada_b[layer * 9216 + cg32 * 32 + c]; }
        __syncthreads();
    }
}
__device__ __forceinline__ void ph_rope(float* ROPE) {
    for (int idx = blockIdx.x * 512 + pg8::otid(); idx < 8192 * 8; idx += gridDim.x * 512) {
        const int s = idx >> 3, i = idx & 7;
        const float inv = exp2f(-(float)i * 0.125f * 18.931568569324174f);
        const float ang = (float)s * inv;
        double rev = (double)ang * 0.15915494309189535; rev -= __builtin_rint(rev);
        const float fr = (float)rev;
        ROPE[s * 16 + i] = __builtin_amdgcn_cosf(fr); ROPE[s * 16 + 8 + i] = __builtin_amdgcn_sinf(fr);
    }
}
__device__ __forceinline__ void tr_item(const float* W, int K, int N, bf16* WT, int k0, int n0, int dst_row0, LAS float* scr, int lane) {
#pragma unroll 8
    for (int i = 0; i < 32; ++i) { const int kk = 2 * i + (lane >> 5), n = n0 + (lane & 31); scr[kk * 33 + (lane & 31)] = (n < N) ? W[(size_t)(k0 + kk) * N + n] : 0.f; }
    LDS_WAIT();
    const int c = lane & 7;
#pragma unroll
    for (int j = 0; j < 4; ++j) { const int n = (lane >> 3) + 8 * j; const LAS float* s = scr + (8 * c) * 33 + n;
        v4u o; o.x = pk2(s[0 * 33], s[1 * 33]); o.y = pk2(s[2 * 33], s[3 * 33]); o.z = pk2(s[4 * 33], s[5 * 33]); o.w = pk2(s[6 * 33], s[7 * 33]);
        *(v4u*)(WT + (size_t)(dst_row0 + n) * K + k0 + 8 * c) = o; }
    LDS_WAIT();
}
__device__ __forceinline__ void ph_wconv(const float* wg1, const float* wu1, const float* wd1, const float* wg2, const float* wu2, const float* wd2, const float* win, const float* wout,
                                         int layer, unsigned char* ws, LAS unsigned char* lds) {
    const int tid_ = pg8::otid(), lane = tid_ & 63, wave = tid_ >> 6;
    LAS float* scr = (LAS float*)(lds + wave * 16384);
    const int gw = blockIdx.x * 8 + wave, NGW = gridDim.x * 8;
    constexpr int I_GU = 16 * 88, I_DN = 44 * 32, I_IN = 16 * 120, I_OUT = 16 * 32;
    constexpr int NIT = 6 * I_GU + I_IN + I_OUT;
    static_assert(I_DN == I_GU, "item counts");
    for (int it = gw; it < NIT; it += NGW) {
        int r = it;
        if (r < 6 * I_GU) {
            const int which = r / I_GU; r -= which * I_GU;
            const int f = which / 3, t = which % 3;
            if (t < 2) { const float* W = (f ? (t ? wu2 : wg2) : (t ? wu1 : wg1)) + (size_t)layer * D * FF; bf16* WT = (bf16*)(ws + (f ? WS_WGU2 : WS_WGU1));
                const int kb = r / 88, nb = r % 88, n0 = nb * 32; tr_item(W, D, FF, WT, kb * 64, n0, (n0 >> 7) * 256 + t * 128 + (n0 & 127), scr, lane); }
            else { const float* W = (f ? wd2 : wd1) + (size_t)layer * D * FF; bf16* WT = (bf16*)(ws + (f ? WS_WD2 : WS_WD1));
                const int kb = r / 32, nb = r % 32; tr_item(W, FF, D, WT, kb * 64, nb * 32, nb * 32, scr, lane); }
            continue;
        }
        r -= 6 * I_GU;
        if (r < I_IN) { const int kb = r / 120, nb = r % 120; tr_item(win + (size_t)layer * D * INW, D, INW, (bf16*)(ws + WS_WIN), kb * 64, nb * 32, nb * 32, scr, lane); continue; }
        r -= I_IN;
        { const int kb = r / 32, nb = r % 32; tr_item(wout + (size_t)layer * D * D, D, D, (bf16*)(ws + WS_WOUT), kb * 64, nb * 32, nb * 32, scr, lane); }
    }
}
__device__ __forceinline__ void ph_norm(const float* x, const float* nw, const float* modl, int sb, int half, bf16* H) {
    const int tid_ = pg8::otid(), lane = tid_ & 63, wave = tid_ >> 6;
    const int gw = blockIdx.x * 8 + wave, NGW = gridDim.x * 8;
    for (int r0 = gw * 16; r0 < MH; r0 += NGW * 16) {
        const int batch = half ? 8 + (r0 >> 13) : (r0 >> 12);
        const float* mp = modl + (size_t)batch * 9216 + sb * 3072;
        f32x4 A[4], B[4];
#pragma unroll
        for (int j = 0; j < 4; ++j) { const int c = 4 * lane + 256 * j; const f32x4 w = *(const f32x4*)(nw + c), sh = *(const f32x4*)(mp + c), scl = *(const f32x4*)(mp + 1024 + c); A[j] = w * (1.0f + scl); B[j] = sh; }
        for (int r = r0; r < r0 + 16; ++r) {
            const f32x4* xr = (const f32x4*)(x + (size_t)r * D) + lane;
            f32x4 v[4]; float s = 0.f;
#pragma unroll
            for (int j = 0; j < 4; ++j) { v[j] = xr[64 * j]; s += (v[j].x * v[j].x + v[j].y * v[j].y) + (v[j].z * v[j].z + v[j].w * v[j].w); }
            const float rstd = __builtin_amdgcn_rsqf(wave_sum(s) * (1.f / D) + EPS);
            v2u* o8 = (v2u*)(H + (size_t)r * D) + lane;
#pragma unroll
            for (int j = 0; j < 4; ++j) { const f32x4 h = v[j] * rstd * A[j] + B[j]; v2u w; w.x = pk2(h.x, h.y); w.y = pk2(h.z, h.w); o8[64 * j] = w; }
        }
    }
}
__device__ __forceinline__ void ph_final(float* x, const float* nw) {
    const int tid_ = pg8::otid(), lane = tid_ & 63, wave = tid_ >> 6;
    const int gw = blockIdx.x * 8 + wave, NGW = gridDim.x * 8;
    f32x4 A[4];
#pragma unroll
    for (int j = 0; j < 4; ++j) A[j] = *(const f32x4*)(nw + 4 * lane + 256 * j);
    for (int r = gw; r < 2 * MH; r += NGW) {
        f32x4* xr = (f32x4*)(x + (size_t)r * D) + lane;
        f32x4 v[4]; float s = 0.f;
#pragma unroll
        for (int j = 0; j < 4; ++j) { v[j] = xr[64 * j]; s += (v[j].x * v[j].x + v[j].y * v[j].y) + (v[j].z * v[j].z + v[j].w * v[j].w); }
        const float rstd = __builtin_amdgcn_rsqf(wave_sum(s) * (1.f / D) + EPS);
#pragma unroll
        for (int j = 0; j < 4; ++j) xr[64 * j] = v[j] * rstd * A[j];
    }
}
__device__ __forceinline__ void ph_dnpre(const bf16* PD, const float* AB, const float* conv_w, const float* a_log, const float* dt_bias,
                                         bf16* DQ, bf16* DK, bf16* DV, float* GB, int S) {
    const int tid_ = pg8::otid(), lane = tid_ & 63, wave = tid_ >> 6;
    const int gw = blockIdx.x * 8 + wave, NGW = gridDim.x * 8;
    for (int t0 = gw * 16; t0 < MH; t0 += NGW * 16) {
        const int s0 = t0 & (S - 1);
        for (int part = 0; part < 3; ++part) {
            const bf16* src = PD + part * 512 + lane * 8;
            bf16* dst = (part == 0 ? DQ : (part == 1 ? DK : DV)) + lane * 8;
            f32x4 w[5][2];
#pragma unroll
            for (int j = 0; j < 5; ++j) { const float* wp = conv_w + j * 1536 + part * 512 + lane * 8; w[j][0] = *(const f32x4*)wp; w[j][1] = *(const f32x4*)(wp + 4); }
            v4u r0, r1, r2, r3, r4;
            const v4u zero = {0u, 0u, 0u, 0u};
#define ROWLD(off) (((unsigned)(s0 + (off)) < (unsigned)S) ? *(const v4u*)(src + (size_t)(t0 + (off)) * 1536) : zero)
            r0 = ROWLD(-2); r1 = ROWLD(-1); r2 = ROWLD(0); r3 = ROWLD(1);
            for (int i = 0; i < 16; ++i) {
                r4 = ROWLD(i + 2);
                f32x4 y0, y1;
#define TAP(rr, j, first) { const f32x4 a = {bflo(rr.x), bfhi(rr.x), bflo(rr.y), bfhi(rr.y)}, b = {bflo(rr.z), bfhi(rr.z), bflo(rr.w), bfhi(rr.w)}; \
                    if (first) { y0 = a * w[j][0]; y1 = b * w[j][1]; } else { y0 += a * w[j][0]; y1 += b * w[j][1]; } }
                TAP(r0, 0, true) TAP(r1, 1, false) TAP(r2, 2, false) TAP(r3, 3, false) TAP(r4, 4, false)
#undef TAP
#pragma unroll
                for (int e = 0; e < 4; ++e) { y0[e] = silu(y0[e]); y1[e] = silu(y1[e]); }
                if (part < 2) {
                    float ss = (y0.x * y0.x + y0.y * y0.y) + (y0.z * y0.z + y0.w * y0.w) + (y1.x * y1.x + y1.y * y1.y) + (y1.z * y1.z + y1.w * y1.w);
                    ss += __shfl_xor(ss, 1); ss += __shfl_xor(ss, 2); ss += __shfl_xor(ss, 4); ss += __shfl_xor(ss, 8);
                    const float scl = __builtin_amdgcn_rsqf(ss + EPS) * (part == 0 ? 0.08838834764831845f : 1.0f);
                    y0 *= scl; y1 *= scl;
                }
                v4u o; o.x = pk2(y0.x, y0.y); o.y = pk2(y0.z, y0.w); o.z = pk2(y1.x, y1.y); o.w = pk2(y1.z, y1.w);
                *(v4u*)(dst + (size_t)(t0 + i) * 512) = o;
                r0 = r1; r1 = r2; r2 = r3; r3 = r4;
            }
#undef ROWLD
        }
#pragma unroll
        for (int jj = 0; jj < 4; ++jj) { const int idx = lane + 64 * jj, tok = t0 + (idx >> 4), c = idx & 15; const float v = AB[(size_t)tok * 16 + c];
            float res;
            if (c < 8) { const float xx = v + dt_bias[c]; const float sp = fmaxf(xx, 0.f) + __logf(1.0f + __expf(-fabsf(xx))); res = -__expf(a_log[c]) * sp; }
            else res = __builtin_amdgcn_rcpf(1.0f + __expf(-v));
            GB[(size_t)tok * 16 + c] = res; }
    }
}
__device__ __forceinline__ void ph_attn(const bf16* P, bf16* OG, float* LSE, int S, int lgS, LAS unsigned char* lds, unsigned* ctr) {
    const int tid = pg8::otid(), lane = tid & 63, wave = tid >> 6, l15 = lane & 15, g = lane >> 4;
    const float one = opaque_one();
    LAS unsigned char* KL = lds; LAS unsigned char* VT = lds + 46080;
    v4u kvr[5], vvr[5];
#define AT_DECODE(u_) const int tb = (u_) & 255, h = ((u_) >> 8) & 7, p = (u_) >> 11; const int lgd = 2 * p, L = S >> lgd, nb = L >> 7, bps = S >> 7; \
        const int seq = tb >> (lgS - 7), lb = tb & (bps - 1); const int r = lb / nb, ib = lb - r * nb, i0 = ib << 7; const int seqbase = seq << lgS;
#define AT_LOAD(u_) do { AT_DECODE(u_) _Pragma("unroll") for (int j = 0; j < 5; ++j) { const int idx = tid + 512 * j; const int kl = idx >> 3, pc = idx & 7, ik = i0 - 64 + kl; \
            kvr[j] = (v4u){0u, 0u, 0u, 0u}; vvr[j] = kvr[j]; \
            if (idx < 288 * 8 && ik >= 0 && ik < L) { const bf16* src = P + (size_t)(seqbase + (ik << lgd) + r) * 1536 + h * 64 + pc * 8; kvr[j] = *(const v4u*)(src + 512); vvr[j] = *(const v4u*)(src + 1024); } } } while (0)
    constexpr int NU = 3 * 8 * 256;
    volatile LAS unsigned* uw = (volatile LAS unsigned*)(lds + LDS_BYTES - 192);
    unsigned tk = 0u; int u, un;
    if (ctr) { if (tid == 0) uw[0] = atomicAdd(ctr, 1u); __syncthreads(); u = __builtin_amdgcn_readfirstlane((int)uw[0]); if (tid == 0) tk = atomicAdd(ctr, 1u); }
    else u = (int)blockIdx.x;
    if (u < NU) AT_LOAD(u);
    while (u < NU) {
        AT_DECODE(u)
        __syncthreads();
#pragma unroll
        for (int j = 0; j < 5; ++j) { const int idx = tid + 512 * j; const int kl = idx >> 3, pc = idx & 7;
            const int k5 = kl & 31, klp = (kl & ~31) + ((k5 & 16) ? (8 * ((k5 - 16) >> 2) + 4 + (k5 & 3)) : (8 * (k5 >> 2) + (k5 & 3)));
            if (idx < 288 * 8) { *(LAS v4u*)(KL + kl * 160 + pc * 16) = kvr[j];
#pragma unroll
                for (int e = 0; e < 8; ++e) { const unsigned wv = vvr[j][e >> 1]; *(LAS unsigned short*)(VT + (pc * 8 + e) * 608 + klp * 2) = (unsigned short)((e & 1) ? (wv >> 16) : (wv & 0xffffu)); } } }
        if (ctr && tid == 0) uw[0] = tk;
        __syncthreads();
        if (ctr) { un = __builtin_amdgcn_readfirstlane((int)uw[0]); if (tid == 0) tk = atomicAdd(ctr, 1u); } else un = u + (int)gridDim.x;
        if (un < NU) AT_LOAD(un);
        const int iq = i0 + 16 * wave + l15, tokq = seqbase + (iq << lgd) + r;
        bf16x8 qf[2];
#pragma unroll
        for (int ks = 0; ks < 2; ++ks) qf[ks] = *(const bf16x8*)(P + (size_t)tokq * 1536 + h * 64 + 32 * ks + 8 * g);
        f32x4 acc[4];
#pragma unroll
        for (int dt = 0; dt < 4; ++dt) acc[dt] = (f32x4){0.f, 0.f, 0.f, 0.f};
        float m = -1e30f, lsum = 0.f;
        for (int s = 0; s < 5; ++s) {
            const int kl0 = 32 * (wave >> 1) + 32 * s;
            bf16x8 ka[2][2], vfr[4];
#pragma unroll
            for (int t = 0; t < 2; ++t)
#pragma unroll
                for (int ks = 0; ks < 2; ++ks) ka[t][ks] = *(const LAS bf16x8*)(KL + (kl0 + 16 * t + l15) * 160 + (32 * ks + 8 * g) * 2);
#pragma unroll
            for (int dt = 0; dt < 4; ++dt) vfr[dt] = *(const LAS bf16x8*)(VT + (16 * dt + l15) * 608 + kl0 * 2 + 16 * g);
            __builtin_amdgcn_sched_barrier(0);
            f32x4 c[2];
#pragma unroll
            for (int t = 0; t < 2; ++t) { c[t] = (f32x4){0.f, 0.f, 0.f, 0.f};
#pragma unroll
                for (int ks = 0; ks < 2; ++ks) c[t] = MFMA16(ka[t][ks], qf[ks], c[t]); }
            float sc[8]; float mx = -1e30f;
#pragma unroll
            for (int t = 0; t < 2; ++t)
#pragma unroll
                for (int rg = 0; rg < 4; ++rg) { const int ik = i0 - 64 + kl0 + 16 * t + 4 * g + rg, dl = ik - iq;
                    const bool valid = (ik >= 0) && (ik < L) && (dl <= 64) && (dl >= -64);
                    const float sv = valid ? c[t][rg] * 0.18033688011112042f : -1e30f; sc[t * 4 + rg] = sv; mx = fmaxf(mx, sv); }
            mx = xmax32(xmax16(mx));
            const float mn = fmaxf(m, mx), alpha = __builtin_amdgcn_exp2f(m - mn); m = mn;
            float ps = 0.f; f32x4 p0, p1;
#pragma unroll
            for (int e = 0; e < 4; ++e) { p0[e] = __builtin_amdgcn_exp2f(sc[e] - mn); p1[e] = __builtin_amdgcn_exp2f(sc[4 + e] - mn); ps += p0[e] + p1[e]; }
            lsum = lsum * alpha + ps;
            const bf16x8 pf = pack8(p0 * one, p1 * one);
#pragma unroll
            for (int dt = 0; dt < 4; ++dt) { acc[dt] *= alpha;
                acc[dt] = MFMA16(vfr[dt], pf, acc[dt]); }
        }
        lsum = xsum32(xsum16(lsum));
        const float inv = 1.0f / lsum;
        bf16* og = OG + ((size_t)p * MH + tokq) * 512 + h * 64 + 4 * g;
#pragma unroll
        for (int dt = 0; dt < 4; ++dt) { v2u w; w.x = pk2(acc[dt][0] * inv, acc[dt][1] * inv); w.y = pk2(acc[dt][2] * inv, acc[dt][3] * inv); *(v2u*)(og + 16 * dt) = w; }
        if (g == 0) LSE[((size_t)p * MH + tokq) * 8 + h] = (m + __log2f(lsum)) * 0.6931471805599453f;
        u = un;
    }
#undef AT_LOAD
#undef AT_DECODE
}
__device__ __forceinline__ void ph_chunk(const bf16* DQ, const bf16* DK, const bf16* DV, const float* GB, unsigned char* CH, float* GC, int S, int lgS, LAS unsigned char* lds) {
    const int tid_ = pg8::otid(), lane = tid_ & 63, wave = tid_ >> 6, l15 = lane & 15, g = lane >> 4;
    const float one = opaque_one();
    LAS unsigned char* wl = lds + wave * 18432;
    LAS float* Al = (LAS float*)wl; LAS float* gcs = (LAS float*)(wl + 17408); LAS float* bts = gcs + 64;
    LAS bf16* TP = (LAS bf16*)wl; LAS bf16* TPP = (LAS bf16*)(wl + 8192);
    for (int job = blockIdx.x * 8 + wave; job < 4096; job += gridDim.x * 8) {
        const int dir = job & 1, h = (job >> 1) & 3, cgi = job >> 3, cps = S >> 6;
        const int seq = cgi >> (lgS - 6), n = cgi & (cps - 1), seqbase = seq << lgS;
#define TOK(c) (seqbase + (dir ? (S - 1 - (64 * n + (c))) : (64 * n + (c))))
        {   const int tokc = TOK(lane);
            const float gv = GB[(size_t)tokc * 16 + dir * 4 + h], bv = GB[(size_t)tokc * 16 + 8 + dir * 4 + h];
            float cs = gv;
#pragma unroll
            for (int o = 1; o < 64; o <<= 1) { const float t = __shfl_up(cs, o); if (lane >= o) cs += t; }
            gcs[lane] = cs; bts[lane] = bv; GC[(size_t)job * 64 + lane] = cs; }
        LDS_WAIT();
        bf16x8 kf[4][4];
#pragma unroll
        for (int t = 0; t < 4; ++t)
#pragma unroll
            for (int ks = 0; ks < 4; ++ks) kf[t][ks] = *(const bf16x8*)(DK + (size_t)TOK(16 * t + l15) * 512 + h * 128 + 32 * ks + 8 * g);
#pragma unroll
        for (int it = 0; it < 4; ++it) { const int i = 16 * it + l15; const float gi = gcs[i], bi = bts[i];
#pragma unroll
            for (int jt = 0; jt <= it; ++jt) { f32x4 c = {0.f, 0.f, 0.f, 0.f};
#pragma unroll
                for (int ks = 0; ks < 4; ++ks) c = MFMA16(kf[jt][ks], kf[it][ks], c);
                const f32x4 gj = *(const LAS f32x4*)(gcs + 16 * jt + 4 * g); f32x4 o;
#pragma unroll
                for (int rg = 0; rg < 4; ++rg) { const int j = 16 * jt + 4 * g + rg; o[rg] = (j < i) ? bi * c[rg] * __expf(gi - gj[rg]) : 0.f; }
                *(LAS f32x4*)(Al + i * 68 + 16 * jt + 4 * g) = o; } }
        unsigned char* chb = CH + (size_t)job * CHJOB;
        bf16* UT = (bf16*)chb; bf16* Wm = (bf16*)(chb + 16384); bf16* KT = (bf16*)(chb + 32768); bf16* QK = (bf16*)(chb + 49152);
#pragma unroll
        for (int it = 0; it < 4; ++it) { const int i = 16 * it + l15; const float gi = gcs[i];
            bf16x8 qfr[4];
#pragma unroll
            for (int ks = 0; ks < 4; ++ks) qfr[ks] = *(const bf16x8*)(DQ + (size_t)TOK(i) * 512 + h * 128 + 32 * ks + 8 * g);
#pragma unroll
            for (int jt = 0; jt < 4; ++jt) { v2u out = {0u, 0u};
                if (jt <= it) { f32x4 c = {0.f, 0.f, 0.f, 0.f};
#pragma unroll
                    for (int ks = 0; ks < 4; ++ks) c = MFMA16(kf[jt][ks], qfr[ks], c);
                    const f32x4 gj = *(const LAS f32x4*)(gcs + 16 * jt + 4 * g); f32x4 o;
#pragma unroll
                    for (int rg = 0; rg < 4; ++rg) { const int j = 16 * jt + 4 * g + rg; o[rg] = (j <= i) ? c[rg] * __expf(gi - gj[rg]) : 0.f; }
                    out.x = pk2(o[0], o[1]); out.y = pk2(o[2], o[3]); }
                *(v2u*)(QK + i * 64 + 16 * jt + 4 * g) = out; } }
        LDS_WAIT();
        float t[64];
#pragma unroll
        for (int i = 0; i < 64; ++i) { float a0 = 0.f, a1 = 0.f, a2 = 0.f, a3 = 0.f;
#pragma unroll
            for (int j4 = 0; j4 * 4 < i; ++j4) { const f32x4 a = *(const LAS f32x4*)(Al + i * 68 + 4 * j4);
                if (4 * j4 + 0 < i) a0 += a[0] * t[4 * j4 + 0];
                if (4 * j4 + 1 < i) a1 += a[1] * t[4 * j4 + 1];
                if (4 * j4 + 2 < i) a2 += a[2] * t[4 * j4 + 2];
                if (4 * j4 + 3 < i) a3 += a[3] * t[4 * j4 + 3]; }
            t[i] = ((lane == i) ? 1.f : 0.f) - ((a0 + a1) + (a2 + a3)); }
        const float bc = bts[lane], ec = bc * __expf(gcs[lane]);
        LDS_WAIT();
#pragma unroll
        for (int i = 0; i < 64; ++i) { const unsigned w = pk2(t[i] * bc, t[i] * ec); TP[i * 64 + lane] = (bf16)(w & 0xffffu); TPP[i * 64 + lane] = (bf16)(w >> 16); }
        LDS_WAIT();
        bf16x8 tf[4][2];
#pragma unroll
        for (int mt = 0; mt < 4; ++mt)
#pragma unroll
            for (int ks = 0; ks < 2; ++ks) tf[mt][ks] = *(const LAS bf16x8*)(TP + (16 * mt + l15) * 64 + 32 * ks + 8 * g);
        for (int nt = 0; nt < 8; ++nt) {
            bf16x8 vf[2];
#pragma unroll
            for (int ks = 0; ks < 2; ++ks)
#pragma unroll
                for (int e = 0; e < 8; ++e) vf[ks][e] = (short)DV[(size_t)TOK(32 * ks + 8 * g + e) * 512 + h * 128 + 16 * nt + l15];
#pragma unroll
            for (int mt = 0; mt < 4; ++mt) { f32x4 c = {0.f, 0.f, 0.f, 0.f};
#pragma unroll
                for (int ks = 0; ks < 2; ++ks) c = MFMA16(tf[mt][ks], vf[ks], c);
                c *= one;
                v2u w; w.x = pk2(c[0], c[1]); w.y = pk2(c[2], c[3]); *(v2u*)(UT + (16 * nt + l15) * 64 + 16 * mt + 4 * g) = w; }
        }
#pragma unroll
        for (int mt = 0; mt < 4; ++mt)
#pragma unroll
            for (int ks = 0; ks < 2; ++ks) tf[mt][ks] = *(const LAS bf16x8*)(TPP + (16 * mt + l15) * 64 + 32 * ks + 8 * g);
        for (int dt = 0; dt < 8; ++dt) {
            bf16x8 kt[2];
#pragma unroll
            for (int ks = 0; ks < 2; ++ks) {
#pragma unroll
                for (int e = 0; e < 8; ++e) kt[ks][e] = (short)DK[(size_t)TOK(32 * ks + 8 * g + e) * 512 + h * 128 + 16 * dt + l15];
                *(bf16x8*)(KT + (16 * dt + l15) * 64 + 32 * ks + 8 * g) = kt[ks]; }
#pragma unroll
            for (int mt = 0; mt < 4; ++mt) { f32x4 c = {0.f, 0.f, 0.f, 0.f};
#pragma unroll
                for (int ks = 0; ks < 2; ++ks) c = MFMA16(kt[ks], tf[mt][ks], c);
                c *= one;
                v2u w; w.x = pk2(c[0], c[1]); w.y = pk2(c[2], c[3]); *(v2u*)(Wm + (16 * mt + l15) * 128 + 16 * dt + 4 * g) = w; }
        }
        LDS_WAIT();
    }
}
#define TOKN(c, nn) (seqbase + (dir ? (S - 1 - (64 * (nn) + (c))) : (64 * (nn) + (c))))
constexpr int SC_PW = 288, SC_PK = 160;
constexpr int SC_W = 0, SC_Q = 64 * SC_PW, SC_QK = 2 * 64 * SC_PW, SC_KT = SC_QK + 64 * SC_PK, SC_GC = SC_KT + 128 * SC_PK, SC_BUF = SC_GC + 256;
static_assert(2 * SC_BUF + 4 * 5120 <= LDS_BYTES - 256, "scan LDS image");
__device__ __forceinline__ void ph_scan(const bf16* DQ, const unsigned char* CH, const float* GC, bf16* OF, bf16* OB, int S, int lgS, int half, LAS unsigned char* lds) {
    const int wave = __builtin_amdgcn_readfirstlane(pg8::otid() >> 6);
    const float one = opaque_one();
#define SC_BAR() do { asm volatile("s_waitcnt lgkmcnt(0)" ::: "memory"); __builtin_amdgcn_s_barrier(); asm volatile("" ::: "memory"); } while (0)
    const int nchain = half ? 32 : 64, cps = S >> 6;
    for (int ub = blockIdx.x; ub < 2 * nchain; ub += gridDim.x) {
        const int chain = (ub & 7) + 8 * (ub >> 4), part = (ub >> 3) & 1;
        const int dir = chain & 1, h = (chain >> 1) & 3, seq = chain >> 3, seqbase = seq << lgS;
        __syncthreads();
        if (wave >= 4) {
            const int lt = pg8::otid() - 256;
            const int wr0 = lt >> 4, wc = lt & 15, kr0 = lt >> 3, kc = lt & 7;
            const int woff = (wc >> 2) * 64 + (wc & 1) * 32 + ((wc >> 1) & 1) * 8, koff = (kc >> 2) * 64 + (kc & 1) * 32 + ((kc >> 1) & 1) * 8;
            v4u rwA[4], rqA[4], rkA[2], rtA[4], rwB[4], rqB[4], rkB[2], rtB[4]; f32x4 rgA = {0.f, 0.f, 0.f, 0.f}, rgB = rgA;
#define SC_LD(rw, rq, rk, rt, rg, n_) do { const int nn_ = (n_); const int job = ((seq * cps + nn_) << 3) | (h << 1) | dir; const unsigned char* chb = CH + (size_t)job * CHJOB; \
                const bf16* Wm_ = (const bf16*)(chb + 16384); const bf16* KT_ = (const bf16*)(chb + 32768); const bf16* QK_ = (const bf16*)(chb + 49152); \
                _Pragma("unroll") for (int k = 0; k < 4; ++k) { rw[k] = *(const v4u*)(Wm_ + (wr0 + 16 * k) * 128 + wc * 8); rq[k] = *(const v4u*)(DQ + (size_t)TOKN(wr0 + 16 * k, nn_) * 512 + h * 128 + wc * 8); rt[k] = *(const v4u*)(KT_ + (kr0 + 32 * k) * 64 + kc * 8); } \
                _Pragma("unroll") for (int k = 0; k < 2; ++k) rk[k] = *(const v4u*)(QK_ + (kr0 + 32 * k) * 64 + kc * 8); \
                if (lt < 16) rg = *(const f32x4*)(GC + (size_t)job * 64 + 4 * lt); } while (0)
#define SC_ST8(dst_, v_) do { LAS unsigned char* d_ = (dst_); *(LAS v2u*)d_ = (v2u){(v_).x, (v_).y}; *(LAS v2u*)(d_ + 16) = (v2u){(v_).z, (v_).w}; } while (0)
#define SC_ST(rw, rq, rk, rt, rg, n_) do { LAS unsigned char* b_ = lds + ((n_) & 1) * SC_BUF; \
                _Pragma("unroll") for (int k = 0; k < 4; ++k) { SC_ST8(b_ + SC_W + (wr0 + 16 * k) * SC_PW + woff, rw[k]); SC_ST8(b_ + SC_Q + (wr0 + 16 * k) * SC_PW + woff, rq[k]); SC_ST8(b_ + SC_KT + (kr0 + 32 * k) * SC_PK + koff, rt[k]); } \
                _Pragma("unroll") for (int k = 0; k < 2; ++k) SC_ST8(b_ + SC_QK + (kr0 + 32 * k) * SC_PK + koff, rk[k]); \
                if (lt < 16) *(LAS f32x4*)(b_ + SC_GC + 16 * lt) = rg; } while (0)
            unsigned pfa = 0u, t00 = 0u, t01 = 0u, t02 = 0u, t10 = 0u, t11 = 0u, t12 = 0u, t20 = 0u, t21 = 0u, t22 = 0u, t30 = 0u, t31 = 0u, t32 = 0u;
#define SC_TOUCH(p0_, p1_, p2_, n_) do { const int nn_ = (n_); pfa += p0_ + p1_ + p2_; if (nn_ < cps) { const int jb_ = ((seq * cps + nn_) << 3) | (h << 1) | dir; const unsigned* cb_ = (const unsigned*)(CH + (size_t)jb_ * CHJOB); \
                p0_ = cb_[lt * 32]; if (lt < 192) p1_ = cb_[(lt + 256) * 32]; if (lt < 128) p2_ = *(const unsigned*)(DQ + (size_t)TOKN(lt >> 1, nn_) * 512 + h * 128 + (lt & 1) * 64); } } while (0)
            SC_LD(rwA, rqA, rkA, rtA, rgA, 0);
            SC_TOUCH(t10, t11, t12, 1); SC_TOUCH(t20, t21, t22, 2); SC_TOUCH(t30, t31, t32, 3);
            for (int n = 0; n < cps; n += 4) {
                SC_LD(rwB, rqB, rkB, rtB, rgB, n + 1); SC_TOUCH(t00, t01, t02, n + 4); SC_ST(rwA, rqA, rkA, rtA, rgA, n); SC_BAR();
                SC_LD(rwA, rqA, rkA, rtA, rgA, n + 2); SC_TOUCH(t10, t11, t12, n + 5); SC_ST(rwB, rqB, rkB, rtB, rgB, n + 1); SC_BAR();
                SC_LD(rwB, rqB, rkB, rtB, rgB, n + 3); SC_TOUCH(t20, t21, t22, n + 6); SC_ST(rwA, rqA, rkA, rtA, rgA, n + 2); SC_BAR();
                if (n + 4 < cps) SC_LD(rwA, rqA, rkA, rtA, rgA, n + 4); SC_TOUCH(t30, t31, t32, n + 7); SC_ST(rwB, rqB, rkB, rtB, rgB, n + 3); SC_BAR();
            }
            pfa += t00 + t01 + t02 + t10 + t11 + t12 + t20 + t21 + t22 + t30 + t31 + t32;
            if (pfa == 0x9e3779b9u && lt == 100000) OF[0] = (bf16)pfa;
#undef SC_TOUCH
#undef SC_LD
#undef SC_ST
#undef SC_ST8
            SC_BAR();
        } else {
            const int tidc = pg8::otid(), lane = tidc & 63, l15 = lane & 15, g = lane >> 4;
            const int dv0 = part * 64 + wave * 16;
            bf16* OX = dir ? OB : OF;
            f32x4 St[8];
#pragma unroll
            for (int t = 0; t < 8; ++t) St[t] = (f32x4){0.f, 0.f, 0.f, 0.f};
            v2u utA[4], utN[4];
#define SC_UT(UT__, n_) do { const int jb_ = ((seq * cps + (n_)) << 3) | (h << 1) | dir; const bf16* UT_ = (const bf16*)(CH + (size_t)jb_ * CHJOB); \
                _Pragma("unroll") for (int mt = 0; mt < 4; ++mt) UT__[mt] = *(const v2u*)(UT_ + (dv0 + l15) * 64 + 16 * mt + 4 * g); } while (0)
            SC_UT(utA, 0);
            SC_BAR();
#define SC_FRAG(p_) (*(const LAS bf16x8*)(p_))
            for (int n = 0; n < cps; ++n) {
                const LAS unsigned char* buf = lds + (n & 1) * SC_BUF;
                const LAS float* gcl = (const LAS float*)(buf + SC_GC);
                if (n + 1 < cps) SC_UT(utN, n + 1);
                const float glast = gcl[63];
                bf16x8 sb[4];
#pragma unroll
                for (int ks = 0; ks < 4; ++ks) sb[ks] = pack8cv(St[2 * ks], St[2 * ks + 1]);
                f32x4 vnew[4];
#pragma unroll
                for (int mp = 0; mp < 2; ++mp) { bf16x8 wf[2][4];
#pragma unroll
                    for (int mm = 0; mm < 2; ++mm) { const LAS unsigned char* wrow = buf + SC_W + (16 * (2 * mp + mm) + l15) * SC_PW + 16 * g;
#pragma unroll
                        for (int ks = 0; ks < 4; ++ks) wf[mm][ks] = SC_FRAG(wrow + 64 * ks); }
                    __builtin_amdgcn_sched_barrier(0);
                    f32x4 ws0 = {0.f, 0.f, 0.f, 0.f}, ws1 = ws0;
#pragma unroll
                    for (int ks = 0; ks < 4; ++ks) { ws0 = MFMA16(wf[0][ks], sb[ks], ws0); ws1 = MFMA16(wf[1][ks], sb[ks], ws1); }
                    vnew[2 * mp] = (f32x4){bflo(utA[2 * mp].x), bfhi(utA[2 * mp].x), bflo(utA[2 * mp].y), bfhi(utA[2 * mp].y)} - ws0;
                    vnew[2 * mp + 1] = (f32x4){bflo(utA[2 * mp + 1].x), bfhi(utA[2 * mp + 1].x), bflo(utA[2 * mp + 1].y), bfhi(utA[2 * mp + 1].y)} - ws1;
                    __builtin_amdgcn_sched_barrier(0);
                }
                bf16x8 vb[2], vbs[2];
#pragma unroll
                for (int k2 = 0; k2 < 2; ++k2) vb[k2] = pack8(vnew[2 * k2], vnew[2 * k2 + 1]);
#pragma unroll
                for (int mp = 0; mp < 2; ++mp) { bf16x8 qf[2][4], kf2[2][2]; float egi[2];
#pragma unroll
                    for (int mm = 0; mm < 2; ++mm) { const int mt = 2 * mp + mm; const LAS unsigned char* qrow = buf + SC_Q + (16 * mt + l15) * SC_PW + 16 * g; const LAS unsigned char* qkrow = buf + SC_QK + (16 * mt + l15) * SC_PK + 16 * g;
#pragma unroll
                        for (int ks = 0; ks < 4; ++ks) qf[mm][ks] = SC_FRAG(qrow + 64 * ks);
#pragma unroll
                        for (int k2 = 0; k2 < 2; ++k2) kf2[mm][k2] = SC_FRAG(qkrow + 64 * k2);
                        egi[mm] = __expf(gcl[16 * mt + l15]); }
                    __builtin_amdgcn_sched_barrier(0);
                    f32x4 o0 = {0.f, 0.f, 0.f, 0.f}, o1 = o0;
#pragma unroll
                    for (int ks = 0; ks < 4; ++ks) { o0 = MFMA16(sb[ks], qf[0][ks], o0); o1 = MFMA16(sb[ks], qf[1][ks], o1); }
                    o0 *= egi[0]; o1 *= egi[1];
#pragma unroll
                    for (int k2 = 0; k2 < 2; ++k2) { o0 = MFMA16(vb[k2], kf2[0][k2], o0); o1 = MFMA16(vb[k2], kf2[1][k2], o1); }
                    o0 *= one; o1 *= one;
                    v2u w0, w1; w0.x = pk2(o0[0], o0[1]); w0.y = pk2(o0[2], o0[3]); w1.x = pk2(o1[0], o1[1]); w1.y = pk2(o1[2], o1[3]);
                    *(v2u*)(OX + (size_t)TOKN(16 * (2 * mp) + l15, n) * 512 + h * 128 + dv0 + 4 * g) = w0;
                    *(v2u*)(OX + (size_t)TOKN(16 * (2 * mp + 1) + l15, n) * 512 + h * 128 + dv0 + 4 * g) = w1;
                    __builtin_amdgcn_sched_barrier(0); }
                const float eg = __expf(glast);
#pragma unroll
                for (int mt = 0; mt < 4; ++mt) { const f32x4 gv = *(const LAS f32x4*)(gcl + 16 * mt + 4 * g);
#pragma unroll
                    for (int rg = 0; rg < 4; ++rg) vnew[mt][rg] *= __expf(glast - gv[rg]); }
#pragma unroll
                for (int k2 = 0; k2 < 2; ++k2) vbs[k2] = pack8(vnew[2 * k2], vnew[2 * k2 + 1]);
#pragma unroll
                for (int tp = 0; tp < 2; ++tp) { bf16x8 kt4[4][2];
#pragma unroll
                    for (int tt = 0; tt < 4; ++tt) { const LAS unsigned char* ktrow = buf + SC_KT + (16 * (4 * tp + tt) + l15) * SC_PK + 16 * g; kt4[tt][0] = SC_FRAG(ktrow); kt4[tt][1] = SC_FRAG(ktrow + 64); }
                    __builtin_amdgcn_sched_barrier(0);
#pragma unroll
                    for (int tt = 0; tt < 4; ++tt) St[4 * tp + tt] *= eg;
#pragma unroll
                    for (int k2 = 0; k2 < 2; ++k2)
#pragma unroll
                        for (int tt = 0; tt < 4; ++tt) St[4 * tp + tt] = MFMA16(kt4[tt][k2], vbs[k2], St[4 * tp + tt]);
                    __builtin_amdgcn_sched_barrier(0); }
#pragma unroll
                for (int mt = 0; mt < 4; ++mt) utA[mt] = utN[mt];
                SC_BAR();
            }
#undef SC_FRAG
#undef SC_UT
        }
    }
#undef SC_BAR
#undef TOKN
#undef TOK
}
__device__ __forceinline__ void ph_post(const bf16* OG, const float* LSE, const bf16* OF, const bf16* OB, const bf16* Z, const float* dn_norm, bf16* MIX) {
    const int tid_ = pg8::otid(), lane = tid_ & 63, wave = tid_ >> 6;
    const int gw = blockIdx.x * 8 + wave, NGW = gridDim.x * 8;
    f32x4 nw0 = *(const f32x4*)(dn_norm + (lane & 15) * 8), nw1 = *(const f32x4*)(dn_norm + (lane & 15) * 8 + 4);
    for (int t = gw; t < MH; t += NGW) {
        {   const int hd = lane >> 3;
            const float l0 = LSE[((size_t)0 * MH + t) * 8 + hd], l1 = LSE[((size_t)1 * MH + t) * 8 + hd], l2 = LSE[((size_t)2 * MH + t) * 8 + hd];
            const float mx = fmaxf(l0, fmaxf(l1, l2));
            float w0 = __expf(l0 - mx), w1 = __expf(l1 - mx), w2 = __expf(l2 - mx); const float inv = 1.0f / (w0 + w1 + w2); w0 *= inv; w1 *= inv; w2 *= inv;
            const v4u a = *(const v4u*)(OG + ((size_t)0 * MH + t) * 512 + lane * 8), b = *(const v4u*)(OG + ((size_t)1 * MH + t) * 512 + lane * 8), c = *(const v4u*)(OG + ((size_t)2 * MH + t) * 512 + lane * 8);
            v4u o;
#pragma unroll
            for (int e = 0; e < 4; ++e) o[e] = pk2(w0 * bflo(a[e]) + w1 * bflo(b[e]) + w2 * bflo(c[e]), w0 * bfhi(a[e]) + w1 * bfhi(b[e]) + w2 * bfhi(c[e]));
            *(v4u*)(MIX + (size_t)t * 1024 + lane * 8) = o; }
        {   const v4u a = *(const v4u*)(OF + (size_t)t * 512 + lane * 8), b = *(const v4u*)(OB + (size_t)t * 512 + lane * 8), z = *(const v4u*)(Z + (size_t)t * 512 + lane * 8);
            float ov[8]; float ss = 0.f;
#pragma unroll
            for (int e = 0; e < 4; ++e) { ov[2 * e] = bflo(a[e]) + bflo(b[e]); ov[2 * e + 1] = bfhi(a[e]) + bfhi(b[e]); ss += ov[2 * e] * ov[2 * e] + ov[2 * e + 1] * ov[2 * e + 1]; }
            ss += __shfl_xor(ss, 1); ss += __shfl_xor(ss, 2); ss += __shfl_xor(ss, 4); ss += __shfl_xor(ss, 8);
            const float rs = __builtin_amdgcn_rsqf(ss * (1.0f / 128.0f) + EPS);
            v4u o;
#pragma unroll
            for (int e = 0; e < 4; ++e) { const float n0 = (e < 2) ? nw0[2 * e] : nw1[2 * e - 4], n1 = (e < 2) ? nw0[2 * e + 1] : nw1[2 * e - 3];
                o[e] = pk2(ov[2 * e] * rs * n0 * silu(bflo(z[e])), ov[2 * e + 1] * rs * n1 * silu(bfhi(z[e]))); }
            *(v4u*)(MIX + (size_t)t * 1024 + 512 + lane * 8) = o; }
    }
}
#define XB_TMO      128
#define XB_XCNT(j)  (256  + 64 * (j))
#define XB_XSUB(j)  (1280 + 64 * (j))
#define XB_XGEN(j)  (2304 + 64 * (j))
#define XB_TOP      3328
#define XB_TOPGEN   3392
#define XCD_BAR_WORDS 3456
#define XB_SPIN_CAP (1u << 18)

__device__ __forceinline__ unsigned xb_ld(unsigned* p)              { return __hip_atomic_load(p, __ATOMIC_RELAXED, __HIP_MEMORY_SCOPE_AGENT); }
__device__ __forceinline__ unsigned xb_add(unsigned* p, unsigned v) { return __hip_atomic_fetch_add(p, v, __ATOMIC_RELAXED, __HIP_MEMORY_SCOPE_AGENT); }
__device__ __forceinline__ unsigned xb_xcc_id() { return (unsigned)__builtin_amdgcn_s_getreg((3 << 11) | 20) & 0xFu; }
#define XB_SPIN(cond, bar) do { unsigned _sp = 0; while (cond) { __builtin_amdgcn_s_sleep(1); \
    if ((++_sp & 255u) == 0u) { if (xb_ld(&(bar)[XB_TMO])) break; if (_sp > XB_SPIN_CAP) { atomicAdd(&(bar)[XB_TMO], 1u); break; } } } } while (0)

struct XcdBarrier {
    unsigned* bar; unsigned x;
    volatile LAS unsigned* st;
};

__device__ __forceinline__ XcdBarrier xcd_barrier_post(unsigned* bar, volatile LAS unsigned* st) {
    XcdBarrier b; b.bar = bar; b.x = xb_xcc_id(); b.st = st;
    if (threadIdx.x == 0) (void)xb_add(&bar[XB_XCNT(b.x)], 1u);
    return b;
}
__device__ __forceinline__ void xcd_barrier_complete(unsigned* bar, unsigned x, unsigned& nloc, unsigned& nx) {
    const unsigned G = gridDim.x * gridDim.y * gridDim.z;
    unsigned sum, cnt, mine, sp = 0u;
    for (;;) {
        sum = 0u; cnt = 0u; mine = 0u;
#pragma unroll
        for (unsigned j = 0; j < 16; ++j) { const unsigned c = xb_ld(&bar[XB_XCNT(j)]); sum += c; cnt += (c > 0u) ? 1u : 0u; mine = (j == x) ? c : mine; }
        if (sum == G) break;
        __builtin_amdgcn_s_sleep(1);
        if ((++sp & 255u) == 0u) { if (xb_ld(&bar[XB_TMO])) break; if (sp > XB_SPIN_CAP) { atomicAdd(&bar[XB_TMO], 1u); break; } }
    }
    nloc = mine > 0u ? mine : 1u; nx = cnt > 0u ? cnt : 1u;
}

__device__ __forceinline__ void xcd_barrier(const XcdBarrier& b) {
    asm volatile("s_waitcnt vmcnt(0)" ::: "memory");
    __syncthreads();
    if (threadIdx.x == 0) {
        unsigned* bar = b.bar;
        __builtin_amdgcn_s_waitcnt(0);
        unsigned nloc = b.st[0], nx = b.st[1];
        if (nloc == 0u) { xcd_barrier_complete(bar, b.x, nloc, nx); b.st[0] = nloc; b.st[1] = nx; }
        const unsigned old = xb_add(&bar[XB_XSUB(b.x)], 1u);
        const unsigned gen = old / nloc;
        if (old + 1u == (gen + 1u) * nloc) {
            __builtin_amdgcn_fence(__ATOMIC_RELEASE, "agent");
            asm volatile("s_waitcnt vmcnt(0)" ::: "memory");
            const unsigned og = xb_add(&bar[XB_TOP], 1u);
            const unsigned tg = og / nx;
            if (og + 1u == (tg + 1u) * nx) xb_add(&bar[XB_TOPGEN], 1u);
            else XB_SPIN(xb_ld(&bar[XB_TOPGEN]) == tg, bar);
            __builtin_amdgcn_fence(__ATOMIC_ACQUIRE, "agent");
            xb_add(&bar[XB_XGEN(b.x)], 1u);
            asm volatile("s_waitcnt vmcnt(0)" ::: "memory");
        } else {
            XB_SPIN(xb_ld(&bar[XB_XGEN(b.x)]) == gen, bar);
            __builtin_amdgcn_fence(__ATOMIC_ACQUIRE, "agent");
            asm volatile("s_waitcnt vmcnt(0)" ::: "memory");
        }
    }
    __syncthreads();
}

#ifndef DBG_SKIP_MIXER
#define DBG_SKIP_MIXER 0
#endif
#ifndef MK_MULTI
#define MK_MULTI 0
#endif
constexpr int NPH = 1 + 2 * (2 * 14) + 1 + 1;
static_assert(pg8::EpiProj::OFF_PA == WS_PA && pg8::EpiProj::OFF_PD == WS_PD && pg8::EpiProj::OFF_Z == WS_Z, "EpiProj offsets");
struct Args { const float* in[22]; float* out; unsigned char* ws; int lo, hi; int big, pad; };

__global__ void __launch_bounds__(512, 2) fwd(Args a) {
    extern __shared__ __attribute__((aligned(16))) unsigned char lds_raw[];
    LAS unsigned char* lds = (LAS unsigned char*)lds_raw;
    cg::grid_group grid = cg::this_grid();
    unsigned char* ws = a.ws;
    const int lo = a.lo, hi = a.hi; int pc = 0;
    const bool big = a.big != 0;
    bf16* OGp = (bf16*)(ws + (big ? WS_OG2 : WS_OG)); float* LSEp = (float*)(ws + (big ? WS_LSE2 : WS_LSE));
    const float* x_prompt = a.in[0]; const float* x_sample = a.in[1];
    float* MOD = (float*)(ws + WS_MOD); float* ROPE = (float*)(ws + WS_ROPE);
    bf16* H = (bf16*)(ws + WS_H); bf16* ACT = (bf16*)(ws + WS_ACT); bf16* PA = (bf16*)(ws + WS_PA); bf16* PD = (bf16*)(ws + WS_PD); bf16* Zb = (bf16*)(ws + WS_Z);
    bf16* DQ = (bf16*)(ws + WS_DQ); bf16* DK = (bf16*)(ws + WS_DK); bf16* DV = (bf16*)(ws + WS_DV); bf16* OF = (bf16*)(ws + WS_OF); bf16* OB = (bf16*)(ws + WS_OB);
    unsigned char* CH = ws + WS_CH; bf16* OG = (bf16*)(ws + WS_OG); float* LSE = (float*)(ws + WS_LSE); bf16* MIX = (bf16*)(ws + WS_MIX);
    float* AB = (float*)(ws + WS_AB); float* GB = (float*)(ws + WS_GB); float* GC = (float*)(ws + WS_GC);
#define PH_BEGIN if (pc >= lo && pc < hi) {
    { volatile LAS unsigned* st = (volatile LAS unsigned*)(lds + LDS_BYTES - 256); if (pg8::otid() < 2) st[pg8::otid()] = 0u; }
    __syncthreads();
    XcdBarrier bar = xcd_barrier_post((unsigned*)ws, (volatile LAS unsigned*)(lds + LDS_BYTES - 256));
#define PH_END } ++pc; if (pc > lo && pc < hi) { if (pc == 1) grid.sync(); else xcd_barrier(bar); }
#define PH_END_IF(c_) } ++pc; if ((c_) && pc > lo && pc < hi) { xcd_barrier(bar); }

    PH_BEGIN
        ph_mod(a.in[2], a.in[3], a.in[4], a.in[5], MOD, lds);
        ph_rope(ROPE);
        ph_wconv(a.in[7], a.in[8], a.in[9], a.in[18], a.in[19], a.in[20], a.in[11], a.in[16], 0, ws, lds);
    PH_END
    for (int layer = 0; layer < 2; ++layer) {
        if (layer == 1) {
            PH_BEGIN ph_wconv(a.in[7], a.in[8], a.in[9], a.in[18], a.in[19], a.in[20], a.in[11], a.in[16], 1, ws, lds); PH_END
        }
        const float* modl = MOD + (size_t)layer * 12 * 9216;
        for (int half = 0; half < 2; ++half) {
            const int S = half ? 8192 : 4096, lgS = half ? 13 : 12;
            float* X = a.out + (size_t)half * MH * D;
            const float* xin0 = half ? x_sample : x_prompt;
            for (int sb = 0; sb < 3; ++sb) {
                if (DBG_SKIP_MIXER && sb == 1) continue;
                const bool first = (layer == 0 && sb == 0);
                const float* xsrc = first ? xin0 : X;
                const float* nw = (sb == 0 ? a.in[6] : (sb == 1 ? a.in[10] : a.in[17])) + layer * D;
                PH_BEGIN ph_norm(xsrc, nw, modl, sb, half, H); PH_END
                if (sb != 1) {
                    PH_BEGIN
                        pg8::Gemm g{H, (const bf16*)(ws + (sb ? WS_WGU2 : WS_WGU1)), MH, 2 * FF, D}; pg8::StaticOrder So; So.init(MH, 2 * FF, gridDim.x, (int)blockIdx.x);
                        pg8::EpiSwiGLU E{ACT, FF};
                        pg8::gemm_phase<pg8::EpiSwiGLU, pg8::StaticOrder, true, true>(lds, g, So, E);
                    PH_END
                    PH_BEGIN
                        pg8::Gemm g{ACT, (const bf16*)(ws + (sb ? WS_WD2 : WS_WD1)), MH, D, FF}; pg8::StaticOrder So; So.init(MH, D, gridDim.x, (int)blockIdx.x);
                        pg8::EpiResid E{xsrc, X, modl + (3 * sb + 2) * 1024, 0.5f, half};
                        pg8::gemm_phase<pg8::EpiResid, pg8::StaticOrder, true, true>(lds, g, So, E);
                    PH_END
                } else {
                    PH_BEGIN
                        pg8::Gemm g{H, (const bf16*)(ws + WS_WIN), MH, NPROJ, D}; pg8::StaticOrder So; So.init(MH, NPROJ, gridDim.x, (int)blockIdx.x);
                        pg8::EpiProj E{ws, AB, ROPE, S - 1};
                        pg8::gemm_phase<pg8::EpiProj, pg8::StaticOrder, true, true>(lds, g, So, E);
                    PH_END
                    PH_BEGIN ph_dnpre(PD, AB, a.in[12] + (size_t)layer * 5 * 1536, a.in[13] + layer * 8, a.in[14] + layer * 8, DQ, DK, DV, GB, S); PH_END
                    PH_BEGIN ph_chunk(DQ, DK, DV, GB, CH, GC, S, lgS, lds); PH_END
                    PH_BEGIN ph_scan(DQ, CH, GC, OF, OB, S, lgS, half, lds); PH_END_IF(!big)
                    PH_BEGIN ph_attn(PA, OGp, LSEp, S, lgS, lds, big ? (unsigned*)ws + ACTR_WORD + 16 * (layer * 2 + half) : (unsigned*)nullptr); PH_END
                    PH_BEGIN ph_post(OGp, LSEp, OF, OB, Zb, a.in[15] + layer * 128, MIX); PH_END
                    PH_BEGIN
                        pg8::Gemm g{MIX, (const bf16*)(ws + WS_WOUT), MH, D, D}; pg8::StaticOrder So; So.init(MH, D, gridDim.x, (int)blockIdx.x);
                        pg8::EpiResid E{X, X, modl + 5 * 1024, 1.0f, half};
                        pg8::gemm_phase<pg8::EpiResid, pg8::StaticOrder, true, true>(lds, g, So, E);
                    PH_END
                }
            }
        }
    }
    PH_BEGIN ph_final(a.out, a.in[21]); PH_END
}

extern "C" void kernel_launch(void* const* d_in, const int* in_sizes, int n_in, void* d_out, int out_size, void* d_ws, size_t ws_size, hipStream_t stream) {
    static int grid = 0;
    if (grid == 0) {
        if (n_in != 22 || ws_size < WS_END) { fprintf(stderr, "kernel_launch: unexpected n_in %d / ws_size %zu\n", n_in, ws_size); grid = -1; return; }
        int dev = 0, cus = 0, per_cu = 0;
        hipGetDevice(&dev); hipDeviceGetAttribute(&cus, hipDeviceAttributeMultiprocessorCount, dev);
        if (hipFuncSetAttribute((const void*)fwd, hipFuncAttributeMaxDynamicSharedMemorySize, LDS_BYTES) != hipSuccess) { fprintf(stderr, "kernel_launch: hipFuncSetAttribute failed\n"); grid = -1; return; }
        if (hipOccupancyMaxActiveBlocksPerMultiprocessor(&per_cu, (const void*)fwd, 512, LDS_BYTES) != hipSuccess || per_cu < 1) { per_cu = 1; (void)hipGetLastError(); }
        grid = cus * per_cu;
        fprintf(stderr, "kernel_launch: grid %d (cus %d x %d), ws %zu MiB\n", grid, cus, per_cu, ws_size >> 20);
    }
    if (grid < 0) return;
    if (hipMemsetAsync(d_ws, 0, 16384, stream) != hipSuccess) { fprintf(stderr, "kernel_launch: memset failed\n"); return; }
    Args a{};
    for (int i = 0; i < 22; ++i) a.in[i] = (const float*)d_in[i];
    a.out = (float*)d_out; a.ws = (unsigned char*)d_ws; a.big = (ws_size >= WS_OVL_END) ? 1 : 0;
#if MK_MULTI
    for (int p = 0; p < NPH; ++p) { a.lo = p; a.hi = p + 1; hipLaunchKernelGGL(fwd, dim3(grid), dim3(512), LDS_BYTES, stream, a); }
#else
    a.lo = 0; a.hi = NPH;
    void* args[] = {&a};
    hipError_t e = hipLaunchCooperativeKernel((const void*)fwd, dim3(grid), dim3(512), args, LDS_BYTES, stream);
    if (e != hipSuccess) fprintf(stderr, "cooperative launch failed: %s (grid %d)\n", hipGetErrorString(e), grid);
#endif
}
```

```cpp
#include <hip/hip_runtime.h>
#include <hip/hip_cooperative_groups.h>
#include <cstdio>
#include <cstdint>
namespace cg = cooperative_groups;
namespace pg8 {
#define PG8_LAS __attribute__((address_space(3)))
typedef unsigned short bf16_t;
typedef short bf16x8 __attribute__((ext_vector_type(8)));
typedef float f32x4 __attribute__((ext_vector_type(4)));
typedef unsigned u32x4 __attribute__((ext_vector_type(4)));
constexpr int BM = 256, BK = 64, HALF = 128, HTB = HALF * BK * 2  , STAGE_BYTES = 8 * HTB, NXCD = 8, WGM = 8;

__host__ __device__ __forceinline__ int lds_byte(int r, int c) { const int st = (r >> 4) * 2 + (c >> 5), rr = r & 15, cc = c & 31, ob = rr * 64 + cc * 2; return st * 1024 + (ob ^ (((ob >> 9) & 1) << 5)); }
__host__ __device__ __forceinline__ void stage_rc(int b, int& R, int& C) { const int st = b / 1024, sb = b % 1024, swz = sb ^ (((sb >> 9) & 1) << 5); R = (st >> 1) * 16 + swz / 64; C = (st & 1) * 32 + (swz % 64) / 2; }
__host__ __device__ __forceinline__ int perm32(int rho) { const int n = rho >> 4, i = rho & 15; return 8 * (i >> 2) + 4 * n + (i & 3); }

struct Unit { int pm, pn; };
struct Gemm { const bf16_t* A; const bf16_t* Bt; int M, N, K; };

struct StaticOrder {
    int nM, nN, nwg, G, c;
    __host__ __device__ void init(int M, int N, int G_, int c_) { nM = M / BM; nN = N / BM; nwg = nM * nN; G = G_; c = c_; }
    __host__ __device__ bool next(int i, Unit& u) const {
        const long L = (long)i * G + c; if (L >= nwg) return false;
        int wgid = (int)L; { const int q = nwg / NXCD, r = nwg % NXCD, xcd = wgid % NXCD, off = wgid / NXCD; wgid = (xcd < r ? xcd * (q + 1) : r * (q + 1) + (xcd - r) * q) + off; }
        const int nig = WGM * nN, gid = wgid / nig, fm = gid * WGM, gsz = (nM - fm) < WGM ? (nM - fm) : WGM;
        u.pm = fm + ((wgid % nig) % gsz); u.pn = (wgid % nig) / gsz; return true;
    }
    __device__ __forceinline__ void a_ready(const Unit&) const {}
    __device__ __forceinline__ void done(const Unit&) const {}
};
typedef __bf16 bf16x2_t __attribute__((ext_vector_type(2)));
typedef float f32x2_t __attribute__((ext_vector_type(2)));
__device__ __forceinline__ unsigned cvt_pk_bf16(float lo, float hi) { unsigned r; asm volatile("v_cvt_pk_bf16_f32 %0, %1, %2" : "=v"(r) : "v"(lo), "v"(hi)); return r; }
__device__ __forceinline__ unsigned cvt_pk_bf16_cv(float lo, float hi) { const f32x2_t v = {lo, hi}; const bf16x2_t b = __builtin_convertvector(v, bf16x2_t); return __builtin_bit_cast(unsigned, b); }
__device__ __forceinline__ int otid() { int t = threadIdx.x; asm volatile("" : "+v"(t)); return t; }
__device__ __forceinline__ float silu_f(float v) { return v * __builtin_amdgcn_rcpf(1.0f + __expf(-v)); }

#define EPI_PIN(p) asm volatile("" : "+v"(p))
struct EpiSwiGLU {
    static constexpr bool PERM = true, AFTER_DRAIN = false;
    bf16_t* O; int ldc;
    __device__ __forceinline__ void operator()(const f32x4 (&acc)[2][2][4][2], const Unit& u, int wr, int wc, int fr, int fq) const {
        const int row0 = u.pm * BM + wr * 64 + fr, col0 = u.pn * 128 + wc * 32 + 8 * fq;
        bf16_t* rowp = O + (size_t)row0 * ldc + col0;
#pragma unroll
        for (int ai = 0; ai < 2; ++ai) {
#pragma unroll
            for (int m = 0; m < 4; ++m) {
                const f32x4 g0 = acc[ai][0][m][0], g1 = acc[ai][0][m][1], u0 = acc[ai][1][m][0], u1 = acc[ai][1][m][1];
                u32x4 w;
                w.x = cvt_pk_bf16(silu_f(g0[0]) * u0[0], silu_f(g0[1]) * u0[1]); w.y = cvt_pk_bf16(silu_f(g0[2]) * u0[2], silu_f(g0[3]) * u0[3]);
                w.z = cvt_pk_bf16(silu_f(g1[0]) * u1[0], silu_f(g1[1]) * u1[1]); w.w = cvt_pk_bf16(silu_f(g1[2]) * u1[2], silu_f(g1[3]) * u1[3]);
                *(u32x4*)rowp = w;
                rowp += (size_t)16 * ldc; EPI_PIN(rowp);
            }
            rowp += (size_t)64 * ldc; EPI_PIN(rowp);
        }
    }
};
struct EpiResid {
    static constexpr bool PERM = false, AFTER_DRAIN = false;
    const float* xin; float* xout; const float* gate; float scale; int half;
    __device__ __forceinline__ void operator()(const f32x4 (&acc)[2][2][4][2], const Unit& u, int wr, int wc, int fr, int fq) const {
        const int row0 = u.pm * BM + wr * 64 + fr, col0 = u.pn * BM + wc * 32 + 4 * fq;
        const int batch = half ? 8 + (u.pm >> 5) : (u.pm >> 4);
        const float* gp = gate + (size_t)batch * 9216 + col0;
        f32x4 gv[2][2];
#pragma unroll
        for (int bj = 0; bj < 2; ++bj)
#pragma unroll
            for (int n = 0; n < 2; ++n) gv[bj][n] = *(const f32x4*)(gp + bj * HALF + n * 16) * scale;
        const float* lp = xin + (size_t)row0 * 1024 + col0; float* op = xout + (size_t)row0 * 1024 + col0;
        f32x4 xb[4][2][2];
#define EPI_LD(slot) do { _Pragma("unroll") for (int bj = 0; bj < 2; ++bj) _Pragma("unroll") for (int n = 0; n < 2; ++n) xb[slot][bj][n] = *(const f32x4*)(lp + bj * HALF + n * 16); } while (0)
#define EPI_LADV(grp) do { lp += (((grp) & 3) == 3 ? 80 : 16) * 1024; EPI_PIN(lp); } while (0)
        EPI_LD(0); EPI_LADV(0); EPI_LD(1); EPI_LADV(1); EPI_LD(2); EPI_LADV(2); EPI_LD(3); EPI_LADV(3);
#pragma unroll
        for (int grp = 0; grp < 8; ++grp) { const int ai = grp >> 2, m = grp & 3, slot = grp & 3;
#pragma unroll
            for (int bj = 0; bj < 2; ++bj)
#pragma unroll
                for (int n = 0; n < 2; ++n) *(f32x4*)(op + bj * HALF + n * 16) = xb[slot][bj][n] + gv[bj][n] * acc[ai][bj][m][n];
            op += (m == 3 ? 80 : 16) * 1024; EPI_PIN(op);
            if (grp + 4 < 8) { EPI_LD(slot); EPI_LADV(grp + 4); }
        }
#undef EPI_LD
#undef EPI_LADV
    }
};
struct EpiProj {
    static constexpr bool PERM = true, AFTER_DRAIN = false;
    static constexpr size_t OFF_PA = (size_t)144 << 20, OFF_PD = (size_t)272 << 20, OFF_Z = (size_t)240 << 20;
    unsigned char* wsb; float* AB; const float* rope; int smask;
    __device__ __forceinline__ void operator()(const f32x4 (&acc)[2][2][4][2], const Unit& u, int wr, int wc, int fr, int fq) const {
        const int row0 = u.pm * BM + wr * 64 + fr, pn = u.pn;
        if (pn < 14) {
            const size_t poff = pn < 6 ? OFF_PA : (pn < 12 ? OFF_PD : OFF_Z); bf16_t* P = (bf16_t*)(wsb + poff); const int ldp = pn < 12 ? 1536 : 512;
            const int col0 = (pn < 6 ? pn : (pn < 12 ? pn - 6 : pn - 12)) * 256 + wc * 32 + 8 * fq;
            const bool rot = (pn < 4) && ((wc & 1) == 0) && (fq < 2);
            const float sgn = (fq & 1) ? 1.f : -1.f;
            bf16_t* rowp = P + (size_t)row0 * ldp + col0; int row = row0;
#pragma unroll
            for (int ai = 0; ai < 2; ++ai) {
#pragma unroll
                for (int m = 0; m < 4; ++m) {
                    f32x4 c0 = {0.f, 0.f, 0.f, 0.f}, c1 = c0, s0 = c0, s1 = c0;
                    if (pn < 4) { const float* rp = rope + (size_t)(row & smask) * 16; c0 = *(const f32x4*)rp; c1 = *(const f32x4*)(rp + 4); s0 = *(const f32x4*)(rp + 8); s1 = *(const f32x4*)(rp + 12); }
#pragma unroll
                    for (int bj = 0; bj < 2; ++bj) { f32x4 v0 = acc[ai][bj][m][0], v1 = acc[ai][bj][m][1];
                        if (pn < 4) { f32x4 p0, p1;
#pragma unroll
                            for (int j = 0; j < 4; ++j) {
                                const auto s0 = __builtin_amdgcn_permlane16_swap(__float_as_uint(v0[j]), __float_as_uint(v0[j]), false, false), s1 = __builtin_amdgcn_permlane16_swap(__float_as_uint(v1[j]), __float_as_uint(v1[j]), false, false);
                                p0[j] = __uint_as_float((fq & 1) ? s0[0] : s0[1]); p1[j] = __uint_as_float((fq & 1) ? s1[0] : s1[1]); }
                            const f32x4 r0 = v0 * c0 + sgn * (p0 * s0), r1 = v1 * c1 + sgn * (p1 * s1);
                            if (rot) { v0 = r0; v1 = r1; } }
                        u32x4 w; w.x = cvt_pk_bf16(v0[0], v0[1]); w.y = cvt_pk_bf16(v0[2], v0[3]); w.z = cvt_pk_bf16(v1[0], v1[1]); w.w = cvt_pk_bf16(v1[2], v1[3]);
                        *(u32x4*)(rowp + bj * HALF) = w; }
                    rowp += (size_t)16 * ldp; row += 16; EPI_PIN(rowp); EPI_PIN(row);
                    asm volatile("" ::: "memory"); }
                rowp += (size_t)64 * ldp; row += 64; EPI_PIN(rowp); EPI_PIN(row);
            }
        } else {
            if (wc == 0 && fq < 2) {
                float* ap = AB + (size_t)row0 * 16 + 8 * fq;
#pragma unroll
                for (int ai = 0; ai < 2; ++ai) {
#pragma unroll
                    for (int m = 0; m < 4; ++m) { *(f32x4*)ap = acc[ai][0][m][0]; *(f32x4*)(ap + 4) = acc[ai][0][m][1]; ap += 16 * 16; EPI_PIN(ap); }
                    ap += 64 * 16; EPI_PIN(ap); }
            }
        }
    }
};

template <class Epi, class Sched, bool ALIGN_EPI = false, bool SP2 = false>
__device__ __forceinline__ void gemm_phase(PG8_LAS unsigned char* lds, const Gemm g, const Sched& S, const Epi& E) {
    const int tid = otid(), wid = __builtin_amdgcn_readfirstlane(tid >> 6), lane = tid & 63, wr = wid >> 2, wc = wid & 3, fr = lane & 15, fq = lane >> 4;
    const int K = g.K, nt = K / BK;
    unsigned voffA[2], voffB[2];
#pragma unroll
    for (int i = 0; i < 2; ++i) { int R, C; stage_rc(tid * 16 + i * 8192, R, C); const int Rb = Epi::PERM ? ((R & ~31) + perm32(R & 31)) : R;
        voffA[i] = (unsigned)(R * K + C) * 2u; voffB[i] = (unsigned)(Rb * K + C) * 2u; }
    const size_t kstep = (size_t)(BK * 2);
    const size_t hstep = (size_t)HALF * K * 2;
    const size_t tstep = 2 * hstep;
    const unsigned ldsw = (unsigned)wid * 1024u;
    const int aoff = lds_byte(wr * 64 + fr, fq * 8), boff = lds_byte(wc * 32 + fr, fq * 8);
#define PG8_SA(b, h) (((b) * 2 + (h)) * HTB)
#define PG8_SB(b, h) ((4 + (b) * 2 + (h)) * HTB)
#define PG8_STAGE(bufoff, gbase, voff) do { _Pragma("unroll") for (int _i = 0; _i < 2; ++_i) \
        __builtin_amdgcn_global_load_lds((const unsigned*)((const char*)(gbase) + (voff)[_i]), (PG8_LAS unsigned*)(lds + (bufoff) + ldsw + _i * 8192), 16, 0, 0); } while (0)
#define PG8_LDA(dst, b, h) do { _Pragma("unroll") for (int m = 0; m < 4; ++m) _Pragma("unroll") for (int k = 0; k < 2; ++k) dst[m][k] = *(const PG8_LAS bf16x8*)(lds + PG8_SA(b, h) + aoff + m * 2048 + k * 1024); } while (0)
#define PG8_LDB(dst, b, h) do { _Pragma("unroll") for (int n = 0; n < 2; ++n) _Pragma("unroll") for (int k = 0; k < 2; ++k) dst[n][k] = *(const PG8_LAS bf16x8*)(lds + PG8_SB(b, h) + boff + n * 2048 + k * 1024); } while (0)
#define PG8_MMA(ai, bj, At, Bt) do { __builtin_amdgcn_s_setprio(1); _Pragma("unroll") for (int m = 0; m < 4; ++m) _Pragma("unroll") for (int n = 0; n < 2; ++n) _Pragma("unroll") for (int k = 0; k < 2; ++k) \
        acc[ai][bj][m][n] = __builtin_amdgcn_mfma_f32_16x16x32_bf16(Bt[n][k], At[m][k], acc[ai][bj][m][n], 0, 0, 0); __builtin_amdgcn_s_setprio(0); } while (0)
#define PG8_WAIT_V(n) asm volatile("s_waitcnt vmcnt(" #n ")" ::: "memory")
#define PG8_WAIT_L(n) asm volatile("s_waitcnt lgkmcnt(" #n ")" ::: "memory")
#define PG8_BAR __builtin_amdgcn_s_barrier()
#define PG8_SCHED __builtin_amdgcn_sched_barrier(0)
    Unit cur, nxt; int ui = 0;
    if (!S.next(0, cur)) return;
    f32x4 acc[2][2][4][2];
#pragma unroll
    for (int a = 0; a < 2; ++a)
#pragma unroll
        for (int b = 0; b < 2; ++b)
#pragma unroll
            for (int m = 0; m < 4; ++m)
#pragma unroll
                for (int n = 0; n < 2; ++n) acc[a][b][m][n] = (f32x4){0.f, 0.f, 0.f, 0.f};
    bf16x8 At[4][2], B0[2][2], B1[2][2];
    const char* cA = (const char*)g.A + (size_t)cur.pm * tstep; const char* cB = (const char*)g.Bt + (size_t)cur.pn * tstep;
    S.a_ready(cur);
    if constexpr (SP2) {
        PG8_STAGE(PG8_SB(0, 0), cB, voffB); PG8_STAGE(PG8_SB(0, 1), cB + hstep, voffB); PG8_STAGE(PG8_SA(0, 0), cA, voffA); PG8_STAGE(PG8_SA(0, 1), cA + hstep, voffA);
        if (wr == 1) PG8_BAR;
        PG8_WAIT_V(2); PG8_BAR;
        PG8_STAGE(PG8_SB(1, 0), cB + kstep, voffB); PG8_STAGE(PG8_SA(1, 0), cA + kstep, voffA); PG8_STAGE(PG8_SB(1, 1), cB + hstep + kstep, voffB);
        PG8_WAIT_V(6); PG8_BAR;
    } else {
        PG8_STAGE(PG8_SB(0, 0), cB, voffB); PG8_STAGE(PG8_SA(0, 0), cA, voffA); PG8_STAGE(PG8_SB(0, 1), cB + hstep, voffB); PG8_STAGE(PG8_SA(0, 1), cA + hstep, voffA);
        if (wr == 1) PG8_BAR;
        PG8_WAIT_V(4); PG8_BAR;
        PG8_STAGE(PG8_SB(1, 0), cB + kstep, voffB); PG8_STAGE(PG8_SA(1, 0), cA + kstep, voffA); PG8_STAGE(PG8_SB(1, 1), cB + hstep + kstep, voffB);
        PG8_WAIT_V(6); PG8_BAR;
    }
    for (;;) {
        const bool has_next = S.next(ui + 1, nxt);
        const char* nA = has_next ? (const char*)g.A + (size_t)nxt.pm * tstep : cA; const char* nB = has_next ? (const char*)g.Bt + (size_t)nxt.pn * tstep : cB;
        for (int t = 0; t < nt; t += 2) {
            const bool last = (t == nt - 2);
            const char* a1 = cA + (size_t)(t + 1) * kstep;
            const char* a2 = last ? nA : cA + (size_t)(t + 2) * kstep; const char* b2 = last ? nB : cB + (size_t)(t + 2) * kstep;
            const char* a3 = a2 + kstep; const char* b3 = b2 + kstep;
            if (last && has_next) S.a_ready(nxt);
            if constexpr (SP2) {
            PG8_LDB(B0, 0, 0); PG8_LDB(B1, 0, 1); PG8_SCHED; PG8_LDA(At, 0, 0); PG8_STAGE(PG8_SA(1, 1), a1 + hstep, voffA);
            PG8_WAIT_V(8); PG8_WAIT_L(0); PG8_BAR; PG8_MMA(0, 0, At, B0); PG8_MMA(0, 1, At, B1); PG8_BAR; PG8_SCHED;
            PG8_LDA(At, 0, 1); PG8_STAGE(PG8_SB(0, 0), b2, voffB); PG8_STAGE(PG8_SB(0, 1), b2 + hstep, voffB); PG8_STAGE(PG8_SA(0, 0), a2, voffA);
            PG8_WAIT_V(8); PG8_WAIT_L(0); PG8_BAR; PG8_MMA(1, 0, At, B0); PG8_MMA(1, 1, At, B1); PG8_BAR; PG8_SCHED;
            PG8_LDB(B0, 1, 0); PG8_LDB(B1, 1, 1); PG8_SCHED; PG8_LDA(At, 1, 0); PG8_STAGE(PG8_SA(0, 1), a2 + hstep, voffA);
            PG8_WAIT_V(8); PG8_WAIT_L(0); PG8_BAR; PG8_MMA(0, 0, At, B0); PG8_MMA(0, 1, At, B1); PG8_BAR; PG8_SCHED;
            PG8_LDA(At, 1, 1); PG8_STAGE(PG8_SB(1, 0), b3, voffB); PG8_STAGE(PG8_SB(1, 1), b3 + hstep, voffB); PG8_STAGE(PG8_SA(1, 0), a3, voffA);
            PG8_WAIT_V(8); PG8_WAIT_L(0); PG8_BAR; PG8_MMA(1, 0, At, B0); PG8_MMA(1, 1, At, B1); PG8_BAR; PG8_SCHED;
            } else {
            PG8_LDB(B0, 0, 0); PG8_SCHED; PG8_LDA(At, 0, 0); PG8_STAGE(PG8_SA(1, 1), a1 + hstep, voffA);
            PG8_WAIT_L(8); PG8_BAR; PG8_WAIT_L(0); PG8_MMA(0, 0, At, B0); PG8_BAR; PG8_SCHED;
            PG8_LDB(B1, 0, 1); PG8_STAGE(PG8_SB(0, 0), b2, voffB);
            PG8_BAR; PG8_WAIT_L(0); PG8_MMA(0, 1, At, B1); PG8_BAR;
            PG8_LDA(At, 0, 1); PG8_STAGE(PG8_SA(0, 0), a2, voffA);
            PG8_BAR; PG8_WAIT_L(0); PG8_MMA(1, 0, At, B0); PG8_BAR; PG8_SCHED;
            PG8_STAGE(PG8_SB(0, 1), b2 + hstep, voffB);
            PG8_WAIT_V(6); PG8_BAR; PG8_MMA(1, 1, At, B1); PG8_BAR;
            PG8_LDB(B0, 1, 0); PG8_SCHED; PG8_LDA(At, 1, 0); PG8_STAGE(PG8_SA(0, 1), a2 + hstep, voffA);
            PG8_WAIT_L(8); PG8_BAR; PG8_WAIT_L(0); PG8_MMA(0, 0, At, B0); PG8_BAR; PG8_SCHED;
            PG8_LDB(B1, 1, 1); PG8_STAGE(PG8_SB(1, 0), b3, voffB);
            PG8_BAR; PG8_WAIT_L(0); PG8_MMA(0, 1, At, B1); PG8_BAR;
            PG8_LDA(At, 1, 1); PG8_STAGE(PG8_SA(1, 0), a3, voffA);
            PG8_BAR; PG8_WAIT_L(0); PG8_MMA(1, 0, At, B0); PG8_BAR; PG8_SCHED;
            PG8_STAGE(PG8_SB(1, 1), b3 + hstep, voffB);
            PG8_WAIT_V(6); PG8_BAR; PG8_MMA(1, 1, At, B1); PG8_BAR;
            }
        }
        if constexpr (ALIGN_EPI) { if (wr == 0) PG8_BAR; }
        if constexpr (!Epi::AFTER_DRAIN) { E(acc, cur, wr, wc, fr, fq); S.done(cur); }
        if (!has_next) break;
#pragma unroll
        for (int a = 0; a < 2; ++a)
#pragma unroll
            for (int b = 0; b < 2; ++b)
#pragma unroll
                for (int m = 0; m < 4; ++m)
#pragma unroll
                    for (int n = 0; n < 2; ++n) acc[a][b][m][n] = (f32x4){0.f, 0.f, 0.f, 0.f};
        cur = nxt; cA = nA; cB = nB; ++ui;
        if constexpr (ALIGN_EPI) { if (wr == 1) PG8_BAR; }
    }
    PG8_WAIT_V(0);
    if constexpr (!ALIGN_EPI) { if (wr == 0) PG8_BAR; }
    PG8_BAR;
    if constexpr (Epi::AFTER_DRAIN) { E.fused(acc, cur, wr, wc, fr, fq, lds, wid, lane); S.done(cur); }
#undef PG8_SA
#undef PG8_SB
#undef PG8_STAGE
#undef PG8_LDA
#undef PG8_LDB
#undef PG8_MMA
#undef PG8_WAIT_V
#undef PG8_WAIT_L
#undef PG8_BAR
#undef PG8_SCHED
}
}

#define LAS __attribute__((address_space(3)))
typedef unsigned short bf16;
typedef short bf16x8 __attribute__((ext_vector_type(8)));
typedef short s16x4 __attribute__((ext_vector_type(4)));
typedef float f32x4 __attribute__((ext_vector_type(4)));
typedef unsigned v4u __attribute__((ext_vector_type(4)));
typedef unsigned v2u __attribute__((ext_vector_type(2)));
#define MFMA16(a, b, c) __builtin_amdgcn_mfma_f32_16x16x32_bf16((a), (b), (c), 0, 0, 0)
#define CAT8(lo, hi) __builtin_shufflevector((lo), (hi), 0, 1, 2, 3, 4, 5, 6, 7)
#define LDS_WAIT() asm volatile("s_waitcnt lgkmcnt(0)" ::: "memory")

constexpr int D = 1024, FF = 2816, MH = 32768, NPROJ = 3840, INW = 3600;
constexpr float EPS = 1e-6f;
constexpr size_t MiB = 1u << 20;
constexpr size_t WS_MOD = 1 * MiB, WS_ROPE = 2 * MiB;
constexpr size_t WS_WGU1 = 4 * MiB, WS_WD1 = 15 * MiB, WS_WIN = 15 * MiB + 5632 * 1024, WS_WOUT = 28 * MiB, WS_WGU2 = 30 * MiB, WS_WD2 = 41 * MiB;
constexpr size_t WS_H = 48 * MiB, WS_DQ = 48 * MiB, WS_DK = 80 * MiB, WS_DV = 112 * MiB, WS_OF = 80 * MiB, WS_OB = 112 * MiB;
constexpr size_t WS_ACT = 112 * MiB, WS_PA = 144 * MiB, WS_Z = 240 * MiB, WS_CH = 272 * MiB, WS_PD = 272 * MiB, WS_OG = 272 * MiB, WS_LSE = 368 * MiB, WS_MIX = 374 * MiB;
constexpr size_t WS_AB = 496 * MiB, WS_GB = 498 * MiB, WS_GC = 500 * MiB, WS_END = 501 * MiB;
constexpr size_t WS_OG2 = 512 * MiB, WS_LSE2 = 608 * MiB, WS_OVL_END = 612 * MiB;
constexpr int ACTR_WORD = 3600;
constexpr int LDS_BYTES = 163840;
constexpr int CHJOB = 57344;

__device__ __forceinline__ float bf2f(unsigned short v) { return __uint_as_float(((unsigned)v) << 16); }
__device__ __forceinline__ float bflo(unsigned w) { return __uint_as_float(w << 16); }
__device__ __forceinline__ float bfhi(unsigned w) { return __uint_as_float(w & 0xffff0000u); }
__device__ __forceinline__ unsigned pk2(float lo, float hi) { return pg8::cvt_pk_bf16(lo, hi); }
__device__ __forceinline__ float opaque_one() { float o = 1.0f; asm volatile("" : "+v"(o)); return o; }
__device__ __forceinline__ float silu(float v) { return v * __builtin_amdgcn_rcpf(1.0f + __expf(-v)); }
__device__ __forceinline__ float xmax16(float x) { auto r = __builtin_amdgcn_permlane16_swap(__float_as_uint(x), __float_as_uint(x), false, false); return fmaxf(__uint_as_float(r[0]), __uint_as_float(r[1])); }
__device__ __forceinline__ float xmax32(float x) { auto r = __builtin_amdgcn_permlane32_swap(__float_as_uint(x), __float_as_uint(x), false, false); return fmaxf(__uint_as_float(r[0]), __uint_as_float(r[1])); }
__device__ __forceinline__ float xsum16(float x) { auto r = __builtin_amdgcn_permlane16_swap(__float_as_uint(x), __float_as_uint(x), false, false); return __uint_as_float(r[0]) + __uint_as_float(r[1]); }
__device__ __forceinline__ float xsum32(float x) { auto r = __builtin_amdgcn_permlane32_swap(__float_as_uint(x), __float_as_uint(x), false, false); return __uint_as_float(r[0]) + __uint_as_float(r[1]); }
__device__ __forceinline__ float wave_sum(float v) {
#pragma unroll
    for (int o = 1; o < 64; o <<= 1) v += __shfl_xor(v, o);
    return v;
}
__device__ __forceinline__ bf16x8 pack8(const f32x4 a, const f32x4 b) {
    v4u w; w.x = pk2(a[0], a[1]); w.y = pk2(a[2], a[3]); w.z = pk2(b[0], b[1]); w.w = pk2(b[2], b[3]);
    return __builtin_bit_cast(bf16x8, w);
}
__device__ __forceinline__ bf16x8 pack8cv(const f32x4 a, const f32x4 b) {
    v4u w; w.x = pg8::cvt_pk_bf16_cv(a[0], a[1]); w.y = pg8::cvt_pk_bf16_cv(a[2], a[3]); w.z = pg8::cvt_pk_bf16_cv(b[0], b[1]); w.w = pg8::cvt_pk_bf16_cv(b[2], b[3]);
    return __builtin_bit_cast(bf16x8, w);
}
__device__ __forceinline__ f32x4 ld_bf4(const bf16* p) { const v2u w = *(const v2u*)p; return (f32x4){bflo(w.x), bfhi(w.x), bflo(w.y), bfhi(w.y)}; }

__device__ __forceinline__ void ph_mod(const float* c_prompt, const float* c_sample, const float* ada_w, const float* ada_b, float* MOD, LAS unsigned char* lds) {
    const int tid = pg8::otid(), lane = tid & 63, wave = tid >> 6;
    LAS float* sc = (LAS float*)lds;
    LAS float* red = (LAS float*)(lds + 49152);
    for (int i = tid; i < 12 * 1024; i += 512) { const int b = i >> 10, k = i & 1023; const float v = b < 8 ? c_prompt[b * 1024 + k] : c_sample[(b - 8) * 1024 + k]; sc[i] = silu(v); }
    __syncthreads();
    const int cl = tid & 7, kg = tid >> 3;
    for (int item = blockIdx.x; item < 576; item += gridDim.x) {
        const int layer = item / 288, cg32 = item % 288, col = cg32 * 32 + cl * 4;
        float acc[12][4];
#pragma unroll
        for (int b = 0; b < 12; ++b)
#pragma unroll
            for (int j = 0; j < 4; ++j) acc[b][j] = 0.f;
        const float* wp = ada_w + (size_t)layer * 1024 * 9216 + col;
#pragma unroll 4
        for (int kk = 0; kk < 16; ++kk) { const int k = kg * 16 + kk; const f32x4 w = *(const f32x4*)(wp + (size_t)k * 9216);
#pragma unroll
            for (int b = 0; b < 12; ++b) { const float s = sc[b * 1024 + k];
#pragma unroll
                for (int j = 0; j < 4; ++j) acc[b][j] += s * w[j]; } }
#pragma unroll
        for (int b = 0; b < 12; ++b)
#pragma unroll
            for (int j = 0; j < 4; ++j) { float v = acc[b][j]; v += __shfl_xor(v, 8); v += __shfl_xor(v, 16); v += __shfl_xor(v, 32); if ((lane >> 3) == 0) red[(wave * 8 + cl) * 48 + b * 4 + j] = v; }
        __syncthreads();
        if (tid < 384) { const int b = tid >> 5, c = tid & 31; float s = 0.f;
#pragma unroll
            for (int w = 0; w < 8; ++w) s += red[(w * 8 + (c >> 2)) * 48 + b * 4 + (c & 3)];
            MOD[(size_t)(layer * 12 + b) * 9216 + cg32 * 32 + c] = s + ada_b[layer * 9216 + cg32 * 32 + c]; }
        __syncthreads();
    }
}
__device__ __forceinline__ void ph_rope(float* ROPE) {
    for (int idx = blockIdx.x * 512 + pg8::otid(); idx < 8192 * 8; idx += gridDim.x * 512) {
        const int s = idx >> 3, i = idx & 7;
        const float inv = exp2f(-(float)i * 0.125f * 18.931568569324174f);
        const float ang = (float)s * inv;
        double rev = (double)ang * 0.15915494309189535; rev -= __builtin_rint(rev);
        const float fr = (float)rev;
        ROPE[s * 16 + i] = __builtin_amdgcn_cosf(fr); ROPE[s * 16 + 8 + i] = __builtin_amdgcn_sinf(fr);
    }
}
__device__ __forceinline__ void tr_item(const float* W, int K, int N, bf16* WT, int k0, int n0, int dst_row0, LAS float* scr, int lane) {
#pragma unroll 8
    for (int i = 0; i < 32; ++i) { const int kk = 2 * i + (lane >> 5), n = n0 + (lane & 31); scr[kk * 33 + (lane & 31)] = (n < N) ? W[(size_t)(k0 + kk) * N + n] : 0.f; }
    LDS_WAIT();
    const int c = lane & 7;
#pragma unroll
    for (int j = 0; j < 4; ++j) { const int n = (lane >> 3) + 8 * j; const LAS float* s = scr + (8 * c) * 33 + n;
        v4u o; o.x = pk2(s[0 * 33], s[1 * 33]); o.y = pk2(s[2 * 33], s[3 * 33]); o.z = pk2(s[4 * 33], s[5 * 33]); o.w = pk2(s[6 * 33], s[7 * 33]);
        *(v4u*)(WT + (size_t)(dst_row0 + n) * K + k0 + 8 * c) = o; }
    LDS_WAIT();
}
__device__ __forceinline__ void ph_wconv(const float* wg1, const float* wu1, const float* wd1, const float* wg2, const float* wu2, const float* wd2, const float* win, const float* wout,
                                         int layer, unsigned char* ws, LAS unsigned char* lds) {
    const int tid_ = pg8::otid(), lane = tid_ & 63, wave = tid_ >> 6;
    LAS float* scr = (LAS float*)(lds + wave * 16384);
    const int gw = blockIdx.x * 8 + wave, NGW = gridDim.x * 8;
    constexpr int I_GU = 16 * 88, I_DN = 44 * 32, I_IN = 16 * 120, I_OUT = 16 * 32;
    constexpr int NIT = 6 * I_GU + I_IN + I_OUT;
    static_assert(I_DN == I_GU, "item counts");
    for (int it = gw; it < NIT; it += NGW) {
        int r = it;
        if (r < 6 * I_GU) {
            const int which = r / I_GU; r -= which * I_GU;
            const int f = which / 3, t = which % 3;
            if (t < 2) { const float* W = (f ? (t ? wu2 : wg2) : (t ? wu1 : wg1)) + (size_t)layer * D * FF; bf16* WT = (bf16*)(ws + (f ? WS_WGU2 : WS_WGU1));
                const int kb = r / 88, nb = r % 88, n0 = nb * 32; tr_item(W, D, FF, WT, kb * 64, n0, (n0 >> 7) * 256 + t * 128 + (n0 & 127), scr, lane); }
            else { const float* W = (f ? wd2 : wd1) + (size_t)layer * D * FF; bf16* WT = (bf16*)(ws + (f ? WS_WD2 : WS_WD1));
                const int kb = r / 32, nb = r % 32; tr_item(W, FF, D, WT, kb * 64, nb * 32, nb * 32, scr, lane); }
            continue;
        }
        r -= 6 * I_GU;
        if (r < I_IN) { const int kb = r / 120, nb = r % 120; tr_item(win + (size_t)layer * D * INW, D, INW, (bf16*)(ws + WS_WIN), kb * 64, nb * 32, nb * 32, scr, lane); continue; }
        r -= I_IN;
        { const int kb = r / 32, nb = r % 32; tr_item(wout + (size_t)layer * D * D, D, D, (bf16*)(ws + WS_WOUT), kb * 64, nb * 32, nb * 32, scr, lane); }
    }
}
__device__ __forceinline__ void ph_norm(const float* x, const float* nw, const float* modl, int sb, int half, bf16* H) {
    const int tid_ = pg8::otid(), lane = tid_ & 63, wave = tid_ >> 6;
    const int gw = blockIdx.x * 8 + wave, NGW = gridDim.x * 8;
    for (int r0 = gw * 16; r0 < MH; r0 += NGW * 16) {
        const int batch = half ? 8 + (r0 >> 13) : (r0 >> 12);
        const float* mp = modl + (size_t)batch * 9216 + sb * 3072;
        f32x4 A[4], B[4];
#pragma unroll
        for (int j = 0; j < 4; ++j) { const int c = 4 * lane + 256 * j; const f32x4 w = *(const f32x4*)(nw + c), sh = *(const f32x4*)(mp + c), scl = *(const f32x4*)(mp + 1024 + c); A[j] = w * (1.0f + scl); B[j] = sh; }
        for (int r = r0; r < r0 + 16; ++r) {
            const f32x4* xr = (const f32x4*)(x + (size_t)r * D) + lane;
            f32x4 v[4]; float s = 0.f;
#pragma unroll
            for (int j = 0; j < 4; ++j) { v[j] = xr[64 * j]; s += (v[j].x * v[j].x + v[j].y * v[j].y) + (v[j].z * v[j].z + v[j].w * v[j].w); }
            const float rstd = __builtin_amdgcn_rsqf(wave_sum(s) * (1.f / D) + EPS);
            v2u* o8 = (v2u*)(H + (size_t)r * D) + lane;
#pragma unroll
            for (int j = 0; j < 4; ++j) { const f32x4 h = v[j] * rstd * A[j] + B[j]; v2u w; w.x = pk2(h.x, h.y); w.y = pk2(h.z, h.w); o8[64 * j] = w; }
        }
    }
}
__device__ __forceinline__ void ph_final(float* x, const float* nw) {
    const int tid_ = pg8::otid(), lane = tid_ & 63, wave = tid_ >> 6;
    const int gw = blockIdx.x * 8 + wave, NGW = gridDim.x * 8;
    f32x4 A[4];
#pragma unroll
    for (int j = 0; j < 4; ++j) A[j] = *(const f32x4*)(nw + 4 * lane + 256 * j);
    for (int r = gw; r < 2 * MH; r += NGW) {
        f32x4* xr = (f32x4*)(x + (size_t)r * D) + lane;
        f32x4 v[4]; float s = 0.f;
#pragma unroll
        for (int j = 0; j < 4; ++j) { v[j] = xr[64 * j]; s += (v[j].x * v[j].x + v[j].y * v[j].y) + (v[j].z * v[j].z + v[j].w * v[j].w); }
        const float rstd = __builtin_amdgcn_rsqf(wave_sum(s) * (1.f / D) + EPS);
#pragma unroll
        for (int j = 0; j < 4; ++j) xr[64 * j] = v[j] * rstd * A[j];
    }
}
__device__ __forceinline__ void ph_dnpre(const bf16* PD, const float* AB, const float* conv_w, const float* a_log, const float* dt_bias,
                                         bf16* DQ, bf16* DK, bf16* DV, float* GB, int S) {
    const int tid_ = pg8::otid(), lane = tid_ & 63, wave = tid_ >> 6;
    const int gw = blockIdx.x * 8 + wave, NGW = gridDim.x * 8;
    for (int t0 = gw * 16; t0 < MH; t0 += NGW * 16) {
        const int s0 = t0 & (S - 1);
        for (int part = 0; part < 3; ++part) {
            const bf16* src = PD + part * 512 + lane * 8;
            bf16* dst = (part == 0 ? DQ : (part == 1 ? DK : DV)) + lane * 8;
            f32x4 w[5][2];
#pragma unroll
            for (int j = 0; j < 5; ++j) { const float* wp = conv_w + j * 1536 + part * 512 + lane * 8; w[j][0] = *(const f32x4*)wp; w[j][1] = *(const f32x4*)(wp + 4); }
            v4u r0, r1, r2, r3, r4;
            const v4u zero = {0u, 0u, 0u, 0u};
#define ROWLD(off) (((unsigned)(s0 + (off)) < (unsigned)S) ? *(const v4u*)(src + (size_t)(t0 + (off)) * 1536) : zero)
            r0 = ROWLD(-2); r1 = ROWLD(-1); r2 = ROWLD(0); r3 = ROWLD(1);
            for (int i = 0; i < 16; ++i) {
                r4 = ROWLD(i + 2);
                f32x4 y0, y1;
#define TAP(rr, j, first) { const f32x4 a = {bflo(rr.x), bfhi(rr.x), bflo(rr.y), bfhi(rr.y)}, b = {bflo(rr.z), bfhi(rr.z), bflo(rr.w), bfhi(rr.w)}; \
                    if (first) { y0 = a * w[j][0]; y1 = b * w[j][1]; } else { y0 += a * w[j][0]; y1 += b * w[j][1]; } }
                TAP(r0, 0, true) TAP(r1, 1, false) TAP(r2, 2, false) TAP(r3, 3, false) TAP(r4, 4, false)
#undef TAP
#pragma unroll
                for (int e = 0; e < 4; ++e) { y0[e] = silu(y0[e]); y1[e] = silu(y1[e]); }
                if (part < 2) {
                    float ss = (y0.x * y0.x + y0.y * y0.y) + (y0.z * y0.z + y0.w * y0.w) + (y1.x * y1.x + y1.y * y1.y) + (y1.z * y1.z + y1.w * y1.w);
                    ss += __shfl_xor(ss, 1); ss += __shfl_xor(ss, 2); ss += __shfl_xor(ss, 4); ss += __shfl_xor(ss, 8);
                    const float scl = __builtin_amdgcn_rsqf(ss + EPS) * (part == 0 ? 0.08838834764831845f : 1.0f);
                    y0 *= scl; y1 *= scl;
                }
                v4u o; o.x = pk2(y0.x, y0.y); o.y = pk2(y0.z, y0.w); o.z = pk2(y1.x, y1.y); o.w = pk2(y1.z, y1.w);
                *(v4u*)(dst + (size_t)(t0 + i) * 512) = o;
                r0 = r1; r1 = r2; r2 = r3; r3 = r4;
            }
#undef ROWLD
        }
#pragma unroll
        for (int jj = 0; jj < 4; ++jj) { const int idx = lane + 64 * jj, tok = t0 + (idx >> 4), c = idx & 15; const float v = AB[(size_t)tok * 16 + c];
            float res;
            if (c < 8) { const float xx = v + dt_bias[c]; const float sp = fmaxf(xx, 0.f) + __logf(1.0f + __expf(-fabsf(xx))); res = -__expf(a_log[c]) * sp; }
            else res = __builtin_amdgcn_rcpf(1.0f + __expf(-v));
            GB[(size_t)tok * 16 + c] = res; }
    }
}
__device__ __forceinline__ void ph_attn(const bf16* P, bf16* OG, float* LSE, int S, int lgS, LAS unsigned char* lds, unsigned* ctr) {
    const int tid = pg8::otid(), lane = tid & 63, wave = tid >> 6, l15 = lane & 15, g = lane >> 4;
    const float one = opaque_one();
    LAS unsigned char* KL = lds; LAS unsigned char* VT = lds + 46080;
    v4u kvr[5], vvr[5];
#define AT_DECODE(u_) const int tb = (u_) & 255, h = ((u_) >> 8) & 7, p = (u_) >> 11; const int lgd = 2 * p, L = S >> lgd, nb = L >> 7, bps = S >> 7; \
        const int seq = tb >> (lgS - 7), lb = tb & (bps - 1); const int r = lb / nb, ib = lb - r * nb, i0 = ib << 7; const int seqbase = seq << lgS;
#define AT_LOAD(u_) do { AT_DECODE(u_) _Pragma("unroll") for (int j = 0; j < 5; ++j) { const int idx = tid + 512 * j; const int kl = idx >> 3, pc = idx & 7, ik = i0 - 64 + kl; \
            kvr[j] = (v4u){0u, 0u, 0u, 0u}; vvr[j] = kvr[j]; \
            if (idx < 288 * 8 && ik >= 0 && ik < L) { const bf16* src = P + (size_t)(seqbase + (ik << lgd) + r) * 1536 + h * 64 + pc * 8; kvr[j] = *(const v4u*)(src + 512); vvr[j] = *(const v4u*)(src + 1024); } } } while (0)
    constexpr int NU = 3 * 8 * 256;
    volatile LAS unsigned* uw = (volatile LAS unsigned*)(lds + LDS_BYTES - 192);
    unsigned tk = 0u; int u, un;
    if (ctr) { if (tid == 0) uw[0] = atomicAdd(ctr, 1u); __syncthreads(); u = __builtin_amdgcn_readfirstlane((int)uw[0]); if (tid == 0) tk = atomicAdd(ctr, 1u); }
    else u = (int)blockIdx.x;
    if (u < NU) AT_LOAD(u);
    while (u < NU) {
        AT_DECODE(u)
        __syncthreads();
#pragma unroll
        for (int j = 0; j < 5; ++j) { const int idx = tid + 512 * j; const int kl = idx >> 3, pc = idx & 7;
            const int k5 = kl & 31, klp = (kl & ~31) + ((k5 & 16) ? (8 * ((k5 - 16) >> 2) + 4 + (k5 & 3)) : (8 * (k5 >> 2) + (k5 & 3)));
            if (idx < 288 * 8) { *(LAS v4u*)(KL + kl * 160 + pc * 16) = kvr[j];
#pragma unroll
                for (int e = 0; e < 8; ++e) { const unsigned wv = vvr[j][e >> 1]; *(LAS unsigned short*)(VT + (pc * 8 + e) * 608 + klp * 2) = (unsigned short)((e & 1) ? (wv >> 16) : (wv & 0xffffu)); } } }
        if (ctr && tid == 0) uw[0] = tk;
        __syncthreads();
        if (ctr) { un = __builtin_amdgcn_readfirstlane((int)uw[0]); if (tid == 0) tk = atomicAdd(ctr, 1u); } else un = u + (int)gridDim.x;
        if (un < NU) AT_LOAD(un);
        const int iq = i0 + 16 * wave + l15, tokq = seqbase + (iq << lgd) + r;
        bf16x8 qf[2];
#pragma unroll
        for (int ks = 0; ks < 2; ++ks) qf[ks] = *(const bf16x8*)(P + (size_t)tokq * 1536 + h * 64 + 32 * ks + 8 * g);
        f32x4 acc[4];
#pragma unroll
        for (int dt = 0; dt < 4; ++dt) acc[dt] = (f32x4){0.f, 0.f, 0.f, 0.f};
        float m = -1e30f, lsum = 0.f;
        for (int s = 0; s < 5; ++s) {
            const int kl0 = 32 * (wave >> 1) + 32 * s;
            bf16x8 ka[2][2], vfr[4];
#pragma unroll
            for (int t = 0; t < 2; ++t)
#pragma unroll
                for (int ks = 0; ks < 2; ++ks) ka[t][ks] = *(const LAS bf16x8*)(KL + (kl0 + 16 * t + l15) * 160 + (32 * ks + 8 * g) * 2);
#pragma unroll
            for (int dt = 0; dt < 4; ++dt) vfr[dt] = *(const LAS bf16x8*)(VT + (16 * dt + l15) * 608 + kl0 * 2 + 16 * g);
            __builtin_amdgcn_sched_barrier(0);
            f32x4 c[2];
#pragma unroll
            for (int t = 0; t < 2; ++t) { c[t] = (f32x4){0.f, 0.f, 0.f, 0.f};
#pragma unroll
                for (int ks = 0; ks < 2; ++ks) c[t] = MFMA16(ka[t][ks], qf[ks], c[t]); }
            float sc[8]; float mx = -1e30f;
#pragma unroll
            for (int t = 0; t < 2; ++t)
#pragma unroll
                for (int rg = 0; rg < 4; ++rg) { const int ik = i0 - 64 + kl0 + 16 * t + 4 * g + rg, dl = ik - iq;
                    const bool valid = (ik >= 0) && (ik < L) && (dl <= 64) && (dl >= -64);
                    const float sv = valid ? c[t][rg] * 0.18033688011112042f : -1e30f; sc[t * 4 + rg] = sv; mx = fmaxf(mx, sv); }
            mx = xmax32(xmax16(mx));
            const float mn = fmaxf(m, mx), alpha = __builtin_amdgcn_exp2f(m - mn); m = mn;
            float ps = 0.f; f32x4 p0, p1;
#pragma unroll
            for (int e = 0; e < 4; ++e) { p0[e] = __builtin_amdgcn_exp2f(sc[e] - mn); p1[e] = __builtin_amdgcn_exp2f(sc[4 + e] - mn); ps += p0[e] + p1[e]; }
            lsum = lsum * alpha + ps;
            const bf16x8 pf = pack8(p0 * one, p1 * one);
#pragma unroll
            for (int dt = 0; dt < 4; ++dt) { acc[dt] *= alpha;
                acc[dt] = MFMA16(vfr[dt], pf, acc[dt]); }
        }
        lsum = xsum32(xsum16(lsum));
        const float inv = 1.0f / lsum;
        bf16* og = OG + ((size_t)p * MH + tokq) * 512 + h * 64 + 4 * g;
#pragma unroll
        for (int dt = 0; dt < 4; ++dt) { v2u w; w.x = pk2(acc[dt][0] * inv, acc[dt][1] * inv); w.y = pk2(acc[dt][2] * inv, acc[dt][3] * inv); *(v2u*)(og + 16 * dt) = w; }
        if (g == 0) LSE[((size_t)p * MH + tokq) * 8 + h] = (m + __log2f(lsum)) * 0.6931471805599453f;
        u = un;
    }
#undef AT_LOAD
#undef AT_DECODE
}
__device__ __forceinline__ void ph_chunk(const bf16* DQ, const bf16* DK, const bf16* DV, const float* GB, unsigned char* CH, float* GC, int S, int lgS, LAS unsigned char* lds) {
    const int tid_ = pg8::otid(), lane = tid_ & 63, wave = tid_ >> 6, l15 = lane & 15, g = lane >> 4;
    const float one = opaque_one();
    LAS unsigned char* wl = lds + wave * 18432;
    LAS float* Al = (LAS float*)wl; LAS float* gcs = (LAS float*)(wl + 17408); LAS float* bts = gcs + 64;
    LAS bf16* TP = (LAS bf16*)wl; LAS bf16* TPP = (LAS bf16*)(wl + 8192);
    for (int job = blockIdx.x * 8 + wave; job < 4096; job += gridDim.x * 8) {
        const int dir = job & 1, h = (job >> 1) & 3, cgi = job >> 3, cps = S >> 6;
        const int seq = cgi >> (lgS - 6), n = cgi & (cps - 1), seqbase = seq << lgS;
#define TOK(c) (seqbase + (dir ? (S - 1 - (64 * n + (c))) : (64 * n + (c))))
        {   const int tokc = TOK(lane);
            const float gv = GB[(size_t)tokc * 16 + dir * 4 + h], bv = GB[(size_t)tokc * 16 + 8 + dir * 4 + h];
            float cs = gv;
#pragma unroll
            for (int o = 1; o < 64; o <<= 1) { const float t = __shfl_up(cs, o); if (lane >= o) cs += t; }
            gcs[lane] = cs; bts[lane] = bv; GC[(size_t)job * 64 + lane] = cs; }
        LDS_WAIT();
        bf16x8 kf[4][4];
#pragma unroll
        for (int t = 0; t < 4; ++t)
#pragma unroll
            for (int ks = 0; ks < 4; ++ks) kf[t][ks] = *(const bf16x8*)(DK + (size_t)TOK(16 * t + l15) * 512 + h * 128 + 32 * ks + 8 * g);
#pragma unroll
        for (int it = 0; it < 4; ++it) { const int i = 16 * it + l15; const float gi = gcs[i], bi = bts[i];
#pragma unroll
            for (int jt = 0; jt <= it; ++jt) { f32x4 c = {0.f, 0.f, 0.f, 0.f};
#pragma unroll
                for (int ks = 0; ks < 4; ++ks) c = MFMA16(kf[jt][ks], kf[it][ks], c);
                const f32x4 gj = *(const LAS f32x4*)(gcs + 16 * jt + 4 * g); f32x4 o;
#pragma unroll
                for (int rg = 0; rg < 4; ++rg) { const int j = 16 * jt + 4 * g + rg; o[rg] = (j < i) ? bi * c[rg] * __expf(gi - gj[rg]) : 0.f; }
                *(LAS f32x4*)(Al + i * 68 + 16 * jt + 4 * g) = o; } }
        unsigned char* chb = CH + (size_t)job * CHJOB;
        bf16* UT = (bf16*)chb; bf16* Wm = (bf16*)(chb + 16384); bf16* KT = (bf16*)(chb + 32768); bf16* QK = (bf16*)(chb + 49152);
#pragma unroll
        for (int it = 0; it < 4; ++it) { const int i = 16 * it + l15; const float gi = gcs[i];
            bf16x8 qfr[4];
#pragma unroll
            for (int ks = 0; ks < 4; ++ks) qfr[ks] = *(const bf16x8*)(DQ + (size_t)TOK(i) * 512 + h * 128 + 32 * ks + 8 * g);
#pragma unroll
            for (int jt = 0; jt < 4; ++jt) { v2u out = {0u, 0u};
                if (jt <= it) { f32x4 c = {0.f, 0.f, 0.f, 0.f};
#pragma unroll
                    for (int ks = 0; ks < 4; ++ks) c = MFMA16(kf[jt][ks], qfr[ks], c);
                    const f32x4 gj = *(const LAS f32x4*)(gcs + 16 * jt + 4 * g); f32x4 o;
#pragma unroll
                    for (int rg = 0; rg < 4; ++rg) { const int j = 16 * jt + 4 * g + rg; o[rg] = (j <= i) ? c[rg] * __expf(gi - gj[rg]) : 0.f; }
                    out.x = pk2(o[0], o[1]); out.y = pk2(o[2], o[3]); }
                *(v2u*)(QK + i * 64 + 16 * jt + 4 * g) = out; } }
        LDS_WAIT();
        float t[64];
#pragma unroll
        for (int i = 0; i < 64; ++i) { float a0 = 0.f, a1 = 0.f, a2 = 0.f, a3 = 0.f;
#pragma unroll
            for (int j4 = 0; j4 * 4 < i; ++j4) { const f32x4 a = *(const LAS f32x4*)(Al + i * 68 + 4 * j4);
                if (4 * j4 + 0 < i) a0 += a[0] * t[4 * j4 + 0];
                if (4 * j4 + 1 < i) a1 += a[1] * t[4 * j4 + 1];
                if (4 * j4 + 2 < i) a2 += a[2] * t[4 * j4 + 2];
                if (4 * j4 + 3 < i) a3 += a[3] * t[4 * j4 + 3]; }
            t[i] = ((lane == i) ? 1.f : 0.f) - ((a0 + a1) + (a2 + a3)); }
        const float bc = bts[lane], ec = bc * __expf(gcs[lane]);
        LDS_WAIT();
#pragma unroll
        for (int i = 0; i < 64; ++i) { const unsigned w = pk2(t[i] * bc, t[i] * ec); TP[i * 64 + lane] = (bf16)(w & 0xffffu); TPP[i * 64 + lane] = (bf16)(w >> 16); }
        LDS_WAIT();
        bf16x8 tf[4][2];
#pragma unroll
        for (int mt = 0; mt < 4; ++mt)
#pragma unroll
            for (int ks = 0; ks < 2; ++ks) tf[mt][ks] = *(const LAS bf16x8*)(TP + (16 * mt + l15) * 64 + 32 * ks + 8 * g);
        for (int nt = 0; nt < 8; ++nt) {
            bf16x8 vf[2];
#pragma unroll
            for (int ks = 0; ks < 2; ++ks)
#pragma unroll
                for (int e = 0; e < 8; ++e) vf[ks][e] = (short)DV[(size_t)TOK(32 * ks + 8 * g + e) * 512 + h * 128 + 16 * nt + l15];
#pragma unroll
            for (int mt = 0; mt < 4; ++mt) { f32x4 c = {0.f, 0.f, 0.f, 0.f};
#pragma unroll
                for (int ks = 0; ks < 2; ++ks) c = MFMA16(tf[mt][ks], vf[ks], c);
                c *= one;
                v2u w; w.x = pk2(c[0], c[1]); w.y = pk2(c[2], c[3]); *(v2u*)(UT + (16 * nt + l15) * 64 + 16 * mt + 4 * g) = w; }
        }
#pragma unroll
        for (int mt = 0; mt < 4; ++mt)
#pragma unroll
            for (int ks = 0; ks < 2; ++ks) tf[mt][ks] = *(const LAS bf16x8*)(TPP + (16 * mt + l15) * 64 + 32 * ks + 8 * g);
        for (int dt = 0; dt < 8; ++dt) {
            bf16x8 kt[2];
#pragma unroll
            for (int ks = 0; ks < 2; ++ks) {
#pragma unroll
                for (int e = 0; e < 8; ++e) kt[ks][e] = (short)DK[(size_t)TOK(32 * ks + 8 * g + e) * 512 + h * 128 + 16 * dt + l15];
                *(bf16x8*)(KT + (16 * dt + l15) * 64 + 32 * ks + 8 * g) = kt[ks]; }
#pragma unroll
            for (int mt = 0; mt < 4; ++mt) { f32x4 c = {0.f, 0.f, 0.f, 0.f};
#pragma unroll
                for (int ks = 0; ks < 2; ++ks) c = MFMA16(kt[ks], tf[mt][ks], c);
                c *= one;
                v2u w; w.x = pk2(c[0], c[1]); w.y = pk2(c[2], c[3]); *(v2u*)(Wm + (16 * mt + l15) * 128 + 16 * dt + 4 * g) = w; }
        }
        LDS_WAIT();
    }
}
#define TOKN(c, nn) (seqbase + (dir ? (S - 1 - (64 * (nn) + (c))) : (64 * (nn) + (c))))
constexpr int SC_PW = 288, SC_PK = 160;
constexpr int SC_W = 0, SC_Q = 64 * SC_PW, SC_QK = 2 * 64 * SC_PW, SC_KT = SC_QK + 64 * SC_PK, SC_GC = SC_KT + 128 * SC_PK, SC_BUF = SC_GC + 256;
static_assert(2 * SC_BUF + 4 * 5120 <= LDS_BYTES - 256, "scan LDS image");
__device__ __forceinline__ void ph_scan(const bf16* DQ, const unsigned char* CH, const float* GC, bf16* OF, bf16* OB, int S, int lgS, int half, LAS unsigned char* lds) {
    const int wave = __builtin_amdgcn_readfirstlane(pg8::otid() >> 6);
    const float one = opaque_one();
#define SC_BAR() do { asm volatile("s_waitcnt lgkmcnt(0)" ::: "memory"); __builtin_amdgcn_s_barrier(); asm volatile("" ::: "memory"); } while (0)
    const int nchain = half ? 32 : 64, cps = S >> 6;
    for (int ub = blockIdx.x; ub < 2 * nchain; ub += gridDim.x) {
        const int chain = (ub & 7) + 8 * (ub >> 4), part = (ub >> 3) & 1;
        const int dir = chain & 1, h = (chain >> 1) & 3, seq = chain >> 3, seqbase = seq << lgS;
        __syncthreads();
        if (wave >= 4) {
            __builtin_amdgcn_s_setprio(3);
            const int lt = pg8::otid() - 256;
            const int wr0 = lt >> 4, wc = lt & 15, kr0 = lt >> 3, kc = lt & 7;
            const int woff = (wc >> 2) * 64 + (wc & 1) * 32 + ((wc >> 1) & 1) * 8, koff = (kc >> 2) * 64 + (kc & 1) * 32 + ((kc >> 1) & 1) * 8;
            v4u rwA[4], rqA[4], rkA[2], rtA[4], rwB[4], rqB[4], rkB[2], rtB[4]; f32x4 rgA = {0.f, 0.f, 0.f, 0.f}, rgB = rgA;
#define SC_LD(rw, rq, rk, rt, rg, n_) do { const int nn_ = (n_); const int job = ((seq * cps + nn_) << 3) | (h << 1) | dir; const unsigned char* chb = CH + (size_t)job * CHJOB; \
                const bf16* Wm_ = (const bf16*)(chb + 16384); const bf16* KT_ = (const bf16*)(chb + 32768); const bf16* QK_ = (const bf16*)(chb + 49152); \
                _Pragma("unroll") for (int k = 0; k < 4; ++k) { rw[k] = *(const v4u*)(Wm_ + (wr0 + 16 * k) * 128 + wc * 8); rq[k] = *(const v4u*)(DQ + (size_t)TOKN(wr0 + 16 * k, nn_) * 512 + h * 128 + wc * 8); rt[k] = *(const v4u*)(KT_ + (kr0 + 32 * k) * 64 + kc * 8); } \
                _Pragma("unroll") for (int k = 0; k < 2; ++k) rk[k] = *(const v4u*)(QK_ + (kr0 + 32 * k) * 64 + kc * 8); \
                if (lt < 16) rg = *(const f32x4*)(GC + (size_t)job * 64 + 4 * lt); } while (0)
#define SC_ST8(dst_, v_) do { LAS unsigned char* d_ = (dst_); *(LAS v2u*)d_ = (v2u){(v_).x, (v_).y}; *(LAS v2u*)(d_ + 16) = (v2u){(v_).z, (v_).w}; } while (0)
#define SC_ST(rw, rq, rk, rt, rg, n_) do { LAS unsigned char* b_ = lds + ((n_) & 1) * SC_BUF; \
                _Pragma("unroll") for (int k = 0; k < 4; ++k) { SC_ST8(b_ + SC_W + (wr0 + 16 * k) * SC_PW + woff, rw[k]); SC_ST8(b_ + SC_Q + (wr0 + 16 * k) * SC_PW + woff, rq[k]); SC_ST8(b_ + SC_KT + (kr0 + 32 * k) * SC_PK + koff, rt[k]); } \
                _Pragma("unroll") for (int k = 0; k < 2; ++k) SC_ST8(b_ + SC_QK + (kr0 + 32 * k) * SC_PK + koff, rk[k]); \
                if (lt < 16) *(LAS f32x4*)(b_ + SC_GC + 16 * lt) = rg; } while (0)
            unsigned pfa = 0u, t00 = 0u, t01 = 0u, t02 = 0u, t10 = 0u, t11 = 0u, t12 = 0u, t20 = 0u, t21 = 0u, t22 = 0u, t30 = 0u, t31 = 0u, t32 = 0u;
#define SC_TOUCH(p0_, p1_, p2_, n_) do { const int nn_ = (n_); pfa += p0_ + p1_ + p2_; if (nn_ < cps) { const int jb_ = ((seq * cps + nn_) << 3) | (h << 1) | dir; const unsigned* cb_ = (const unsigned*)(CH + (size_t)jb_ * CHJOB); \
                p0_ = cb_[lt * 32]; if (lt < 192) p1_ = cb_[(lt + 256) * 32]; if (lt < 128) p2_ = *(const unsigned*)(DQ + (size_t)TOKN(lt >> 1, nn_) * 512 + h * 128 + (lt & 1) * 64); } } while (0)
            SC_LD(rwA, rqA, rkA, rtA, rgA, 0);
            SC_TOUCH(t10, t11, t12, 1); SC_TOUCH(t20, t21, t22, 2); SC_TOUCH(t30, t31, t32, 3);
            for (int n = 0; n < cps; n += 4) {
                SC_LD(rwB, rqB, rkB, rtB, rgB, n + 1); SC_TOUCH(t00, t01, t02, n + 4); SC_ST(rwA, rqA, rkA, rtA, rgA, n); SC_BAR();
                SC_LD(rwA, rqA, rkA, rtA, rgA, n + 2); SC_TOUCH(t10, t11, t12, n + 5); SC_ST(rwB, rqB, rkB, rtB, rgB, n + 1); SC_BAR();
                SC_LD(rwB, rqB, rkB, rtB, rgB, n + 3); SC_TOUCH(t20, t21, t22, n + 6); SC_ST(rwA, rqA, rkA, rtA, rgA, n + 2); SC_BAR();
                if (n + 4 < cps) SC_LD(rwA, rqA, rkA, rtA, rgA, n + 4); SC_TOUCH(t30, t31, t32, n + 7); SC_ST(rwB, rqB, rkB, rtB, rgB, n + 3); SC_BAR();
            }
            pfa += t00 + t01 + t02 + t10 + t11 + t12 + t20 + t21 + t22 + t30 + t31 + t32;
            if (pfa == 0x9e3779b9u && lt == 100000) OF[0] = (bf16)pfa;
#undef SC_TOUCH
#undef SC_LD
#undef SC_ST
#undef SC_ST8
            SC_BAR();
            __builtin_amdgcn_s_setprio(0);
        } else {
            const int tidc = pg8::otid(), lane = tidc & 63, l15 = lane & 15, g = lane >> 4;
            const int dv0 = part * 64 + wave * 16;
            bf16* OX = dir ? OB : OF;
            f32x4 St[8];
#pragma unroll
            for (int t = 0; t < 8; ++t) St[t] = (f32x4){0.f, 0.f, 0.f, 0.f};
            v2u utA[4], utN[4];
#define SC_UT(UT__, n_) do { const int jb_ = ((seq * cps + (n_)) << 3) | (h << 1) | dir; const bf16* UT_ = (const bf16*)(CH + (size_t)jb_ * CHJOB); \
                _Pragma("unroll") for (int mt = 0; mt < 4; ++mt) UT__[mt] = *(const v2u*)(UT_ + (dv0 + l15) * 64 + 16 * mt + 4 * g); } while (0)
            SC_UT(utA, 0);
            SC_BAR();
#define SC_FRAG(p_) (*(const LAS bf16x8*)(p_))
            for (int n = 0; n < cps; ++n) {
                const LAS unsigned char* buf = lds + (n & 1) * SC_BUF;
                const LAS float* gcl = (const LAS float*)(buf + SC_GC);
                if (n + 1 < cps) SC_UT(utN, n + 1);
                const float glast = gcl[63];
                bf16x8 sb[4];
#pragma unroll
                for (int ks = 0; ks < 4; ++ks) sb[ks] = pack8cv(St[2 * ks], St[2 * ks + 1]);
                f32x4 vnew[4];
#pragma unroll
                for (int mp = 0; mp < 2; ++mp) { bf16x8 wf[2][4];
#pragma unroll
                    for (int mm = 0; mm < 2; ++mm) { const LAS unsigned char* wrow = buf + SC_W + (16 * (2 * mp + mm) + l15) * SC_PW + 16 * g;
#pragma unroll
                        for (int ks = 0; ks < 4; ++ks) wf[mm][ks] = SC_FRAG(wrow + 64 * ks); }
                    __builtin_amdgcn_sched_barrier(0);
                    f32x4 ws0 = {0.f, 0.f, 0.f, 0.f}, ws1 = ws0;
#pragma unroll
                    for (int ks = 0; ks < 4; ++ks) { ws0 = MFMA16(wf[0][ks], sb[ks], ws0); ws1 = MFMA16(wf[1][ks], sb[ks], ws1); }
                    vnew[2 * mp] = (f32x4){bflo(utA[2 * mp].x), bfhi(utA[2 * mp].x), bflo(utA[2 * mp].y), bfhi(utA[2 * mp].y)} - ws0;
                    vnew[2 * mp + 1] = (f32x4){bflo(utA[2 * mp + 1].x), bfhi(utA[2 * mp + 1].x), bflo(utA[2 * mp + 1].y), bfhi(utA[2 * mp + 1].y)} - ws1;
                    __builtin_amdgcn_sched_barrier(0);
                }
                bf16x8 vb[2], vbs[2];
#pragma unroll
                for (int k2 = 0; k2 < 2; ++k2) vb[k2] = pack8(vnew[2 * k2], vnew[2 * k2 + 1]);
#pragma unroll
                for (int mp = 0; mp < 2; ++mp) { bf16x8 qf[2][4], kf2[2][2]; float egi[2];
#pragma unroll
                    for (int mm = 0; mm < 2; ++mm) { const int mt = 2 * mp + mm; const LAS unsigned char* qrow = buf + SC_Q + (16 * mt + l15) * SC_PW + 16 * g; const LAS unsigned char* qkrow = buf + SC_QK + (16 * mt + l15) * SC_PK + 16 * g;
#pragma unroll
                        for (int ks = 0; ks < 4; ++ks) qf[mm][ks] = SC_FRAG(qrow + 64 * ks);
#pragma unroll
                        for (int k2 = 0; k2 < 2; ++k2) kf2[mm][k2] = SC_FRAG(qkrow + 64 * k2);
                        egi[mm] = __expf(gcl[16 * mt + l15]); }
                    __builtin_amdgcn_sched_barrier(0);
                    f32x4 o0 = {0.f, 0.f, 0.f, 0.f}, o1 = o0;
#pragma unroll
                    for (int ks = 0; ks < 4; ++ks) { o0 = MFMA16(sb[ks], qf[0][ks], o0); o1 = MFMA16(sb[ks], qf[1][ks], o1); }
                    o0 *= egi[0]; o1 *= egi[1];
#pragma unroll
                    for (int k2 = 0; k2 < 2; ++k2) { o0 = MFMA16(vb[k2], kf2[0][k2], o0); o1 = MFMA16(vb[k2], kf2[1][k2], o1); }
                    o0 *= one; o1 *= one;
                    v2u w0, w1; w0.x = pk2(o0[0], o0[1]); w0.y = pk2(o0[2], o0[3]); w1.x = pk2(o1[0], o1[1]); w1.y = pk2(o1[2], o1[3]);
                    *(v2u*)(OX + (size_t)TOKN(16 * (2 * mp) + l15, n) * 512 + h * 128 + dv0 + 4 * g) = w0;
                    *(v2u*)(OX + (size_t)TOKN(16 * (2 * mp + 1) + l15, n) * 512 + h * 128 + dv0 + 4 * g) = w1;
                    __builtin_amdgcn_sched_barrier(0); }
                const float eg = __expf(glast);
#pragma unroll
                for (int mt = 0; mt < 4; ++mt) { const f32x4 gv = *(const LAS f32x4*)(gcl + 16 * mt + 4 * g);
#pragma unroll
                    for (int rg = 0; rg < 4; ++rg) vnew[mt][rg] *= __expf(glast - gv[rg]); }
#pragma unroll
                for (int k2 = 0; k2 < 2; ++k2) vbs[k2] = pack8(vnew[2 * k2], vnew[2 * k2 + 1]);
#pragma unroll
                for (int tp = 0; tp < 2; ++tp) { bf16x8 kt4[4][2];
#pragma unroll
                    for (int tt = 0; tt < 4; ++tt) { const LAS unsigned char* ktrow = buf + SC_KT + (16 * (4 * tp + tt) + l15) * SC_PK + 16 * g; kt4[tt][0] = SC_FRAG(ktrow); kt4[tt][1] = SC_FRAG(ktrow + 64); }
                    __builtin_amdgcn_sched_barrier(0);
#pragma unroll
                    for (int tt = 0; tt < 4; ++tt) St[4 * tp + tt] *= eg;
#pragma unroll
                    for (int k2 = 0; k2 < 2; ++k2)
#pragma unroll
                        for (int tt = 0; tt < 4; ++tt) St[4 * tp + tt] = MFMA16(kt4[tt][k2], vbs[k2], St[4 * tp + tt]);
                    __builtin_amdgcn_sched_barrier(0); }
#pragma unroll
                for (int mt = 0; mt < 4; ++mt) utA[mt] = utN[mt];
                SC_BAR();
            }
#undef SC_FRAG
#undef SC_UT
        }
    }
#undef SC_BAR
#undef TOKN
#undef TOK
}
__device__ __forceinline__ void ph_post(const bf16* OG, const float* LSE, const bf16* OF, const bf16* OB, const bf16* Z, const float* dn_norm, bf16* MIX) {
    const int tid_ = pg8::otid(), lane = tid_ & 63, wave = tid_ >> 6;
    const int gw = blockIdx.x * 8 + wave, NGW = gridDim.x * 8;
    f32x4 nw0 = *(const f32x4*)(dn_norm + (lane & 15) * 8), nw1 = *(const f32x4*)(dn_norm + (lane & 15) * 8 + 4);
    for (int t = gw; t < MH; t += NGW) {
        {   const int hd = lane >> 3;
            const float l0 = LSE[((size_t)0 * MH + t) * 8 + hd], l1 = LSE[((size_t)1 * MH + t) * 8 + hd], l2 = LSE[((size_t)2 * MH + t) * 8 + hd];
            const float mx = fmaxf(l0, fmaxf(l1, l2));
            float w0 = __expf(l0 - mx), w1 = __expf(l1 - mx), w2 = __expf(l2 - mx); const float inv = 1.0f / (w0 + w1 + w2); w0 *= inv; w1 *= inv; w2 *= inv;
            const v4u a = *(const v4u*)(OG + ((size_t)0 * MH + t) * 512 + lane * 8), b = *(const v4u*)(OG + ((size_t)1 * MH + t) * 512 + lane * 8), c = *(const v4u*)(OG + ((size_t)2 * MH + t) * 512 + lane * 8);
            v4u o;
#pragma unroll
            for (int e = 0; e < 4; ++e) o[e] = pk2(w0 * bflo(a[e]) + w1 * bflo(b[e]) + w2 * bflo(c[e]), w0 * bfhi(a[e]) + w1 * bfhi(b[e]) + w2 * bfhi(c[e]));
            *(v4u*)(MIX + (size_t)t * 1024 + lane * 8) = o; }
        {   const v4u a = *(const v4u*)(OF + (size_t)t * 512 + lane * 8), b = *(const v4u*)(OB + (size_t)t * 512 + lane * 8), z = *(const v4u*)(Z + (size_t)t * 512 + lane * 8);
            float ov[8]; float ss = 0.f;
#pragma unroll
            for (int e = 0; e < 4; ++e) { ov[2 * e] = bflo(a[e]) + bflo(b[e]); ov[2 * e + 1] = bfhi(a[e]) + bfhi(b[e]); ss += ov[2 * e] * ov[2 * e] + ov[2 * e + 1] * ov[2 * e + 1]; }
            ss += __shfl_xor(ss, 1); ss += __shfl_xor(ss, 2); ss += __shfl_xor(ss, 4); ss += __shfl_xor(ss, 8);
            const float rs = __builtin_amdgcn_rsqf(ss * (1.0f / 128.0f) + EPS);
            v4u o;
#pragma unroll
            for (int e = 0; e < 4; ++e) { const float n0 = (e < 2) ? nw0[2 * e] : nw1[2 * e - 4], n1 = (e < 2) ? nw0[2 * e + 1] : nw1[2 * e - 3];
                o[e] = pk2(ov[2 * e] * rs * n0 * silu(bflo(z[e])), ov[2 * e + 1] * rs * n1 * silu(bfhi(z[e]))); }
            *(v4u*)(MIX + (size_t)t * 1024 + 512 + lane * 8) = o; }
    }
}
#define XB_TMO      128
#define XB_XCNT(j)  (256  + 64 * (j))
#define XB_XSUB(j)  (1280 + 64 * (j))
#define XB_XGEN(j)  (2304 + 64 * (j))
#define XB_TOP      3328
#define XB_TOPGEN   3392
#define XCD_BAR_WORDS 3456
#define XB_SPIN_CAP (1u << 18)

__device__ __forceinline__ unsigned xb_ld(unsigned* p)              { return __hip_atomic_load(p, __ATOMIC_RELAXED, __HIP_MEMORY_SCOPE_AGENT); }
__device__ __forceinline__ unsigned xb_add(unsigned* p, unsigned v) { return __hip_atomic_fetch_add(p, v, __ATOMIC_RELAXED, __HIP_MEMORY_SCOPE_AGENT); }
__device__ __forceinline__ unsigned xb_xcc_id() { return (unsigned)__builtin_amdgcn_s_getreg((3 << 11) | 20) & 0xFu; }
#define XB_SPIN(cond, bar) do { unsigned _sp = 0; while (cond) { __builtin_amdgcn_s_sleep(1); \
    if ((++_sp & 255u) == 0u) { if (xb_ld(&(bar)[XB_TMO])) break; if (_sp > XB_SPIN_CAP) { atomicAdd(&(bar)[XB_TMO], 1u); break; } } } } while (0)

struct XcdBarrier {
    unsigned* bar; unsigned x;
    volatile LAS unsigned* st;
};

__device__ __forceinline__ XcdBarrier xcd_barrier_post(unsigned* bar, volatile LAS unsigned* st) {
    XcdBarrier b; b.bar = bar; b.x = xb_xcc_id(); b.st = st;
    if (threadIdx.x == 0) (void)xb_add(&bar[XB_XCNT(b.x)], 1u);
    return b;
}
__device__ __forceinline__ void xcd_barrier_complete(unsigned* bar, unsigned x, unsigned& nloc, unsigned& nx) {
    const unsigned G = gridDim.x * gridDim.y * gridDim.z;
    unsigned sum, cnt, mine, sp = 0u;
    for (;;) {
        sum = 0u; cnt = 0u; mine = 0u;
#pragma unroll
        for (unsigned j = 0; j < 16; ++j) { const unsigned c = xb_ld(&bar[XB_XCNT(j)]); sum += c; cnt += (c > 0u) ? 1u : 0u; mine = (j == x) ? c : mine; }
        if (sum == G) break;
        __builtin_amdgcn_s_sleep(1);
        if ((++sp & 255u) == 0u) { if (xb_ld(&bar[XB_TMO])) break; if (sp > XB_SPIN_CAP) { atomicAdd(&bar[XB_TMO], 1u); break; } }
    }
    nloc = mine > 0u ? mine : 1u; nx = cnt > 0u ? cnt : 1u;
}

__device__ __forceinline__ void xcd_barrier(const XcdBarrier& b) {
    asm volatile("s_waitcnt vmcnt(0)" ::: "memory");
    __syncthreads();
    if (threadIdx.x == 0) {
        unsigned* bar = b.bar;
        __builtin_amdgcn_s_waitcnt(0);
        unsigned nloc = b.st[0], nx = b.st[1];
        if (nloc == 0u) { xcd_barrier_complete(bar, b.x, nloc, nx); b.st[0] = nloc; b.st[1] = nx; }
        const unsigned old = xb_add(&bar[XB_XSUB(b.x)], 1u);
        const unsigned gen = old / nloc;
        if (old + 1u == (gen + 1u) * nloc) {
            __builtin_amdgcn_fence(__ATOMIC_RELEASE, "agent");
            asm volatile("s_waitcnt vmcnt(0)" ::: "memory");
            const unsigned og = xb_add(&bar[XB_TOP], 1u);
            const unsigned tg = og / nx;
            if (og + 1u == (tg + 1u) * nx) xb_add(&bar[XB_TOPGEN], 1u);
            else XB_SPIN(xb_ld(&bar[XB_TOPGEN]) == tg, bar);
            __builtin_amdgcn_fence(__ATOMIC_ACQUIRE, "agent");
            xb_add(&bar[XB_XGEN(b.x)], 1u);
            asm volatile("s_waitcnt vmcnt(0)" ::: "memory");
        } else {
            XB_SPIN(xb_ld(&bar[XB_XGEN(b.x)]) == gen, bar);
            __builtin_amdgcn_fence(__ATOMIC_ACQUIRE, "agent");
            asm volatile("s_waitcnt vmcnt(0)" ::: "memory");
        }
    }
    __syncthreads();
}

#ifndef DBG_SKIP_MIXER
#define DBG_SKIP_MIXER 0
#endif
#ifndef MK_MULTI
#define MK_MULTI 0
#endif
constexpr int NPH = 1 + 2 * (2 * 14) + 1 + 1;
static_assert(pg8::EpiProj::OFF_PA == WS_PA && pg8::EpiProj::OFF_PD == WS_PD && pg8::EpiProj::OFF_Z == WS_Z, "EpiProj offsets");
struct Args { const float* in[22]; float* out; unsigned char* ws; int lo, hi; int big, pad; };

__global__ void __launch_bounds__(512, 2) fwd(Args a) {
    extern __shared__ __attribute__((aligned(16))) unsigned char lds_raw[];
    LAS unsigned char* lds = (LAS unsigned char*)lds_raw;
    cg::grid_group grid = cg::this_grid();
    unsigned char* ws = a.ws;
    const int lo = a.lo, hi = a.hi; int pc = 0;
    const bool big = a.big != 0;
    bf16* OGp = (bf16*)(ws + (big ? WS_OG2 : WS_OG)); float* LSEp = (float*)(ws + (big ? WS_LSE2 : WS_LSE));
    const float* x_prompt = a.in[0]; const float* x_sample = a.in[1];
    float* MOD = (float*)(ws + WS_MOD); float* ROPE = (float*)(ws + WS_ROPE);
    bf16* H = (bf16*)(ws + WS_H); bf16* ACT = (bf16*)(ws + WS_ACT); bf16* PA = (bf16*)(ws + WS_PA); bf16* PD = (bf16*)(ws + WS_PD); bf16* Zb = (bf16*)(ws + WS_Z);
    bf16* DQ = (bf16*)(ws + WS_DQ); bf16* DK = (bf16*)(ws + WS_DK); bf16* DV = (bf16*)(ws + WS_DV); bf16* OF = (bf16*)(ws + WS_OF); bf16* OB = (bf16*)(ws + WS_OB);
    unsigned char* CH = ws + WS_CH; bf16* OG = (bf16*)(ws + WS_OG); float* LSE = (float*)(ws + WS_LSE); bf16* MIX = (bf16*)(ws + WS_MIX);
    float* AB = (float*)(ws + WS_AB); float* GB = (float*)(ws + WS_GB); float* GC = (float*)(ws + WS_GC);
#define PH_BEGIN if (pc >= lo && pc < hi) {
    { volatile LAS unsigned* st = (volatile LAS unsigned*)(lds + LDS_BYTES - 256); if (pg8::otid() < 2) st[pg8::otid()] = 0u; }
    __syncthreads();
    XcdBarrier bar = xcd_barrier_post((unsigned*)ws, (volatile LAS unsigned*)(lds + LDS_BYTES - 256));
#define PH_END } ++pc; if (pc > lo && pc < hi) { if (pc == 1) grid.sync(); else xcd_barrier(bar); }
#define PH_END_IF(c_) } ++pc; if ((c_) && pc > lo && pc < hi) { xcd_barrier(bar); }

    PH_BEGIN
        ph_mod(a.in[2], a.in[3], a.in[4], a.in[5], MOD, lds);
        ph_rope(ROPE);
        ph_wconv(a.in[7], a.in[8], a.in[9], a.in[18], a.in[19], a.in[20], a.in[11], a.in[16], 0, ws, lds);
    PH_END
    for (int layer = 0; layer < 2; ++layer) {
        if (layer == 1) {
            PH_BEGIN ph_wconv(a.in[7], a.in[8], a.in[9], a.in[18], a.in[19], a.in[20], a.in[11], a.in[16], 1, ws, lds); PH_END
        }
        const float* modl = MOD + (size_t)layer * 12 * 9216;
        for (int half = 0; half < 2; ++half) {
            const int S = half ? 8192 : 4096, lgS = half ? 13 : 12;
            float* X = a.out + (size_t)half * MH * D;
            const float* xin0 = half ? x_sample : x_prompt;
            for (int sb = 0; sb < 3; ++sb) {
                if (DBG_SKIP_MIXER && sb == 1) continue;
                const bool first = (layer == 0 && sb == 0);
                const float* xsrc = first ? xin0 : X;
                const float* nw = (sb == 0 ? a.in[6] : (sb == 1 ? a.in[10] : a.in[17])) + layer * D;
                PH_BEGIN ph_norm(xsrc, nw, modl, sb, half, H); PH_END
                if (sb != 1) {
                    PH_BEGIN
                        pg8::Gemm g{H, (const bf16*)(ws + (sb ? WS_WGU2 : WS_WGU1)), MH, 2 * FF, D}; pg8::StaticOrder So; So.init(MH, 2 * FF, gridDim.x, (int)blockIdx.x);
                        pg8::EpiSwiGLU E{ACT, FF};
                        pg8::gemm_phase<pg8::EpiSwiGLU, pg8::StaticOrder, true, true>(lds, g, So, E);
                    PH_END
                    PH_BEGIN
                        pg8::Gemm g{ACT, (const bf16*)(ws + (sb ? WS_WD2 : WS_WD1)), MH, D, FF}; pg8::StaticOrder So; So.init(MH, D, gridDim.x, (int)blockIdx.x);
                        pg8::EpiResid E{xsrc, X, modl + (3 * sb + 2) * 1024, 0.5f, half};
                        pg8::gemm_phase<pg8::EpiResid, pg8::StaticOrder, true, true>(lds, g, So, E);
                    PH_END
                } else {
                    PH_BEGIN
                        pg8::Gemm g{H, (const bf16*)(ws + WS_WIN), MH, NPROJ, D}; pg8::StaticOrder So; So.init(MH, NPROJ, gridDim.x, (int)blockIdx.x);
                        pg8::EpiProj E{ws, AB, ROPE, S - 1};
                        pg8::gemm_phase<pg8::EpiProj, pg8::StaticOrder, true, true>(lds, g, So, E);
                    PH_END
                    PH_BEGIN ph_dnpre(PD, AB, a.in[12] + (size_t)layer * 5 * 1536, a.in[13] + layer * 8, a.in[14] + layer * 8, DQ, DK, DV, GB, S); PH_END
                    PH_BEGIN ph_chunk(DQ, DK, DV, GB, CH, GC, S, lgS, lds); PH_END
                    PH_BEGIN ph_scan(DQ, CH, GC, OF, OB, S, lgS, half, lds); PH_END_IF(!big)
                    PH_BEGIN ph_attn(PA, OGp, LSEp, S, lgS, lds, big ? (unsigned*)ws + ACTR_WORD + 16 * (layer * 2 + half) : (unsigned*)nullptr); PH_END
                    PH_BEGIN ph_post(OGp, LSEp, OF, OB, Zb, a.in[15] + layer * 128, MIX); PH_END
                    PH_BEGIN
                        pg8::Gemm g{MIX, (const bf16*)(ws + WS_WOUT), MH, D, D}; pg8::StaticOrder So; So.init(MH, D, gridDim.x, (int)blockIdx.x);
                        pg8::EpiResid E{X, X, modl + 5 * 1024, 1.0f, half};
                        pg8::gemm_phase<pg8::EpiResid, pg8::StaticOrder, true, true>(lds, g, So, E);
                    PH_END
                }
            }
        }
    }
    PH_BEGIN ph_final(a.out, a.in[21]); PH_END
}

extern "C" void kernel_launch(void* const* d_in, const int* in_sizes, int n_in, void* d_out, int out_size, void* d_ws, size_t ws_size, hipStream_t stream) {
    static int grid = 0;
    if (grid == 0) {
        if (n_in != 22 || ws_size < WS_END) { fprintf(stderr, "kernel_launch: unexpected n_in %d / ws_size %zu\n", n_in, ws_size); grid = -1; return; }
        int dev = 0, cus = 0, per_cu = 0;
        hipGetDevice(&dev); hipDeviceGetAttribute(&cus, hipDeviceAttributeMultiprocessorCount, dev);
        if (hipFuncSetAttribute((const void*)fwd, hipFuncAttributeMaxDynamicSharedMemorySize, LDS_BYTES) != hipSuccess) { fprintf(stderr, "kernel_launch: hipFuncSetAttribute failed\n"); grid = -1; return; }
        if (hipOccupancyMaxActiveBlocksPerMultiprocessor(&per_cu, (const void*)fwd, 512, LDS_BYTES) != hipSuccess || per_cu < 1) { per_cu = 1; (void)hipGetLastError(); }
        grid = cus * per_cu;
        fprintf(stderr, "kernel_launch: grid %d (cus %d x %d), ws %zu MiB\n", grid, cus, per_cu, ws_size >> 20);
    }
    if (grid < 0) return;
    if (hipMemsetAsync(d_ws, 0, 16384, stream) != hipSuccess) { fprintf(stderr, "kernel_launch: memset failed\n"); return; }
    Args a{};
    for (int i = 0; i < 22; ++i) a.in[i] = (const float*)d_in[i];
    a.out = (float*)d_out; a.ws = (unsigned char*)d_ws; a.big = (ws_size >= WS_OVL_END) ? 1 : 0;
#if MK_MULTI
    for (int p = 0; p < NPH; ++p) { a.lo = p; a.hi = p + 1; hipLaunchKernelGGL(fwd, dim3(grid), dim3(512), LDS_BYTES, stream, a); }
#else
    a.lo = 0; a.hi = NPH;
    void* args[] = {&a};
    hipError_t e = hipLaunchCooperativeKernel((const void*)fwd, dim3(grid), dim3(512), args, LDS_BYTES, stream);
    if (e != hipSuccess) fprintf(stderr, "cooperative launch failed: %s (grid %d)\n", hipGetErrorString(e), grid);
#endif
}
```

```cpp
#include <hip/hip_runtime.h>
#include <hip/hip_cooperative_groups.h>
#include <cstdio>
#include <cstdint>
namespace cg = cooperative_groups;
namespace pg8 {
#define PG8_LAS __attribute__((address_space(3)))
typedef unsigned short bf16_t;
typedef short bf16x8 __attribute__((ext_vector_type(8)));
typedef float f32x4 __attribute__((ext_vector_type(4)));
typedef unsigned u32x4 __attribute__((ext_vector_type(4)));
constexpr int BM = 256, BK = 64, HALF = 128, HTB = HALF * BK * 2  , STAGE_BYTES = 8 * HTB, NXCD = 8, WGM = 8;

__host__ __device__ __forceinline__ int lds_byte(int r, int c) { const int st = (r >> 4) * 2 + (c >> 5), rr = r & 15, cc = c & 31, ob = rr * 64 + cc * 2; return st * 1024 + (ob ^ (((ob >> 9) & 1) << 5)); }
__host__ __device__ __forceinline__ void stage_rc(int b, int& R, int& C) { const int st = b / 1024, sb = b % 1024, swz = sb ^ (((sb >> 9) & 1) << 5); R = (st >> 1) * 16 + swz / 64; C = (st & 1) * 32 + (swz % 64) / 2; }
__host__ __device__ __forceinline__ int perm32(int rho) { const int n = rho >> 4, i = rho & 15; return 8 * (i >> 2) + 4 * n + (i & 3); }

struct Unit { int pm, pn; };
struct Gemm { const bf16_t* A; const bf16_t* Bt; int M, N, K; };

struct StaticOrder {
    int nM, nN, nwg, G, c;
    __host__ __device__ void init(int M, int N, int G_, int c_) { nM = M / BM; nN = N / BM; nwg = nM * nN; G = G_; c = c_; }
    __host__ __device__ bool next(int i, Unit& u) const {
        const long L = (long)i * G + c; if (L >= nwg) return false;
        int wgid = (int)L; { const int q = nwg / NXCD, r = nwg % NXCD, xcd = wgid % NXCD, off = wgid / NXCD; wgid = (xcd < r ? xcd * (q + 1) : r * (q + 1) + (xcd - r) * q) + off; }
        const int nig = WGM * nN, gid = wgid / nig, fm = gid * WGM, gsz = (nM - fm) < WGM ? (nM - fm) : WGM;
        u.pm = fm + ((wgid % nig) % gsz); u.pn = (wgid % nig) / gsz; return true;
    }
    __device__ __forceinline__ void a_ready(const Unit&) const {}
    __device__ __forceinline__ void done(const Unit&) const {}
};
typedef __bf16 bf16x2_t __attribute__((ext_vector_type(2)));
typedef float f32x2_t __attribute__((ext_vector_type(2)));
__device__ __forceinline__ unsigned cvt_pk_bf16(float lo, float hi) { unsigned r; asm volatile("v_cvt_pk_bf16_f32 %0, %1, %2" : "=v"(r) : "v"(lo), "v"(hi)); return r; }
__device__ __forceinline__ unsigned cvt_pk_bf16_cv(float lo, float hi) { const f32x2_t v = {lo, hi}; const bf16x2_t b = __builtin_convertvector(v, bf16x2_t); return __builtin_bit_cast(unsigned, b); }
__device__ __forceinline__ int otid() { int t = threadIdx.x; asm volatile("" : "+v"(t)); return t; }
__device__ __forceinline__ float silu_f(float v) { return v * __builtin_amdgcn_rcpf(1.0f + __expf(-v)); }

#define EPI_PIN(p) asm volatile("" : "+v"(p))
struct EpiSwiGLU {
    static constexpr bool PERM = true, AFTER_DRAIN = false;
    bf16_t* O; int ldc;
    __device__ __forceinline__ void operator()(const f32x4 (&acc)[2][2][4][2], const Unit& u, int wr, int wc, int fr, int fq) const {
        const int row0 = u.pm * BM + wr * 64 + fr, col0 = u.pn * 128 + wc * 32 + 8 * fq;
        bf16_t* rowp = O + (size_t)row0 * ldc + col0;
#pragma unroll
        for (int ai = 0; ai < 2; ++ai) {
#pragma unroll
            for (int m = 0; m < 4; ++m) {
                const f32x4 g0 = acc[ai][0][m][0], g1 = acc[ai][0][m][1], u0 = acc[ai][1][m][0], u1 = acc[ai][1][m][1];
                u32x4 w;
                w.x = cvt_pk_bf16(silu_f(g0[0]) * u0[0], silu_f(g0[1]) * u0[1]); w.y = cvt_pk_bf16(silu_f(g0[2]) * u0[2], silu_f(g0[3]) * u0[3]);
                w.z = cvt_pk_bf16(silu_f(g1[0]) * u1[0], silu_f(g1[1]) * u1[1]); w.w = cvt_pk_bf16(silu_f(g1[2]) * u1[2], silu_f(g1[3]) * u1[3]);
                *(u32x4*)rowp = w;
                rowp += (size_t)16 * ldc; EPI_PIN(rowp);
            }
            rowp += (size_t)64 * ldc; EPI_PIN(rowp);
        }
    }
};
struct EpiResid {
    static constexpr bool PERM = false, AFTER_DRAIN = false;
    const float* xin; float* xout; const float* gate; float scale; int half;
    __device__ __forceinline__ void operator()(const f32x4 (&acc)[2][2][4][2], const Unit& u, int wr, int wc, int fr, int fq) const {
        const int row0 = u.pm * BM + wr * 64 + fr, col0 = u.pn * BM + wc * 32 + 4 * fq;
        const int batch = half ? 8 + (u.pm >> 5) : (u.pm >> 4);
        const float* gp = gate + (size_t)batch * 9216 + col0;
        f32x4 gv[2][2];
#pragma unroll
        for (int bj = 0; bj < 2; ++bj)
#pragma unroll
            for (int n = 0; n < 2; ++n) gv[bj][n] = *(const f32x4*)(gp + bj * HALF + n * 16) * scale;
        const float* lp = xin + (size_t)row0 * 1024 + col0; float* op = xout + (size_t)row0 * 1024 + col0;
        f32x4 xb[4][2][2];
#define EPI_LD(slot) do { _Pragma("unroll") for (int bj = 0; bj < 2; ++bj) _Pragma("unroll") for (int n = 0; n < 2; ++n) xb[slot][bj][n] = *(const f32x4*)(lp + bj * HALF + n * 16); } while (0)
#define EPI_LADV(grp) do { lp += (((grp) & 3) == 3 ? 80 : 16) * 1024; EPI_PIN(lp); } while (0)
        EPI_LD(0); EPI_LADV(0); EPI_LD(1); EPI_LADV(1); EPI_LD(2); EPI_LADV(2); EPI_LD(3); EPI_LADV(3);
#pragma unroll
        for (int grp = 0; grp < 8; ++grp) { const int ai = grp >> 2, m = grp & 3, slot = grp & 3;
#pragma unroll
            for (int bj = 0; bj < 2; ++bj)
#pragma unroll
                for (int n = 0; n < 2; ++n) *(f32x4*)(op + bj * HALF + n * 16) = xb[slot][bj][n] + gv[bj][n] * acc[ai][bj][m][n];
            op += (m == 3 ? 80 : 16) * 1024; EPI_PIN(op);
            if (grp + 4 < 8) { EPI_LD(slot); EPI_LADV(grp + 4); }
        }
#undef EPI_LD
#undef EPI_LADV
    }
};
struct EpiProj {
    static constexpr bool PERM = true, AFTER_DRAIN = false;
    static constexpr size_t OFF_PA = (size_t)144 << 20, OFF_PD = (size_t)272 << 20, OFF_Z = (size_t)240 << 20;
    unsigned char* wsb; float* AB; const float* rope; int smask;
    __device__ __forceinline__ void operator()(const f32x4 (&acc)[2][2][4][2], const Unit& u, int wr, int wc, int fr, int fq) const {
        const int row0 = u.pm * BM + wr * 64 + fr, pn = u.pn;
        if (pn < 14) {
            const size_t poff = pn < 6 ? OFF_PA : (pn < 12 ? OFF_PD : OFF_Z); bf16_t* P = (bf16_t*)(wsb + poff); const int ldp = pn < 12 ? 1536 : 512;
            const int col0 = (pn < 6 ? pn : (pn < 12 ? pn - 6 : pn - 12)) * 256 + wc * 32 + 8 * fq;
            const bool rot = (pn < 4) && ((wc & 1) == 0) && (fq < 2);
            const float sgn = (fq & 1) ? 1.f : -1.f;
            bf16_t* rowp = P + (size_t)row0 * ldp + col0; int row = row0;
#pragma unroll
            for (int ai = 0; ai < 2; ++ai) {
#pragma unroll
                for (int m = 0; m < 4; ++m) {
                    f32x4 c0 = {0.f, 0.f, 0.f, 0.f}, c1 = c0, s0 = c0, s1 = c0;
                    if (pn < 4) { const float* rp = rope + (size_t)(row & smask) * 16; c0 = *(const f32x4*)rp; c1 = *(const f32x4*)(rp + 4); s0 = *(const f32x4*)(rp + 8); s1 = *(const f32x4*)(rp + 12); }
#pragma unroll
                    for (int bj = 0; bj < 2; ++bj) { f32x4 v0 = acc[ai][bj][m][0], v1 = acc[ai][bj][m][1];
                        if (pn < 4) { f32x4 p0, p1;
#pragma unroll
                            for (int j = 0; j < 4; ++j) {
                                const auto s0 = __builtin_amdgcn_permlane16_swap(__float_as_uint(v0[j]), __float_as_uint(v0[j]), false, false), s1 = __builtin_amdgcn_permlane16_swap(__float_as_uint(v1[j]), __float_as_uint(v1[j]), false, false);
                                p0[j] = __uint_as_float((fq & 1) ? s0[0] : s0[1]); p1[j] = __uint_as_float((fq & 1) ? s1[0] : s1[1]); }
                            const f32x4 r0 = v0 * c0 + sgn * (p0 * s0), r1 = v1 * c1 + sgn * (p1 * s1);
                            if (rot) { v0 = r0; v1 = r1; } }
                        u32x4 w; w.x = cvt_pk_bf16(v0[0], v0[1]); w.y = cvt_pk_bf16(v0[2], v0[3]); w.z = cvt_pk_bf16(v1[0], v1[1]); w.w = cvt_pk_bf16(v1[2], v1[3]);
                        *(u32x4*)(rowp + bj * HALF) = w; }
                    rowp += (size_t)16 * ldp; row += 16; EPI_PIN(rowp); EPI_PIN(row);
                    asm volatile("" ::: "memory"); }
                rowp += (size_t)64 * ldp; row += 64; EPI_PIN(rowp); EPI_PIN(row);
            }
        } else {
            if (wc == 0 && fq < 2) {
                float* ap = AB + (size_t)row0 * 16 + 8 * fq;
#pragma unroll
                for (int ai = 0; ai < 2; ++ai) {
#pragma unroll
                    for (int m = 0; m < 4; ++m) { *(f32x4*)ap = acc[ai][0][m][0]; *(f32x4*)(ap + 4) = acc[ai][0][m][1]; ap += 16 * 16; EPI_PIN(ap); }
                    ap += 64 * 16; EPI_PIN(ap); }
            }
        }
    }
};

template <class Epi, class Sched, bool ALIGN_EPI = false, bool SP2 = false>
__device__ __forceinline__ void gemm_phase(PG8_LAS unsigned char* lds, const Gemm g, const Sched& S, const Epi& E) {
    const int tid = otid(), wid = __builtin_amdgcn_readfirstlane(tid >> 6), lane = tid & 63, wr = wid >> 2, wc = wid & 3, fr = lane & 15, fq = lane >> 4;
    const int K = g.K, nt = K / BK;
    unsigned voffA[2], voffB[2];
#pragma unroll
    for (int i = 0; i < 2; ++i) { int R, C; stage_rc(tid * 16 + i * 8192, R, C); const int Rb = Epi::PERM ? ((R & ~31) + perm32(R & 31)) : R;
        voffA[i] = (unsigned)(R * K + C) * 2u; voffB[i] = (unsigned)(Rb * K + C) * 2u; }
    const size_t kstep = (size_t)(BK * 2);
    const size_t hstep = (size_t)HALF * K * 2;
    const size_t tstep = 2 * hstep;
    const unsigned ldsw = (unsigned)wid * 1024u;
    const int aoff = lds_byte(wr * 64 + fr, fq * 8), boff = lds_byte(wc * 32 + fr, fq * 8);
#define PG8_SA(b, h) (((b) * 2 + (h)) * HTB)
#define PG8_SB(b, h) ((4 + (b) * 2 + (h)) * HTB)
#define PG8_STAGE(bufoff, gbase, voff) do { _Pragma("unroll") for (int _i = 0; _i < 2; ++_i) \
        __builtin_amdgcn_global_load_lds((const unsigned*)((const char*)(gbase) + (voff)[_i]), (PG8_LAS unsigned*)(lds + (bufoff) + ldsw + _i * 8192), 16, 0, 0); } while (0)
#define PG8_LDA(dst, b, h) do { _Pragma("unroll") for (int m = 0; m < 4; ++m) _Pragma("unroll") for (int k = 0; k < 2; ++k) dst[m][k] = *(const PG8_LAS bf16x8*)(lds + PG8_SA(b, h) + aoff + m * 2048 + k * 1024); } while (0)
#define PG8_LDB(dst, b, h) do { _Pragma("unroll") for (int n = 0; n < 2; ++n) _Pragma("unroll") for (int k = 0; k < 2; ++k) dst[n][k] = *(const PG8_LAS bf16x8*)(lds + PG8_SB(b, h) + boff + n * 2048 + k * 1024); } while (0)
#define PG8_MMA(ai, bj, At, Bt) do { __builtin_amdgcn_s_setprio(1); _Pragma("unroll") for (int m = 0; m < 4; ++m) _Pragma("unroll") for (int n = 0; n < 2; ++n) _Pragma("unroll") for (int k = 0; k < 2; ++k) \
        acc[ai][bj][m][n] = __builtin_amdgcn_mfma_f32_16x16x32_bf16(Bt[n][k], At[m][k], acc[ai][bj][m][n], 0, 0, 0); __builtin_amdgcn_s_setprio(0); } while (0)
#define PG8_WAIT_V(n) asm volatile("s_waitcnt vmcnt(" #n ")" ::: "memory")
#define PG8_WAIT_L(n) asm volatile("s_waitcnt lgkmcnt(" #n ")" ::: "memory")
#define PG8_BAR __builtin_amdgcn_s_barrier()
#define PG8_SCHED __builtin_amdgcn_sched_barrier(0)
    Unit cur, nxt; int ui = 0;
    if (!S.next(0, cur)) return;
    f32x4 acc[2][2][4][2];
#pragma unroll
    for (int a = 0; a < 2; ++a)
#pragma unroll
        for (int b = 0; b < 2; ++b)
#pragma unroll
            for (int m = 0; m < 4; ++m)
#pragma unroll
                for (int n = 0; n < 2; ++n) acc[a][b][m][n] = (f32x4){0.f, 0.f, 0.f, 0.f};
    bf16x8 At[4][2], B0[2][2], B1[2][2];
    const char* cA = (const char*)g.A + (size_t)cur.pm * tstep; const char* cB = (const char*)g.Bt + (size_t)cur.pn * tstep;
    S.a_ready(cur);
    if constexpr (SP2) {
        PG8_STAGE(PG8_SB(0, 0), cB, voffB); PG8_STAGE(PG8_SB(0, 1), cB + hstep, voffB); PG8_STAGE(PG8_SA(0, 0), cA, voffA); PG8_STAGE(PG8_SA(0, 1), cA + hstep, voffA);
        if (wr == 1) PG8_BAR;
        PG8_WAIT_V(2); PG8_BAR;
        PG8_STAGE(PG8_SB(1, 0), cB + kstep, voffB); PG8_STAGE(PG8_SA(1, 0), cA + kstep, voffA); PG8_STAGE(PG8_SB(1, 1), cB + hstep + kstep, voffB);
        PG8_WAIT_V(6); PG8_BAR;
    } else {
        PG8_STAGE(PG8_SB(0, 0), cB, voffB); PG8_STAGE(PG8_SA(0, 0), cA, voffA); PG8_STAGE(PG8_SB(0, 1), cB + hstep, voffB); PG8_STAGE(PG8_SA(0, 1), cA + hstep, voffA);
        if (wr == 1) PG8_BAR;
        PG8_WAIT_V(4); PG8_BAR;
        PG8_STAGE(PG8_SB(1, 0), cB + kstep, voffB); PG8_STAGE(PG8_SA(1, 0), cA + kstep, voffA); PG8_STAGE(PG8_SB(1, 1), cB + hstep + kstep, voffB);
        PG8_WAIT_V(6); PG8_BAR;
    }
    for (;;) {
        const bool has_next = S.next(ui + 1, nxt);
        const char* nA = has_next ? (const char*)g.A + (size_t)nxt.pm * tstep : cA; const char* nB = has_next ? (const char*)g.Bt + (size_t)nxt.pn * tstep : cB;
        for (int t = 0; t < nt; t += 2) {
            const bool last = (t == nt - 2);
            const char* a1 = cA + (size_t)(t + 1) * kstep;
            const char* a2 = last ? nA : cA + (size_t)(t + 2) * kstep; const char* b2 = last ? nB : cB + (size_t)(t + 2) * kstep;
            const char* a3 = a2 + kstep; const char* b3 = b2 + kstep;
            if (last && has_next) S.a_ready(nxt);
            if constexpr (SP2) {
            PG8_LDB(B0, 0, 0); PG8_LDB(B1, 0, 1); PG8_SCHED; PG8_LDA(At, 0, 0); PG8_STAGE(PG8_SA(1, 1), a1 + hstep, voffA);
            PG8_WAIT_V(8); PG8_WAIT_L(0); PG8_BAR; PG8_MMA(0, 0, At, B0); PG8_MMA(0, 1, At, B1); PG8_BAR; PG8_SCHED;
            PG8_LDA(At, 0, 1); PG8_STAGE(PG8_SB(0, 0), b2, voffB); PG8_STAGE(PG8_SB(0, 1), b2 + hstep, voffB); PG8_STAGE(PG8_SA(0, 0), a2, voffA);
            PG8_WAIT_V(8); PG8_WAIT_L(0); PG8_BAR; PG8_MMA(1, 0, At, B0); PG8_MMA(1, 1, At, B1); PG8_BAR; PG8_SCHED;
            PG8_LDB(B0, 1, 0); PG8_LDB(B1, 1, 1); PG8_SCHED; PG8_LDA(At, 1, 0); PG8_STAGE(PG8_SA(0, 1), a2 + hstep, voffA);
            PG8_WAIT_V(8); PG8_WAIT_L(0); PG8_BAR; PG8_MMA(0, 0, At, B0); PG8_MMA(0, 1, At, B1); PG8_BAR; PG8_SCHED;
            PG8_LDA(At, 1, 1); PG8_STAGE(PG8_SB(1, 0), b3, voffB); PG8_STAGE(PG8_SB(1, 1), b3 + hstep, voffB); PG8_STAGE(PG8_SA(1, 0), a3, voffA);
            PG8_WAIT_V(8); PG8_WAIT_L(0); PG8_BAR; PG8_MMA(1, 0, At, B0); PG8_MMA(1, 1, At, B1); PG8_BAR; PG8_SCHED;
            } else {
            PG8_LDB(B0, 0, 0); PG8_SCHED; PG8_LDA(At, 0, 0); PG8_STAGE(PG8_SA(1, 1), a1 + hstep, voffA);
            PG8_WAIT_L(8); PG8_BAR; PG8_WAIT_L(0); PG8_MMA(0, 0, At, B0); PG8_BAR; PG8_SCHED;
            PG8_LDB(B1, 0, 1); PG8_STAGE(PG8_SB(0, 0), b2, voffB);
            PG8_BAR; PG8_WAIT_L(0); PG8_MMA(0, 1, At, B1); PG8_BAR;
            PG8_LDA(At, 0, 1); PG8_STAGE(PG8_SA(0, 0), a2, voffA);
            PG8_BAR; PG8_WAIT_L(0); PG8_MMA(1, 0, At, B0); PG8_BAR; PG8_SCHED;
            PG8_STAGE(PG8_SB(0, 1), b2 + hstep, voffB);
            PG8_WAIT_V(6); PG8_BAR; PG8_MMA(1, 1, At, B1); PG8_BAR;
            PG8_LDB(B0, 1, 0); PG8_SCHED; PG8_LDA(At, 1, 0); PG8_STAGE(PG8_SA(0, 1), a2 + hstep, voffA);
            PG8_WAIT_L(8); PG8_BAR; PG8_WAIT_L(0); PG8_MMA(0, 0, At, B0); PG8_BAR; PG8_SCHED;
            PG8_LDB(B1, 1, 1); PG8_STAGE(PG8_SB(1, 0), b3, voffB);
            PG8_BAR; PG8_WAIT_L(0); PG8_MMA(0, 1, At, B1); PG8_BAR;
            PG8_LDA(At, 1, 1); PG8_STAGE(PG8_SA(1, 0), a3, voffA);
            PG8_BAR; PG8_WAIT_L(0); PG8_MMA(1, 0, At, B0); PG8_BAR; PG8_SCHED;
            PG8_STAGE(PG8_SB(1, 1), b3 + hstep, voffB);
            PG8_WAIT_V(6); PG8_BAR; PG8_MMA(1, 1, At, B1); PG8_BAR;
            }
        }
        if constexpr (ALIGN_EPI) { if (wr == 0) PG8_BAR; }
        if constexpr (!Epi::AFTER_DRAIN) { E(acc, cur, wr, wc, fr, fq); S.done(cur); }
        if (!has_next) break;
#pragma unroll
        for (int a = 0; a < 2; ++a)
#pragma unroll
            for (int b = 0; b < 2; ++b)
#pragma unroll
                for (int m = 0; m < 4; ++m)
#pragma unroll
                    for (int n = 0; n < 2; ++n) acc[a][b][m][n] = (f32x4){0.f, 0.f, 0.f, 0.f};
        cur = nxt; cA = nA; cB = nB; ++ui;
        if constexpr (ALIGN_EPI) { if (wr == 1) PG8_BAR; }
    }
    PG8_WAIT_V(0);
    if constexpr (!ALIGN_EPI) { if (wr == 0) PG8_BAR; }
    PG8_BAR;
    if constexpr (Epi::AFTER_DRAIN) { E.fused(acc, cur, wr, wc, fr, fq, lds, wid, lane); S.done(cur); }
#undef PG8_SA
#undef PG8_SB
#undef PG8_STAGE
#undef PG8_LDA
#undef PG8_LDB
#undef PG8_MMA
#undef PG8_WAIT_V
#undef PG8_WAIT_L
#undef PG8_BAR
#undef PG8_SCHED
}
}

#define LAS __attribute__((address_space(3)))
typedef unsigned short bf16;
typedef short bf16x8 __attribute__((ext_vector_type(8)));
typedef short s16x4 __attribute__((ext_vector_type(4)));
typedef float f32x4 __attribute__((ext_vector_type(4)));
typedef unsigned v4u __attribute__((ext_vector_type(4)));
typedef unsigned v2u __attribute__((ext_vector_type(2)));
#define MFMA16(a, b, c) __builtin_amdgcn_mfma_f32_16x16x32_bf16((a), (b), (c), 0, 0, 0)
#define CAT8(lo, hi) __builtin_shufflevector((lo), (hi), 0, 1, 2, 3, 4, 5, 6, 7)
#define LDS_WAIT() asm volatile("s_waitcnt lgkmcnt(0)" ::: "memory")

constexpr int D = 1024, FF = 2816, MH = 32768, NPROJ = 3840, INW = 3600;
constexpr float EPS = 1e-6f;
constexpr size_t MiB = 1u << 20;
constexpr size_t WS_MOD = 1 * MiB, WS_ROPE = 2 * MiB;
constexpr size_t WS_WGU1 = 4 * MiB, WS_WD1 = 15 * MiB, WS_WIN = 15 * MiB + 5632 * 1024, WS_WOUT = 28 * MiB, WS_WGU2 = 30 * MiB, WS_WD2 = 41 * MiB;
constexpr size_t WS_H = 48 * MiB, WS_DQ = 48 * MiB, WS_DK = 80 * MiB, WS_DV = 112 * MiB, WS_OF = 80 * MiB, WS_OB = 112 * MiB;
constexpr size_t WS_ACT = 112 * MiB, WS_PA = 144 * MiB, WS_Z = 240 * MiB, WS_CH = 272 * MiB, WS_PD = 272 * MiB, WS_OG = 272 * MiB, WS_LSE = 368 * MiB, WS_MIX = 374 * MiB;
constexpr size_t WS_AB = 496 * MiB, WS_GB = 498 * MiB, WS_GC = 500 * MiB, WS_END = 501 * MiB;
constexpr size_t WS_OG2 = 512 * MiB, WS_LSE2 = 608 * MiB, WS_OVL_END = 612 * MiB;
constexpr int ACTR_WORD = 3600;
constexpr int LDS_BYTES = 163840;
constexpr int CHJOB = 57344;

__device__ __forceinline__ float bf2f(unsigned short v) { return __uint_as_float(((unsigned)v) << 16); }
__device__ __forceinline__ float bflo(unsigned w) { return __uint_as_float(w << 16); }
__device__ __forceinline__ float bfhi(unsigned w) { return __uint_as_float(w & 0xffff0000u); }
__device__ __forceinline__ unsigned pk2(float lo, float hi) { return pg8::cvt_pk_bf16(lo, hi); }
__device__ __forceinline__ float opaque_one() { float o = 1.0f; asm volatile("" : "+v"(o)); return o; }
__device__ __forceinline__ float silu(float v) { return v * __builtin_amdgcn_rcpf(1.0f + __expf(-v)); }
__device__ __forceinline__ float xmax16(float x) { auto r = __builtin_amdgcn_permlane16_swap(__float_as_uint(x), __float_as_uint(x), false, false); return fmaxf(__uint_as_float(r[0]), __uint_as_float(r[1])); }
__device__ __forceinline__ float xmax32(float x) { auto r = __builtin_amdgcn_permlane32_swap(__float_as_uint(x), __float_as_uint(x), false, false); return fmaxf(__uint_as_float(r[0]), __uint_as_float(r[1])); }
__device__ __forceinline__ float xsum16(float x) { auto r = __builtin_amdgcn_permlane16_swap(__float_as_uint(x), __float_as_uint(x), false, false); return __uint_as_float(r[0]) + __uint_as_float(r[1]); }
__device__ __forceinline__ float xsum32(float x) { auto r = __builtin_amdgcn_permlane32_swap(__float_as_uint(x), __float_as_uint(x), false, false); return __uint_as_float(r[0]) + __uint_as_float(r[1]); }
__device__ __forceinline__ float wave_sum(float v) {
#pragma unroll
    for (int o = 1; o < 64; o <<= 1) v += __shfl_xor(v, o);
    return v;
}
__device__ __forceinline__ bf16x8 pack8(const f32x4 a, const f32x4 b) {
    v4u w; w.x = pk2(a[0], a[1]); w.y = pk2(a[2], a[3]); w.z = pk2(b[0], b[1]); w.w = pk2(b[2], b[3]);
    return __builtin_bit_cast(bf16x8, w);
}
__device__ __forceinline__ bf16x8 pack8cv(const f32x4 a, const f32x4 b) {
    v4u w; w.x = pg8::cvt_pk_bf16_cv(a[0], a[1]); w.y = pg8::cvt_pk_bf16_cv(a[2], a[3]); w.z = pg8::cvt_pk_bf16_cv(b[0], b[1]); w.w = pg8::cvt_pk_bf16_cv(b[2], b[3]);
    return __builtin_bit_cast(bf16x8, w);
}
__device__ __forceinline__ f32x4 ld_bf4(const bf16* p) { const v2u w = *(const v2u*)p; return (f32x4){bflo(w.x), bfhi(w.x), bflo(w.y), bfhi(w.y)}; }

__device__ __forceinline__ void ph_mod(const float* c_prompt, const float* c_sample, const float* ada_w, const float* ada_b, float* MOD, LAS unsigned char* lds) {
    const int tid = pg8::otid(), lane = tid & 63, wave = tid >> 6;
    LAS float* sc = (LAS float*)lds;
    LAS float* red = (LAS float*)(lds + 49152);
    for (int i = tid; i < 12 * 1024; i += 512) { const int b = i >> 10, k = i & 1023; const float v = b < 8 ? c_prompt[b * 1024 + k] : c_sample[(b - 8) * 1024 + k]; sc[i] = silu(v); }
    __syncthreads();
    const int cl = tid & 7, kg = tid >> 3;
    for (int item = blockIdx.x; item < 576; item += gridDim.x) {
        const int layer = item / 288, cg32 = item % 288, col = cg32 * 32 + cl * 4;
        float acc[12][4];
#pragma unroll
        for (int b = 0; b < 12; ++b)
#pragma unroll
            for (int j = 0; j < 4; ++j) acc[b][j] = 0.f;
        const float* wp = ada_w + (size_t)layer * 1024 * 9216 + col;
#pragma unroll 4
        for (int kk = 0; kk < 16; ++kk) { const int k = kg * 16 + kk; const f32x4 w = *(const f32x4*)(wp + (size_t)k * 9216);
#pragma unroll
            for (int b = 0; b < 12; ++b) { const float s = sc[b * 1024 + k];
#pragma unroll
                for (int j = 0; j < 4; ++j) acc[b][j] += s * w[j]; } }
#pragma unroll
        for (int b = 0; b < 12; ++b)
#pragma unroll
            for (int j = 0; j < 4; ++j) { float v = acc[b][j]; v += __shfl_xor(v, 8); v += __shfl_xor(v, 16); v += __shfl_xor(v, 32); if ((lane >> 3) == 0) red[(wave * 8 + cl) * 48 + b * 4 + j] = v; }
        __syncthreads();
        if (tid < 384) { const int b = tid >> 5, c = tid & 31; float s = 0.f;
#pragma unroll
            for (int w = 0; w < 8; ++w) s += red[(w * 8 + (c >> 2)) * 48 + b * 4 + (c & 3)];
            MOD[(size_t)(layer * 12 + b) * 9216 + cg32 * 32 + c] = s + ada_b[layer * 9216 + cg32 * 32 + c]; }
        __syncthreads();
    }
}
__device__ __forceinline__ void ph_rope(float* ROPE) {
    for (int idx = blockIdx.x * 512 + pg8::otid(); idx < 8192 * 8; idx += gridDim.x * 512) {
        const int s = idx >> 3, i = idx & 7;
        const float inv = exp2f(-(float)i * 0.125f * 18.931568569324174f);
        const float ang = (float)s * inv;
        double rev = (double)ang * 0.15915494309189535; rev -= __builtin_rint(rev);
        const float fr = (float)rev;
        ROPE[s * 16 + i] = __builtin_amdgcn_cosf(fr); ROPE[s * 16 + 8 + i] = __builtin_amdgcn_sinf(fr);
    }
}
__device__ __forceinline__ void tr_item(const float* W, int K, int N, bf16* WT, int k0, int n0, int dst_row0, LAS float* scr, int lane) {
#pragma unroll 8
    for (int i = 0; i < 32; ++i) { const int kk = 2 * i + (lane >> 5), n = n0 + (lane & 31); scr[kk * 33 + (lane & 31)] = (n < N) ? W[(size_t)(k0 + kk) * N + n] : 0.f; }
    LDS_WAIT();
    const int c = lane & 7;
#pragma unroll
    for (int j = 0; j < 4; ++j) { const int n = (lane >> 3) + 8 * j; const LAS float* s = scr + (8 * c) * 33 + n;
        v4u o; o.x = pk2(s[0 * 33], s[1 * 33]); o.y = pk2(s[2 * 33], s[3 * 33]); o.z = pk2(s[4 * 33], s[5 * 33]); o.w = pk2(s[6 * 33], s[7 * 33]);
        *(v4u*)(WT + (size_t)(dst_row0 + n) * K + k0 + 8 * c) = o; }
    LDS_WAIT();
}
__device__ __forceinline__ void ph_wconv(const float* wg1, const float* wu1, const float* wd1, const float* wg2, const float* wu2, const float* wd2, const float* win, const float* wout,
                                         int layer, unsigned char* ws, LAS unsigned char* lds) {
    const int tid_ = pg8::otid(), lane = tid_ & 63, wave = tid_ >> 6;
    LAS float* scr = (LAS float*)(lds + wave * 16384);
    const int gw = blockIdx.x * 8 + wave, NGW = gridDim.x * 8;
    constexpr int I_GU = 16 * 88, I_DN = 44 * 32, I_IN = 16 * 120, I_OUT = 16 * 32;
    constexpr int NIT = 6 * I_GU + I_IN + I_OUT;
    static_assert(I_DN == I_GU, "item counts");
    for (int it = gw; it < NIT; it += NGW) {
        int r = it;
        if (r < 6 * I_GU) {
            const int which = r / I_GU; r -= which * I_GU;
            const int f = which / 3, t = which % 3;
            if (t < 2) { const float* W = (f ? (t ? wu2 : wg2) : (t ? wu1 : wg1)) + (size_t)layer * D * FF; bf16* WT = (bf16*)(ws + (f ? WS_WGU2 : WS_WGU1));
                const int kb = r / 88, nb = r % 88, n0 = nb * 32; tr_item(W, D, FF, WT, kb * 64, n0, (n0 >> 7) * 256 + t * 128 + (n0 & 127), scr, lane); }
            else { const float* W = (f ? wd2 : wd1) + (size_t)layer * D * FF; bf16* WT = (bf16*)(ws + (f ? WS_WD2 : WS_WD1));
                const int kb = r / 32, nb = r % 32; tr_item(W, FF, D, WT, kb * 64, nb * 32, nb * 32, scr, lane); }
            continue;
        }
        r -= 6 * I_GU;
        if (r < I_IN) { const int kb = r / 120, nb = r % 120; tr_item(win + (size_t)layer * D * INW, D, INW, (bf16*)(ws + WS_WIN), kb * 64, nb * 32, nb * 32, scr, lane); continue; }
        r -= I_IN;
        { const int kb = r / 32, nb = r % 32; tr_item(wout + (size_t)layer * D * D, D, D, (bf16*)(ws + WS_WOUT), kb * 64, nb * 32, nb * 32, scr, lane); }
    }
}
__device__ __forceinline__ void ph_norm(const float* x, const float* nw, const float* modl, int sb, int half, bf16* H) {
    const int tid_ = pg8::otid(), lane = tid_ & 63, wave = tid_ >> 6;
    const int gw = blockIdx.x * 8 + wave, NGW = gridDim.x * 8;
    for (int r0 = gw * 16; r0 < MH; r0 += NGW * 16) {
        const int batch = half ? 8 + (r0 >> 13) : (r0 >> 12);
        const float* mp = modl + (size_t)batch * 9216 + sb * 3072;
        f32x4 A[4], B[4];
#pragma unroll
        for (int j = 0; j < 4; ++j) { const int c = 4 * lane + 256 * j; const f32x4 w = *(const f32x4*)(nw + c), sh = *(const f32x4*)(mp + c), scl = *(const f32x4*)(mp + 1024 + c); A[j] = w * (1.0f + scl); B[j] = sh; }
        for (int r = r0; r < r0 + 16; ++r) {
            const f32x4* xr = (const f32x4*)(x + (size_t)r * D) + lane;
            f32x4 v[4]; float s = 0.f;
#pragma unroll
            for (int j = 0; j < 4; ++j) { v[j] = xr[64 * j]; s += (v[j].x * v[j].x + v[j].y * v[j].y) + (v[j].z * v[j].z + v[j].w * v[j].w); }
            const float rstd = __builtin_amdgcn_rsqf(wave_sum(s) * (1.f / D) + EPS);
            v2u* o8 = (v2u*)(H + (size_t)r * D) + lane;
#pragma unroll
            for (int j = 0; j < 4; ++j) { const f32x4 h = v[j] * rstd * A[j] + B[j]; v2u w; w.x = pk2(h.x, h.y); w.y = pk2(h.z, h.w); o8[64 * j] = w; }
        }
    }
}
__device__ __forceinline__ void ph_final(float* x, const float* nw) {
    const int tid_ = pg8::otid(), lane = tid_ & 63, wave = tid_ >> 6;
    const int gw = blockIdx.x * 8 + wave, NGW = gridDim.x * 8;
    f32x4 A[4];
#pragma unroll
    for (int j = 0; j < 4; ++j) A[j] = *(const f32x4*)(nw + 4 * lane + 256 * j);
    for (int r = gw; r < 2 * MH; r += NGW) {
        f32x4* xr = (f32x4*)(x + (size_t)r * D) + lane;
        f32x4 v[4]; float s = 0.f;
#pragma unroll
        for (int j = 0; j < 4; ++j) { v[j] = xr[64 * j]; s += (v[j].x * v[j].x + v[j].y * v[j].y) + (v[j].z * v[j].z + v[j].w * v[j].w); }
        const float rstd = __builtin_amdgcn_rsqf(wave_sum(s) * (1.f / D) + EPS);
#pragma unroll
        for (int j = 0; j < 4; ++j) xr[64 * j] = v[j] * rstd * A[j];
    }
}
__device__ __forceinline__ void ph_dnpre(const bf16* PD, const float* AB, const float* conv_w, const float* a_log, const float* dt_bias,
                                         bf16* DQ, bf16* DK, bf16* DV, float* GB, int S) {
    const int tid_ = pg8::otid(), lane = tid_ & 63, wave = tid_ >> 6;
    const int gw = blockIdx.x * 8 + wave, NGW = gridDim.x * 8;
    for (int t0 = gw * 16; t0 < MH; t0 += NGW * 16) {
        const int s0 = t0 & (S - 1);
        for (int part = 0; part < 3; ++part) {
            const bf16* src = PD + part * 512 + lane * 8;
            bf16* dst = (part == 0 ? DQ : (part == 1 ? DK : DV)) + lane * 8;
            f32x4 w[5][2];
#pragma unroll
            for (int j = 0; j < 5; ++j) { const float* wp = conv_w + j * 1536 + part * 512 + lane * 8; w[j][0] = *(const f32x4*)wp; w[j][1] = *(const f32x4*)(wp + 4); }
            v4u r0, r1, r2, r3, r4;
            const v4u zero = {0u, 0u, 0u, 0u};
#define ROWLD(off) (((unsigned)(s0 + (off)) < (unsigned)S) ? *(const v4u*)(src + (size_t)(t0 + (off)) * 1536) : zero)
            r0 = ROWLD(-2); r1 = ROWLD(-1); r2 = ROWLD(0); r3 = ROWLD(1);
            for (int i = 0; i < 16; ++i) {
                r4 = ROWLD(i + 2);
                f32x4 y0, y1;
#define TAP(rr, j, first) { const f32x4 a = {bflo(rr.x), bfhi(rr.x), bflo(rr.y), bfhi(rr.y)}, b = {bflo(rr.z), bfhi(rr.z), bflo(rr.w), bfhi(rr.w)}; \
                    if (first) { y0 = a * w[j][0]; y1 = b * w[j][1]; } else { y0 += a * w[j][0]; y1 += b * w[j][1]; } }
                TAP(r0, 0, true) TAP(r1, 1, false) TAP(r2, 2, false) TAP(r3, 3, false) TAP(r4, 4, false)
#undef TAP
#pragma unroll
                for (int e = 0; e < 4; ++e) { y0[e] = silu(y0[e]); y1[e] = silu(y1[e]); }
                if (part < 2) {
                    float ss = (y0.x * y0.x + y0.y * y0.y) + (y0.z * y0.z + y0.w * y0.w) + (y1.x * y1.x + y1.y * y1.y) + (y1.z * y1.z + y1.w * y1.w);
                    ss += __shfl_xor(ss, 1); ss += __shfl_xor(ss, 2); ss += __shfl_xor(ss, 4); ss += __shfl_xor(ss, 8);
                    const float scl = __builtin_amdgcn_rsqf(ss + EPS) * (part == 0 ? 0.08838834764831845f : 1.0f);
                    y0 *= scl; y1 *= scl;
                }
                v4u o; o.x = pk2(y0.x, y0.y); o.y = pk2(y0.z, y0.w); o.z = pk2(y1.x, y1.y); o.w = pk2(y1.z, y1.w);
                *(v4u*)(dst + (size_t)(t0 + i) * 512) = o;
                r0 = r1; r1 = r2; r2 = r3; r3 = r4;
            }
#undef ROWLD
        }
#pragma unroll
        for (int jj = 0; jj < 4; ++jj) { const int idx = lane + 64 * jj, tok = t0 + (idx >> 4), c = idx & 15; const float v = AB[(size_t)tok * 16 + c];
            float res;
            if (c < 8) { const float xx = v + dt_bias[c]; const float sp = fmaxf(xx, 0.f) + __logf(1.0f + __expf(-fabsf(xx))); res = -__expf(a_log[c]) * sp; }
            else res = __builtin_amdgcn_rcpf(1.0f + __expf(-v));
            GB[(size_t)tok * 16 + c] = res; }
    }
}
__device__ __forceinline__ void ph_attn(const bf16* P, bf16* OG, float* LSE, int S, int lgS, LAS unsigned char* lds, unsigned* ctr) {
    const int tid = pg8::otid(), lane = tid & 63, wave = tid >> 6, l15 = lane & 15, g = lane >> 4;
    const float one = opaque_one();
    LAS unsigned char* KL = lds; LAS unsigned char* VT = lds + 46080;
    v4u kvr[5], vvr[5];
#define AT_DECODE(u_) const int tb = (u_) & 255, h = ((u_) >> 8) & 7, p = (u_) >> 11; const int lgd = 2 * p, L = S >> lgd, nb = L >> 7, bps = S >> 7; \
        const int seq = tb >> (lgS - 7), lb = tb & (bps - 1); const int r = lb / nb, ib = lb - r * nb, i0 = ib << 7; const int seqbase = seq << lgS;
#define AT_LOAD(u_) do { AT_DECODE(u_) _Pragma("unroll") for (int j = 0; j < 5; ++j) { const int idx = tid + 512 * j; const int kl = idx >> 3, pc = idx & 7, ik = i0 - 64 + kl; \
            kvr[j] = (v4u){0u, 0u, 0u, 0u}; vvr[j] = kvr[j]; \
            if (idx < 288 * 8 && ik >= 0 && ik < L) { const bf16* src = P + (size_t)(seqbase + (ik << lgd) + r) * 1536 + h * 64 + pc * 8; kvr[j] = *(const v4u*)(src + 512); vvr[j] = *(const v4u*)(src + 1024); } } } while (0)
    constexpr int NU = 3 * 8 * 256;
    volatile LAS unsigned* uw = (volatile LAS unsigned*)(lds + LDS_BYTES - 192);
    unsigned tk = 0u; int u, un;
    if (ctr) { if (tid == 0) uw[0] = atomicAdd(ctr, 1u); __syncthreads(); u = __builtin_amdgcn_readfirstlane((int)uw[0]); if (tid == 0) tk = atomicAdd(ctr, 1u); }
    else u = (int)blockIdx.x;
    if (u < NU) AT_LOAD(u);
    while (u < NU) {
        AT_DECODE(u)
        __syncthreads();
#pragma unroll
        for (int j = 0; j < 5; ++j) { const int idx = tid + 512 * j; const int kl = idx >> 3, pc = idx & 7;
            const int k5 = kl & 31, klp = (kl & ~31) + ((k5 & 16) ? (8 * ((k5 - 16) >> 2) + 4 + (k5 & 3)) : (8 * (k5 >> 2) + (k5 & 3)));
            if (idx < 288 * 8) { *(LAS v4u*)(KL + kl * 160 + pc * 16) = kvr[j];
#pragma unroll
                for (int e = 0; e < 8; ++e) { const unsigned wv = vvr[j][e >> 1]; *(LAS unsigned short*)(VT + (pc * 8 + e) * 608 + klp * 2) = (unsigned short)((e & 1) ? (wv >> 16) : (wv & 0xffffu)); } } }
        if (ctr && tid == 0) uw[0] = tk;
        __syncthreads();
        if (ctr) { un = __builtin_amdgcn_readfirstlane((int)uw[0]); if (tid == 0) tk = atomicAdd(ctr, 1u); } else un = u + (int)gridDim.x;
        if (un < NU) AT_LOAD(un);
        const int iq = i0 + 16 * wave + l15, tokq = seqbase + (iq << lgd) + r;
        bf16x8 qf[2];
#pragma unroll
        for (int ks = 0; ks < 2; ++ks) qf[ks] = *(const bf16x8*)(P + (size_t)tokq * 1536 + h * 64 + 32 * ks + 8 * g);
        f32x4 acc[4];
#pragma unroll
        for (int dt = 0; dt < 4; ++dt) acc[dt] = (f32x4){0.f, 0.f, 0.f, 0.f};
        float m = -1e30f, lsum = 0.f;
        for (int s = 0; s < 5; ++s) {
            const int kl0 = 32 * (wave >> 1) + 32 * s;
            bf16x8 ka[2][2], vfr[4];
#pragma unroll
            for (int t = 0; t < 2; ++t)
#pragma unroll
                for (int ks = 0; ks < 2; ++ks) ka[t][ks] = *(const LAS bf16x8*)(KL + (kl0 + 16 * t + l15) * 160 + (32 * ks + 8 * g) * 2);
#pragma unroll
            for (int dt = 0; dt < 4; ++dt) vfr[dt] = *(const LAS bf16x8*)(VT + (16 * dt + l15) * 608 + kl0 * 2 + 16 * g);
            __builtin_amdgcn_sched_barrier(0);
            f32x4 c[2];
#pragma unroll
            for (int t = 0; t < 2; ++t) { c[t] = (f32x4){0.f, 0.f, 0.f, 0.f};
#pragma unroll
                for (int ks = 0; ks < 2; ++ks) c[t] = MFMA16(ka[t][ks], qf[ks], c[t]); }
            float sc[8]; float mx = -1e30f;
#pragma unroll
            for (int t = 0; t < 2; ++t)
#pragma unroll
                for (int rg = 0; rg < 4; ++rg) { const int ik = i0 - 64 + kl0 + 16 * t + 4 * g + rg, dl = ik - iq;
                    const bool valid = (ik >= 0) && (ik < L) && (dl <= 64) && (dl >= -64);
                    const float sv = valid ? c[t][rg] * 0.18033688011112042f : -1e30f; sc[t * 4 + rg] = sv; mx = fmaxf(mx, sv); }
            mx = xmax32(xmax16(mx));
            const float mn = fmaxf(m, mx), alpha = __builtin_amdgcn_exp2f(m - mn); m = mn;
            float ps = 0.f; f32x4 p0, p1;
#pragma unroll
            for (int e = 0; e < 4; ++e) { p0[e] = __builtin_amdgcn_exp2f(sc[e] - mn); p1[e] = __builtin_amdgcn_exp2f(sc[4 + e] - mn); ps += p0[e] + p1[e]; }
            lsum = lsum * alpha + ps;
            const bf16x8 pf = pack8(p0 * one, p1 * one);
#pragma unroll
            for (int dt = 0; dt < 4; ++dt) { acc[dt] *= alpha;
                acc[dt] = MFMA16(vfr[dt], pf, acc[dt]); }
        }
        lsum = xsum32(xsum16(lsum));
        const float inv = 1.0f / lsum;
        bf16* og = OG + ((size_t)p * MH + tokq) * 512 + h * 64 + 4 * g;
#pragma unroll
        for (int dt = 0; dt < 4; ++dt) { v2u w; w.x = pk2(acc[dt][0] * inv, acc[dt][1] * inv); w.y = pk2(acc[dt][2] * inv, acc[dt][3] * inv); *(v2u*)(og + 16 * dt) = w; }
        if (g == 0) LSE[((size_t)p * MH + tokq) * 8 + h] = (m + __log2f(lsum)) * 0.6931471805599453f;
        u = un;
    }
#undef AT_LOAD
#undef AT_DECODE
}
__device__ __forceinline__ void ph_chunk(const bf16* DQ, const bf16* DK, const bf16* DV, const float* GB, unsigned char* CH, float* GC, int S, int lgS, LAS unsigned char* lds) {
    const int tid_ = pg8::otid(), lane = tid_ & 63, wave = tid_ >> 6, l15 = lane & 15, g = lane >> 4;
    const float one = opaque_one();
    LAS unsigned char* wl = lds + wave * 18432;
    LAS float* Al = (LAS float*)wl; LAS float* gcs = (LAS float*)(wl + 17408); LAS float* bts = gcs + 64;
    LAS bf16* TP = (LAS bf16*)wl; LAS bf16* TPP = (LAS bf16*)(wl + 8192);
    for (int job = blockIdx.x * 8 + wave; job < 4096; job += gridDim.x * 8) {
        const int dir = job & 1, h = (job >> 1) & 3, cgi = job >> 3, cps = S >> 6;
        const int seq = cgi >> (lgS - 6), n = cgi & (cps - 1), seqbase = seq << lgS;
#define TOK(c) (seqbase + (dir ? (S - 1 - (64 * n + (c))) : (64 * n + (c))))
        {   const int tokc = TOK(lane);
            const float gv = GB[(size_t)tokc * 16 + dir * 4 + h], bv = GB[(size_t)tokc * 16 + 8 + dir * 4 + h];
            float cs = gv;
#pragma unroll
            for (int o = 1; o < 64; o <<= 1) { const float t = __shfl_up(cs, o); if (lane >= o) cs += t; }
            gcs[lane] = cs; bts[lane] = bv; GC[(size_t)job * 64 + lane] = cs; }
        LDS_WAIT();
        bf16x8 kf[4][4];
#pragma unroll
        for (int t = 0; t < 4; ++t)
#pragma unroll
            for (int ks = 0; ks < 4; ++ks) kf[t][ks] = *(const bf16x8*)(DK + (size_t)TOK(16 * t + l15) * 512 + h * 128 + 32 * ks + 8 * g);
#pragma unroll
        for (int it = 0; it < 4; ++it) { const int i = 16 * it + l15; const float gi = gcs[i], bi = bts[i];
#pragma unroll
            for (int jt = 0; jt <= it; ++jt) { f32x4 c = {0.f, 0.f, 0.f, 0.f};
#pragma unroll
                for (int ks = 0; ks < 4; ++ks) c = MFMA16(kf[jt][ks], kf[it][ks], c);
                const f32x4 gj = *(const LAS f32x4*)(gcs + 16 * jt + 4 * g); f32x4 o;
#pragma unroll
                for (int rg = 0; rg < 4; ++rg) { const int j = 16 * jt + 4 * g + rg; o[rg] = (j < i) ? bi * c[rg] * __expf(gi - gj[rg]) : 0.f; }
                *(LAS f32x4*)(Al + i * 68 + 16 * jt + 4 * g) = o; } }
        unsigned char* chb = CH + (size_t)job * CHJOB;
        bf16* UT = (bf16*)chb; bf16* Wm = (bf16*)(chb + 16384); bf16* KT = (bf16*)(chb + 32768); bf16* QK = (bf16*)(chb + 49152);
#pragma unroll
        for (int it = 0; it < 4; ++it) { const int i = 16 * it + l15; const float gi = gcs[i];
            bf16x8 qfr[4];
#pragma unroll
            for (int ks = 0; ks < 4; ++ks) qfr[ks] = *(const bf16x8*)(DQ + (size_t)TOK(i) * 512 + h * 128 + 32 * ks + 8 * g);
#pragma unroll
            for (int jt = 0; jt < 4; ++jt) { v2u out = {0u, 0u};
                if (jt <= it) { f32x4 c = {0.f, 0.f, 0.f, 0.f};
#pragma unroll
                    for (int ks = 0; ks < 4; ++ks) c = MFMA16(kf[jt][ks], qfr[ks], c);
                    const f32x4 gj = *(const LAS f32x4*)(gcs + 16 * jt + 4 * g); f32x4 o;
#pragma unroll
                    for (int rg = 0; rg < 4; ++rg) { const int j = 16 * jt + 4 * g + rg; o[rg] = (j <= i) ? c[rg] * __expf(gi - gj[rg]) : 0.f; }
                    out.x = pk2(o[0], o[1]); out.y = pk2(o[2], o[3]); }
                *(v2u*)(QK + i * 64 + 16 * jt + 4 * g) = out; } }
        LDS_WAIT();
        float t[64];
#pragma unroll
        for (int i = 0; i < 64; ++i) { float a0 = 0.f, a1 = 0.f, a2 = 0.f, a3 = 0.f;
#pragma unroll
            for (int j4 = 0; j4 * 4 < i; ++j4) { const f32x4 a = *(const LAS f32x4*)(Al + i * 68 + 4 * j4);
                if (4 * j4 + 0 < i) a0 += a[0] * t[4 * j4 + 0];
                if (4 * j4 + 1 < i) a1 += a[1] * t[4 * j4 + 1];
                if (4 * j4 + 2 < i) a2 += a[2] * t[4 * j4 + 2];
                if (4 * j4 + 3 < i) a3 += a[3] * t[4 * j4 + 3]; }
            t[i] = ((lane == i) ? 1.f : 0.f) - ((a0 + a1) + (a2 + a3)); }
        const float bc = bts[lane], ec = bc * __expf(gcs[lane]);
        LDS_WAIT();
#pragma unroll
        for (int i = 0; i < 64; ++i) { const unsigned w = pk2(t[i] * bc, t[i] * ec); TP[i * 64 + lane] = (bf16)(w & 0xffffu); TPP[i * 64 + lane] = (bf16)(w >> 16); }
        LDS_WAIT();
        bf16x8 tf[4][2];
#pragma unroll
        for (int mt = 0; mt < 4; ++mt)
#pragma unroll
            for (int ks = 0; ks < 2; ++ks) tf[mt][ks] = *(const LAS bf16x8*)(TP + (16 * mt + l15) * 64 + 32 * ks + 8 * g);
        for (int nt = 0; nt < 8; ++nt) {
            bf16x8 vf[2];
#pragma unroll
            for (int ks = 0; ks < 2; ++ks)
#pragma unroll
                for (int e = 0; e < 8; ++e) vf[ks][e] = (short)DV[(size_t)TOK(32 * ks + 8 * g + e) * 512 + h * 128 + 16 * nt + l15];
#pragma unroll
            for (int mt = 0; mt < 4; ++mt) { f32x4 c = {0.f, 0.f, 0.f, 0.f};
#pragma unroll
                for (int ks = 0; ks < 2; ++ks) c = MFMA16(tf[mt][ks], vf[ks], c);
                c *= one;
                v2u w; w.x = pk2(c[0], c[1]); w.y = pk2(c[2], c[3]); *(v2u*)(UT + (16 * nt + l15) * 64 + 16 * mt + 4 * g) = w; }
        }
#pragma unroll
        for (int mt = 0; mt < 4; ++mt)
#pragma unroll
            for (int ks = 0; ks < 2; ++ks) tf[mt][ks] = *(const LAS bf16x8*)(TPP + (16 * mt + l15) * 64 + 32 * ks + 8 * g);
        for (int dt = 0; dt < 8; ++dt) {
            bf16x8 kt[2];
#pragma unroll
            for (int ks = 0; ks < 2; ++ks) {
#pragma unroll
                for (int e = 0; e < 8; ++e) kt[ks][e] = (short)DK[(size_t)TOK(32 * ks + 8 * g + e) * 512 + h * 128 + 16 * dt + l15];
                *(bf16x8*)(KT + (16 * dt + l15) * 64 + 32 * ks + 8 * g) = kt[ks]; }
#pragma unroll
            for (int mt = 0; mt < 4; ++mt) { f32x4 c = {0.f, 0.f, 0.f, 0.f};
#pragma unroll
                for (int ks = 0; ks < 2; ++ks) c = MFMA16(kt[ks], tf[mt][ks], c);
                c *= one;
                v2u w; w.x = pk2(c[0], c[1]); w.y = pk2(c[2], c[3]); *(v2u*)(Wm + (16 * mt + l15) * 128 + 16 * dt + 4 * g) = w; }
        }
        LDS_WAIT();
    }
}
#define TOKN(c, nn) (seqbase + (dir ? (S - 1 - (64 * (nn) + (c))) : (64 * (nn) + (c))))
constexpr int SC_PW = 288, SC_PK = 160;
constexpr int SC_W = 0, SC_Q = 64 * SC_PW, SC_QK = 2 * 64 * SC_PW, SC_KT = SC_QK + 64 * SC_PK, SC_GC = SC_KT + 128 * SC_PK, SC_BUF = SC_GC + 256;
static_assert(2 * SC_BUF + 4 * 5120 <= LDS_BYTES - 256, "scan LDS image");
__device__ __forceinline__ void ph_scan(const bf16* DQ, const unsigned char* CH, const float* GC, bf16* OF, bf16* OB, int S, int lgS, int half, LAS unsigned char* lds) {
    const int wave = __builtin_amdgcn_readfirstlane(pg8::otid() >> 6);
    const float one = opaque_one();
#define SC_BAR() do { asm volatile("s_waitcnt lgkmcnt(0)" ::: "memory"); __builtin_amdgcn_s_barrier(); asm volatile("" ::: "memory"); } while (0)
    const int nchain = half ? 32 : 64, cps = S >> 6;
    for (int ub = blockIdx.x; ub < 2 * nchain; ub += gridDim.x) {
        const int chain = (ub & 7) + 8 * (ub >> 4), part = (ub >> 3) & 1;
        const int dir = chain & 1, h = (chain >> 1) & 3, seq = chain >> 3, seqbase = seq << lgS;
        __syncthreads();
        if (wave >= 4) {
            __builtin_amdgcn_s_setprio(3);
            const int lt = pg8::otid() - 256;
            const int wr0 = lt >> 4, wc = lt & 15, kr0 = lt >> 3, kc = lt & 7;
            const int woff = (wc >> 2) * 64 + (wc & 1) * 32 + ((wc >> 1) & 1) * 8, koff = (kc >> 2) * 64 + (kc & 1) * 32 + ((kc >> 1) & 1) * 8;
            v4u rwA[4], rqA[4], rkA[2], rtA[4], rwB[4], rqB[4], rkB[2], rtB[4]; f32x4 rgA = {0.f, 0.f, 0.f, 0.f}, rgB = rgA;
#define SC_LD(rw, rq, rk, rt, rg, n_) do { const int nn_ = (n_); const int job = ((seq * cps + nn_) << 3) | (h << 1) | dir; const unsigned char* chb = CH + (size_t)job * CHJOB; \
                const bf16* Wm_ = (const bf16*)(chb + 16384); const bf16* KT_ = (const bf16*)(chb + 32768); const bf16* QK_ = (const bf16*)(chb + 49152); \
                _Pragma("unroll") for (int k = 0; k < 4; ++k) { rw[k] = *(const v4u*)(Wm_ + (wr0 + 16 * k) * 128 + wc * 8); rq[k] = *(const v4u*)(DQ + (size_t)TOKN(wr0 + 16 * k, nn_) * 512 + h * 128 + wc * 8); rt[k] = *(const v4u*)(KT_ + (kr0 + 32 * k) * 64 + kc * 8); } \
                _Pragma("unroll") for (int k = 0; k < 2; ++k) rk[k] = *(const v4u*)(QK_ + (kr0 + 32 * k) * 64 + kc * 8); \
                if (lt < 16) rg = *(const f32x4*)(GC + (size_t)job * 64 + 4 * lt); } while (0)
#define SC_ST8(dst_, v_) do { LAS unsigned char* d_ = (dst_); *(LAS v2u*)d_ = (v2u){(v_).x, (v_).y}; *(LAS v2u*)(d_ + 16) = (v2u){(v_).z, (v_).w}; } while (0)
#define SC_ST(rw, rq, rk, rt, rg, n_) do { LAS unsigned char* b_ = lds + ((n_) & 1) * SC_BUF; \
                _Pragma("unroll") for (int k = 0; k < 4; ++k) { SC_ST8(b_ + SC_W + (wr0 + 16 * k) * SC_PW + woff, rw[k]); SC_ST8(b_ + SC_Q + (wr0 + 16 * k) * SC_PW + woff, rq[k]); SC_ST8(b_ + SC_KT + (kr0 + 32 * k) * SC_PK + koff, rt[k]); } \
                _Pragma("unroll") for (int k = 0; k < 2; ++k) SC_ST8(b_ + SC_QK + (kr0 + 32 * k) * SC_PK + koff, rk[k]); \
                if (lt < 16) *(LAS f32x4*)(b_ + SC_GC + 16 * lt) = rg; } while (0)
            SC_LD(rwA, rqA, rkA, rtA, rgA, 0);
            for (int n = 0; n < cps; n += 4) {
                SC_LD(rwB, rqB, rkB, rtB, rgB, n + 1); SC_ST(rwA, rqA, rkA, rtA, rgA, n); SC_BAR();
                SC_LD(rwA, rqA, rkA, rtA, rgA, n + 2); SC_ST(rwB, rqB, rkB, rtB, rgB, n + 1); SC_BAR();
                SC_LD(rwB, rqB, rkB, rtB, rgB, n + 3); SC_ST(rwA, rqA, rkA, rtA, rgA, n + 2); SC_BAR();
                if (n + 4 < cps) SC_LD(rwA, rqA, rkA, rtA, rgA, n + 4); SC_ST(rwB, rqB, rkB, rtB, rgB, n + 3); SC_BAR();
            }
#undef SC_LD
#undef SC_ST
#undef SC_ST8
            SC_BAR();
            __builtin_amdgcn_s_setprio(0);
        } else {
            const int tidc = pg8::otid(), lane = tidc & 63, l15 = lane & 15, g = lane >> 4;
            const int dv0 = part * 64 + wave * 16;
            bf16* OX = dir ? OB : OF;
            f32x4 St[8];
#pragma unroll
            for (int t = 0; t < 8; ++t) St[t] = (f32x4){0.f, 0.f, 0.f, 0.f};
            v2u utA[4], utN[4];
#define SC_UT(UT__, n_) do { const int jb_ = ((seq * cps + (n_)) << 3) | (h << 1) | dir; const bf16* UT_ = (const bf16*)(CH + (size_t)jb_ * CHJOB); \
                _Pragma("unroll") for (int mt = 0; mt < 4; ++mt) UT__[mt] = *(const v2u*)(UT_ + (dv0 + l15) * 64 + 16 * mt + 4 * g); } while (0)
            SC_UT(utA, 0);
            SC_BAR();
#define SC_FRAG(p_) (*(const LAS bf16x8*)(p_))
            for (int n = 0; n < cps; ++n) {
                const LAS unsigned char* buf = lds + (n & 1) * SC_BUF;
                const LAS float* gcl = (const LAS float*)(buf + SC_GC);
                if (n + 1 < cps) SC_UT(utN, n + 1);
                const float glast = gcl[63];
                bf16x8 sb[4];
#pragma unroll
                for (int ks = 0; ks < 4; ++ks) sb[ks] = pack8cv(St[2 * ks], St[2 * ks + 1]);
                f32x4 vnew[4];
#pragma unroll
                for (int mp = 0; mp < 2; ++mp) { bf16x8 wf[2][4];
#pragma unroll
                    for (int mm = 0; mm < 2; ++mm) { const LAS unsigned char* wrow = buf + SC_W + (16 * (2 * mp + mm) + l15) * SC_PW + 16 * g;
#pragma unroll
                        for (int ks = 0; ks < 4; ++ks) wf[mm][ks] = SC_FRAG(wrow + 64 * ks); }
                    __builtin_amdgcn_sched_barrier(0);
                    f32x4 ws0 = {0.f, 0.f, 0.f, 0.f}, ws1 = ws0;
#pragma unroll
                    for (int ks = 0; ks < 4; ++ks) { ws0 = MFMA16(wf[0][ks], sb[ks], ws0); ws1 = MFMA16(wf[1][ks], sb[ks], ws1); }
                    vnew[2 * mp] = (f32x4){bflo(utA[2 * mp].x), bfhi(utA[2 * mp].x), bflo(utA[2 * mp].y), bfhi(utA[2 * mp].y)} - ws0;
                    vnew[2 * mp + 1] = (f32x4){bflo(utA[2 * mp + 1].x), bfhi(utA[2 * mp + 1].x), bflo(utA[2 * mp + 1].y), bfhi(utA[2 * mp + 1].y)} - ws1;
                    __builtin_amdgcn_sched_barrier(0);
                }
                bf16x8 vb[2], vbs[2];
#pragma unroll
                for (int k2 = 0; k2 < 2; ++k2) vb[k2] = pack8(vnew[2 * k2], vnew[2 * k2 + 1]);
#pragma unroll
                for (int mp = 0; mp < 2; ++mp) { bf16x8 qf[2][4], kf2[2][2]; float egi[2];
#pragma unroll
                    for (int mm = 0; mm < 2; ++mm) { const int mt = 2 * mp + mm; const LAS unsigned char* qrow = buf + SC_Q + (16 * mt + l15) * SC_PW + 16 * g; const LAS unsigned char* qkrow = buf + SC_QK + (16 * mt + l15) * SC_PK + 16 * g;
#pragma unroll
                        for (int ks = 0; ks < 4; ++ks) qf[mm][ks] = SC_FRAG(qrow + 64 * ks);
#pragma unroll
                        for (int k2 = 0; k2 < 2; ++k2) kf2[mm][k2] = SC_FRAG(qkrow + 64 * k2);
                        egi[mm] = __expf(gcl[16 * mt + l15]); }
                    __builtin_amdgcn_sched_barrier(0);
                    f32x4 o0 = {0.f, 0.f, 0.f, 0.f}, o1 = o0;
#pragma unroll
                    for (int ks = 0; ks < 4; ++ks) { o0 = MFMA16(sb[ks], qf[0][ks], o0); o1 = MFMA16(sb[ks], qf[1][ks], o1); }
                    o0 *= egi[0]; o1 *= egi[1];
#pragma unroll
                    for (int k2 = 0; k2 < 2; ++k2) { o0 = MFMA16(vb[k2], kf2[0][k2], o0); o1 = MFMA16(vb[k2], kf2[1][k2], o1); }
                    o0 *= one; o1 *= one;
                    v2u w0, w1; w0.x = pk2(o0[0], o0[1]); w0.y = pk2(o0[2], o0[3]); w1.x = pk2(o1[0], o1[1]); w1.y = pk2(o1[2], o1[3]);
                    *(v2u*)(OX + (size_t)TOKN(16 * (2 * mp) + l15, n) * 512 + h * 128 + dv0 + 4 * g) = w0;
                    *(v2u*)(OX + (size_t)TOKN(16 * (2 * mp + 1) + l15, n) * 512 + h * 128 + dv0 + 4 * g) = w1;
                    __builtin_amdgcn_sched_barrier(0); }
                const float eg = __expf(glast);
#pragma unroll
                for (int mt = 0; mt < 4; ++mt) { const f32x4 gv = *(const LAS f32x4*)(gcl + 16 * mt + 4 * g);
#pragma unroll
                    for (int rg = 0; rg < 4; ++rg) vnew[mt][rg] *= __expf(glast - gv[rg]); }
#pragma unroll
                for (int k2 = 0; k2 < 2; ++k2) vbs[k2] = pack8(vnew[2 * k2], vnew[2 * k2 + 1]);
#pragma unroll
                for (int tp = 0; tp < 2; ++tp) { bf16x8 kt4[4][2];
#pragma unroll
                    for (int tt = 0; tt < 4; ++tt) { const LAS unsigned char* ktrow = buf + SC_KT + (16 * (4 * tp + tt) + l15) * SC_PK + 16 * g; kt4[tt][0] = SC_FRAG(ktrow); kt4[tt][1] = SC_FRAG(ktrow + 64); }
                    __builtin_amdgcn_sched_barrier(0);
#pragma unroll
                    for (int tt = 0; tt < 4; ++tt) St[4 * tp + tt] *= eg;
#pragma unroll
                    for (int k2 = 0; k2 < 2; ++k2)
#pragma unroll
                        for (int tt = 0; tt < 4; ++tt) St[4 * tp + tt] = MFMA16(kt4[tt][k2], vbs[k2], St[4 * tp + tt]);
                    __builtin_amdgcn_sched_barrier(0); }
#pragma unroll
                for (int mt = 0; mt < 4; ++mt) utA[mt] = utN[mt];
                SC_BAR();
            }
#undef SC_FRAG
#undef SC_UT
        }
    }
#undef SC_BAR
#undef TOKN
#undef TOK
}
__device__ __forceinline__ void ph_post(const bf16* OG, const float* LSE, const bf16* OF, const bf16* OB, const bf16* Z, const float* dn_norm, bf16* MIX) {
    const int tid_ = pg8::otid(), lane = tid_ & 63, wave = tid_ >> 6;
    const int gw = blockIdx.x * 8 + wave, NGW = gridDim.x * 8;
    f32x4 nw0 = *(const f32x4*)(dn_norm + (lane & 15) * 8), nw1 = *(const f32x4*)(dn_norm + (lane & 15) * 8 + 4);
    for (int t = gw; t < MH; t += NGW) {
        {   const int hd = lane >> 3;
            const float l0 = LSE[((size_t)0 * MH + t) * 8 + hd], l1 = LSE[((size_t)1 * MH + t) * 8 + hd], l2 = LSE[((size_t)2 * MH + t) * 8 + hd];
            const float mx = fmaxf(l0, fmaxf(l1, l2));
            float w0 = __expf(l0 - mx), w1 = __expf(l1 - mx), w2 = __expf(l2 - mx); const float inv = 1.0f / (w0 + w1 + w2); w0 *= inv; w1 *= inv; w2 *= inv;
            const v4u a = *(const v4u*)(OG + ((size_t)0 * MH + t) * 512 + lane * 8), b = *(const v4u*)(OG + ((size_t)1 * MH + t) * 512 + lane * 8), c = *(const v4u*)(OG + ((size_t)2 * MH + t) * 512 + lane * 8);
            v4u o;
#pragma unroll
            for (int e = 0; e < 4; ++e) o[e] = pk2(w0 * bflo(a[e]) + w1 * bflo(b[e]) + w2 * bflo(c[e]), w0 * bfhi(a[e]) + w1 * bfhi(b[e]) + w2 * bfhi(c[e]));
            *(v4u*)(MIX + (size_t)t * 1024 + lane * 8) = o; }
        {   const v4u a = *(const v4u*)(OF + (size_t)t * 512 + lane * 8), b = *(const v4u*)(OB + (size_t)t * 512 + lane * 8), z = *(const v4u*)(Z + (size_t)t * 512 + lane * 8);
            float ov[8]; float ss = 0.f;
#pragma unroll
            for (int e = 0; e < 4; ++e) { ov[2 * e] = bflo(a[e]) + bflo(b[e]); ov[2 * e + 1] = bfhi(a[e]) + bfhi(b[e]); ss += ov[2 * e] * ov[2 * e] + ov[2 * e + 1] * ov[2 * e + 1]; }
            ss += __shfl_xor(ss, 1); ss += __shfl_xor(ss, 2); ss += __shfl_xor(ss, 4); ss += __shfl_xor(ss, 8);
            const float rs = __builtin_amdgcn_rsqf(ss * (1.0f / 128.0f) + EPS);
            v4u o;
#pragma unroll
            for (int e = 0; e < 4; ++e) { const float n0 = (e < 2) ? nw0[2 * e] : nw1[2 * e - 4], n1 = (e < 2) ? nw0[2 * e + 1] : nw1[2 * e - 3];
                o[e] = pk2(ov[2 * e] * rs * n0 * silu(bflo(z[e])), ov[2 * e + 1] * rs * n1 * silu(bfhi(z[e]))); }
            *(v4u*)(MIX + (size_t)t * 1024 + 512 + lane * 8) = o; }
    }
}
#define XB_TMO      128
#define XB_XCNT(j)  (256  + 64 * (j))
#define XB_XSUB(j)  (1280 + 64 * (j))
#define XB_XGEN(j)  (2304 + 64 * (j))
#define XB_TOP      3328
#define XB_TOPGEN   3392
#define XCD_BAR_WORDS 3456
#define XB_SPIN_CAP (1u << 18)

__device__ __forceinline__ unsigned xb_ld(unsigned* p)              { return __hip_atomic_load(p, __ATOMIC_RELAXED, __HIP_MEMORY_SCOPE_AGENT); }
__device__ __forceinline__ unsigned xb_add(unsigned* p, unsigned v) { return __hip_atomic_fetch_add(p, v, __ATOMIC_RELAXED, __HIP_MEMORY_SCOPE_AGENT); }
__device__ __forceinline__ unsigned xb_xcc_id() { return (unsigned)__builtin_amdgcn_s_getreg((3 << 11) | 20) & 0xFu; }
#define XB_SPIN(cond, bar) do { unsigned _sp = 0; while (cond) { __builtin_amdgcn_s_sleep(1); \
    if ((++_sp & 255u) == 0u) { if (xb_ld(&(bar)[XB_TMO])) break; if (_sp > XB_SPIN_CAP) { atomicAdd(&(bar)[XB_TMO], 1u); break; } } } } while (0)

struct XcdBarrier {
    unsigned* bar; unsigned x;
    volatile LAS unsigned* st;
};

__device__ __forceinline__ XcdBarrier xcd_barrier_post(unsigned* bar, volatile LAS unsigned* st) {
    XcdBarrier b; b.bar = bar; b.x = xb_xcc_id(); b.st = st;
    if (threadIdx.x == 0) (void)xb_add(&bar[XB_XCNT(b.x)], 1u);
    return b;
}
__device__ __forceinline__ void xcd_barrier_complete(unsigned* bar, unsigned x, unsigned& nloc, unsigned& nx) {
    const unsigned G = gridDim.x * gridDim.y * gridDim.z;
    unsigned sum, cnt, mine, sp = 0u;
    for (;;) {
        sum = 0u; cnt = 0u; mine = 0u;
#pragma unroll
        for (unsigned j = 0; j < 16; ++j) { const unsigned c = xb_ld(&bar[XB_XCNT(j)]); sum += c; cnt += (c > 0u) ? 1u : 0u; mine = (j == x) ? c : mine; }
        if (sum == G) break;
        __builtin_amdgcn_s_sleep(1);
        if ((++sp & 255u) == 0u) { if (xb_ld(&bar[XB_TMO])) break; if (sp > XB_SPIN_CAP) { atomicAdd(&bar[XB_TMO], 1u); break; } }
    }
    nloc = mine > 0u ? mine : 1u; nx = cnt > 0u ? cnt : 1u;
}

__device__ __forceinline__ void xcd_barrier(const XcdBarrier& b) {
    asm volatile("s_waitcnt vmcnt(0)" ::: "memory");
    __syncthreads();
    if (threadIdx.x == 0) {
        unsigned* bar = b.bar;
        __builtin_amdgcn_s_waitcnt(0);
        unsigned nloc = b.st[0], nx = b.st[1];
        if (nloc == 0u) { xcd_barrier_complete(bar, b.x, nloc, nx); b.st[0] = nloc; b.st[1] = nx; }
        const unsigned old = xb_add(&bar[XB_XSUB(b.x)], 1u);
        const unsigned gen = old / nloc;
        if (old + 1u == (gen + 1u) * nloc) {
            __builtin_amdgcn_fence(__ATOMIC_RELEASE, "agent");
            asm volatile("s_waitcnt vmcnt(0)" ::: "memory");
            const unsigned og = xb_add(&bar[XB_TOP], 1u);
            const unsigned tg = og / nx;
            if (og + 1u == (tg + 1u) * nx) xb_add(&bar[XB_TOPGEN], 1u);
            else XB_SPIN(xb_ld(&bar[XB_TOPGEN]) == tg, bar);
            __builtin_amdgcn_fence(__ATOMIC_ACQUIRE, "agent");
            xb_add(&bar[XB_XGEN(b.x)], 1u);
            asm volatile("s_waitcnt vmcnt(0)" ::: "memory");
        } else {
            XB_SPIN(xb_ld(&bar[XB_XGEN(b.x)]) == gen, bar);
            __builtin_amdgcn_fence(__ATOMIC_ACQUIRE, "agent");
            asm volatile("s_waitcnt vmcnt(0)" ::: "memory");
        }
    }
    __syncthreads();
}

#ifndef DBG_SKIP_MIXER
#define DBG_SKIP_MIXER 0
#endif
#ifndef MK_MULTI
#define MK_MULTI 0
#endif
constexpr int NPH = 1 + 2 * (2 * 14) + 1 + 1;
static_assert(pg8::EpiProj::OFF_PA == WS_PA && pg8::EpiProj::OFF_PD == WS_PD && pg8::EpiProj::OFF_Z == WS_Z, "EpiProj offsets");
struct Args { const float* in[22]; float* out; unsigned char* ws; int lo, hi; int big, pad; };

__global__ void __launch_bounds__(512, 2) fwd(Args a) {
    extern __shared__ __attribute__((aligned(16))) unsigned char lds_raw[];
    LAS unsigned char* lds = (LAS unsigned char*)lds_raw;
    cg::grid_group grid = cg::this_grid();
    unsigned char* ws = a.ws;
    const int lo = a.lo, hi = a.hi; int pc = 0;
    const bool big = a.big != 0;
    bf16* OGp = (bf16*)(ws + (big ? WS_OG2 : WS_OG)); float* LSEp = (float*)(ws + (big ? WS_LSE2 : WS_LSE));
    const float* x_prompt = a.in[0]; const float* x_sample = a.in[1];
    float* MOD = (float*)(ws + WS_MOD); float* ROPE = (float*)(ws + WS_ROPE);
    bf16* H = (bf16*)(ws + WS_H); bf16* ACT = (bf16*)(ws + WS_ACT); bf16* PA = (bf16*)(ws + WS_PA); bf16* PD = (bf16*)(ws + WS_PD); bf16* Zb = (bf16*)(ws + WS_Z);
    bf16* DQ = (bf16*)(ws + WS_DQ); bf16* DK = (bf16*)(ws + WS_DK); bf16* DV = (bf16*)(ws + WS_DV); bf16* OF = (bf16*)(ws + WS_OF); bf16* OB = (bf16*)(ws + WS_OB);
    unsigned char* CH = ws + WS_CH; bf16* OG = (bf16*)(ws + WS_OG); float* LSE = (float*)(ws + WS_LSE); bf16* MIX = (bf16*)(ws + WS_MIX);
    float* AB = (float*)(ws + WS_AB); float* GB = (float*)(ws + WS_GB); float* GC = (float*)(ws + WS_GC);
#define PH_BEGIN if (pc >= lo && pc < hi) {
    { volatile LAS unsigned* st = (volatile LAS unsigned*)(lds + LDS_BYTES - 256); if (pg8::otid() < 2) st[pg8::otid()] = 0u; }
    __syncthreads();
    XcdBarrier bar = xcd_barrier_post((unsigned*)ws, (volatile LAS unsigned*)(lds + LDS_BYTES - 256));
#define PH_END } ++pc; if (pc > lo && pc < hi) { if (pc == 1) grid.sync(); else xcd_barrier(bar); }
#define PH_END_IF(c_) } ++pc; if ((c_) && pc > lo && pc < hi) { xcd_barrier(bar); }

    PH_BEGIN
        ph_mod(a.in[2], a.in[3], a.in[4], a.in[5], MOD, lds);
        ph_rope(ROPE);
        ph_wconv(a.in[7], a.in[8], a.in[9], a.in[18], a.in[19], a.in[20], a.in[11], a.in[16], 0, ws, lds);
    PH_END
    for (int layer = 0; layer < 2; ++layer) {
        if (layer == 1) {
            PH_BEGIN ph_wconv(a.in[7], a.in[8], a.in[9], a.in[18], a.in[19], a.in[20], a.in[11], a.in[16], 1, ws, lds); PH_END
        }
        const float* modl = MOD + (size_t)layer * 12 * 9216;
        for (int half = 0; half < 2; ++half) {
            const int S = half ? 8192 : 4096, lgS = half ? 13 : 12;
            float* X = a.out + (size_t)half * MH * D;
            const float* xin0 = half ? x_sample : x_prompt;
            for (int sb = 0; sb < 3; ++sb) {
                if (DBG_SKIP_MIXER && sb == 1) continue;
                const bool first = (layer == 0 && sb == 0);
                const float* xsrc = first ? xin0 : X;
                const float* nw = (sb == 0 ? a.in[6] : (sb == 1 ? a.in[10] : a.in[17])) + layer * D;
                PH_BEGIN ph_norm(xsrc, nw, modl, sb, half, H); PH_END
                if (sb != 1) {
                    PH_BEGIN
                        pg8::Gemm g{H, (const bf16*)(ws + (sb ? WS_WGU2 : WS_WGU1)), MH, 2 * FF, D}; pg8::StaticOrder So; So.init(MH, 2 * FF, gridDim.x, (int)blockIdx.x);
                        pg8::EpiSwiGLU E{ACT, FF};
                        pg8::gemm_phase<pg8::EpiSwiGLU, pg8::StaticOrder, true, true>(lds, g, So, E);
                    PH_END
                    PH_BEGIN
                        pg8::Gemm g{ACT, (const bf16*)(ws + (sb ? WS_WD2 : WS_WD1)), MH, D, FF}; pg8::StaticOrder So; So.init(MH, D, gridDim.x, (int)blockIdx.x);
                        pg8::EpiResid E{xsrc, X, modl + (3 * sb + 2) * 1024, 0.5f, half};
                        pg8::gemm_phase<pg8::EpiResid, pg8::StaticOrder, true, true>(lds, g, So, E);
                    PH_END
                } else {
                    PH_BEGIN
                        pg8::Gemm g{H, (const bf16*)(ws + WS_WIN), MH, NPROJ, D}; pg8::StaticOrder So; So.init(MH, NPROJ, gridDim.x, (int)blockIdx.x);
                        pg8::EpiProj E{ws, AB, ROPE, S - 1};
                        pg8::gemm_phase<pg8::EpiProj, pg8::StaticOrder, true, true>(lds, g, So, E);
                    PH_END
                    PH_BEGIN ph_dnpre(PD, AB, a.in[12] + (size_t)layer * 5 * 1536, a.in[13] + layer * 8, a.in[14] + layer * 8, DQ, DK, DV, GB, S); PH_END
                    PH_BEGIN ph_chunk(DQ, DK, DV, GB, CH, GC, S, lgS, lds); PH_END
                    PH_BEGIN ph_scan(DQ, CH, GC, OF, OB, S, lgS, half, lds); PH_END_IF(!big)
                    PH_BEGIN ph_attn(PA, OGp, LSEp, S, lgS, lds, big ? (unsigned*)ws + ACTR_WORD + 16 * (layer * 2 + half) : (unsigned*)nullptr); PH_END
                    PH_BEGIN ph_post(OGp, LSEp, OF, OB, Zb, a.in[15] + layer * 128, MIX); PH_END
                    PH_BEGIN
                        pg8::Gemm g{MIX, (const bf16*)(ws + WS_WOUT), MH, D, D}; pg8::StaticOrder So; So.init(MH, D, gridDim.x, (int)blockIdx.x);
                        pg8::EpiResid E{X, X, modl + 5 * 1024, 1.0f, half};
                        pg8::gemm_phase<pg8::EpiResid, pg8::StaticOrder, true, true>(lds, g, So, E);
                    PH_END
                }
            }
        }
    }
    PH_BEGIN ph_final(a.out, a.in[21]); PH_END
}

extern "C" void kernel_launch(void* const* d_in, const int* in_sizes, int n_in, void* d_out, int out_size, void* d_ws, size_t ws_size, hipStream_t stream) {
    static int grid = 0;
    if (grid == 0) {
        if (n_in != 22 || ws_size < WS_END) { fprintf(stderr, "kernel_launch: unexpected n_in %d / ws_size %zu\n", n_in, ws_size); grid = -1; return; }
        int dev = 0, cus = 0, per_cu = 0;
        hipGetDevice(&dev); hipDeviceGetAttribute(&cus, hipDeviceAttributeMultiprocessorCount, dev);
        if (hipFuncSetAttribute((const void*)fwd, hipFuncAttributeMaxDynamicSharedMemorySize, LDS_BYTES) != hipSuccess) { fprintf(stderr, "kernel_launch: hipFuncSetAttribute failed\n"); grid = -1; return; }
        if (hipOccupancyMaxActiveBlocksPerMultiprocessor(&per_cu, (const void*)fwd, 512, LDS_BYTES) != hipSuccess || per_cu < 1) { per_cu = 1; (void)hipGetLastError(); }
        grid = cus * per_cu;
        fprintf(stderr, "kernel_launch: grid %d (cus %d x %d), ws %zu MiB\n", grid, cus, per_cu, ws_size >> 20);
    }
    if (grid < 0) return;
    if (hipMemsetAsync(d_ws, 0, 16384, stream) != hipSuccess) { fprintf(stderr, "kernel_launch: memset failed\n"); return; }
    Args a{};
    for (int i = 0; i < 22; ++i) a.in[i] = (const float*)d_in[i];
    a.out = (float*)d_out; a.ws = (unsigned char*)d_ws; a.big = (ws_size >= WS_OVL_END) ? 1 : 0;
#if MK_MULTI
    for (int p = 0; p < NPH; ++p) { a.lo = p; a.hi = p + 1; hipLaunchKernelGGL(fwd, dim3(grid), dim3(512), LDS_BYTES, stream, a); }
#else
    a.lo = 0; a.hi = NPH;
    void* args[] = {&a};
    hipError_t e = hipLaunchCooperativeKernel((const void*)fwd, dim3(grid), dim3(512), args, LDS_BYTES, stream);
    if (e != hipSuccess) fprintf(stderr, "cooperative launch failed: %s (grid %d)\n", hipGetErrorString(e), grid);
#endif
}
```
